# Optimizing an MI355X kernel written in HIP

```python
import math
import jax, jax.numpy as jnp
from jax import lax
import numpy as np

D_MODEL = 1024
BATCH = 8
SEQ = 2048
DEPTH = 2
DEC_BATCH = 128
DEC_SEQ = 4
PAST_LEN = 2048
PAGE_SIZE = 128

N_EVEN = (DEPTH + 1) // 2
N_ODD = DEPTH // 2
POOL_WINDOWS = (2, 4, 8, 16)
N_POOL_GROUPS = len(POOL_WINDOWS)
POOL_WIDTH = D_MODEL // 2
POOL_GROUP = POOL_WIDTH // N_POOL_GROUPS
POOL_BUF = max(POOL_WINDOWS) - 1
SB_HEADS = 8
SB_HEAD_DIM = (D_MODEL // 2) // SB_HEADS
SB_WIDTH = SB_HEADS * SB_HEAD_DIM
SB_BIAS_INIT = -8.0
Q_BLOCK = 128
EVEN_MIX = POOL_WIDTH + SB_WIDTH
EVEN_IN = POOL_WIDTH + 3 * SB_WIDTH + EVEN_MIX
DN_HEADS = 8
DN_KEY_DIM = 128
DN_VAL_DIM = 128
DN_QK = DN_HEADS * DN_KEY_DIM
DN_V = DN_HEADS * DN_VAL_DIM
DN_CONV_DIM = 2 * DN_QK + DN_V
CONV_WIDTH = 4
DN_CHUNK = 64
ODD_IN = DN_CONV_DIM + DN_V + 2 * DN_HEADS
NORM_EPS = 1e-6

kernel_name = 'pool_stickbreak_gdn_hybrid_step'

f32 = jnp.float32


def rms_norm(x, g):
    xf = x.astype(f32)
    y = xf * lax.rsqrt(jnp.mean(xf * xf, axis=-1, keepdims=True) + NORM_EPS)
    return (y * g.astype(f32)).astype(x.dtype)


def l2_norm(x):
    xf = x.astype(f32)
    return xf * lax.rsqrt(jnp.sum(xf * xf, axis=-1, keepdims=True) + NORM_EPS)


def pool_mix(u, buf, start, w_pool, scale):
    B, L, P = u.shape
    ext = jnp.concatenate([buf.astype(f32), u.astype(f32)], axis=1)
    csum = jnp.concatenate([jnp.zeros_like(ext[:, :1]), jnp.cumsum(ext, axis=1)], axis=1)
    pos = start + jnp.arange(L)
    end = csum[:, POOL_BUF + 1:]
    cur = ext[:, POOL_BUF:]
    outs = []
    for gi, w in enumerate(POOL_WINDOWS):
        sl = slice(gi * POOL_GROUP, (gi + 1) * POOL_GROUP)
        win = end[..., sl] - csum[:, POOL_BUF + 1 - w:POOL_BUF + 1 - w + L, sl]
        cnt = jnp.minimum(pos + 1, w).astype(f32)[None, :, None]
        outs.append(win / cnt - cur[..., sl])
    d = jnp.stack(outs, axis=2)
    y = jnp.einsum('blgc,gcd->blgd', d, w_pool.astype(f32)).reshape(B, L, P)
    return y * scale.astype(f32)


def stick_breaking_block(q, k, v, bias, q_pos, k_pos):
    z = jnp.einsum('bqhd,bkhd->bhqk', q.astype(f32), k.astype(f32)) / math.sqrt(SB_HEAD_DIM)
    z = z + bias.astype(f32)[None, :, None, None]
    mask = k_pos[None, :] < q_pos[:, None]
    log_keep = jnp.where(mask, jax.nn.log_sigmoid(-z), 0.0)
    suffix = lax.cumsum(log_keep, axis=3, reverse=True) - log_keep
    a = jnp.where(mask, jnp.exp(jax.nn.log_sigmoid(z) + suffix), 0.0)
    return jnp.einsum('bhqk,bkhd->bqhd', a, v.astype(f32))


def stick_breaking_prompt(q, k, v, bias):
    B, L, H, d = q.shape
    qb_len = Q_BLOCK if L % Q_BLOCK == 0 else L
    nb = L // qb_len
    qb = jnp.moveaxis(q.reshape(B, nb, qb_len, H, d), 1, 0)
    k_pos = jnp.arange(L)

    def body(args):
        q_blk, blk = args
        q_pos = blk * qb_len + jnp.arange(qb_len)
        return stick_breaking_block(q_blk, k, v, bias, q_pos, k_pos)

    o = lax.map(body, (qb, jnp.arange(nb)))
    return jnp.moveaxis(o, 0, 1).reshape(B, L, H, d)


def even_layer(h, start, pool_buf, k_past, v_past, norm_g, w_in, w_pool, pool_scale, q_g, k_g, sb_bias, w_out):
    B, L, _ = h.shape
    proj = rms_norm(h, norm_g) @ w_in
    i1 = POOL_WIDTH
    i2 = i1 + SB_WIDTH
    i3 = i2 + SB_WIDTH
    i4 = i3 + SB_WIDTH
    u, q, k, v, gate = jnp.split(proj, [i1, i2, i3, i4], axis=-1)
    pool_y = pool_mix(u, pool_buf, start, w_pool, pool_scale)
    q = rms_norm(q.reshape(B, L, SB_HEADS, SB_HEAD_DIM), q_g)
    k = rms_norm(k.reshape(B, L, SB_HEADS, SB_HEAD_DIM), k_g)
    v = v.reshape(B, L, SB_HEADS, SB_HEAD_DIM)
    if k_past is None:
        sb = stick_breaking_prompt(q, k, v, sb_bias)
    else:
        k_all = jnp.concatenate([k_past.astype(k.dtype), k], axis=1)
        v_all = jnp.concatenate([v_past.astype(v.dtype), v], axis=1)
        sb = stick_breaking_block(q, k_all, v_all, sb_bias, start + jnp.arange(L), jnp.arange(start + L))
    mix = jnp.concatenate([pool_y, sb.reshape(B, L, SB_WIDTH)], axis=-1) * jax.nn.silu(gate.astype(f32))
    y = h + mix.astype(h.dtype) @ w_out
    new_buf = jnp.concatenate([pool_buf.astype(u.dtype), u], axis=1)[:, -POOL_BUF:]
    return y, new_buf, k, v


def gated_delta_rule(q, k, v, g, beta, state):
    B, L, H, dk = k.shape
    dv = v.shape[-1]
    C = DN_CHUNK if L % DN_CHUNK == 0 else L
    n = L // C

    def to_chunks(x):
        x = x.reshape(B, n, C, H, *x.shape[3:])
        return jnp.moveaxis(jnp.moveaxis(x, 1, 0), 3, 2)

    qc, kc, vc = to_chunks(q), to_chunks(k), to_chunks(v.astype(f32))
    gc = jnp.cumsum(to_chunks(g), axis=-1)
    bc = to_chunks(beta)
    incl = jnp.tril(jnp.ones((C, C), bool))
    strict = jnp.tril(jnp.ones((C, C), bool), -1)
    decay = jnp.where(incl, jnp.exp(jnp.where(incl, gc[..., :, None] - gc[..., None, :], 0.0)), 0.0)
    kb = kc * bc[..., None]
    lmat = jnp.where(strict, jnp.einsum('nbhid,nbhjd->nbhij', kb, kc) * decay, 0.0)
    eye = jnp.broadcast_to(jnp.eye(C, dtype=f32), lmat.shape)
    tmat = lax.linalg.triangular_solve(eye + lmat, eye, left_side=True, lower=True, unit_diagonal=True)
    u = jnp.einsum('nbhij,nbhjd->nbhid', tmat, vc * bc[..., None])
    w = jnp.einsum('nbhij,nbhjd->nbhid', tmat, kb * jnp.exp(gc)[..., None])

    def step(S, xs):
        q_i, k_i, u_i, w_i, g_i, dec_i = xs
        v_new = u_i - jnp.einsum('bhcd,bhde->bhce', w_i, S)
        att = jnp.einsum('bhid,bhjd->bhij', q_i, k_i) * dec_i
        o = jnp.einsum('bhcd,bhde->bhce', q_i * jnp.exp(g_i)[..., None], S) + jnp.einsum('bhij,bhje->bhie', att, v_new)
        g_last = g_i[..., -1:]
        S = S * jnp.exp(g_last)[..., None] + jnp.einsum('bhcd,bhce->bhde', k_i * jnp.exp(g_last - g_i)[..., None], v_new)
        return S, o

    S, o = lax.scan(step, state, (qc, kc, u, w, gc, decay))
    o = jnp.moveaxis(jnp.moveaxis(o, 2, 3), 0, 1).reshape(B, L, H, dv)
    return o, S


def odd_layer(h, conv_buf, state, norm_g, w_in, conv_w, a_log, dt_bias, o_g, w_out):
    B, L, _ = h.shape
    proj = rms_norm(h, norm_g) @ w_in
    qkv, z, b, a = jnp.split(proj, [DN_CONV_DIM, DN_CONV_DIM + DN_V, DN_CONV_DIM + DN_V + DN_HEADS], axis=-1)
    ext = jnp.concatenate([conv_buf.astype(qkv.dtype), qkv], axis=1)
    conv = ext[:, 0:L].astype(f32) * conv_w[0].astype(f32)
    for j in range(1, CONV_WIDTH):
        conv = conv + ext[:, j:j + L].astype(f32) * conv_w[j].astype(f32)
    conv = jax.nn.silu(conv)
    q, k, v = jnp.split(conv, [DN_QK, 2 * DN_QK], axis=-1)
    q = l2_norm(q.reshape(B, L, DN_HEADS, DN_KEY_DIM)) * (DN_KEY_DIM ** -0.5)
    k = l2_norm(k.reshape(B, L, DN_HEADS, DN_KEY_DIM))
    v = v.reshape(B, L, DN_HEADS, DN_VAL_DIM)
    beta = jax.nn.sigmoid(b.astype(f32))
    g = -jnp.exp(a_log.astype(f32)) * jax.nn.softplus(a.astype(f32) + dt_bias.astype(f32))
    o, new_state = gated_delta_rule(q, k, v, g, beta, state.astype(f32))
    o = rms_norm(o, o_g) * jax.nn.silu(z.reshape(B, L, DN_HEADS, DN_VAL_DIM).astype(f32))
    y = h + o.reshape(B, L, DN_V).astype(h.dtype) @ w_out
    return y, ext[:, -(CONV_WIDTH - 1):], new_state.astype(state.dtype)


def setup_inputs(seed: int = 0) -> dict:
    key = jax.random.key(seed)
    ks = jax.random.split(key, 24)
    n_pages = PAST_LEN // PAGE_SIZE
    n_phys = (DEC_BATCH * n_pages * 5) // 4

    def nrm(k, shape, scale=1.0):
        return jax.random.normal(k, shape, f32) * scale

    page_table = jax.random.permutation(ks[7], n_phys)[:DEC_BATCH * n_pages].reshape(DEC_BATCH, n_pages).astype(jnp.int32)
    a_init = jax.random.uniform(ks[17], (N_ODD, DN_HEADS), f32, 1.0, 16.0)
    dt = jnp.exp(jax.random.uniform(ks[18], (N_ODD, DN_HEADS), f32, math.log(1e-3), math.log(1e-1)))
    return {
        'x_prompt': nrm(ks[0], (BATCH, SEQ, D_MODEL)),
        'x_sample': nrm(ks[1], (DEC_BATCH, DEC_SEQ, D_MODEL)),
        'cache_pool': nrm(ks[2], (N_EVEN, DEC_BATCH, POOL_BUF, POOL_WIDTH)),
        'cache_k': nrm(ks[3], (N_EVEN, n_phys, PAGE_SIZE, SB_HEADS, SB_HEAD_DIM)),
        'cache_v': nrm(ks[4], (N_EVEN, n_phys, PAGE_SIZE, SB_HEADS, SB_HEAD_DIM)),
        'state_conv': nrm(ks[5], (N_ODD, DEC_BATCH, CONV_WIDTH - 1, DN_CONV_DIM)),
        'state_delta': nrm(ks[6], (N_ODD, DEC_BATCH, DN_HEADS, DN_KEY_DIM, DN_VAL_DIM), 0.1),
        'page_table': page_table,
        'norm_even': 1.0 + nrm(ks[8], (N_EVEN, D_MODEL), 0.1),
        'w_in_even': nrm(ks[9], (N_EVEN, D_MODEL, EVEN_IN), D_MODEL ** -0.5),
        'w_pool': nrm(ks[10], (N_EVEN, N_POOL_GROUPS, POOL_GROUP, POOL_GROUP), POOL_GROUP ** -0.5),
        'pool_scale': 1.0 + nrm(ks[11], (N_EVEN, POOL_WIDTH), 0.1),
        'q_norm': 1.0 + nrm(ks[12], (N_EVEN, SB_HEAD_DIM), 0.1),
        'k_norm': 1.0 + nrm(ks[13], (N_EVEN, SB_HEAD_DIM), 0.1),
        'sb_bias': SB_BIAS_INIT + nrm(ks[22], (N_EVEN, SB_HEADS), 0.1),
        'w_out_even': nrm(ks[14], (N_EVEN, EVEN_MIX, D_MODEL), EVEN_MIX ** -0.5),
        'norm_odd': 1.0 + nrm(ks[15], (N_ODD, D_MODEL), 0.1),
        'w_in_odd': nrm(ks[16], (N_ODD, D_MODEL, ODD_IN), D_MODEL ** -0.5),
        'conv_w': nrm(ks[19], (N_ODD, CONV_WIDTH, DN_CONV_DIM), 0.5),
        'a_log': jnp.log(a_init),
        'dt_bias': dt + jnp.log(-jnp.expm1(-dt)),
        'o_norm': 1.0 + nrm(ks[20], (N_ODD, DN_VAL_DIM), 0.1),
        'w_out_odd': nrm(ks[21], (N_ODD, DN_V, D_MODEL), DN_V ** -0.5),
    }


def reference(x_prompt, x_sample, cache_pool, cache_k, cache_v, state_conv, state_delta, page_table,
              norm_even, w_in_even, w_pool, pool_scale, q_norm, k_norm, sb_bias, w_out_even,
              norm_odd, w_in_odd, conv_w, a_log, dt_bias, o_norm, w_out_odd):
    n_dec = x_sample.shape[0]
    past_len = page_table.shape[1] * cache_k.shape[2]
    bp = x_prompt.shape[0]
    hp, hs = x_prompt, x_sample
    pool_p, pool_s, kp_l, vp_l, ks_l, vs_l = [], [], [], [], [], []
    conv_p, conv_s, dp_l, ds_l = [], [], [], []
    for layer in range(DEPTH):
        i = layer // 2
        if layer % 2 == 0:
            ev = (norm_even[i], w_in_even[i], w_pool[i], pool_scale[i], q_norm[i], k_norm[i], sb_bias[i], w_out_even[i])
            zero_buf = jnp.zeros((bp, POOL_BUF, POOL_WIDTH), hp.dtype)
            hp, pb, kn, vn = even_layer(hp, 0, zero_buf, None, None, *ev)
            pool_p.append(pb); kp_l.append(kn); vp_l.append(vn)
            k_past = cache_k[i][page_table].reshape(n_dec, past_len, SB_HEADS, SB_HEAD_DIM)
            v_past = cache_v[i][page_table].reshape(n_dec, past_len, SB_HEADS, SB_HEAD_DIM)
            hs, pb, kn, vn = even_layer(hs, past_len, cache_pool[i], k_past, v_past, *ev)
            pool_s.append(pb); ks_l.append(kn); vs_l.append(vn)
        else:
            od = (norm_odd[i], w_in_odd[i], conv_w[i], a_log[i], dt_bias[i], o_norm[i], w_out_odd[i])
            zero_conv = jnp.zeros((bp, CONV_WIDTH - 1, DN_CONV_DIM), hp.dtype)
            zero_state = jnp.zeros((bp, DN_HEADS, DN_KEY_DIM, DN_VAL_DIM), hp.dtype)
            hp, cb, st = odd_layer(hp, zero_conv, zero_state, *od)
            conv_p.append(cb); dp_l.append(st)
            hs, cb, st = odd_layer(hs, state_conv[i], state_delta[i], *od)
            conv_s.append(cb); ds_l.append(st)
    return (hp, hs,
            jnp.stack(pool_p), jnp.stack(pool_s),
            jnp.stack(kp_l), jnp.stack(vp_l), jnp.stack(ks_l), jnp.stack(vs_l),
            jnp.stack(conv_p), jnp.stack(conv_s),
            jnp.stack(dp_l), jnp.stack(ds_l))
```

```cpp
#include <hip/hip_runtime.h>
#include <cstdio>
#include <cstdint>

constexpr int D = 1024, BP = 8, SEQ = 2048, MP = BP * SEQ;
constexpr int DB = 128, DS = 4, MS = DB * DS, MT = MP + MS;
constexpr int PAST = 2048, PAGE = 128, NPAGE = PAST / PAGE;
constexpr int PW = 512, PG = 128, PBUF = 15;
constexpr int SBH = 8, SBD = 64;
constexpr int EVEN_IN = 3072;
constexpr int DNH = 8, DNK = 128, DNV = 128, CONVD = 3072, ODD_IN = 4112;
constexpr float EPS = 1e-6f;

constexpr size_t O_YP = 0;
constexpr size_t O_YS = O_YP + (size_t)MP * D;
constexpr size_t O_POOLP = O_YS + (size_t)MS * D;
constexpr size_t O_POOLS = O_POOLP + (size_t)BP * PBUF * PW;
constexpr size_t O_KP = O_POOLS + (size_t)DB * PBUF * PW;
constexpr size_t O_VP = O_KP + (size_t)MP * 512;
constexpr size_t O_KS = O_VP + (size_t)MP * 512;
constexpr size_t O_VS = O_KS + (size_t)MS * 512;
constexpr size_t O_CONVP = O_VS + (size_t)MS * 512;
constexpr size_t O_CONVS = O_CONVP + (size_t)BP * 3 * CONVD;
constexpr size_t O_DP = O_CONVS + (size_t)DB * 3 * CONVD;
constexpr size_t O_DS = O_DP + (size_t)BP * DNH * DNK * DNV;
constexpr size_t O_END = O_DS + (size_t)DB * DNH * DNK * DNV;
static_assert(O_END == 54726656, "output size");

struct In {
    const float *x_p, *x_s, *cache_pool, *cache_k, *cache_v, *state_conv, *state_delta;
    const int* page_table;
    const float *norm_even, *w_in_even, *w_pool, *pool_scale, *q_norm, *k_norm, *sb_bias, *w_out_even;
    const float *norm_odd, *w_in_odd, *conv_w, *a_log, *dt_bias, *o_norm, *w_out_odd;
};

__device__ __forceinline__ float wave_sum(float v) {
#pragma unroll
    for (int o = 1; o < 64; o <<= 1) v += __shfl_xor(v, o);
    return v;
}
__device__ __forceinline__ float silu_f(float x) { return x / (1.f + __expf(-x)); }
__device__ __forceinline__ float softplus_f(float x) { return fmaxf(x, 0.f) + log1pf(__expf(-fabsf(x))); }
__device__ __forceinline__ const float* xrow(const In& in, int r) { return r < MP ? in.x_p + (size_t)r * D : in.x_s + (size_t)(r - MP) * D; }

namespace nv {
__global__ void __launch_bounds__(256) k_rmsnorm(const float* src_p, const float* src_s, const float* g, float* out) {
    const int lane = threadIdx.x & 63, w = (blockIdx.x * 256 + threadIdx.x) >> 6, nw = gridDim.x * 4;
    for (int r = w; r < MT; r += nw) {
        const float* x = r < MP ? src_p + (size_t)r * D : src_s + (size_t)(r - MP) * D;
        float v[16]; float s = 0.f;
#pragma unroll
        for (int j = 0; j < 16; ++j) { v[j] = x[lane + 64 * j]; s += v[j] * v[j]; }
        s = wave_sum(s);
        const float rs = rsqrtf(s / D + EPS);
#pragma unroll
        for (int j = 0; j < 16; ++j) out[(size_t)r * D + lane + 64 * j] = v[j] * rs * g[lane + 64 * j];
    }
}
__global__ void __launch_bounds__(256) k_gemm(const float* A, const float* W, const float* Rp, const float* Rs, float* Cp, float* Cs, int M, int N, int K) {
    __shared__ float As[16][68];
    __shared__ float Bs[16][68];
    const int ntn = (N + 63) / 64, ntm = M / 64;
    const int tid = threadIdx.x, tx = tid & 15, ty = tid >> 4;
    for (int tile = blockIdx.x; tile < ntn * ntm; tile += gridDim.x) {
        const int tm = tile / ntn, tn = tile % ntn, m0 = tm * 64, n0 = tn * 64;
        float acc[4][4];
#pragma unroll
        for (int i = 0; i < 4; ++i)
#pragma unroll
            for (int j = 0; j < 4; ++j) acc[i][j] = 0.f;
        for (int k0 = 0; k0 < K; k0 += 16) {
            { const int r = tid >> 2, kk = (tid & 3) * 4; const float4 a = *(const float4*)(A + (size_t)(m0 + r) * K + k0 + kk);
              As[kk + 0][r] = a.x; As[kk + 1][r] = a.y; As[kk + 2][r] = a.z; As[kk + 3][r] = a.w; }
            { const int kk = tid >> 4, c = (tid & 15) * 4;
#pragma unroll
              for (int j = 0; j < 4; ++j) Bs[kk][c + j] = (n0 + c + j < N) ? W[(size_t)(k0 + kk) * N + n0 + c + j] : 0.f; }
            __syncthreads();
#pragma unroll
            for (int kk = 0; kk < 16; ++kk) {
                float a[4], b[4];
#pragma unroll
                for (int i = 0; i < 4; ++i) a[i] = As[kk][ty * 4 + i];
#pragma unroll
                for (int j = 0; j < 4; ++j) b[j] = Bs[kk][tx * 4 + j];
#pragma unroll
                for (int i = 0; i < 4; ++i)
#pragma unroll
                    for (int j = 0; j < 4; ++j) acc[i][j] += a[i] * b[j];
            }
            __syncthreads();
        }
#pragma unroll
        for (int i = 0; i < 4; ++i) {
            const int r = m0 + ty * 4 + i;
#pragma unroll
            for (int j = 0; j < 4; ++j) {
                const int c = n0 + tx * 4 + j;
                if (c < N) {
                    float v = acc[i][j];
                    if (Rp) v += (r < MP) ? Rp[(size_t)r * N + c] : Rs[(size_t)(r - MP) * N + c];
                    if (r < MP) Cp[(size_t)r * N + c] = v; else Cs[(size_t)(r - MP) * N + c] = v;
                }
            }
        }
    }
}
__global__ void __launch_bounds__(256) k_split1(const float* proj, const float* qg, const float* kg, float* nQ, float* nK, float* out) {
    const int lane = threadIdx.x & 63, w = (blockIdx.x * 256 + threadIdx.x) >> 6, nw = gridDim.x * 4;
    for (int r = w; r < MT; r += nw) {
        const float* p = proj + (size_t)r * EVEN_IN;
        float* ko = r < MP ? out + O_KP + (size_t)r * 512 : out + O_KS + (size_t)(r - MP) * 512;
        float* vo = r < MP ? out + O_VP + (size_t)r * 512 : out + O_VS + (size_t)(r - MP) * 512;
        for (int h = 0; h < SBH; ++h) {
            const float q = p[512 + h * 64 + lane], k = p[1024 + h * 64 + lane], v = p[1536 + h * 64 + lane];
            const float qs = wave_sum(q * q), ks = wave_sum(k * k);
            const float qn = q * rsqrtf(qs / 64.f + EPS) * qg[lane], kn = k * rsqrtf(ks / 64.f + EPS) * kg[lane];
            nQ[(size_t)r * 512 + h * 64 + lane] = qn; nK[(size_t)r * 512 + h * 64 + lane] = kn;
            ko[h * 64 + lane] = kn; vo[h * 64 + lane] = v;
        }
    }
}
__global__ void __launch_bounds__(256) k_pool_d(const float* proj, const float* cache_pool, float* nD, float* out) {
    const size_t n = (size_t)MT * PW;
    for (size_t i = (size_t)blockIdx.x * 256 + threadIdx.x; i < n; i += (size_t)gridDim.x * 256) {
        const int r = (int)(i / PW), c = (int)(i % PW), g = c / PG, w = 2 << g;
        float sum = 0.f, cnt;
        if (r < MP) {
            const int t = r % SEQ;
            for (int j = 0; j < w; ++j) if (t - j >= 0) sum += proj[(size_t)(r - j) * EVEN_IN + c];
            cnt = (float)min(t + 1, w);
        } else {
            const int s = (r - MP) / DS, t = (r - MP) % DS;
            for (int j = 0; j < w; ++j) { const int tt = t - j; sum += tt >= 0 ? proj[(size_t)(r - j) * EVEN_IN + c] : cache_pool[((size_t)s * PBUF + (PBUF + tt)) * PW + c]; }
            cnt = (float)w;
        }
        nD[i] = sum / cnt - proj[(size_t)r * EVEN_IN + c];
    }
    const size_t n2 = (size_t)BP * PBUF * PW;
    for (size_t i = (size_t)blockIdx.x * 256 + threadIdx.x; i < n2; i += (size_t)gridDim.x * 256) {
        const int c = (int)(i % PW), j = (int)((i / PW) % PBUF), b = (int)(i / ((size_t)PW * PBUF));
        out[O_POOLP + i] = proj[(size_t)(b * SEQ + SEQ - PBUF + j) * EVEN_IN + c];
    }
    const size_t n3 = (size_t)DB * PBUF * PW;
    for (size_t i = (size_t)blockIdx.x * 256 + threadIdx.x; i < n3; i += (size_t)gridDim.x * 256) {
        const int c = (int)(i % PW), j = (int)((i / PW) % PBUF), s = (int)(i / ((size_t)PW * PBUF));
        const int e = j + DS;
        out[O_POOLS + i] = e < PBUF ? cache_pool[((size_t)s * PBUF + e) * PW + c] : proj[(size_t)(MP + s * DS + (e - PBUF)) * EVEN_IN + c];
    }
}
__global__ void __launch_bounds__(256) k_pool_y(const float* nD, const float* w_pool, const float* scale, const float* proj, float* mix) {
    const size_t n = (size_t)MT * PW;
    for (size_t i = (size_t)blockIdx.x * 256 + threadIdx.x; i < n; i += (size_t)gridDim.x * 256) {
        const int r = (int)(i / PW), c = (int)(i % PW), g = c / PG, dd = c % PG;
        const float* d = nD + (size_t)r * PW + g * PG; const float* wp = w_pool + (size_t)g * PG * PG + dd;
        float s = 0.f;
        for (int k = 0; k < PG; ++k) s += d[k] * wp[(size_t)k * PG];
        mix[(size_t)r * D + c] = s * scale[c] * silu_f(proj[(size_t)r * EVEN_IN + 2048 + c]);
    }
}
__global__ void __launch_bounds__(256) k_attn(const float* nQ, const float* nK, const float* proj, const float* cache_k, const float* cache_v, const int* page_table,
                                              const float* bias, float* mix) {
    const int lane = threadIdx.x & 63;
    const long w = ((long)blockIdx.x * 256 + threadIdx.x) >> 6, nw = (long)gridDim.x * 4;
    for (long it = w; it < (long)MT * SBH; it += nw) {
        const int r = (int)(it / SBH), h = (int)(it % SBH);
        const float q = nQ[(size_t)r * 512 + h * 64 + lane];
        const float bh = bias[h];
        int nkeys, s = 0, b = 0;
        if (r < MP) { b = r / SEQ; nkeys = r % SEQ; } else { s = (r - MP) / DS; nkeys = PAST + (r - MP) % DS; }
        float R = 0.f, o = 0.f;
        for (int blk = (nkeys - 1) / 64; blk >= 0 && nkeys > 0; --blk) {
            const int j0 = blk * 64 + lane; const bool valid = j0 < nkeys;
            const int j = valid ? j0 : nkeys - 1;
            const float* kp;
            if (r < MP) kp = nK + (size_t)(b * SEQ + j) * 512 + h * 64;
            else if (j < PAST) kp = cache_k + (((size_t)page_table[s * NPAGE + j / PAGE] * PAGE + j % PAGE) * SBH + h) * SBD;
            else kp = nK + (size_t)(MP + s * DS + (j - PAST)) * 512 + h * 64;
            float dot = 0.f;
            for (int d = 0; d < 64; ++d) dot += __shfl(q, d) * kp[d];
            const float z = valid ? dot * 0.125f + bh : 0.f;
            const float sp = softplus_f(z);
            const float lk = valid ? -sp : 0.f;
            float inc = lk;
#pragma unroll
            for (int off = 1; off < 64; off <<= 1) { const float t = __shfl_down(inc, off); if (lane + off < 64) inc += t; }
            const float suffix = inc - lk + R;
            const float a = valid ? __expf(z - sp + suffix) : 0.f;
            R += __shfl(inc, 0);
            for (int k = 0; k < 64; ++k) {
                const int jj = blk * 64 + k;
                const float ak = __shfl(a, k);
                if (jj < nkeys) {
                    float vv;
                    if (r < MP) vv = proj[(size_t)(b * SEQ + jj) * EVEN_IN + 1536 + h * 64 + lane];
                    else if (jj < PAST) vv = cache_v[(((size_t)page_table[s * NPAGE + jj / PAGE] * PAGE + jj % PAGE) * SBH + h) * SBD + lane];
                    else vv = proj[(size_t)(MP + s * DS + (jj - PAST)) * EVEN_IN + 1536 + h * 64 + lane];
                    o += ak * vv;
                }
            }
        }
        mix[(size_t)r * D + 512 + h * 64 + lane] = o * silu_f(proj[(size_t)r * EVEN_IN + 2048 + 512 + h * 64 + lane]);
    }
}
__global__ void __launch_bounds__(256) k_conv(const float* proj2, const float* state_conv, const float* conv_w, float* nC, float* out) {
    const size_t n = (size_t)MT * CONVD;
    for (size_t i = (size_t)blockIdx.x * 256 + threadIdx.x; i < n; i += (size_t)gridDim.x * 256) {
        const int r = (int)(i / CONVD), c = (int)(i % CONVD);
        float acc = 0.f;
        for (int j = 0; j < 4; ++j) {
            float xv;
            if (r < MP) { const int t = r % SEQ, e = t + j; xv = e >= 3 ? proj2[(size_t)(r - 3 + j) * ODD_IN + c] : 0.f; }
            else { const int s = (r - MP) / DS, t = (r - MP) % DS, e = t + j; xv = e >= 3 ? proj2[(size_t)(MP + s * DS + e - 3) * ODD_IN + c] : state_conv[((size_t)s * 3 + e) * CONVD + c]; }
            acc += xv * conv_w[(size_t)j * CONVD + c];
        }
        nC[i] = silu_f(acc);
    }
    const size_t n2 = (size_t)BP * 3 * CONVD;
    for (size_t i = (size_t)blockIdx.x * 256 + threadIdx.x; i < n2; i += (size_t)gridDim.x * 256) {
        const int c = (int)(i % CONVD), j = (int)((i / CONVD) % 3), b = (int)(i / ((size_t)CONVD * 3));
        out[O_CONVP + i] = proj2[(size_t)(b * SEQ + SEQ - 3 + j) * ODD_IN + c];
    }
    const size_t n3 = (size_t)DB * 3 * CONVD;
    for (size_t i = (size_t)blockIdx.x * 256 + threadIdx.x; i < n3; i += (size_t)gridDim.x * 256) {
        const int c = (int)(i % CONVD), j = (int)((i / CONVD) % 3), s = (int)(i / ((size_t)CONVD * 3));
        out[O_CONVS + i] = proj2[(size_t)(MP + s * DS + 1 + j) * ODD_IN + c];
    }
}
__global__ void __launch_bounds__(256) k_qknorm(float* nC, const float* proj2, const float* a_log, const float* dt_bias, float* nBeta, float* nG) {
    const int lane = threadIdx.x & 63;
    const long w = ((long)blockIdx.x * 256 + threadIdx.x) >> 6, nw = (long)gridDim.x * 4;
    for (long it = w; it < (long)MT * DNH; it += nw) {
        const int r = (int)(it / DNH), h = (int)(it % DNH);
        float* q = nC + (size_t)r * CONVD + h * 128; float* k = q + 1024;
        const float q0 = q[lane], q1 = q[lane + 64], k0 = k[lane], k1 = k[lane + 64];
        const float qs = wave_sum(q0 * q0 + q1 * q1), ks = wave_sum(k0 * k0 + k1 * k1);
        const float qr = rsqrtf(qs + EPS) * 0.08838834764831845f, kr = rsqrtf(ks + EPS);
        q[lane] = q0 * qr; q[lane + 64] = q1 * qr; k[lane] = k0 * kr; k[lane + 64] = k1 * kr;
        if (lane == 0) {
            const float bb = proj2[(size_t)r * ODD_IN + 4096 + h], aa = proj2[(size_t)r * ODD_IN + 4104 + h];
            nBeta[(size_t)r * DNH + h] = 1.f / (1.f + __expf(-bb));
            nG[(size_t)r * DNH + h] = -__expf(a_log[h]) * softplus_f(aa + dt_bias[h]);
        }
    }
}
__global__ void __launch_bounds__(512) k_gdn(const float* nC, const float* nBeta, const float* nG, const float* state_delta, float* nO, float* out) {
    __shared__ float sq[128], sk[128], red[4][128], red2[4][128];
    const int tid = threadIdx.x, e = tid & 127, part = tid >> 7;
    for (int c = blockIdx.x; c < BP * DNH + DB * DNH; c += gridDim.x) {
        int base, L, h; const float* S0 = nullptr; float* Sout;
        if (c < BP * DNH) { const int b = c / DNH; h = c % DNH; base = b * SEQ; L = SEQ; Sout = out + O_DP + (size_t)c * DNK * DNV; }
        else { const int cc = c - BP * DNH, s = cc / DNH; h = cc % DNH; base = MP + s * DS; L = DS; S0 = state_delta + (size_t)cc * DNK * DNV; Sout = out + O_DS + (size_t)cc * DNK * DNV; }
        float S[32];
#pragma unroll
        for (int i = 0; i < 32; ++i) S[i] = S0 ? S0[(size_t)(part * 32 + i) * DNV + e] : 0.f;
        for (int t = 0; t < L; ++t) {
            const int r = base + t;
            __syncthreads();
            if (tid < 128) sq[tid] = nC[(size_t)r * CONVD + h * 128 + tid];
            else if (tid < 256) sk[tid - 128] = nC[(size_t)r * CONVD + 1024 + h * 128 + (tid - 128)];
            const float v = nC[(size_t)r * CONVD + 2048 + h * 128 + e];
            const float beta = nBeta[(size_t)r * DNH + h], alpha = __expf(nG[(size_t)r * DNH + h]);
            __syncthreads();
            float ks = 0.f;
#pragma unroll
            for (int i = 0; i < 32; ++i) ks += sk[part * 32 + i] * S[i];
            red[part][e] = ks;
            __syncthreads();
            const float kS = alpha * (red[0][e] + red[1][e] + red[2][e] + red[3][e]);
            const float vn = beta * (v - kS);
            float op = 0.f;
#pragma unroll
            for (int i = 0; i < 32; ++i) { S[i] = alpha * S[i] + sk[part * 32 + i] * vn; op += sq[part * 32 + i] * S[i]; }
            red2[part][e] = op;
            __syncthreads();
            if (part == 0) nO[(size_t)r * D + h * 128 + e] = red2[0][e] + red2[1][e] + red2[2][e] + red2[3][e];
        }
#pragma unroll
        for (int i = 0; i < 32; ++i) Sout[(size_t)(part * 32 + i) * DNV + e] = S[i];
        __syncthreads();
    }
}
__global__ void __launch_bounds__(256) k_onorm(const float* nO, const float* proj2, const float* og, float* nON) {
    const int lane = threadIdx.x & 63;
    const long w = ((long)blockIdx.x * 256 + threadIdx.x) >> 6, nw = (long)gridDim.x * 4;
    for (long it = w; it < (long)MT * DNH; it += nw) {
        const int r = (int)(it / DNH), h = (int)(it % DNH);
        const float* o = nO + (size_t)r * D + h * 128;
        const float o0 = o[lane], o1 = o[lane + 64];
        const float ss = wave_sum(o0 * o0 + o1 * o1);
        const float rs = rsqrtf(ss / 128.f + EPS);
        const float* z = proj2 + (size_t)r * ODD_IN + 3072 + h * 128;
        nON[(size_t)r * D + h * 128 + lane] = o0 * rs * og[lane] * silu_f(z[lane]);
        nON[(size_t)r * D + h * 128 + lane + 64] = o1 * rs * og[lane + 64] * silu_f(z[lane + 64]);
    }
}
}

constexpr size_t al256(size_t x) { return (x + 255) & ~(size_t)255; }
constexpr size_t NW_XN = 0;
constexpr size_t NW_PROJ1 = NW_XN + al256((size_t)MT * D * 4);
constexpr size_t NW_Q = NW_PROJ1 + al256((size_t)MT * EVEN_IN * 4);
constexpr size_t NW_K = NW_Q + al256((size_t)MT * 512 * 4);
constexpr size_t NW_D = NW_K + al256((size_t)MT * 512 * 4);
constexpr size_t NW_MIX = NW_D + al256((size_t)MT * 512 * 4);
constexpr size_t NW_Y1 = NW_MIX + al256((size_t)MT * D * 4);
constexpr size_t NW_XN2 = NW_Y1 + al256((size_t)MT * D * 4);
constexpr size_t NW_PROJ2 = NW_XN2 + al256((size_t)MT * D * 4);
constexpr size_t NW_C = NW_PROJ2 + al256((size_t)MT * ODD_IN * 4);
constexpr size_t NW_BETA = NW_C + al256((size_t)MT * CONVD * 4);
constexpr size_t NW_G = NW_BETA + al256((size_t)MT * DNH * 4);
constexpr size_t NW_O = NW_G + al256((size_t)MT * DNH * 4);
constexpr size_t NW_ON = NW_O + al256((size_t)MT * D * 4);
constexpr size_t NW_END = NW_ON + al256((size_t)MT * D * 4);

extern "C" void kernel_launch(void* const* d_in, const int* in_sizes, int n_in, void* d_out, int out_size, void* d_ws, size_t ws_size, hipStream_t stream) {
    if (n_in != 23 || (size_t)out_size != O_END || ws_size < NW_END) { fprintf(stderr, "kernel_launch: unexpected sizes n_in %d out %d ws %zu\n", n_in, out_size, ws_size); return; }
    In in;
    in.x_p = (const float*)d_in[0]; in.x_s = (const float*)d_in[1]; in.cache_pool = (const float*)d_in[2]; in.cache_k = (const float*)d_in[3]; in.cache_v = (const float*)d_in[4];
    in.state_conv = (const float*)d_in[5]; in.state_delta = (const float*)d_in[6]; in.page_table = (const int*)d_in[7];
    in.norm_even = (const float*)d_in[8]; in.w_in_even = (const float*)d_in[9]; in.w_pool = (const float*)d_in[10]; in.pool_scale = (const float*)d_in[11];
    in.q_norm = (const float*)d_in[12]; in.k_norm = (const float*)d_in[13]; in.sb_bias = (const float*)d_in[14]; in.w_out_even = (const float*)d_in[15];
    in.norm_odd = (const float*)d_in[16]; in.w_in_odd = (const float*)d_in[17]; in.conv_w = (const float*)d_in[18]; in.a_log = (const float*)d_in[19];
    in.dt_bias = (const float*)d_in[20]; in.o_norm = (const float*)d_in[21]; in.w_out_odd = (const float*)d_in[22];
    float* out = (float*)d_out; char* ws = (char*)d_ws;
    float* nXN = (float*)(ws + NW_XN); float* nP1 = (float*)(ws + NW_PROJ1); float* nQ = (float*)(ws + NW_Q); float* nK = (float*)(ws + NW_K);
    float* nD = (float*)(ws + NW_D); float* nMIX = (float*)(ws + NW_MIX); float* nY1 = (float*)(ws + NW_Y1); float* nXN2 = (float*)(ws + NW_XN2);
    float* nP2 = (float*)(ws + NW_PROJ2); float* nC = (float*)(ws + NW_C); float* nBeta = (float*)(ws + NW_BETA); float* nG = (float*)(ws + NW_G);
    float* nO = (float*)(ws + NW_O); float* nON = (float*)(ws + NW_ON);
    const int G = 2048;
    nv::k_rmsnorm<<<G, 256, 0, stream>>>(in.x_p, in.x_s, in.norm_even, nXN);
    nv::k_gemm<<<G, 256, 0, stream>>>(nXN, in.w_in_even, nullptr, nullptr, nP1, nP1 + (size_t)MP * EVEN_IN, MT, EVEN_IN, D);
    nv::k_split1<<<G, 256, 0, stream>>>(nP1, in.q_norm, in.k_norm, nQ, nK, out);
    nv::k_pool_d<<<G, 256, 0, stream>>>(nP1, in.cache_pool, nD, out);
    nv::k_pool_y<<<G, 256, 0, stream>>>(nD, in.w_pool, in.pool_scale, nP1, nMIX);
    nv::k_attn<<<G * 4, 256, 0, stream>>>(nQ, nK, nP1, in.cache_k, in.cache_v, in.page_table, in.sb_bias, nMIX);
    nv::k_gemm<<<G, 256, 0, stream>>>(nMIX, in.w_out_even, in.x_p, in.x_s, nY1, nY1 + (size_t)MP * D, MT, D, D);
    nv::k_rmsnorm<<<G, 256, 0, stream>>>(nY1, nY1 + (size_t)MP * D, in.norm_odd, nXN2);
    nv::k_gemm<<<G, 256, 0, stream>>>(nXN2, in.w_in_odd, nullptr, nullptr, nP2, nP2 + (size_t)MP * ODD_IN, MT, ODD_IN, D);
    nv::k_conv<<<G, 256, 0, stream>>>(nP2, in.state_conv, in.conv_w, nC, out);
    nv::k_qknorm<<<G, 256, 0, stream>>>(nC, nP2, in.a_log, in.dt_bias, nBeta, nG);
    nv::k_gdn<<<BP * DNH + DB * DNH, 512, 0, stream>>>(nC, nBeta, nG, in.state_delta, nO, out);
    nv::k_onorm<<<G, 256, 0, stream>>>(nO, nP2, in.o_norm, nON);
    nv::k_gemm<<<G, 256, 0, stream>>>(nON, in.w_out_odd, nY1, nY1 + (size_t)MP * D, out + O_YP, out + O_YS, MT, D, D);
}
```

```cpp
#include <hip/hip_runtime.h>
#include <cstdio>
#include <cstdint>

constexpr int D = 1024, BP = 8, SEQ = 2048, MP = BP * SEQ;
constexpr int DB = 128, DS = 4, MS = DB * DS, MT = MP + MS;
constexpr int PAST = 2048, PAGE = 128, NPAGE = PAST / PAGE;
constexpr int PW = 512, PG = 128, PBUF = 15;
constexpr int SBH = 8, SBD = 64;
constexpr int EVEN_IN = 3072;
constexpr int DNH = 8, DNK = 128, DNV = 128, CONVD = 3072, ODD_IN = 4112, ODD_PAD = 4352;
constexpr float EPS = 1e-6f;
constexpr float LOG2E = 1.4426950408889634f;
constexpr float QSCALE = 0.125f * LOG2E;

constexpr size_t O_YP = 0;
constexpr size_t O_YS = O_YP + (size_t)MP * D;
constexpr size_t O_POOLP = O_YS + (size_t)MS * D;
constexpr size_t O_POOLS = O_POOLP + (size_t)BP * PBUF * PW;
constexpr size_t O_KP = O_POOLS + (size_t)DB * PBUF * PW;
constexpr size_t O_VP = O_KP + (size_t)MP * 512;
constexpr size_t O_KS = O_VP + (size_t)MP * 512;
constexpr size_t O_VS = O_KS + (size_t)MS * 512;
constexpr size_t O_CONVP = O_VS + (size_t)MS * 512;
constexpr size_t O_CONVS = O_CONVP + (size_t)BP * 3 * CONVD;
constexpr size_t O_DP = O_CONVS + (size_t)DB * 3 * CONVD;
constexpr size_t O_DS = O_DP + (size_t)BP * DNH * DNK * DNV;
constexpr size_t O_END = O_DS + (size_t)DB * DNH * DNK * DNV;
static_assert(O_END == 54726656, "output size");

struct In {
    const float *x_p, *x_s, *cache_pool, *cache_k, *cache_v, *state_conv, *state_delta;
    const int* page_table;
    const float *norm_even, *w_in_even, *w_pool, *pool_scale, *q_norm, *k_norm, *sb_bias, *w_out_even;
    const float *norm_odd, *w_in_odd, *conv_w, *a_log, *dt_bias, *o_norm, *w_out_odd;
};

__device__ __forceinline__ float wave_sum(float v) {
#pragma unroll
    for (int o = 1; o < 64; o <<= 1) v += __shfl_xor(v, o);
    return v;
}
__device__ __forceinline__ float silu_f(float x) { return x / (1.f + __expf(-x)); }
__device__ __forceinline__ float softplus_f(float x) { return fmaxf(x, 0.f) + log1pf(__expf(-fabsf(x))); }
__device__ __forceinline__ float softplus2_f(float z2) { return fmaxf(z2, 0.f) + __log2f(1.f + exp2f(-fabsf(z2))); }
typedef unsigned short bf16;
__device__ __forceinline__ unsigned f2bf(float f) { unsigned u = __builtin_bit_cast(unsigned, f); return (u + 0x7fffu + ((u >> 16) & 1u)) >> 16; }
__device__ __forceinline__ unsigned pk2(float lo, float hi) { return f2bf(lo) | (f2bf(hi) << 16); }
__device__ __forceinline__ float bf2f(bf16 b) { return __builtin_bit_cast(float, (unsigned)b << 16); }
__device__ __forceinline__ const float* xrow(const In& in, int r) { return r < MP ? in.x_p + (size_t)r * D : in.x_s + (size_t)(r - MP) * D; }
namespace pg8 {
#define PG8_LAS __attribute__((address_space(3)))
typedef unsigned short bf16_t;
typedef short bf16x8 __attribute__((ext_vector_type(8)));
typedef float f32x4 __attribute__((ext_vector_type(4)));
typedef unsigned u32x4 __attribute__((ext_vector_type(4)));
constexpr int BM = 256, BK = 64, HALF = 128, HTB = HALF * BK * 2  , STAGE_BYTES = 8 * HTB, NXCD = 8, WGM = 8;

__host__ __device__ __forceinline__ int lds_byte(int r, int c) { const int st = (r >> 4) * 2 + (c >> 5), rr = r & 15, cc = c & 31, ob = rr * 64 + cc * 2; return st * 1024 + (ob ^ (((ob >> 9) & 1) << 5)); }
__host__ __device__ __forceinline__ void stage_rc(int b, int& R, int& C) { const int st = b / 1024, sb = b % 1024, swz = sb ^ (((sb >> 9) & 1) << 5); R = (st >> 1) * 16 + swz / 64; C = (st & 1) * 32 + (swz % 64) / 2; }
__host__ __device__ __forceinline__ int perm32(int rho) { const int n = rho >> 4, i = rho & 15; return 8 * (i >> 2) + 4 * n + (i & 3); }

struct Unit { int pm, pn; };
struct Gemm { const bf16_t* A; const bf16_t* Bt; int M, N, K; };

struct StaticOrder {
    int nM, nN, nwg, G, c;
    __host__ __device__ void init(int M, int N, int G_, int c_) { nM = M / BM; nN = N / BM; nwg = nM * nN; G = G_; c = c_; }
    __host__ __device__ bool next(int i, Unit& u) const {
        const long L = (long)i * G + c; if (L >= nwg) return false;
        int wgid = (int)L; { const int q = nwg / NXCD, r = nwg % NXCD, xcd = wgid % NXCD, off = wgid / NXCD; wgid = (xcd < r ? xcd * (q + 1) : r * (q + 1) + (xcd - r) * q) + off; }
        const int nig = WGM * nN, gid = wgid / nig, fm = gid * WGM, gsz = (nM - fm) < WGM ? (nM - fm) : WGM;
        u.pm = fm + ((wgid % nig) % gsz); u.pn = (wgid % nig) / gsz; return true;
    }
    __device__ __forceinline__ void a_ready(const Unit&) const {}
    __device__ __forceinline__ void done(const Unit&) const {}
};

__device__ __forceinline__ unsigned cvt_pk_bf16(float lo, float hi) { unsigned r; asm volatile("v_cvt_pk_bf16_f32 %0, %1, %2" : "=v"(r) : "v"(lo), "v"(hi)); return r; }
template <class Epi, class Sched, bool ALIGN_EPI = false, bool SP2 = false>
__device__ __forceinline__ void gemm_phase(PG8_LAS unsigned char* lds, const Gemm g, const Sched& S, const Epi& E) {
    const int tid = threadIdx.x, wid = __builtin_amdgcn_readfirstlane(tid >> 6), lane = tid & 63, wr = wid >> 2, wc = wid & 3, fr = lane & 15, fq = lane >> 4;
    const int K = g.K, nt = K / BK;
    unsigned voffA[2], voffB[2];
#pragma unroll
    for (int i = 0; i < 2; ++i) { int R, C; stage_rc(tid * 16 + i * 8192, R, C); const int Rb = Epi::PERM ? ((R & ~31) + perm32(R & 31)) : R;
        voffA[i] = (unsigned)(R * K + C) * 2u; voffB[i] = (unsigned)(Rb * K + C) * 2u; }
    const size_t kstep = (size_t)(BK * 2);
    const size_t hstep = (size_t)HALF * K * 2;
    const size_t tstep = 2 * hstep;
    const unsigned ldsw = (unsigned)wid * 1024u;
    const int aoff = lds_byte(wr * 64 + fr, fq * 8), boff = lds_byte(wc * 32 + fr, fq * 8);
#define PG8_SA(b, h) (((b) * 2 + (h)) * HTB)
#define PG8_SB(b, h) ((4 + (b) * 2 + (h)) * HTB)
#define PG8_STAGE(bufoff, gbase, voff) do { _Pragma("unroll") for (int _i = 0; _i < 2; ++_i) \
        __builtin_amdgcn_global_load_lds((const unsigned*)((const char*)(gbase) + (voff)[_i]), (PG8_LAS unsigned*)(lds + (bufoff) + ldsw + _i * 8192), 16, 0, 0); } while (0)
#define PG8_LDA(dst, b, h) do { _Pragma("unroll") for (int m = 0; m < 4; ++m) _Pragma("unroll") for (int k = 0; k < 2; ++k) dst[m][k] = *(const PG8_LAS bf16x8*)(lds + PG8_SA(b, h) + aoff + m * 2048 + k * 1024); } while (0)
#define PG8_LDB(dst, b, h) do { _Pragma("unroll") for (int n = 0; n < 2; ++n) _Pragma("unroll") for (int k = 0; k < 2; ++k) dst[n][k] = *(const PG8_LAS bf16x8*)(lds + PG8_SB(b, h) + boff + n * 2048 + k * 1024); } while (0)
#define PG8_MMA(ai, bj, At, Bt) do { __builtin_amdgcn_s_setprio(1); _Pragma("unroll") for (int m = 0; m < 4; ++m) _Pragma("unroll") for (int n = 0; n < 2; ++n) _Pragma("unroll") for (int k = 0; k < 2; ++k) \
        acc[ai][bj][m][n] = __builtin_amdgcn_mfma_f32_16x16x32_bf16(Bt[n][k], At[m][k], acc[ai][bj][m][n], 0, 0, 0); __builtin_amdgcn_s_setprio(0); } while (0)
#define PG8_WAIT_V(n) asm volatile("s_waitcnt vmcnt(" #n ")" ::: "memory")
#define PG8_WAIT_L(n) asm volatile("s_waitcnt lgkmcnt(" #n ")" ::: "memory")
#define PG8_BAR __builtin_amdgcn_s_barrier()
#define PG8_SCHED __builtin_amdgcn_sched_barrier(0)
    Unit cur, nxt; int ui = 0;
    if (!S.next(0, cur)) return;
    f32x4 acc[2][2][4][2];
#pragma unroll
    for (int a = 0; a < 2; ++a)
#pragma unroll
        for (int b = 0; b < 2; ++b)
#pragma unroll
            for (int m = 0; m < 4; ++m)
#pragma unroll
                for (int n = 0; n < 2; ++n) acc[a][b][m][n] = (f32x4){0.f, 0.f, 0.f, 0.f};
    bf16x8 At[4][2], B0[2][2], B1[2][2];
    const char* cA = (const char*)g.A + (size_t)cur.pm * tstep; const char* cB = (const char*)g.Bt + (size_t)cur.pn * tstep;
    S.a_ready(cur);
    if constexpr (SP2) {
        PG8_STAGE(PG8_SB(0, 0), cB, voffB); PG8_STAGE(PG8_SB(0, 1), cB + hstep, voffB); PG8_STAGE(PG8_SA(0, 0), cA, voffA); PG8_STAGE(PG8_SA(0, 1), cA + hstep, voffA);
        if (wr == 1) PG8_BAR;
        PG8_WAIT_V(2); PG8_BAR;
        PG8_STAGE(PG8_SB(1, 0), cB + kstep, voffB); PG8_STAGE(PG8_SA(1, 0), cA + kstep, voffA); PG8_STAGE(PG8_SB(1, 1), cB + hstep + kstep, voffB);
        PG8_WAIT_V(6); PG8_BAR;
    } else {
        PG8_STAGE(PG8_SB(0, 0), cB, voffB); PG8_STAGE(PG8_SA(0, 0), cA, voffA); PG8_STAGE(PG8_SB(0, 1), cB + hstep, voffB); PG8_STAGE(PG8_SA(0, 1), cA + hstep, voffA);
        if (wr == 1) PG8_BAR;
        PG8_WAIT_V(4); PG8_BAR;
        PG8_STAGE(PG8_SB(1, 0), cB + kstep, voffB); PG8_STAGE(PG8_SA(1, 0), cA + kstep, voffA); PG8_STAGE(PG8_SB(1, 1), cB + hstep + kstep, voffB);
        PG8_WAIT_V(6); PG8_BAR;
    }
    for (;;) {
        const bool has_next = S.next(ui + 1, nxt);
        const char* nA = has_next ? (const char*)g.A + (size_t)nxt.pm * tstep : cA; const char* nB = has_next ? (const char*)g.Bt + (size_t)nxt.pn * tstep : cB;
        for (int t = 0; t < nt; t += 2) {
            const bool last = (t == nt - 2);
            const char* a1 = cA + (size_t)(t + 1) * kstep;
            const char* a2 = last ? nA : cA + (size_t)(t + 2) * kstep; const char* b2 = last ? nB : cB + (size_t)(t + 2) * kstep;
            const char* a3 = a2 + kstep; const char* b3 = b2 + kstep;
            if (last && has_next) S.a_ready(nxt);
            if constexpr (SP2) {
            PG8_LDB(B0, 0, 0); PG8_LDB(B1, 0, 1); PG8_SCHED; PG8_LDA(At, 0, 0); PG8_STAGE(PG8_SA(1, 1), a1 + hstep, voffA);
            PG8_WAIT_V(8); PG8_WAIT_L(0); PG8_BAR; PG8_MMA(0, 0, At, B0); PG8_MMA(0, 1, At, B1); PG8_BAR; PG8_SCHED;
            PG8_LDA(At, 0, 1); PG8_STAGE(PG8_SB(0, 0), b2, voffB); PG8_STAGE(PG8_SB(0, 1), b2 + hstep, voffB); PG8_STAGE(PG8_SA(0, 0), a2, voffA);
            PG8_WAIT_V(8); PG8_WAIT_L(0); PG8_BAR; PG8_MMA(1, 0, At, B0); PG8_MMA(1, 1, At, B1); PG8_BAR; PG8_SCHED;
            PG8_LDB(B0, 1, 0); PG8_LDB(B1, 1, 1); PG8_SCHED; PG8_LDA(At, 1, 0); PG8_STAGE(PG8_SA(0, 1), a2 + hstep, voffA);
            PG8_WAIT_V(8); PG8_WAIT_L(0); PG8_BAR; PG8_MMA(0, 0, At, B0); PG8_MMA(0, 1, At, B1); PG8_BAR; PG8_SCHED;
            PG8_LDA(At, 1, 1); PG8_STAGE(PG8_SB(1, 0), b3, voffB); PG8_STAGE(PG8_SB(1, 1), b3 + hstep, voffB); PG8_STAGE(PG8_SA(1, 0), a3, voffA);
            PG8_WAIT_V(8); PG8_WAIT_L(0); PG8_BAR; PG8_MMA(1, 0, At, B0); PG8_MMA(1, 1, At, B1); PG8_BAR; PG8_SCHED;
            } else {
            PG8_LDB(B0, 0, 0); PG8_SCHED; PG8_LDA(At, 0, 0); PG8_STAGE(PG8_SA(1, 1), a1 + hstep, voffA);
            PG8_WAIT_L(8); PG8_BAR; PG8_WAIT_L(0); PG8_MMA(0, 0, At, B0); PG8_BAR; PG8_SCHED;
            PG8_LDB(B1, 0, 1); PG8_STAGE(PG8_SB(0, 0), b2, voffB);
            PG8_BAR; PG8_WAIT_L(0); PG8_MMA(0, 1, At, B1); PG8_BAR;
            PG8_LDA(At, 0, 1); PG8_STAGE(PG8_SA(0, 0), a2, voffA);
            PG8_BAR; PG8_WAIT_L(0); PG8_MMA(1, 0, At, B0); PG8_BAR; PG8_SCHED;
            PG8_STAGE(PG8_SB(0, 1), b2 + hstep, voffB);
            PG8_WAIT_V(6); PG8_BAR; PG8_MMA(1, 1, At, B1); PG8_BAR;
            PG8_LDB(B0, 1, 0); PG8_SCHED; PG8_LDA(At, 1, 0); PG8_STAGE(PG8_SA(0, 1), a2 + hstep, voffA);
            PG8_WAIT_L(8); PG8_BAR; PG8_WAIT_L(0); PG8_MMA(0, 0, At, B0); PG8_BAR; PG8_SCHED;
            PG8_LDB(B1, 1, 1); PG8_STAGE(PG8_SB(1, 0), b3, voffB);
            PG8_BAR; PG8_WAIT_L(0); PG8_MMA(0, 1, At, B1); PG8_BAR;
            PG8_LDA(At, 1, 1); PG8_STAGE(PG8_SA(1, 0), a3, voffA);
            PG8_BAR; PG8_WAIT_L(0); PG8_MMA(1, 0, At, B0); PG8_BAR; PG8_SCHED;
            PG8_STAGE(PG8_SB(1, 1), b3 + hstep, voffB);
            PG8_WAIT_V(6); PG8_BAR; PG8_MMA(1, 1, At, B1); PG8_BAR;
            }
        }
        if constexpr (ALIGN_EPI) { if (wr == 0) PG8_BAR; }
        if constexpr (!Epi::AFTER_DRAIN) { E(acc, cur, wr, wc, fr, fq); S.done(cur); }
        if (!has_next) break;
#pragma unroll
        for (int a = 0; a < 2; ++a)
#pragma unroll
            for (int b = 0; b < 2; ++b)
#pragma unroll
                for (int m = 0; m < 4; ++m)
#pragma unroll
                    for (int n = 0; n < 2; ++n) acc[a][b][m][n] = (f32x4){0.f, 0.f, 0.f, 0.f};
        cur = nxt; cA = nA; cB = nB; ++ui;
        if constexpr (ALIGN_EPI) { if (wr == 1) PG8_BAR; }
    }
    PG8_WAIT_V(0);
    if constexpr (!ALIGN_EPI) { if (wr == 0) PG8_BAR; }
    PG8_BAR;
    if constexpr (Epi::AFTER_DRAIN) { E.fused(acc, cur, wr, wc, fr, fq, lds, wid, lane); S.done(cur); }
#undef PG8_SA
#undef PG8_SB
#undef PG8_STAGE
#undef PG8_LDA
#undef PG8_LDB
#undef PG8_MMA
#undef PG8_WAIT_V
#undef PG8_WAIT_L
#undef PG8_BAR
#undef PG8_SCHED
}
}

#define GAS __attribute__((address_space(1)))
#define LAS __attribute__((address_space(3)))
typedef unsigned v4u __attribute__((ext_vector_type(4)));
typedef unsigned v2u __attribute__((ext_vector_type(2)));
typedef float f32x4 __attribute__((ext_vector_type(4)));
typedef float f32x16 __attribute__((ext_vector_type(16)));
typedef short bf16x8 __attribute__((ext_vector_type(8)));
typedef short bf16x4 __attribute__((ext_vector_type(4)));
typedef GAS unsigned gu32;
#define RLX_AGENT __ATOMIC_RELAXED, __HIP_MEMORY_SCOPE_AGENT
#define LDS_WAIT() asm volatile("s_waitcnt lgkmcnt(0)" ::: "memory")
#define VM_WAIT() asm volatile("s_waitcnt vmcnt(0)" ::: "memory")
using pg8::cvt_pk_bf16;
#define XB_TMO      128
#define XB_XCNT(j)  (256  + 64 * (j))
#define XB_XSUB(j)  (1280 + 64 * (j))
#define XB_XGEN(j)  (2304 + 64 * (j))
#define XB_TOP      3328
#define XB_TOPGEN   3392
#define XCD_BAR_WORDS 3456
#define XB_SPIN_CAP (1u << 18)

__device__ __forceinline__ unsigned xb_ld(unsigned* p)              { return __hip_atomic_load(p, __ATOMIC_RELAXED, __HIP_MEMORY_SCOPE_AGENT); }
__device__ __forceinline__ unsigned xb_add(unsigned* p, unsigned v) { return __hip_atomic_fetch_add(p, v, __ATOMIC_RELAXED, __HIP_MEMORY_SCOPE_AGENT); }
__device__ __forceinline__ unsigned xb_xcc_id() { return (unsigned)__builtin_amdgcn_s_getreg((3 << 11) | 20) & 0xFu; }
#define XB_SPIN(cond, bar) do { unsigned _sp = 0; while (cond) { __builtin_amdgcn_s_sleep(1); \
    if ((++_sp & 255u) == 0u) { if (xb_ld(&(bar)[XB_TMO])) break; if (_sp > XB_SPIN_CAP) { atomicAdd(&(bar)[XB_TMO], 1u); break; } } } } while (0)

struct XcdBarrier {
    unsigned* bar; unsigned x;
    volatile LAS unsigned* st;
};

__device__ __forceinline__ XcdBarrier xcd_barrier_post(unsigned* bar, volatile LAS unsigned* st) {
    XcdBarrier b; b.bar = bar; b.x = xb_xcc_id(); b.st = st;
    if (threadIdx.x == 0) (void)xb_add(&bar[XB_XCNT(b.x)], 1u);
    return b;
}
__device__ __forceinline__ void xcd_barrier_complete(unsigned* bar, unsigned x, unsigned& nloc, unsigned& nx) {
    const unsigned G = gridDim.x * gridDim.y * gridDim.z;
    unsigned sum, cnt, mine, sp = 0u;
    for (;;) {
        sum = 0u; cnt = 0u; mine = 0u;
#pragma unroll
        for (unsigned j = 0; j < 16; ++j) { const unsigned c = xb_ld(&bar[XB_XCNT(j)]); sum += c; cnt += (c > 0u) ? 1u : 0u; mine = (j == x) ? c : mine; }
        if (sum == G) break;
        __builtin_amdgcn_s_sleep(1);
        if ((++sp & 255u) == 0u) { if (xb_ld(&bar[XB_TMO])) break; if (sp > XB_SPIN_CAP) { atomicAdd(&bar[XB_TMO], 1u); break; } }
    }
    nloc = mine > 0u ? mine : 1u; nx = cnt > 0u ? cnt : 1u;
}

__device__ __forceinline__ void xcd_barrier(const XcdBarrier& b) {
    asm volatile("s_waitcnt vmcnt(0)" ::: "memory");
    __syncthreads();
    if (threadIdx.x == 0) {
        unsigned* bar = b.bar;
        __builtin_amdgcn_s_waitcnt(0);
        unsigned nloc = b.st[0], nx = b.st[1];
        if (nloc == 0u) { xcd_barrier_complete(bar, b.x, nloc, nx); b.st[0] = nloc; b.st[1] = nx; }
        const unsigned old = xb_add(&bar[XB_XSUB(b.x)], 1u);
        const unsigned gen = old / nloc;
        if (old + 1u == (gen + 1u) * nloc) {
            __builtin_amdgcn_fence(__ATOMIC_RELEASE, "agent");
            asm volatile("s_waitcnt vmcnt(0)" ::: "memory");
            const unsigned og = xb_add(&bar[XB_TOP], 1u);
            const unsigned tg = og / nx;
            if (og + 1u == (tg + 1u) * nx) xb_add(&bar[XB_TOPGEN], 1u);
            else XB_SPIN(xb_ld(&bar[XB_TOPGEN]) == tg, bar);
            __builtin_amdgcn_fence(__ATOMIC_ACQUIRE, "agent");
            xb_add(&bar[XB_XGEN(b.x)], 1u);
            asm volatile("s_waitcnt vmcnt(0)" ::: "memory");
        } else {
            XB_SPIN(xb_ld(&bar[XB_XGEN(b.x)]) == gen, bar);
            __builtin_amdgcn_fence(__ATOMIC_ACQUIRE, "agent");
            asm volatile("s_waitcnt vmcnt(0)" ::: "memory");
        }
    }
    __syncthreads();
}


constexpr size_t al256(size_t x) { return (x + 255) & ~(size_t)255; }
constexpr size_t MiB = 1u << 20;
constexpr size_t WS_CTL = 0, CTL_ZERO_BYTES = 1 * MiB;
constexpr int CW_BAR = 4096;
constexpr size_t WS_W1T = 1 * MiB;
constexpr size_t WS_W2T = WS_W1T + (size_t)EVEN_IN * D * 2;
constexpr size_t WS_W3T = WS_W2T + (size_t)D * D * 2;
constexpr size_t WS_W4T = WS_W3T + (size_t)ODD_PAD * D * 2;
constexpr size_t WS_WPT = WS_W4T + (size_t)D * D * 2;
constexpr size_t WS_XN1 = WS_WPT + (size_t)4 * PG * PG * 2;
constexpr size_t WS_U = WS_XN1 + (size_t)MT * D * 2;
constexpr size_t WS_QN = WS_U + (size_t)MT * 512 * 2;
constexpr size_t WS_KN = WS_QN + (size_t)MT * 512 * 2;
constexpr size_t WS_VB = WS_KN + (size_t)MT * 512 * 2;
constexpr size_t WS_VT = WS_VB + (size_t)MT * 512 * 2;
constexpr size_t WS_SG = WS_VT + (size_t)MP * 512 * 2;
constexpr size_t WS_MIX = WS_SG + (size_t)MT * D * 2;
constexpr size_t WS_Y1 = WS_MIX + (size_t)MT * D * 2;
constexpr size_t WS_A2 = WS_Y1 + (size_t)MT * D * 4;
constexpr size_t WS_SSP = WS_A2 + (size_t)MT * D * 2;
constexpr size_t WS_QKVP = WS_SSP + (size_t)MT * 16 * 4;
constexpr size_t WS_SZ = WS_QKVP + (size_t)MT * CONVD * 2;
constexpr size_t WS_BA = WS_SZ + (size_t)MT * D * 2;
constexpr size_t WS_A4 = WS_BA + (size_t)MT * 16 * 4;
constexpr size_t WS_SLOW = al256(WS_A4 + (size_t)MT * D * 2);
constexpr size_t NW_D = WS_SLOW;
constexpr size_t NW_C = NW_D + (size_t)MT * 512 * 4;
constexpr size_t NW_BETA = NW_C + (size_t)MT * CONVD * 4;
constexpr size_t NW_G = NW_BETA + (size_t)MT * DNH * 4;
constexpr size_t NW_O = NW_G + (size_t)MT * DNH * 4;
constexpr size_t WS_END = NW_O + (size_t)MT * D * 4;
static_assert(WS_W1T % 256 == 0 && WS_XN1 % 256 == 0 && WS_U % 256 == 0 && WS_Y1 % 256 == 0 && WS_QKVP % 256 == 0 && WS_A4 % 256 == 0, "alignment");

constexpr int RING_OFF = 0, RING_BYTES = 131072;
constexpr int LDSCTL_OFF = RING_BYTES, MISC_OFF = LDSCTL_OFF + 320;
constexpr int LDS_BYTES = 147456;
constexpr int NWAVES = 8;

struct Params { const void* in[23]; float* out; unsigned char* ws; int ph_lo, ph_hi; };
struct Frame {
    LAS unsigned char* lds;
    volatile LAS unsigned* MISC;
    gu32* ctl;
    int tid, lane, wave;
    int vcu, G;
};
__device__ __forceinline__ In make_in(const Params& P) {
    In in;
    in.x_p = (const float*)P.in[0]; in.x_s = (const float*)P.in[1]; in.cache_pool = (const float*)P.in[2]; in.cache_k = (const float*)P.in[3]; in.cache_v = (const float*)P.in[4];
    in.state_conv = (const float*)P.in[5]; in.state_delta = (const float*)P.in[6]; in.page_table = (const int*)P.in[7];
    in.norm_even = (const float*)P.in[8]; in.w_in_even = (const float*)P.in[9]; in.w_pool = (const float*)P.in[10]; in.pool_scale = (const float*)P.in[11];
    in.q_norm = (const float*)P.in[12]; in.k_norm = (const float*)P.in[13]; in.sb_bias = (const float*)P.in[14]; in.w_out_even = (const float*)P.in[15];
    in.norm_odd = (const float*)P.in[16]; in.w_in_odd = (const float*)P.in[17]; in.conv_w = (const float*)P.in[18]; in.a_log = (const float*)P.in[19];
    in.dt_bias = (const float*)P.in[20]; in.o_norm = (const float*)P.in[21]; in.w_out_odd = (const float*)P.in[22];
    return in;
}

template <int MODE>
__device__ __forceinline__ void p0_transpose_item(const float* W, int K, int ldw, int nblk, bf16* WT, LAS float* scr, int item, int lane) {
    const int kb = item / nblk, nb = item % nblk, k0 = 64 * kb, n0 = 32 * nb;
#pragma unroll 8
    for (int i = 0; i < 32; ++i) { const int kk = 2 * i + (lane >> 5); scr[kk * 33 + (lane & 31)] = W[(size_t)(k0 + kk) * ldw + n0 + (lane & 31)]; }
    LDS_WAIT(); asm volatile("" ::: "memory");
    const int c = lane & 7;
#pragma unroll
    for (int j = 0; j < 4; ++j) { const int n = (lane >> 3) + 8 * j; const LAS float* s = scr + (8 * c) * 33 + n;
        v4u o; o.x = pk2(s[0 * 33], s[1 * 33]); o.y = pk2(s[2 * 33], s[3 * 33]); o.z = pk2(s[4 * 33], s[5 * 33]); o.w = pk2(s[6 * 33], s[7 * 33]);
        const int col = n0 + n;
        const int row = MODE == 1 ? ((col & ~255) + 128 * ((col & 63) >> 5) + 32 * ((col & 255) >> 6) + (col & 31)) : col;
        *(GAS v4u*)(WT + (size_t)row * K + k0 + 8 * c) = o; }
    LDS_WAIT(); asm volatile("" ::: "memory");
}
__device__ __forceinline__ void rms_row_to_bf16(const float* xrow_, const float* g, bf16* orow, int lane) {
    const GAS f32x4* xr = (const GAS f32x4*)xrow_ + lane; const GAS f32x4* gr = (const GAS f32x4*)g + lane;
    f32x4 v[4]; float s = 0.f;
#pragma unroll
    for (int j = 0; j < 4; ++j) { v[j] = xr[64 * j]; s += (v[j].x * v[j].x + v[j].y * v[j].y) + (v[j].z * v[j].z + v[j].w * v[j].w); }
    const float rstd = rsqrtf(wave_sum(s) * (1.f / D) + EPS);
    GAS unsigned long long* o8 = (GAS unsigned long long*)orow + lane;
#pragma unroll
    for (int j = 0; j < 4; ++j) { const f32x4 gg = gr[64 * j];
        o8[64 * j] = (unsigned long long)pk2(v[j].x * rstd * gg.x, v[j].y * rstd * gg.y) | ((unsigned long long)pk2(v[j].z * rstd * gg.z, v[j].w * rstd * gg.w) << 32); }
}
__device__ __forceinline__ void p0_prologue(const Frame& F, const In& in, unsigned char* ws) {
    LAS float* scr = (LAS float*)(F.lds + RING_OFF + F.wave * 16384);
    const int gw = F.vcu * NWAVES + F.wave, NGW = F.G * NWAVES;
    bf16* W1t = (bf16*)(ws + WS_W1T); bf16* W2t = (bf16*)(ws + WS_W2T); bf16* W3t = (bf16*)(ws + WS_W3T); bf16* W4t = (bf16*)(ws + WS_W4T); bf16* Wpt = (bf16*)(ws + WS_WPT);
    constexpr int I_1 = 16 * 96, I_2 = 16 * 32, I_3 = 16 * 128, I_4 = 16 * 32, I_P = 4 * 8;
    constexpr int NITEMS = I_1 + I_2 + I_3 + I_4 + I_P;
    for (int it = gw; it < NITEMS; it += NGW) {
        int r = it;
        if (r < I_1) { p0_transpose_item<1>(in.w_in_even, D, EVEN_IN, 96, W1t, scr, r, F.lane); continue; } r -= I_1;
        if (r < I_2) { p0_transpose_item<0>(in.w_out_even, D, D, 32, W2t, scr, r, F.lane); continue; } r -= I_2;
        if (r < I_3) { p0_transpose_item<0>(in.w_in_odd, D, ODD_IN, 128, W3t, scr, r, F.lane); continue; } r -= I_3;
        if (r < I_4) { p0_transpose_item<0>(in.w_out_odd, D, D, 32, W4t, scr, r, F.lane); continue; } r -= I_4;
        { const int g = r / 8; p0_transpose_item<0>(in.w_pool + (size_t)g * PG * PG, PG, PG, 4, Wpt + (size_t)g * PG * PG, scr, r % 8, F.lane); }
    }
    const int gt = F.vcu * (NWAVES * 64) + F.tid, NGT = F.G * NWAVES * 64;
    for (int i = gt; i < 16 * D; i += NGT) { const int k = i >> 4, n = i & 15; W3t[(size_t)(4096 + n) * D + k] = (bf16)f2bf(in.w_in_odd[(size_t)k * ODD_IN + 4096 + n]); }
    for (int i = gt; i < (ODD_PAD - ODD_IN) * D / 8; i += NGT) ((GAS v4u*)(W3t + (size_t)ODD_IN * D))[i] = (v4u){0u, 0u, 0u, 0u};
    bf16* XN1 = (bf16*)(ws + WS_XN1);
    for (int m = gw; m < MT; m += NGW) rms_row_to_bf16(xrow(in, m), in.norm_even, XN1 + (size_t)m * D, F.lane);
}

namespace ep {
using pg8::Unit; using pg8::BM;
__device__ __forceinline__ v4u pack8(f32x4 a, f32x4 b) { v4u w; w.x = cvt_pk_bf16(a[0], a[1]); w.y = cvt_pk_bf16(a[2], a[3]); w.z = cvt_pk_bf16(b[0], b[1]); w.w = cvt_pk_bf16(b[2], b[3]); return w; }
__device__ __forceinline__ float silu_fast(float x) { return x * __builtin_amdgcn_rcpf(1.f + __builtin_amdgcn_exp2f(-x * LOG2E)); }
__device__ __forceinline__ f32x4 silu4(f32x4 v) { return (f32x4){silu_fast(v[0]), silu_fast(v[1]), silu_fast(v[2]), silu_fast(v[3])}; }
__device__ __forceinline__ float sq4(f32x4 v) { return (v[0] * v[0] + v[1] * v[1]) + (v[2] * v[2] + v[3] * v[3]); }

struct Epi1 {
    static constexpr bool PERM = true, AFTER_DRAIN = false;
    bf16 *U, *QN, *KN, *VB, *VT, *SG; float* out; const float *qg, *kg;
    __device__ __forceinline__ void operator()(const f32x4 (&acc)[2][2][4][2], const Unit& u, int wr, int wc, int fr, int fq) const {
        const int pn = u.pn, row0 = u.pm * BM + wr * 64 + fr, cb = 64 * wc + 8 * fq;
        if (pn < 2) {
#pragma unroll
            for (int ai = 0; ai < 2; ++ai)
#pragma unroll
                for (int m = 0; m < 4; ++m) { const int row = row0 + ai * 128 + m * 16; bf16* p = U + (size_t)row * 512 + 256 * pn + cb;
#pragma unroll
                    for (int bj = 0; bj < 2; ++bj) *(v4u*)(p + 32 * bj) = pack8(acc[ai][bj][m][0], acc[ai][bj][m][1]); }
        } else if (pn < 6) {
            const bool isq = pn < 4; const float* g = isq ? qg : kg; const int hc = 256 * (pn - (isq ? 2 : 4)) + cb;
            f32x4 gv[2][2];
#pragma unroll
            for (int bj = 0; bj < 2; ++bj)
#pragma unroll
                for (int n = 0; n < 2; ++n) gv[bj][n] = *(const f32x4*)(g + 32 * bj + 8 * fq + 4 * n);
#pragma unroll
            for (int ai = 0; ai < 2; ++ai)
#pragma unroll
                for (int m = 0; m < 4; ++m) { const int row = row0 + ai * 128 + m * 16;
                    float ss = (sq4(acc[ai][0][m][0]) + sq4(acc[ai][0][m][1])) + (sq4(acc[ai][1][m][0]) + sq4(acc[ai][1][m][1]));
                    ss += __shfl_xor(ss, 16); ss += __shfl_xor(ss, 32);
                    const float rs = rsqrtf(ss * (1.f / 64.f) + EPS) * (isq ? QSCALE : 1.f);
                    f32x4 v[2][2];
#pragma unroll
                    for (int bj = 0; bj < 2; ++bj)
#pragma unroll
                        for (int n = 0; n < 2; ++n) v[bj][n] = acc[ai][bj][m][n] * rs * gv[bj][n];
                    if (isq) {
#pragma unroll
                        for (int bj = 0; bj < 2; ++bj) *(v4u*)(QN + (size_t)row * 512 + hc + 32 * bj) = pack8(v[bj][0], v[bj][1]);
                    } else {
                        float* ko = row < MP ? out + O_KP + (size_t)row * 512 : out + O_KS + (size_t)(row - MP) * 512;
#pragma unroll
                        for (int bj = 0; bj < 2; ++bj) { *(v4u*)(KN + (size_t)row * 512 + hc + 32 * bj) = pack8(v[bj][0], v[bj][1]);
                            *(f32x4*)(ko + hc + 32 * bj) = v[bj][0]; *(f32x4*)(ko + hc + 32 * bj + 4) = v[bj][1]; }
                    } }
        } else if (pn < 8) {
            const int hc = 256 * (pn - 6) + cb, h = 4 * (pn - 6) + wc;
#pragma unroll
            for (int ai = 0; ai < 2; ++ai)
#pragma unroll
                for (int m = 0; m < 4; ++m) { const int row = row0 + ai * 128 + m * 16;
                    float* vo = row < MP ? out + O_VP + (size_t)row * 512 : out + O_VS + (size_t)(row - MP) * 512;
#pragma unroll
                    for (int bj = 0; bj < 2; ++bj) { const f32x4 a = acc[ai][bj][m][0], b = acc[ai][bj][m][1];
                        *(v4u*)(VB + (size_t)row * 512 + hc + 32 * bj) = pack8(a, b);
                        *(f32x4*)(vo + hc + 32 * bj) = a; *(f32x4*)(vo + hc + 32 * bj + 4) = b;
                        if (row < MP) { bf16* vt = VT + ((size_t)((row >> 11) * 8 + h) * 64 + 32 * bj + 8 * fq) * SEQ + (row & 2047);
#pragma unroll
                            for (int e = 0; e < 4; ++e) { vt[(size_t)e * SEQ] = (bf16)f2bf(a[e]); vt[(size_t)(4 + e) * SEQ] = (bf16)f2bf(b[e]); } } } }
        } else {
            const int hc = 256 * (pn - 8) + cb;
#pragma unroll
            for (int ai = 0; ai < 2; ++ai)
#pragma unroll
                for (int m = 0; m < 4; ++m) { const int row = row0 + ai * 128 + m * 16; bf16* p = SG + (size_t)row * 1024 + hc;
#pragma unroll
                    for (int bj = 0; bj < 2; ++bj) *(v4u*)(p + 32 * bj) = pack8(silu4(acc[ai][bj][m][0]), silu4(acc[ai][bj][m][1])); }
        }
    }
};
struct Epi4 {
    static constexpr bool PERM = true, AFTER_DRAIN = false;
    const float *xp, *xs, *g2; float* Y1; bf16* A2; float* SSP;
    __device__ __forceinline__ void operator()(const f32x4 (&acc)[2][2][4][2], const Unit& u, int wr, int wc, int fr, int fq) const {
        const int row0 = u.pm * BM + wr * 64 + fr, c0 = u.pn * BM + wc * 32 + 8 * fq;
        f32x4 gv[2][2];
#pragma unroll
        for (int bj = 0; bj < 2; ++bj)
#pragma unroll
            for (int n = 0; n < 2; ++n) gv[bj][n] = *(const f32x4*)(g2 + c0 + 128 * bj + 4 * n);
#pragma unroll
        for (int ai = 0; ai < 2; ++ai)
#pragma unroll
            for (int m = 0; m < 4; ++m) { const int row = row0 + ai * 128 + m * 16;
                const float* xr = (row < MP ? xp + (size_t)row * D : xs + (size_t)(row - MP) * D) + c0;
                float ss = 0.f;
#pragma unroll
                for (int bj = 0; bj < 2; ++bj) { const f32x4 y0 = *(const f32x4*)(xr + 128 * bj) + acc[ai][bj][m][0], y1 = *(const f32x4*)(xr + 128 * bj + 4) + acc[ai][bj][m][1];
                    *(f32x4*)(Y1 + (size_t)row * D + c0 + 128 * bj) = y0; *(f32x4*)(Y1 + (size_t)row * D + c0 + 128 * bj + 4) = y1;
                    ss += sq4(y0) + sq4(y1);
                    *(v4u*)(A2 + (size_t)row * D + c0 + 128 * bj) = pack8(y0 * gv[bj][0], y1 * gv[bj][1]); }
                ss += __shfl_xor(ss, 16); ss += __shfl_xor(ss, 32);
                if (fq == 0) SSP[(size_t)row * 16 + u.pn * 4 + wc] = ss; }
    }
};
struct Epi5 {
    static constexpr bool PERM = true, AFTER_DRAIN = false;
    const float* SSP; bf16 *QKVP, *SZ; float *BA, *out;
    __device__ __forceinline__ void operator()(const f32x4 (&acc)[2][2][4][2], const Unit& u, int wr, int wc, int fr, int fq) const {
        const int pn = u.pn, row0 = u.pm * BM + wr * 64 + fr, c0 = pn * BM + wc * 32 + 8 * fq;
#pragma unroll
        for (int ai = 0; ai < 2; ++ai)
#pragma unroll
            for (int m = 0; m < 4; ++m) { const int row = row0 + ai * 128 + m * 16;
                const f32x4* sp = (const f32x4*)(SSP + (size_t)row * 16);
                const f32x4 s0 = sp[0], s1 = sp[1], s2 = sp[2], s3 = sp[3];
                const float st = ((s0[0] + s0[1]) + (s0[2] + s0[3])) + ((s1[0] + s1[1]) + (s1[2] + s1[3])) + ((s2[0] + s2[1]) + (s2[2] + s2[3])) + ((s3[0] + s3[1]) + (s3[2] + s3[3]));
                const float rs = rsqrtf(st * (1.f / D) + EPS);
                if (pn < 12) {
                    float* cs = nullptr;
                    if (row < MP) { const int t = row & 2047; if (t >= SEQ - 3) cs = out + O_CONVP + (size_t)((row >> 11) * 3 + (t - (SEQ - 3))) * CONVD; }
                    else { const int i = (row - MP) & 3; if (i >= 1) cs = out + O_CONVS + (size_t)(((row - MP) >> 2) * 3 + (i - 1)) * CONVD; }
#pragma unroll
                    for (int bj = 0; bj < 2; ++bj) { const f32x4 a = acc[ai][bj][m][0] * rs, b = acc[ai][bj][m][1] * rs;
                        *(v4u*)(QKVP + (size_t)row * CONVD + c0 + 128 * bj) = pack8(a, b);
                        if (cs) { *(f32x4*)(cs + c0 + 128 * bj) = a; *(f32x4*)(cs + c0 + 128 * bj + 4) = b; } }
                } else if (pn < 16) {
#pragma unroll
                    for (int bj = 0; bj < 2; ++bj) *(v4u*)(SZ + (size_t)row * D + (c0 - CONVD) + 128 * bj) = pack8(silu4(acc[ai][bj][m][0] * rs), silu4(acc[ai][bj][m][1] * rs));
                } else if (wc == 0 && fq < 2) {
                    *(f32x4*)(BA + (size_t)row * 16 + 8 * fq) = acc[ai][0][m][0] * rs; *(f32x4*)(BA + (size_t)row * 16 + 8 * fq + 4) = acc[ai][0][m][1] * rs;
                } }
    }
};
struct Epi8 {
    static constexpr bool PERM = true, AFTER_DRAIN = false;
    const float* Y1; float* out;
    __device__ __forceinline__ void operator()(const f32x4 (&acc)[2][2][4][2], const Unit& u, int wr, int wc, int fr, int fq) const {
        const int row0 = u.pm * BM + wr * 64 + fr, c0 = u.pn * BM + wc * 32 + 8 * fq;
#pragma unroll
        for (int ai = 0; ai < 2; ++ai)
#pragma unroll
            for (int m = 0; m < 4; ++m) { const int row = row0 + ai * 128 + m * 16;
                const float* yr = Y1 + (size_t)row * D + c0; float* o = (row < MP ? out + O_YP + (size_t)row * D : out + O_YS + (size_t)(row - MP) * D) + c0;
#pragma unroll
                for (int bj = 0; bj < 2; ++bj) { *(f32x4*)(o + 128 * bj) = *(const f32x4*)(yr + 128 * bj) + acc[ai][bj][m][0]; *(f32x4*)(o + 128 * bj + 4) = *(const f32x4*)(yr + 128 * bj + 4) + acc[ai][bj][m][1]; } }
    }
};
}

namespace nv {
__global__ void __launch_bounds__(256) k_pool_d(const bf16* U, const float* cache_pool, float* nD, float* out) {
    const size_t n = (size_t)MT * PW;
    for (size_t i = (size_t)blockIdx.x * 256 + threadIdx.x; i < n; i += (size_t)gridDim.x * 256) {
        const int r = (int)(i / PW), c = (int)(i % PW), g = c / PG, w = 2 << g;
        float sum = 0.f, cnt;
        if (r < MP) {
            const int t = r % SEQ;
            for (int j = 0; j < w; ++j) if (t - j >= 0) sum += bf2f(U[(size_t)(r - j) * PW + c]);
            cnt = (float)min(t + 1, w);
        } else {
            const int s = (r - MP) / DS, t = (r - MP) % DS;
            for (int j = 0; j < w; ++j) { const int tt = t - j; sum += tt >= 0 ? bf2f(U[(size_t)(r - j) * PW + c]) : cache_pool[((size_t)s * PBUF + (PBUF + tt)) * PW + c]; }
            cnt = (float)w;
        }
        nD[i] = sum / cnt - bf2f(U[(size_t)r * PW + c]);
    }
    const size_t n2 = (size_t)BP * PBUF * PW;
    for (size_t i = (size_t)blockIdx.x * 256 + threadIdx.x; i < n2; i += (size_t)gridDim.x * 256) {
        const int c = (int)(i % PW), j = (int)((i / PW) % PBUF), b = (int)(i / ((size_t)PW * PBUF));
        out[O_POOLP + i] = bf2f(U[(size_t)(b * SEQ + SEQ - PBUF + j) * PW + c]);
    }
    const size_t n3 = (size_t)DB * PBUF * PW;
    for (size_t i = (size_t)blockIdx.x * 256 + threadIdx.x; i < n3; i += (size_t)gridDim.x * 256) {
        const int c = (int)(i % PW), j = (int)((i / PW) % PBUF), s = (int)(i / ((size_t)PW * PBUF));
        const int e = j + DS;
        out[O_POOLS + i] = e < PBUF ? cache_pool[((size_t)s * PBUF + e) * PW + c] : bf2f(U[(size_t)(MP + s * DS + (e - PBUF)) * PW + c]);
    }
}
__global__ void __launch_bounds__(256) k_pool_y(const float* nD, const float* w_pool, const float* scale, const bf16* SG, bf16* mix) {
    const size_t n = (size_t)MT * PW;
    for (size_t i = (size_t)blockIdx.x * 256 + threadIdx.x; i < n; i += (size_t)gridDim.x * 256) {
        const int r = (int)(i / PW), c = (int)(i % PW), g = c / PG, dd = c % PG;
        const float* d = nD + (size_t)r * PW + g * PG; const float* wp = w_pool + (size_t)g * PG * PG + dd;
        float s = 0.f;
        for (int k = 0; k < PG; ++k) s += d[k] * wp[(size_t)k * PG];
        mix[(size_t)r * D + c] = (bf16)f2bf(s * scale[c] * bf2f(SG[(size_t)r * D + c]));
    }
}
__global__ void __launch_bounds__(256) k_attn(const bf16* QN, const bf16* KN, const bf16* VB, const float* cache_k, const float* cache_v, const int* page_table,
                                              const float* bias, const bf16* SG, bf16* mix) {
    const int lane = threadIdx.x & 63;
    const long w = ((long)blockIdx.x * 256 + threadIdx.x) >> 6, nw = (long)gridDim.x * 4;
    for (long it = w; it < (long)MT * SBH; it += nw) {
        const int r = (int)(it / SBH), h = (int)(it % SBH);
        const float q = bf2f(QN[(size_t)r * 512 + h * 64 + lane]);
        const float bh = bias[h] * LOG2E;
        int nkeys, s = 0, b = 0;
        if (r < MP) { b = r / SEQ; nkeys = r % SEQ; } else { s = (r - MP) / DS; nkeys = PAST + (r - MP) % DS; }
        float R = 0.f, o = 0.f;
        for (int blk = (nkeys - 1) / 64; blk >= 0 && nkeys > 0; --blk) {
            const int j0 = blk * 64 + lane; const bool valid = j0 < nkeys;
            const int j = valid ? j0 : nkeys - 1;
            const bool is16 = (r < MP) || (j >= PAST);
            const bf16* k16 = KN + (size_t)(r < MP ? b * SEQ + j : MP + s * DS + (is16 ? j - PAST : 0)) * 512 + h * 64;
            const float* k32 = cache_k + (((size_t)page_table[s * NPAGE + (is16 ? 0 : j / PAGE)] * PAGE + (is16 ? 0 : j % PAGE)) * SBH + h) * SBD;
            float dot = 0.f;
            for (int d = 0; d < 64; ++d) { const float qd = __shfl(q, d); dot += qd * (is16 ? bf2f(k16[d]) : k32[d]); }
            const float z = valid ? dot + bh : 0.f;
            const float sp = softplus2_f(z);
            const float lk = valid ? -sp : 0.f;
            float inc = lk;
#pragma unroll
            for (int off = 1; off < 64; off <<= 1) { const float t = __shfl_down(inc, off); if (lane + off < 64) inc += t; }
            const float suffix = inc - lk + R;
            const float a = valid ? exp2f(z - sp + suffix) : 0.f;
            R += __shfl(inc, 0);
            for (int k = 0; k < 64; ++k) {
                const int jj = blk * 64 + k;
                const float ak = __shfl(a, k);
                if (jj < nkeys) {
                    float vv;
                    if (r < MP) vv = bf2f(VB[(size_t)(b * SEQ + jj) * 512 + h * 64 + lane]);
                    else if (jj < PAST) vv = cache_v[(((size_t)page_table[s * NPAGE + jj / PAGE] * PAGE + jj % PAGE) * SBH + h) * SBD + lane];
                    else vv = bf2f(VB[(size_t)(MP + s * DS + (jj - PAST)) * 512 + h * 64 + lane]);
                    o += ak * vv;
                }
            }
        }
        mix[(size_t)r * D + 512 + h * 64 + lane] = (bf16)f2bf(o * bf2f(SG[(size_t)r * D + 512 + h * 64 + lane]));
    }
}
__global__ void __launch_bounds__(256) k_conv(const bf16* QKVP, const float* state_conv, const float* conv_w, float* nC) {
    const size_t n = (size_t)MT * CONVD;
    for (size_t i = (size_t)blockIdx.x * 256 + threadIdx.x; i < n; i += (size_t)gridDim.x * 256) {
        const int r = (int)(i / CONVD), c = (int)(i % CONVD);
        float acc = 0.f;
        for (int j = 0; j < 4; ++j) {
            float xv;
            if (r < MP) { const int t = r % SEQ, e = t + j; xv = e >= 3 ? bf2f(QKVP[(size_t)(r - 3 + j) * CONVD + c]) : 0.f; }
            else { const int s = (r - MP) / DS, t = (r - MP) % DS, e = t + j; xv = e >= 3 ? bf2f(QKVP[(size_t)(MP + s * DS + e - 3) * CONVD + c]) : state_conv[((size_t)s * 3 + e) * CONVD + c]; }
            acc += xv * conv_w[(size_t)j * CONVD + c];
        }
        nC[i] = silu_f(acc);
    }
}
__global__ void __launch_bounds__(256) k_qknorm(float* nC, const float* BA, const float* a_log, const float* dt_bias, float* nBeta, float* nG) {
    const int lane = threadIdx.x & 63;
    const long w = ((long)blockIdx.x * 256 + threadIdx.x) >> 6, nw = (long)gridDim.x * 4;
    for (long it = w; it < (long)MT * DNH; it += nw) {
        const int r = (int)(it / DNH), h = (int)(it % DNH);
        float* q = nC + (size_t)r * CONVD + h * 128; float* k = q + 1024;
        const float q0 = q[lane], q1 = q[lane + 64], k0 = k[lane], k1 = k[lane + 64];
        const float qs = wave_sum(q0 * q0 + q1 * q1), ks = wave_sum(k0 * k0 + k1 * k1);
        const float qr = rsqrtf(qs + EPS) * 0.08838834764831845f, kr = rsqrtf(ks + EPS);
        q[lane] = q0 * qr; q[lane + 64] = q1 * qr; k[lane] = k0 * kr; k[lane + 64] = k1 * kr;
        if (lane == 0) {
            const float bb = BA[(size_t)r * 16 + h], aa = BA[(size_t)r * 16 + 8 + h];
            nBeta[(size_t)r * DNH + h] = 1.f / (1.f + __expf(-bb));
            nG[(size_t)r * DNH + h] = -__expf(a_log[h]) * softplus_f(aa + dt_bias[h]);
        }
    }
}
__global__ void __launch_bounds__(512) k_gdn(const float* nC, const float* nBeta, const float* nG, const float* state_delta, float* nO, float* out) {
    __shared__ float sq[128], sk[128], red[4][128], red2[4][128];
    const int tid = threadIdx.x, e = tid & 127, part = tid >> 7;
    for (int c = blockIdx.x; c < BP * DNH + DB * DNH; c += gridDim.x) {
        int base, L, h; const float* S0 = nullptr; float* Sout;
        if (c < BP * DNH) { const int b = c / DNH; h = c % DNH; base = b * SEQ; L = SEQ; Sout = out + O_DP + (size_t)c * DNK * DNV; }
        else { const int cc = c - BP * DNH, s = cc / DNH; h = cc % DNH; base = MP + s * DS; L = DS; S0 = state_delta + (size_t)cc * DNK * DNV; Sout = out + O_DS + (size_t)cc * DNK * DNV; }
        float S[32];
#pragma unroll
        for (int i = 0; i < 32; ++i) S[i] = S0 ? S0[(size_t)(part * 32 + i) * DNV + e] : 0.f;
        for (int t = 0; t < L; ++t) {
            const int r = base + t;
            __syncthreads();
            if (tid < 128) sq[tid] = nC[(size_t)r * CONVD + h * 128 + tid];
            else if (tid < 256) sk[tid - 128] = nC[(size_t)r * CONVD + 1024 + h * 128 + (tid - 128)];
            const float v = nC[(size_t)r * CONVD + 2048 + h * 128 + e];
            const float beta = nBeta[(size_t)r * DNH + h], alpha = __expf(nG[(size_t)r * DNH + h]);
            __syncthreads();
            float ks = 0.f;
#pragma unroll
            for (int i = 0; i < 32; ++i) ks += sk[part * 32 + i] * S[i];
            red[part][e] = ks;
            __syncthreads();
            const float kS = alpha * (red[0][e] + red[1][e] + red[2][e] + red[3][e]);
            const float vn = beta * (v - kS);
            float op = 0.f;
#pragma unroll
            for (int i = 0; i < 32; ++i) { S[i] = alpha * S[i] + sk[part * 32 + i] * vn; op += sq[part * 32 + i] * S[i]; }
            red2[part][e] = op;
            __syncthreads();
            if (part == 0) nO[(size_t)r * D + h * 128 + e] = red2[0][e] + red2[1][e] + red2[2][e] + red2[3][e];
        }
#pragma unroll
        for (int i = 0; i < 32; ++i) Sout[(size_t)(part * 32 + i) * DNV + e] = S[i];
        __syncthreads();
    }
}
__global__ void __launch_bounds__(256) k_onorm(const float* nO, const bf16* SZ, const float* og, bf16* A4) {
    const int lane = threadIdx.x & 63;
    const long w = ((long)blockIdx.x * 256 + threadIdx.x) >> 6, nw = (long)gridDim.x * 4;
    for (long it = w; it < (long)MT * DNH; it += nw) {
        const int r = (int)(it / DNH), h = (int)(it % DNH);
        const float* o = nO + (size_t)r * D + h * 128;
        const float o0 = o[lane], o1 = o[lane + 64];
        const float ss = wave_sum(o0 * o0 + o1 * o1);
        const float rs = rsqrtf(ss / 128.f + EPS);
        const bf16* z = SZ + (size_t)r * D + h * 128;
        A4[(size_t)r * D + h * 128 + lane] = (bf16)f2bf(o0 * rs * og[lane] * bf2f(z[lane]));
        A4[(size_t)r * D + h * 128 + lane + 64] = (bf16)f2bf(o1 * rs * og[lane + 64] * bf2f(z[lane + 64]));
    }
}
}

constexpr int N_PHASES = 9;
__global__ void __launch_bounds__(NWAVES * 64, 2) fwd(Params P) {
    extern __shared__ __attribute__((aligned(16))) unsigned char lds[];
    Frame F;
    F.lds = (LAS unsigned char*)lds;
    F.MISC = (volatile LAS unsigned*)(F.lds + MISC_OFF);
    F.tid = threadIdx.x; F.lane = F.tid & 63; F.wave = __builtin_amdgcn_readfirstlane(F.tid >> 6);
    F.G = gridDim.x; { const int bx = blockIdx.x; F.vcu = (F.G % 8 == 0) ? (bx % 8) * (F.G / 8) + bx / 8 : bx; }
    unsigned char* ws = P.ws;
    F.ctl = (gu32*)(ws + WS_CTL);
    const In in = make_in(P);
    for (int u = F.tid; u < (LDS_BYTES - LDSCTL_OFF) / 4; u += NWAVES * 64) ((LAS unsigned*)(F.lds + LDSCTL_OFF))[u] = 0u;
    __syncthreads();
    const int lo = P.ph_lo, hi = P.ph_hi;
    const bool use_bar = (hi - lo) > 1;
    XcdBarrier bar; bar.bar = (unsigned*)(F.ctl + CW_BAR); bar.x = 0; bar.st = nullptr;
    if (use_bar) bar = xcd_barrier_post((unsigned*)(F.ctl + CW_BAR), F.MISC + 8);
#define IN(k) (lo <= (k) && (k) < hi)
#define BOTH(k) (IN(k) && IN((k) + 1))
#define GRID_BAR() xcd_barrier(bar)

    if (IN(0)) { p0_prologue(F, in, ws); if (BOTH(0)) GRID_BAR(); }

    if (IN(1)) {
        pg8::Gemm g{(const pg8::bf16_t*)(ws + WS_XN1), (const pg8::bf16_t*)(ws + WS_W1T), MT, EVEN_IN, D}; pg8::StaticOrder S; S.init(MT, EVEN_IN, F.G, (int)blockIdx.x);
        ep::Epi1 E{(bf16*)(ws + WS_U), (bf16*)(ws + WS_QN), (bf16*)(ws + WS_KN), (bf16*)(ws + WS_VB), (bf16*)(ws + WS_VT), (bf16*)(ws + WS_SG), P.out, in.q_norm, in.k_norm};
        pg8::gemm_phase<ep::Epi1, pg8::StaticOrder, true, true>(F.lds + RING_OFF, g, S, E);
        if (BOTH(1)) GRID_BAR();
    }

    if (IN(4)) {
        pg8::Gemm g{(const pg8::bf16_t*)(ws + WS_MIX), (const pg8::bf16_t*)(ws + WS_W2T), MT, D, D}; pg8::StaticOrder S; S.init(MT, D, F.G, (int)blockIdx.x);
        ep::Epi4 E{in.x_p, in.x_s, in.norm_odd, (float*)(ws + WS_Y1), (bf16*)(ws + WS_A2), (float*)(ws + WS_SSP)};
        pg8::gemm_phase<ep::Epi4, pg8::StaticOrder, true, true>(F.lds + RING_OFF, g, S, E);
        if (BOTH(4)) GRID_BAR();
    }
    if (IN(5)) {
        pg8::Gemm g{(const pg8::bf16_t*)(ws + WS_A2), (const pg8::bf16_t*)(ws + WS_W3T), MT, ODD_PAD, D}; pg8::StaticOrder S; S.init(MT, ODD_PAD, F.G, (int)blockIdx.x);
        ep::Epi5 E{(const float*)(ws + WS_SSP), (bf16*)(ws + WS_QKVP), (bf16*)(ws + WS_SZ), (float*)(ws + WS_BA), P.out};
        pg8::gemm_phase<ep::Epi5, pg8::StaticOrder, true, true>(F.lds + RING_OFF, g, S, E);
        if (BOTH(5)) GRID_BAR();
    }

    if (IN(8)) {
        pg8::Gemm g{(const pg8::bf16_t*)(ws + WS_A4), (const pg8::bf16_t*)(ws + WS_W4T), MT, D, D}; pg8::StaticOrder S; S.init(MT, D, F.G, (int)blockIdx.x);
        ep::Epi8 E{(const float*)(ws + WS_Y1), P.out};
        pg8::gemm_phase<ep::Epi8, pg8::StaticOrder, true, true>(F.lds + RING_OFF, g, S, E);
    }
#undef IN
#undef BOTH
#undef GRID_BAR
}

extern "C" void kernel_launch(void* const* d_in, const int* in_sizes, int n_in, void* d_out, int out_size, void* d_ws, size_t ws_size, hipStream_t stream) {
    static int grid = 0;
    if (grid == 0) {
        if (n_in != 23 || (size_t)out_size != O_END || ws_size < WS_END) { fprintf(stderr, "kernel_launch: unexpected sizes n_in %d out %d ws %zu (need %zu)\n", n_in, out_size, ws_size, (size_t)WS_END); grid = -1; return; }
        int dev = 0, cus = 0, per_cu = 0;
        if (hipGetDevice(&dev) != hipSuccess || hipDeviceGetAttribute(&cus, hipDeviceAttributeMultiprocessorCount, dev) != hipSuccess) { grid = -1; return; }
        if (hipFuncSetAttribute((const void*)fwd, hipFuncAttributeMaxDynamicSharedMemorySize, LDS_BYTES) != hipSuccess) { fprintf(stderr, "kernel_launch: hipFuncSetAttribute failed\n"); grid = -1; return; }
        if (hipOccupancyMaxActiveBlocksPerMultiprocessor(&per_cu, (const void*)fwd, NWAVES * 64, LDS_BYTES) != hipSuccess || per_cu < 1) fprintf(stderr, "kernel_launch: occupancy query reports %d\n", per_cu);
        (void)hipGetLastError();
        grid = cus;
    }
    if (grid < 0) return;
    (void)hipMemsetAsync((char*)d_ws + WS_CTL, 0, CTL_ZERO_BYTES, stream);
    Params p{};
    for (int i = 0; i < 23; ++i) p.in[i] = d_in[i];
    p.out = (float*)d_out; p.ws = (unsigned char*)d_ws;
    In in;
    in.x_p = (const float*)d_in[0]; in.x_s = (const float*)d_in[1]; in.cache_pool = (const float*)d_in[2]; in.cache_k = (const float*)d_in[3]; in.cache_v = (const float*)d_in[4];
    in.state_conv = (const float*)d_in[5]; in.state_delta = (const float*)d_in[6]; in.page_table = (const int*)d_in[7];
    in.norm_even = (const float*)d_in[8]; in.w_in_even = (const float*)d_in[9]; in.w_pool = (const float*)d_in[10]; in.pool_scale = (const float*)d_in[11];
    in.q_norm = (const float*)d_in[12]; in.k_norm = (const float*)d_in[13]; in.sb_bias = (const float*)d_in[14]; in.w_out_even = (const float*)d_in[15];
    in.norm_odd = (const float*)d_in[16]; in.w_in_odd = (const float*)d_in[17]; in.conv_w = (const float*)d_in[18]; in.a_log = (const float*)d_in[19];
    in.dt_bias = (const float*)d_in[20]; in.o_norm = (const float*)d_in[21]; in.w_out_odd = (const float*)d_in[22];
    float* out = (float*)d_out; char* ws = (char*)d_ws;
    auto launch = [&](int lo, int hi) { p.ph_lo = lo; p.ph_hi = hi; hipLaunchKernelGGL(fwd, dim3(grid), dim3(NWAVES * 64), LDS_BYTES, stream, p); };
    const int G = 2048;
    launch(0, 1);
    launch(1, 2);
    nv::k_pool_d<<<G, 256, 0, stream>>>((const bf16*)(ws + WS_U), in.cache_pool, (float*)(ws + NW_D), out);
    nv::k_pool_y<<<G, 256, 0, stream>>>((const float*)(ws + NW_D), in.w_pool, in.pool_scale, (const bf16*)(ws + WS_SG), (bf16*)(ws + WS_MIX));
    nv::k_attn<<<G * 4, 256, 0, stream>>>((const bf16*)(ws + WS_QN), (const bf16*)(ws + WS_KN), (const bf16*)(ws + WS_VB), in.cache_k, in.cache_v, in.page_table, in.sb_bias, (const bf16*)(ws + WS_SG), (bf16*)(ws + WS_MIX));
    launch(4, 5);
    launch(5, 6);
    nv::k_conv<<<G, 256, 0, stream>>>((const bf16*)(ws + WS_QKVP), in.state_conv, in.conv_w, (float*)(ws + NW_C));
    nv::k_qknorm<<<G, 256, 0, stream>>>((float*)(ws + NW_C), (const float*)(ws + WS_BA), in.a_log, in.dt_bias, (float*)(ws + NW_BETA), (float*)(ws + NW_G));
    nv::k_gdn<<<BP * DNH + DB * DNH, 512, 0, stream>>>((const float*)(ws + NW_C), (const float*)(ws + NW_BETA), (const float*)(ws + NW_G), in.state_delta, (float*)(ws + NW_O), out);
    nv::k_onorm<<<G, 256, 0, stream>>>((const float*)(ws + NW_O), (const bf16*)(ws + WS_SZ), in.o_norm, (bf16*)(ws + WS_A4));
    launch(8, 9);
}
```

```cpp
#include <hip/hip_runtime.h>
#include <cstdio>
#include <cstdint>

constexpr int D = 1024, BP = 8, SEQ = 2048, MP = BP * SEQ;
constexpr int DB = 128, DS = 4, MS = DB * DS, MT = MP + MS;
constexpr int PAST = 2048, PAGE = 128, NPAGE = PAST / PAGE;
constexpr int PW = 512, PG = 128, PBUF = 15;
constexpr int SBH = 8, SBD = 64;
constexpr int EVEN_IN = 3072;
constexpr int DNH = 8, DNK = 128, DNV = 128, CONVD = 3072, ODD_IN = 4112, ODD_PAD = 4352;
constexpr float EPS = 1e-6f;
constexpr float LOG2E = 1.4426950408889634f;
constexpr float QSCALE = 0.125f * LOG2E;

constexpr size_t O_YP = 0;
constexpr size_t O_YS = O_YP + (size_t)MP * D;
constexpr size_t O_POOLP = O_YS + (size_t)MS * D;
constexpr size_t O_POOLS = O_POOLP + (size_t)BP * PBUF * PW;
constexpr size_t O_KP = O_POOLS + (size_t)DB * PBUF * PW;
constexpr size_t O_VP = O_KP + (size_t)MP * 512;
constexpr size_t O_KS = O_VP + (size_t)MP * 512;
constexpr size_t O_VS = O_KS + (size_t)MS * 512;
constexpr size_t O_CONVP = O_VS + (size_t)MS * 512;
constexpr size_t O_CONVS = O_CONVP + (size_t)BP * 3 * CONVD;
constexpr size_t O_DP = O_CONVS + (size_t)DB * 3 * CONVD;
constexpr size_t O_DS = O_DP + (size_t)BP * DNH * DNK * DNV;
constexpr size_t O_END = O_DS + (size_t)DB * DNH * DNK * DNV;
static_assert(O_END == 54726656, "output size");

struct In {
    const float *x_p, *x_s, *cache_pool, *cache_k, *cache_v, *state_conv, *state_delta;
    const int* page_table;
    const float *norm_even, *w_in_even, *w_pool, *pool_scale, *q_norm, *k_norm, *sb_bias, *w_out_even;
    const float *norm_odd, *w_in_odd, *conv_w, *a_log, *dt_bias, *o_norm, *w_out_odd;
};

__device__ __forceinline__ float wave_sum(float v) {
#pragma unroll
    for (int o = 1; o < 64; o <<= 1) v += __shfl_xor(v, o);
    return v;
}
__device__ __forceinline__ float silu_f(float x) { return x / (1.f + __expf(-x)); }
__device__ __forceinline__ float softplus_f(float x) { return fmaxf(x, 0.f) + log1pf(__expf(-fabsf(x))); }
__device__ __forceinline__ float softplus2_f(float z2) { return fmaxf(z2, 0.f) + __log2f(1.f + exp2f(-fabsf(z2))); }
typedef unsigned short bf16;
__device__ __forceinline__ unsigned f2bf(float f) { unsigned u = __builtin_bit_cast(unsigned, f); return (u + 0x7fffu + ((u >> 16) & 1u)) >> 16; }
__device__ __forceinline__ unsigned pk2(float lo, float hi) { return f2bf(lo) | (f2bf(hi) << 16); }
__device__ __forceinline__ float bf2f(bf16 b) { return __builtin_bit_cast(float, (unsigned)b << 16); }
__device__ __forceinline__ const float* xrow(const In& in, int r) { return r < MP ? in.x_p + (size_t)r * D : in.x_s + (size_t)(r - MP) * D; }
namespace pg8 {
#define PG8_LAS __attribute__((address_space(3)))
typedef unsigned short bf16_t;
typedef short bf16x8 __attribute__((ext_vector_type(8)));
typedef float f32x4 __attribute__((ext_vector_type(4)));
typedef unsigned u32x4 __attribute__((ext_vector_type(4)));
constexpr int BM = 256, BK = 64, HALF = 128, HTB = HALF * BK * 2  , STAGE_BYTES = 8 * HTB, NXCD = 8, WGM = 8;

__host__ __device__ __forceinline__ int lds_byte(int r, int c) { const int st = (r >> 4) * 2 + (c >> 5), rr = r & 15, cc = c & 31, ob = rr * 64 + cc * 2; return st * 1024 + (ob ^ (((ob >> 9) & 1) << 5)); }
__host__ __device__ __forceinline__ void stage_rc(int b, int& R, int& C) { const int st = b / 1024, sb = b % 1024, swz = sb ^ (((sb >> 9) & 1) << 5); R = (st >> 1) * 16 + swz / 64; C = (st & 1) * 32 + (swz % 64) / 2; }
__host__ __device__ __forceinline__ int perm32(int rho) { const int n = rho >> 4, i = rho & 15; return 8 * (i >> 2) + 4 * n + (i & 3); }

struct Unit { int pm, pn; };
struct Gemm { const bf16_t* A; const bf16_t* Bt; int M, N, K; };

struct StaticOrder {
    int nM, nN, nwg, G, c;
    __host__ __device__ void init(int M, int N, int G_, int c_) { nM = M / BM; nN = N / BM; nwg = nM * nN; G = G_; c = c_; }
    __host__ __device__ bool next(int i, Unit& u) const {
        const long L = (long)i * G + c; if (L >= nwg) return false;
        int wgid = (int)L; { const int q = nwg / NXCD, r = nwg % NXCD, xcd = wgid % NXCD, off = wgid / NXCD; wgid = (xcd < r ? xcd * (q + 1) : r * (q + 1) + (xcd - r) * q) + off; }
        const int nig = WGM * nN, gid = wgid / nig, fm = gid * WGM, gsz = (nM - fm) < WGM ? (nM - fm) : WGM;
        u.pm = fm + ((wgid % nig) % gsz); u.pn = (wgid % nig) / gsz; return true;
    }
    __device__ __forceinline__ void a_ready(const Unit&) const {}
    __device__ __forceinline__ void done(const Unit&) const {}
};

__device__ __forceinline__ unsigned cvt_pk_bf16(float lo, float hi) { unsigned r; asm volatile("v_cvt_pk_bf16_f32 %0, %1, %2" : "=v"(r) : "v"(lo), "v"(hi)); return r; }
template <class Epi, class Sched, bool ALIGN_EPI = false, bool SP2 = false>
__device__ __forceinline__ void gemm_phase(PG8_LAS unsigned char* lds, const Gemm g, const Sched& S, const Epi& E) {
    const int tid = threadIdx.x, wid = __builtin_amdgcn_readfirstlane(tid >> 6), lane = tid & 63, wr = wid >> 2, wc = wid & 3, fr = lane & 15, fq = lane >> 4;
    const int K = g.K, nt = K / BK;
    unsigned voffA[2], voffB[2];
#pragma unroll
    for (int i = 0; i < 2; ++i) { int R, C; stage_rc(tid * 16 + i * 8192, R, C); const int Rb = Epi::PERM ? ((R & ~31) + perm32(R & 31)) : R;
        voffA[i] = (unsigned)(R * K + C) * 2u; voffB[i] = (unsigned)(Rb * K + C) * 2u; }
    const size_t kstep = (size_t)(BK * 2);
    const size_t hstep = (size_t)HALF * K * 2;
    const size_t tstep = 2 * hstep;
    const unsigned ldsw = (unsigned)wid * 1024u;
    const int aoff = lds_byte(wr * 64 + fr, fq * 8), boff = lds_byte(wc * 32 + fr, fq * 8);
#define PG8_SA(b, h) (((b) * 2 + (h)) * HTB)
#define PG8_SB(b, h) ((4 + (b) * 2 + (h)) * HTB)
#define PG8_STAGE(bufoff, gbase, voff) do { _Pragma("unroll") for (int _i = 0; _i < 2; ++_i) \
        __builtin_amdgcn_global_load_lds((const unsigned*)((const char*)(gbase) + (voff)[_i]), (PG8_LAS unsigned*)(lds + (bufoff) + ldsw + _i * 8192), 16, 0, 0); } while (0)
#define PG8_LDA(dst, b, h) do { _Pragma("unroll") for (int m = 0; m < 4; ++m) _Pragma("unroll") for (int k = 0; k < 2; ++k) dst[m][k] = *(const PG8_LAS bf16x8*)(lds + PG8_SA(b, h) + aoff + m * 2048 + k * 1024); } while (0)
#define PG8_LDB(dst, b, h) do { _Pragma("unroll") for (int n = 0; n < 2; ++n) _Pragma("unroll") for (int k = 0; k < 2; ++k) dst[n][k] = *(const PG8_LAS bf16x8*)(lds + PG8_SB(b, h) + boff + n * 2048 + k * 1024); } while (0)
#define PG8_MMA(ai, bj, At, Bt) do { __builtin_amdgcn_s_setprio(1); _Pragma("unroll") for (int m = 0; m < 4; ++m) _Pragma("unroll") for (int n = 0; n < 2; ++n) _Pragma("unroll") for (int k = 0; k < 2; ++k) \
        acc[ai][bj][m][n] = __builtin_amdgcn_mfma_f32_16x16x32_bf16(Bt[n][k], At[m][k], acc[ai][bj][m][n], 0, 0, 0); __builtin_amdgcn_s_setprio(0); } while (0)
#define PG8_WAIT_V(n) asm volatile("s_waitcnt vmcnt(" #n ")" ::: "memory")
#define PG8_WAIT_L(n) asm volatile("s_waitcnt lgkmcnt(" #n ")" ::: "memory")
#define PG8_BAR __builtin_amdgcn_s_barrier()
#define PG8_SCHED __builtin_amdgcn_sched_barrier(0)
    Unit cur, nxt; int ui = 0;
    if (!S.next(0, cur)) return;
    f32x4 acc[2][2][4][2];
#pragma unroll
    for (int a = 0; a < 2; ++a)
#pragma unroll
        for (int b = 0; b < 2; ++b)
#pragma unroll
            for (int m = 0; m < 4; ++m)
#pragma unroll
                for (int n = 0; n < 2; ++n) acc[a][b][m][n] = (f32x4){0.f, 0.f, 0.f, 0.f};
    bf16x8 At[4][2], B0[2][2], B1[2][2];
    const char* cA = (const char*)g.A + (size_t)cur.pm * tstep; const char* cB = (const char*)g.Bt + (size_t)cur.pn * tstep;
    S.a_ready(cur);
    if constexpr (SP2) {
        PG8_STAGE(PG8_SB(0, 0), cB, voffB); PG8_STAGE(PG8_SB(0, 1), cB + hstep, voffB); PG8_STAGE(PG8_SA(0, 0), cA, voffA); PG8_STAGE(PG8_SA(0, 1), cA + hstep, voffA);
        if (wr == 1) PG8_BAR;
        PG8_WAIT_V(2); PG8_BAR;
        PG8_STAGE(PG8_SB(1, 0), cB + kstep, voffB); PG8_STAGE(PG8_SA(1, 0), cA + kstep, voffA); PG8_STAGE(PG8_SB(1, 1), cB + hstep + kstep, voffB);
        PG8_WAIT_V(6); PG8_BAR;
    } else {
        PG8_STAGE(PG8_SB(0, 0), cB, voffB); PG8_STAGE(PG8_SA(0, 0), cA, voffA); PG8_STAGE(PG8_SB(0, 1), cB + hstep, voffB); PG8_STAGE(PG8_SA(0, 1), cA + hstep, voffA);
        if (wr == 1) PG8_BAR;
        PG8_WAIT_V(4); PG8_BAR;
        PG8_STAGE(PG8_SB(1, 0), cB + kstep, voffB); PG8_STAGE(PG8_SA(1, 0), cA + kstep, voffA); PG8_STAGE(PG8_SB(1, 1), cB + hstep + kstep, voffB);
        PG8_WAIT_V(6); PG8_BAR;
    }
    for (;;) {
        const bool has_next = S.next(ui + 1, nxt);
        const char* nA = has_next ? (const char*)g.A + (size_t)nxt.pm * tstep : cA; const char* nB = has_next ? (const char*)g.Bt + (size_t)nxt.pn * tstep : cB;
        for (int t = 0; t < nt; t += 2) {
            const bool last = (t == nt - 2);
            const char* a1 = cA + (size_t)(t + 1) * kstep;
            const char* a2 = last ? nA : cA + (size_t)(t + 2) * kstep; const char* b2 = last ? nB : cB + (size_t)(t + 2) * kstep;
            const char* a3 = a2 + kstep; const char* b3 = b2 + kstep;
            if (last && has_next) S.a_ready(nxt);
            if constexpr (SP2) {
            PG8_LDB(B0, 0, 0); PG8_LDB(B1, 0, 1); PG8_SCHED; PG8_LDA(At, 0, 0); PG8_STAGE(PG8_SA(1, 1), a1 + hstep, voffA);
            PG8_WAIT_V(8); PG8_WAIT_L(0); PG8_BAR; PG8_MMA(0, 0, At, B0); PG8_MMA(0, 1, At, B1); PG8_BAR; PG8_SCHED;
            PG8_LDA(At, 0, 1); PG8_STAGE(PG8_SB(0, 0), b2, voffB); PG8_STAGE(PG8_SB(0, 1), b2 + hstep, voffB); PG8_STAGE(PG8_SA(0, 0), a2, voffA);
            PG8_WAIT_V(8); PG8_WAIT_L(0); PG8_BAR; PG8_MMA(1, 0, At, B0); PG8_MMA(1, 1, At, B1); PG8_BAR; PG8_SCHED;
            PG8_LDB(B0, 1, 0); PG8_LDB(B1, 1, 1); PG8_SCHED; PG8_LDA(At, 1, 0); PG8_STAGE(PG8_SA(0, 1), a2 + hstep, voffA);
            PG8_WAIT_V(8); PG8_WAIT_L(0); PG8_BAR; PG8_MMA(0, 0, At, B0); PG8_MMA(0, 1, At, B1); PG8_BAR; PG8_SCHED;
            PG8_LDA(At, 1, 1); PG8_STAGE(PG8_SB(1, 0), b3, voffB); PG8_STAGE(PG8_SB(1, 1), b3 + hstep, voffB); PG8_STAGE(PG8_SA(1, 0), a3, voffA);
            PG8_WAIT_V(8); PG8_WAIT_L(0); PG8_BAR; PG8_MMA(1, 0, At, B0); PG8_MMA(1, 1, At, B1); PG8_BAR; PG8_SCHED;
            } else {
            PG8_LDB(B0, 0, 0); PG8_SCHED; PG8_LDA(At, 0, 0); PG8_STAGE(PG8_SA(1, 1), a1 + hstep, voffA);
            PG8_WAIT_L(8); PG8_BAR; PG8_WAIT_L(0); PG8_MMA(0, 0, At, B0); PG8_BAR; PG8_SCHED;
            PG8_LDB(B1, 0, 1); PG8_STAGE(PG8_SB(0, 0), b2, voffB);
            PG8_BAR; PG8_WAIT_L(0); PG8_MMA(0, 1, At, B1); PG8_BAR;
            PG8_LDA(At, 0, 1); PG8_STAGE(PG8_SA(0, 0), a2, voffA);
            PG8_BAR; PG8_WAIT_L(0); PG8_MMA(1, 0, At, B0); PG8_BAR; PG8_SCHED;
            PG8_STAGE(PG8_SB(0, 1), b2 + hstep, voffB);
            PG8_WAIT_V(6); PG8_BAR; PG8_MMA(1, 1, At, B1); PG8_BAR;
            PG8_LDB(B0, 1, 0); PG8_SCHED; PG8_LDA(At, 1, 0); PG8_STAGE(PG8_SA(0, 1), a2 + hstep, voffA);
            PG8_WAIT_L(8); PG8_BAR; PG8_WAIT_L(0); PG8_MMA(0, 0, At, B0); PG8_BAR; PG8_SCHED;
            PG8_LDB(B1, 1, 1); PG8_STAGE(PG8_SB(1, 0), b3, voffB);
            PG8_BAR; PG8_WAIT_L(0); PG8_MMA(0, 1, At, B1); PG8_BAR;
            PG8_LDA(At, 1, 1); PG8_STAGE(PG8_SA(1, 0), a3, voffA);
            PG8_BAR; PG8_WAIT_L(0); PG8_MMA(1, 0, At, B0); PG8_BAR; PG8_SCHED;
            PG8_STAGE(PG8_SB(1, 1), b3 + hstep, voffB);
            PG8_WAIT_V(6); PG8_BAR; PG8_MMA(1, 1, At, B1); PG8_BAR;
            }
        }
        if constexpr (ALIGN_EPI) { if (wr == 0) PG8_BAR; }
        if constexpr (!Epi::AFTER_DRAIN) { E(acc, cur, wr, wc, fr, fq); S.done(cur); }
        if (!has_next) break;
#pragma unroll
        for (int a = 0; a < 2; ++a)
#pragma unroll
            for (int b = 0; b < 2; ++b)
#pragma unroll
                for (int m = 0; m < 4; ++m)
#pragma unroll
                    for (int n = 0; n < 2; ++n) acc[a][b][m][n] = (f32x4){0.f, 0.f, 0.f, 0.f};
        cur = nxt; cA = nA; cB = nB; ++ui;
        if constexpr (ALIGN_EPI) { if (wr == 1) PG8_BAR; }
    }
    PG8_WAIT_V(0);
    if constexpr (!ALIGN_EPI) { if (wr == 0) PG8_BAR; }
    PG8_BAR;
    if constexpr (Epi::AFTER_DRAIN) { E.fused(acc, cur, wr, wc, fr, fq, lds, wid, lane); S.done(cur); }
#undef PG8_SA
#undef PG8_SB
#undef PG8_STAGE
#undef PG8_LDA
#undef PG8_LDB
#undef PG8_MMA
#undef PG8_WAIT_V
#undef PG8_WAIT_L
#undef PG8_BAR
#undef PG8_SCHED
}
}

#define GAS __attribute__((address_space(1)))
#define LAS __attribute__((address_space(3)))
typedef unsigned v4u __attribute__((ext_vector_type(4)));
typedef unsigned v2u __attribute__((ext_vector_type(2)));
typedef float f32x4 __attribute__((ext_vector_type(4)));
typedef float f32x16 __attribute__((ext_vector_type(16)));
typedef short bf16x8 __attribute__((ext_vector_type(8)));
typedef short bf16x4 __attribute__((ext_vector_type(4)));
typedef GAS unsigned gu32;
#define RLX_AGENT __ATOMIC_RELAXED, __HIP_MEMORY_SCOPE_AGENT
#define LDS_WAIT() asm volatile("s_waitcnt lgkmcnt(0)" ::: "memory")
#define VM_WAIT() asm volatile("s_waitcnt vmcnt(0)" ::: "memory")
using pg8::cvt_pk_bf16;
#define XB_TMO      128
#define XB_XCNT(j)  (256  + 64 * (j))
#define XB_XSUB(j)  (1280 + 64 * (j))
#define XB_XGEN(j)  (2304 + 64 * (j))
#define XB_TOP      3328
#define XB_TOPGEN   3392
#define XCD_BAR_WORDS 3456
#define XB_SPIN_CAP (1u << 18)

__device__ __forceinline__ unsigned xb_ld(unsigned* p)              { return __hip_atomic_load(p, __ATOMIC_RELAXED, __HIP_MEMORY_SCOPE_AGENT); }
__device__ __forceinline__ unsigned xb_add(unsigned* p, unsigned v) { return __hip_atomic_fetch_add(p, v, __ATOMIC_RELAXED, __HIP_MEMORY_SCOPE_AGENT); }
__device__ __forceinline__ unsigned xb_xcc_id() { return (unsigned)__builtin_amdgcn_s_getreg((3 << 11) | 20) & 0xFu; }
#define XB_SPIN(cond, bar) do { unsigned _sp = 0; while (cond) { __builtin_amdgcn_s_sleep(1); \
    if ((++_sp & 255u) == 0u) { if (xb_ld(&(bar)[XB_TMO])) break; if (_sp > XB_SPIN_CAP) { atomicAdd(&(bar)[XB_TMO], 1u); break; } } } } while (0)

struct XcdBarrier {
    unsigned* bar; unsigned x;
    volatile LAS unsigned* st;
};

__device__ __forceinline__ XcdBarrier xcd_barrier_post(unsigned* bar, volatile LAS unsigned* st) {
    XcdBarrier b; b.bar = bar; b.x = xb_xcc_id(); b.st = st;
    if (threadIdx.x == 0) (void)xb_add(&bar[XB_XCNT(b.x)], 1u);
    return b;
}
__device__ __forceinline__ void xcd_barrier_complete(unsigned* bar, unsigned x, unsigned& nloc, unsigned& nx) {
    const unsigned G = gridDim.x * gridDim.y * gridDim.z;
    unsigned sum, cnt, mine, sp = 0u;
    for (;;) {
        sum = 0u; cnt = 0u; mine = 0u;
#pragma unroll
        for (unsigned j = 0; j < 16; ++j) { const unsigned c = xb_ld(&bar[XB_XCNT(j)]); sum += c; cnt += (c > 0u) ? 1u : 0u; mine = (j == x) ? c : mine; }
        if (sum == G) break;
        __builtin_amdgcn_s_sleep(1);
        if ((++sp & 255u) == 0u) { if (xb_ld(&bar[XB_TMO])) break; if (sp > XB_SPIN_CAP) { atomicAdd(&bar[XB_TMO], 1u); break; } }
    }
    nloc = mine > 0u ? mine : 1u; nx = cnt > 0u ? cnt : 1u;
}

__device__ __forceinline__ void xcd_barrier(const XcdBarrier& b) {
    asm volatile("s_waitcnt vmcnt(0)" ::: "memory");
    __syncthreads();
    if (threadIdx.x == 0) {
        unsigned* bar = b.bar;
        __builtin_amdgcn_s_waitcnt(0);
        unsigned nloc = b.st[0], nx = b.st[1];
        if (nloc == 0u) { xcd_barrier_complete(bar, b.x, nloc, nx); b.st[0] = nloc; b.st[1] = nx; }
        const unsigned old = xb_add(&bar[XB_XSUB(b.x)], 1u);
        const unsigned gen = old / nloc;
        if (old + 1u == (gen + 1u) * nloc) {
            __builtin_amdgcn_fence(__ATOMIC_RELEASE, "agent");
            asm volatile("s_waitcnt vmcnt(0)" ::: "memory");
            const unsigned og = xb_add(&bar[XB_TOP], 1u);
            const unsigned tg = og / nx;
            if (og + 1u == (tg + 1u) * nx) xb_add(&bar[XB_TOPGEN], 1u);
            else XB_SPIN(xb_ld(&bar[XB_TOPGEN]) == tg, bar);
            __builtin_amdgcn_fence(__ATOMIC_ACQUIRE, "agent");
            xb_add(&bar[XB_XGEN(b.x)], 1u);
            asm volatile("s_waitcnt vmcnt(0)" ::: "memory");
        } else {
            XB_SPIN(xb_ld(&bar[XB_XGEN(b.x)]) == gen, bar);
            __builtin_amdgcn_fence(__ATOMIC_ACQUIRE, "agent");
            asm volatile("s_waitcnt vmcnt(0)" ::: "memory");
        }
    }
    __syncthreads();
}


constexpr size_t al256(size_t x) { return (x + 255) & ~(size_t)255; }
constexpr size_t MiB = 1u << 20;
constexpr size_t WS_CTL = 0, CTL_ZERO_BYTES = 1 * MiB;
constexpr int CW_BAR = 4096;
constexpr size_t WS_W1T = 1 * MiB;
constexpr size_t WS_W2T = WS_W1T + (size_t)EVEN_IN * D * 2;
constexpr size_t WS_W3T = WS_W2T + (size_t)D * D * 2;
constexpr size_t WS_W4T = WS_W3T + (size_t)ODD_PAD * D * 2;
constexpr size_t WS_WPT = WS_W4T + (size_t)D * D * 2;
constexpr size_t WS_XN1 = WS_WPT + (size_t)4 * PG * PG * 2;
constexpr size_t WS_U = WS_XN1 + (size_t)MT * D * 2;
constexpr size_t WS_QN = WS_U + (size_t)MT * 512 * 2;
constexpr size_t WS_KN = WS_QN + (size_t)MT * 512 * 2;
constexpr size_t WS_VB = WS_KN + (size_t)MT * 512 * 2;
constexpr size_t WS_VT = WS_VB + (size_t)MT * 512 * 2;
constexpr size_t WS_SG = WS_VT + (size_t)MP * 512 * 2;
constexpr size_t WS_MIX = WS_SG + (size_t)MT * D * 2;
constexpr size_t WS_Y1 = WS_MIX + (size_t)MT * D * 2;
constexpr size_t WS_A2 = WS_Y1 + (size_t)MT * D * 4;
constexpr size_t WS_SSP = WS_A2 + (size_t)MT * D * 2;
constexpr size_t WS_QKVP = WS_SSP + (size_t)MT * 16 * 4;
constexpr size_t WS_SZ = WS_QKVP + (size_t)MT * CONVD * 2;
constexpr size_t WS_BA = WS_SZ + (size_t)MT * D * 2;
constexpr size_t WS_A4 = WS_BA + (size_t)MT * 16 * 4;
constexpr size_t WS_SLOW = al256(WS_A4 + (size_t)MT * D * 2);
constexpr size_t NW_D = WS_SLOW;
constexpr size_t NW_C = NW_D + (size_t)MT * 512 * 4;
constexpr size_t NW_BETA = NW_C + (size_t)MT * CONVD * 4;
constexpr size_t NW_G = NW_BETA + (size_t)MT * DNH * 4;
constexpr size_t NW_O = NW_G + (size_t)MT * DNH * 4;
constexpr size_t WS_END = NW_O + (size_t)MT * D * 4;
static_assert(WS_W1T % 256 == 0 && WS_XN1 % 256 == 0 && WS_U % 256 == 0 && WS_Y1 % 256 == 0 && WS_QKVP % 256 == 0 && WS_A4 % 256 == 0, "alignment");

constexpr int RING_OFF = 0, RING_BYTES = 131072;
constexpr int LDSCTL_OFF = RING_BYTES, MISC_OFF = LDSCTL_OFF + 320;
constexpr int LDS_BYTES = 147456;
constexpr int NWAVES = 8;

struct Params { const void* in[23]; float* out; unsigned char* ws; int ph_lo, ph_hi; };
struct Frame {
    LAS unsigned char* lds;
    volatile LAS unsigned* MISC;
    gu32* ctl;
    int tid, lane, wave;
    int vcu, G;
};
__device__ __forceinline__ In make_in(const Params& P) {
    In in;
    in.x_p = (const float*)P.in[0]; in.x_s = (const float*)P.in[1]; in.cache_pool = (const float*)P.in[2]; in.cache_k = (const float*)P.in[3]; in.cache_v = (const float*)P.in[4];
    in.state_conv = (const float*)P.in[5]; in.state_delta = (const float*)P.in[6]; in.page_table = (const int*)P.in[7];
    in.norm_even = (const float*)P.in[8]; in.w_in_even = (const float*)P.in[9]; in.w_pool = (const float*)P.in[10]; in.pool_scale = (const float*)P.in[11];
    in.q_norm = (const float*)P.in[12]; in.k_norm = (const float*)P.in[13]; in.sb_bias = (const float*)P.in[14]; in.w_out_even = (const float*)P.in[15];
    in.norm_odd = (const float*)P.in[16]; in.w_in_odd = (const float*)P.in[17]; in.conv_w = (const float*)P.in[18]; in.a_log = (const float*)P.in[19];
    in.dt_bias = (const float*)P.in[20]; in.o_norm = (const float*)P.in[21]; in.w_out_odd = (const float*)P.in[22];
    return in;
}

template <int MODE>
__device__ __forceinline__ void p0_transpose_item(const float* W, int K, int ldw, int nblk, bf16* WT, LAS float* scr, int item, int lane) {
    const int kb = item / nblk, nb = item % nblk, k0 = 64 * kb, n0 = 32 * nb;
#pragma unroll 8
    for (int i = 0; i < 32; ++i) { const int kk = 2 * i + (lane >> 5); scr[kk * 33 + (lane & 31)] = W[(size_t)(k0 + kk) * ldw + n0 + (lane & 31)]; }
    LDS_WAIT(); asm volatile("" ::: "memory");
    const int c = lane & 7;
#pragma unroll
    for (int j = 0; j < 4; ++j) { const int n = (lane >> 3) + 8 * j; const LAS float* s = scr + (8 * c) * 33 + n;
        v4u o; o.x = pk2(s[0 * 33], s[1 * 33]); o.y = pk2(s[2 * 33], s[3 * 33]); o.z = pk2(s[4 * 33], s[5 * 33]); o.w = pk2(s[6 * 33], s[7 * 33]);
        const int col = n0 + n;
        const int row = MODE == 1 ? ((col & ~255) + 128 * ((col & 63) >> 5) + 32 * ((col & 255) >> 6) + (col & 31)) : col;
        *(GAS v4u*)(WT + (size_t)row * K + k0 + 8 * c) = o; }
    LDS_WAIT(); asm volatile("" ::: "memory");
}
__device__ __forceinline__ void rms_row_to_bf16(const float* xrow_, const float* g, bf16* orow, int lane) {
    const GAS f32x4* xr = (const GAS f32x4*)xrow_ + lane; const GAS f32x4* gr = (const GAS f32x4*)g + lane;
    f32x4 v[4]; float s = 0.f;
#pragma unroll
    for (int j = 0; j < 4; ++j) { v[j] = xr[64 * j]; s += (v[j].x * v[j].x + v[j].y * v[j].y) + (v[j].z * v[j].z + v[j].w * v[j].w); }
    const float rstd = rsqrtf(wave_sum(s) * (1.f / D) + EPS);
    GAS unsigned long long* o8 = (GAS unsigned long long*)orow + lane;
#pragma unroll
    for (int j = 0; j < 4; ++j) { const f32x4 gg = gr[64 * j];
        o8[64 * j] = (unsigned long long)pk2(v[j].x * rstd * gg.x, v[j].y * rstd * gg.y) | ((unsigned long long)pk2(v[j].z * rstd * gg.z, v[j].w * rstd * gg.w) << 32); }
}
__device__ __forceinline__ void p0_prologue(const Frame& F, const In& in, unsigned char* ws) {
    LAS float* scr = (LAS float*)(F.lds + RING_OFF + F.wave * 16384);
    const int gw = F.vcu * NWAVES + F.wave, NGW = F.G * NWAVES;
    bf16* W1t = (bf16*)(ws + WS_W1T); bf16* W2t = (bf16*)(ws + WS_W2T); bf16* W3t = (bf16*)(ws + WS_W3T); bf16* W4t = (bf16*)(ws + WS_W4T); bf16* Wpt = (bf16*)(ws + WS_WPT);
    constexpr int I_1 = 16 * 96, I_2 = 16 * 32, I_3 = 16 * 128, I_4 = 16 * 32, I_P = 4 * 8;
    constexpr int NITEMS = I_1 + I_2 + I_3 + I_4 + I_P;
    for (int it = gw; it < NITEMS; it += NGW) {
        int r = it;
        if (r < I_1) { p0_transpose_item<1>(in.w_in_even, D, EVEN_IN, 96, W1t, scr, r, F.lane); continue; } r -= I_1;
        if (r < I_2) { p0_transpose_item<0>(in.w_out_even, D, D, 32, W2t, scr, r, F.lane); continue; } r -= I_2;
        if (r < I_3) { p0_transpose_item<0>(in.w_in_odd, D, ODD_IN, 128, W3t, scr, r, F.lane); continue; } r -= I_3;
        if (r < I_4) { p0_transpose_item<0>(in.w_out_odd, D, D, 32, W4t, scr, r, F.lane); continue; } r -= I_4;
        { const int g = r / 8; p0_transpose_item<0>(in.w_pool + (size_t)g * PG * PG, PG, PG, 4, Wpt + (size_t)g * PG * PG, scr, r % 8, F.lane); }
    }
    const int gt = F.vcu * (NWAVES * 64) + F.tid, NGT = F.G * NWAVES * 64;
    for (int i = gt; i < 16 * D; i += NGT) { const int k = i >> 4, n = i & 15; W3t[(size_t)(4096 + n) * D + k] = (bf16)f2bf(in.w_in_odd[(size_t)k * ODD_IN + 4096 + n]); }
    for (int i = gt; i < (ODD_PAD - ODD_IN) * D / 8; i += NGT) ((GAS v4u*)(W3t + (size_t)ODD_IN * D))[i] = (v4u){0u, 0u, 0u, 0u};
    bf16* XN1 = (bf16*)(ws + WS_XN1);
    for (int m = gw; m < MT; m += NGW) rms_row_to_bf16(xrow(in, m), in.norm_even, XN1 + (size_t)m * D, F.lane);
}

namespace ep {
using pg8::Unit; using pg8::BM;
__device__ __forceinline__ v4u pack8(f32x4 a, f32x4 b) { v4u w; w.x = cvt_pk_bf16(a[0], a[1]); w.y = cvt_pk_bf16(a[2], a[3]); w.z = cvt_pk_bf16(b[0], b[1]); w.w = cvt_pk_bf16(b[2], b[3]); return w; }
__device__ __forceinline__ float silu_fast(float x) { return x * __builtin_amdgcn_rcpf(1.f + __builtin_amdgcn_exp2f(-x * LOG2E)); }
__device__ __forceinline__ f32x4 silu4(f32x4 v) { return (f32x4){silu_fast(v[0]), silu_fast(v[1]), silu_fast(v[2]), silu_fast(v[3])}; }
__device__ __forceinline__ float sq4(f32x4 v) { return (v[0] * v[0] + v[1] * v[1]) + (v[2] * v[2] + v[3] * v[3]); }

struct Epi1 {
    static constexpr bool PERM = true, AFTER_DRAIN = false;
    bf16 *U, *QN, *KN, *VB, *VT, *SG; float* out; const float *qg, *kg;
    __device__ __forceinline__ void operator()(const f32x4 (&acc)[2][2][4][2], const Unit& u, int wr, int wc, int fr, int fq) const {
        const int pn = u.pn, row0 = u.pm * BM + wr * 64 + fr, cb = 64 * wc + 8 * fq;
        if (pn < 2) {
#pragma unroll
            for (int ai = 0; ai < 2; ++ai)
#pragma unroll
                for (int m = 0; m < 4; ++m) { const int row = row0 + ai * 128 + m * 16; bf16* p = U + (size_t)row * 512 + 256 * pn + cb;
#pragma unroll
                    for (int bj = 0; bj < 2; ++bj) *(v4u*)(p + 32 * bj) = pack8(acc[ai][bj][m][0], acc[ai][bj][m][1]); }
        } else if (pn < 6) {
            const bool isq = pn < 4; const float* g = isq ? qg : kg; const int hc = 256 * (pn - (isq ? 2 : 4)) + cb;
            f32x4 gv[2][2];
#pragma unroll
            for (int bj = 0; bj < 2; ++bj)
#pragma unroll
                for (int n = 0; n < 2; ++n) gv[bj][n] = *(const f32x4*)(g + 32 * bj + 8 * fq + 4 * n);
#pragma unroll
            for (int ai = 0; ai < 2; ++ai)
#pragma unroll
                for (int m = 0; m < 4; ++m) { const int row = row0 + ai * 128 + m * 16;
                    float ss = (sq4(acc[ai][0][m][0]) + sq4(acc[ai][0][m][1])) + (sq4(acc[ai][1][m][0]) + sq4(acc[ai][1][m][1]));
                    ss += __shfl_xor(ss, 16); ss += __shfl_xor(ss, 32);
                    const float rs = rsqrtf(ss * (1.f / 64.f) + EPS) * (isq ? QSCALE : 1.f);
                    f32x4 v[2][2];
#pragma unroll
                    for (int bj = 0; bj < 2; ++bj)
#pragma unroll
                        for (int n = 0; n < 2; ++n) v[bj][n] = acc[ai][bj][m][n] * rs * gv[bj][n];
                    if (isq) {
#pragma unroll
                        for (int bj = 0; bj < 2; ++bj) *(v4u*)(QN + (size_t)row * 512 + hc + 32 * bj) = pack8(v[bj][0], v[bj][1]);
                    } else {
                        float* ko = row < MP ? out + O_KP + (size_t)row * 512 : out + O_KS + (size_t)(row - MP) * 512;
#pragma unroll
                        for (int bj = 0; bj < 2; ++bj) { *(v4u*)(KN + (size_t)row * 512 + hc + 32 * bj) = pack8(v[bj][0], v[bj][1]);
                            *(f32x4*)(ko + hc + 32 * bj) = v[bj][0]; *(f32x4*)(ko + hc + 32 * bj + 4) = v[bj][1]; }
                    } }
        } else if (pn < 8) {
            const int hc = 256 * (pn - 6) + cb, h = 4 * (pn - 6) + wc;
#pragma unroll
            for (int ai = 0; ai < 2; ++ai)
#pragma unroll
                for (int m = 0; m < 4; ++m) { const int row = row0 + ai * 128 + m * 16;
                    float* vo = row < MP ? out + O_VP + (size_t)row * 512 : out + O_VS + (size_t)(row - MP) * 512;
#pragma unroll
                    for (int bj = 0; bj < 2; ++bj) { const f32x4 a = acc[ai][bj][m][0], b = acc[ai][bj][m][1];
                        *(v4u*)(VB + (size_t)row * 512 + hc + 32 * bj) = pack8(a, b);
                        *(f32x4*)(vo + hc + 32 * bj) = a; *(f32x4*)(vo + hc + 32 * bj + 4) = b;
                        if (row < MP) { bf16* vt = VT + ((size_t)((row >> 11) * 8 + h) * 64 + 32 * bj + 8 * fq) * SEQ + (row & 2047);
#pragma unroll
                            for (int e = 0; e < 4; ++e) { vt[(size_t)e * SEQ] = (bf16)f2bf(a[e]); vt[(size_t)(4 + e) * SEQ] = (bf16)f2bf(b[e]); } } } }
        } else {
            const int hc = 256 * (pn - 8) + cb;
#pragma unroll
            for (int ai = 0; ai < 2; ++ai)
#pragma unroll
                for (int m = 0; m < 4; ++m) { const int row = row0 + ai * 128 + m * 16; bf16* p = SG + (size_t)row * 1024 + hc;
#pragma unroll
                    for (int bj = 0; bj < 2; ++bj) *(v4u*)(p + 32 * bj) = pack8(silu4(acc[ai][bj][m][0]), silu4(acc[ai][bj][m][1])); }
        }
    }
};
struct Epi4 {
    static constexpr bool PERM = true, AFTER_DRAIN = false;
    const float *xp, *xs, *g2; float* Y1; bf16* A2; float* SSP;
    __device__ __forceinline__ void operator()(const f32x4 (&acc)[2][2][4][2], const Unit& u, int wr, int wc, int fr, int fq) const {
        const int row0 = u.pm * BM + wr * 64 + fr, c0 = u.pn * BM + wc * 32 + 8 * fq;
        f32x4 gv[2][2];
#pragma unroll
        for (int bj = 0; bj < 2; ++bj)
#pragma unroll
            for (int n = 0; n < 2; ++n) gv[bj][n] = *(const f32x4*)(g2 + c0 + 128 * bj + 4 * n);
#pragma unroll
        for (int ai = 0; ai < 2; ++ai)
#pragma unroll
            for (int m = 0; m < 4; ++m) { const int row = row0 + ai * 128 + m * 16;
                const float* xr = (row < MP ? xp + (size_t)row * D : xs + (size_t)(row - MP) * D) + c0;
                float ss = 0.f;
#pragma unroll
                for (int bj = 0; bj < 2; ++bj) { const f32x4 y0 = *(const f32x4*)(xr + 128 * bj) + acc[ai][bj][m][0], y1 = *(const f32x4*)(xr + 128 * bj + 4) + acc[ai][bj][m][1];
                    *(f32x4*)(Y1 + (size_t)row * D + c0 + 128 * bj) = y0; *(f32x4*)(Y1 + (size_t)row * D + c0 + 128 * bj + 4) = y1;
                    ss += sq4(y0) + sq4(y1);
                    *(v4u*)(A2 + (size_t)row * D + c0 + 128 * bj) = pack8(y0 * gv[bj][0], y1 * gv[bj][1]); }
                ss += __shfl_xor(ss, 16); ss += __shfl_xor(ss, 32);
                if (fq == 0) SSP[(size_t)row * 16 + u.pn * 4 + wc] = ss; }
    }
};
struct Epi5 {
    static constexpr bool PERM = true, AFTER_DRAIN = false;
    const float* SSP; bf16 *QKVP, *SZ; float *BA, *out;
    __device__ __forceinline__ void operator()(const f32x4 (&acc)[2][2][4][2], const Unit& u, int wr, int wc, int fr, int fq) const {
        const int pn = u.pn, row0 = u.pm * BM + wr * 64 + fr, c0 = pn * BM + wc * 32 + 8 * fq;
#pragma unroll
        for (int ai = 0; ai < 2; ++ai)
#pragma unroll
            for (int m = 0; m < 4; ++m) { const int row = row0 + ai * 128 + m * 16;
                const f32x4* sp = (const f32x4*)(SSP + (size_t)row * 16);
                const f32x4 s0 = sp[0], s1 = sp[1], s2 = sp[2], s3 = sp[3];
                const float st = ((s0[0] + s0[1]) + (s0[2] + s0[3])) + ((s1[0] + s1[1]) + (s1[2] + s1[3])) + ((s2[0] + s2[1]) + (s2[2] + s2[3])) + ((s3[0] + s3[1]) + (s3[2] + s3[3]));
                const float rs = rsqrtf(st * (1.f / D) + EPS);
                if (pn < 12) {
                    float* cs = nullptr;
                    if (row < MP) { const int t = row & 2047; if (t >= SEQ - 3) cs = out + O_CONVP + (size_t)((row >> 11) * 3 + (t - (SEQ - 3))) * CONVD; }
                    else { const int i = (row - MP) & 3; if (i >= 1) cs = out + O_CONVS + (size_t)(((row - MP) >> 2) * 3 + (i - 1)) * CONVD; }
#pragma unroll
                    for (int bj = 0; bj < 2; ++bj) { const f32x4 a = acc[ai][bj][m][0] * rs, b = acc[ai][bj][m][1] * rs;
                        *(v4u*)(QKVP + (size_t)row * CONVD + c0 + 128 * bj) = pack8(a, b);
                        if (cs) { *(f32x4*)(cs + c0 + 128 * bj) = a; *(f32x4*)(cs + c0 + 128 * bj + 4) = b; } }
                } else if (pn < 16) {
#pragma unroll
                    for (int bj = 0; bj < 2; ++bj) *(v4u*)(SZ + (size_t)row * D + (c0 - CONVD) + 128 * bj) = pack8(silu4(acc[ai][bj][m][0] * rs), silu4(acc[ai][bj][m][1] * rs));
                } else if (wc == 0 && fq < 2) {
                    *(f32x4*)(BA + (size_t)row * 16 + 8 * fq) = acc[ai][0][m][0] * rs; *(f32x4*)(BA + (size_t)row * 16 + 8 * fq + 4) = acc[ai][0][m][1] * rs;
                } }
    }
};
struct Epi8 {
    static constexpr bool PERM = true, AFTER_DRAIN = false;
    const float* Y1; float* out;
    __device__ __forceinline__ void operator()(const f32x4 (&acc)[2][2][4][2], const Unit& u, int wr, int wc, int fr, int fq) const {
        const int row0 = u.pm * BM + wr * 64 + fr, c0 = u.pn * BM + wc * 32 + 8 * fq;
#pragma unroll
        for (int ai = 0; ai < 2; ++ai)
#pragma unroll
            for (int m = 0; m < 4; ++m) { const int row = row0 + ai * 128 + m * 16;
                const float* yr = Y1 + (size_t)row * D + c0; float* o = (row < MP ? out + O_YP + (size_t)row * D : out + O_YS + (size_t)(row - MP) * D) + c0;
#pragma unroll
                for (int bj = 0; bj < 2; ++bj) { *(f32x4*)(o + 128 * bj) = *(const f32x4*)(yr + 128 * bj) + acc[ai][bj][m][0]; *(f32x4*)(o + 128 * bj + 4) = *(const f32x4*)(yr + 128 * bj + 4) + acc[ai][bj][m][1]; } }
    }
};
}

namespace nv {
__device__ __forceinline__ void k_pool_d(const bf16* U, const float* cache_pool, float* nD, float* out, int gtid, int gthreads) {
    const size_t n = (size_t)MT * PW;
    for (size_t i = (size_t)gtid; i < n; i += (size_t)gthreads) {
        const int r = (int)(i / PW), c = (int)(i % PW), g = c / PG, w = 2 << g;
        float sum = 0.f, cnt;
        if (r < MP) {
            const int t = r % SEQ;
            for (int j = 0; j < w; ++j) if (t - j >= 0) sum += bf2f(U[(size_t)(r - j) * PW + c]);
            cnt = (float)min(t + 1, w);
        } else {
            const int s = (r - MP) / DS, t = (r - MP) % DS;
            for (int j = 0; j < w; ++j) { const int tt = t - j; sum += tt >= 0 ? bf2f(U[(size_t)(r - j) * PW + c]) : cache_pool[((size_t)s * PBUF + (PBUF + tt)) * PW + c]; }
            cnt = (float)w;
        }
        nD[i] = sum / cnt - bf2f(U[(size_t)r * PW + c]);
    }
    const size_t n2 = (size_t)BP * PBUF * PW;
    for (size_t i = (size_t)gtid; i < n2; i += (size_t)gthreads) {
        const int c = (int)(i % PW), j = (int)((i / PW) % PBUF), b = (int)(i / ((size_t)PW * PBUF));
        out[O_POOLP + i] = bf2f(U[(size_t)(b * SEQ + SEQ - PBUF + j) * PW + c]);
    }
    const size_t n3 = (size_t)DB * PBUF * PW;
    for (size_t i = (size_t)gtid; i < n3; i += (size_t)gthreads) {
        const int c = (int)(i % PW), j = (int)((i / PW) % PBUF), s = (int)(i / ((size_t)PW * PBUF));
        const int e = j + DS;
        out[O_POOLS + i] = e < PBUF ? cache_pool[((size_t)s * PBUF + e) * PW + c] : bf2f(U[(size_t)(MP + s * DS + (e - PBUF)) * PW + c]);
    }
}
__device__ __forceinline__ void k_pool_y(const float* nD, const float* w_pool, const float* scale, const bf16* SG, bf16* mix, int gtid, int gthreads) {
    const size_t n = (size_t)MT * PW;
    for (size_t i = (size_t)gtid; i < n; i += (size_t)gthreads) {
        const int r = (int)(i / PW), c = (int)(i % PW), g = c / PG, dd = c % PG;
        const float* d = nD + (size_t)r * PW + g * PG; const float* wp = w_pool + (size_t)g * PG * PG + dd;
        float s = 0.f;
        for (int k = 0; k < PG; ++k) s += d[k] * wp[(size_t)k * PG];
        mix[(size_t)r * D + c] = (bf16)f2bf(s * scale[c] * bf2f(SG[(size_t)r * D + c]));
    }
}
__device__ __forceinline__ void k_attn(const bf16* QN, const bf16* KN, const bf16* VB, const float* cache_k, const float* cache_v, const int* page_table,
                                              const float* bias, const bf16* SG, bf16* mix, int gtid, int gthreads) {
    const int lane = threadIdx.x & 63;
    const long w = gtid >> 6, nw = gthreads >> 6;
    for (long it = w; it < (long)MT * SBH; it += nw) {
        const int r = (int)(it / SBH), h = (int)(it % SBH);
        const float q = bf2f(QN[(size_t)r * 512 + h * 64 + lane]);
        const float bh = bias[h] * LOG2E;
        int nkeys, s = 0, b = 0;
        if (r < MP) { b = r / SEQ; nkeys = r % SEQ; } else { s = (r - MP) / DS; nkeys = PAST + (r - MP) % DS; }
        float R = 0.f, o = 0.f;
        for (int blk = (nkeys - 1) / 64; blk >= 0 && nkeys > 0; --blk) {
            const int j0 = blk * 64 + lane; const bool valid = j0 < nkeys;
            const int j = valid ? j0 : nkeys - 1;
            const bool is16 = (r < MP) || (j >= PAST);
            const bf16* k16 = KN + (size_t)(r < MP ? b * SEQ + j : MP + s * DS + (is16 ? j - PAST : 0)) * 512 + h * 64;
            const float* k32 = cache_k + (((size_t)page_table[s * NPAGE + (is16 ? 0 : j / PAGE)] * PAGE + (is16 ? 0 : j % PAGE)) * SBH + h) * SBD;
            float dot = 0.f;
            for (int d = 0; d < 64; ++d) { const float qd = __shfl(q, d); dot += qd * (is16 ? bf2f(k16[d]) : k32[d]); }
            const float z = valid ? dot + bh : 0.f;
            const float sp = softplus2_f(z);
            const float lk = valid ? -sp : 0.f;
            float inc = lk;
#pragma unroll
            for (int off = 1; off < 64; off <<= 1) { const float t = __shfl_down(inc, off); if (lane + off < 64) inc += t; }
            const float suffix = inc - lk + R;
            const float a = valid ? exp2f(z - sp + suffix) : 0.f;
            R += __shfl(inc, 0);
            for (int k = 0; k < 64; ++k) {
                const int jj = blk * 64 + k;
                const float ak = __shfl(a, k);
                if (jj < nkeys) {
                    float vv;
                    if (r < MP) vv = bf2f(VB[(size_t)(b * SEQ + jj) * 512 + h * 64 + lane]);
                    else if (jj < PAST) vv = cache_v[(((size_t)page_table[s * NPAGE + jj / PAGE] * PAGE + jj % PAGE) * SBH + h) * SBD + lane];
                    else vv = bf2f(VB[(size_t)(MP + s * DS + (jj - PAST)) * 512 + h * 64 + lane]);
                    o += ak * vv;
                }
            }
        }
        mix[(size_t)r * D + 512 + h * 64 + lane] = (bf16)f2bf(o * bf2f(SG[(size_t)r * D + 512 + h * 64 + lane]));
    }
}
__device__ __forceinline__ void k_conv(const bf16* QKVP, const float* state_conv, const float* conv_w, float* nC, int gtid, int gthreads) {
    const size_t n = (size_t)MT * CONVD;
    for (size_t i = (size_t)gtid; i < n; i += (size_t)gthreads) {
        const int r = (int)(i / CONVD), c = (int)(i % CONVD);
        float acc = 0.f;
        for (int j = 0; j < 4; ++j) {
            float xv;
            if (r < MP) { const int t = r % SEQ, e = t + j; xv = e >= 3 ? bf2f(QKVP[(size_t)(r - 3 + j) * CONVD + c]) : 0.f; }
            else { const int s = (r - MP) / DS, t = (r - MP) % DS, e = t + j; xv = e >= 3 ? bf2f(QKVP[(size_t)(MP + s * DS + e - 3) * CONVD + c]) : state_conv[((size_t)s * 3 + e) * CONVD + c]; }
            acc += xv * conv_w[(size_t)j * CONVD + c];
        }
        nC[i] = silu_f(acc);
    }
}
__device__ __forceinline__ void k_qknorm(float* nC, const float* BA, const float* a_log, const float* dt_bias, float* nBeta, float* nG, int gtid, int gthreads) {
    const int lane = threadIdx.x & 63;
    const long w = gtid >> 6, nw = gthreads >> 6;
    for (long it = w; it < (long)MT * DNH; it += nw) {
        const int r = (int)(it / DNH), h = (int)(it % DNH);
        float* q = nC + (size_t)r * CONVD + h * 128; float* k = q + 1024;
        const float q0 = q[lane], q1 = q[lane + 64], k0 = k[lane], k1 = k[lane + 64];
        const float qs = wave_sum(q0 * q0 + q1 * q1), ks = wave_sum(k0 * k0 + k1 * k1);
        const float qr = rsqrtf(qs + EPS) * 0.08838834764831845f, kr = rsqrtf(ks + EPS);
        q[lane] = q0 * qr; q[lane + 64] = q1 * qr; k[lane] = k0 * kr; k[lane + 64] = k1 * kr;
        if (lane == 0) {
            const float bb = BA[(size_t)r * 16 + h], aa = BA[(size_t)r * 16 + 8 + h];
            nBeta[(size_t)r * DNH + h] = 1.f / (1.f + __expf(-bb));
            nG[(size_t)r * DNH + h] = -__expf(a_log[h]) * softplus_f(aa + dt_bias[h]);
        }
    }
}
__device__ __forceinline__ void k_gdn(const float* nC, const float* nBeta, const float* nG, const float* state_delta, float* nO, float* out, LAS float* sm) {
    LAS float* sq = sm; LAS float* sk = sm + 128; LAS float (*red)[128] = (LAS float (*)[128])(sm + 256); LAS float (*red2)[128] = (LAS float (*)[128])(sm + 768);
    const int tid = threadIdx.x, e = tid & 127, part = tid >> 7;
    for (int c = blockIdx.x; c < BP * DNH + DB * DNH; c += gridDim.x) {
        int base, L, h; const float* S0 = nullptr; float* Sout;
        if (c < BP * DNH) { const int b = c / DNH; h = c % DNH; base = b * SEQ; L = SEQ; Sout = out + O_DP + (size_t)c * DNK * DNV; }
        else { const int cc = c - BP * DNH, s = cc / DNH; h = cc % DNH; base = MP + s * DS; L = DS; S0 = state_delta + (size_t)cc * DNK * DNV; Sout = out + O_DS + (size_t)cc * DNK * DNV; }
        float S[32];
#pragma unroll
        for (int i = 0; i < 32; ++i) S[i] = S0 ? S0[(size_t)(part * 32 + i) * DNV + e] : 0.f;
        for (int t = 0; t < L; ++t) {
            const int r = base + t;
            __syncthreads();
            if (tid < 128) sq[tid] = nC[(size_t)r * CONVD + h * 128 + tid];
            else if (tid < 256) sk[tid - 128] = nC[(size_t)r * CONVD + 1024 + h * 128 + (tid - 128)];
            const float v = nC[(size_t)r * CONVD + 2048 + h * 128 + e];
            const float beta = nBeta[(size_t)r * DNH + h], alpha = __expf(nG[(size_t)r * DNH + h]);
            __syncthreads();
            float ks = 0.f;
#pragma unroll
            for (int i = 0; i < 32; ++i) ks += sk[part * 32 + i] * S[i];
            red[part][e] = ks;
            __syncthreads();
            const float kS = alpha * (red[0][e] + red[1][e] + red[2][e] + red[3][e]);
            const float vn = beta * (v - kS);
            float op = 0.f;
#pragma unroll
            for (int i = 0; i < 32; ++i) { S[i] = alpha * S[i] + sk[part * 32 + i] * vn; op += sq[part * 32 + i] * S[i]; }
            red2[part][e] = op;
            __syncthreads();
            if (part == 0) nO[(size_t)r * D + h * 128 + e] = red2[0][e] + red2[1][e] + red2[2][e] + red2[3][e];
        }
#pragma unroll
        for (int i = 0; i < 32; ++i) Sout[(size_t)(part * 32 + i) * DNV + e] = S[i];
        __syncthreads();
    }
}
__device__ __forceinline__ void k_onorm(const float* nO, const bf16* SZ, const float* og, bf16* A4, int gtid, int gthreads) {
    const int lane = threadIdx.x & 63;
    const long w = gtid >> 6, nw = gthreads >> 6;
    for (long it = w; it < (long)MT * DNH; it += nw) {
        const int r = (int)(it / DNH), h = (int)(it % DNH);
        const float* o = nO + (size_t)r * D + h * 128;
        const float o0 = o[lane], o1 = o[lane + 64];
        const float ss = wave_sum(o0 * o0 + o1 * o1);
        const float rs = rsqrtf(ss / 128.f + EPS);
        const bf16* z = SZ + (size_t)r * D + h * 128;
        A4[(size_t)r * D + h * 128 + lane] = (bf16)f2bf(o0 * rs * og[lane] * bf2f(z[lane]));
        A4[(size_t)r * D + h * 128 + lane + 64] = (bf16)f2bf(o1 * rs * og[lane + 64] * bf2f(z[lane + 64]));
    }
}
}

constexpr int N_PHASES = 9;
__global__ void __launch_bounds__(NWAVES * 64, 2) fwd(Params P) {
    extern __shared__ __attribute__((aligned(16))) unsigned char lds[];
    Frame F;
    F.lds = (LAS unsigned char*)lds;
    F.MISC = (volatile LAS unsigned*)(F.lds + MISC_OFF);
    F.tid = threadIdx.x; F.lane = F.tid & 63; F.wave = __builtin_amdgcn_readfirstlane(F.tid >> 6);
    F.G = gridDim.x; { const int bx = blockIdx.x; F.vcu = (F.G % 8 == 0) ? (bx % 8) * (F.G / 8) + bx / 8 : bx; }
    unsigned char* ws = P.ws;
    F.ctl = (gu32*)(ws + WS_CTL);
    const In in = make_in(P);
    for (int u = F.tid; u < (LDS_BYTES - LDSCTL_OFF) / 4; u += NWAVES * 64) ((LAS unsigned*)(F.lds + LDSCTL_OFF))[u] = 0u;
    __syncthreads();
    const int lo = P.ph_lo, hi = P.ph_hi;
    const bool use_bar = true;
    XcdBarrier bar; bar.bar = (unsigned*)(F.ctl + CW_BAR); bar.x = 0; bar.st = nullptr;
    if (use_bar) bar = xcd_barrier_post((unsigned*)(F.ctl + CW_BAR), F.MISC + 8);
#define IN(k) (lo <= (k) && (k) < hi)
#define BOTH(k) (IN(k) && IN((k) + 1))
#define GRID_BAR() xcd_barrier(bar)

    if (IN(0)) { p0_prologue(F, in, ws); if (BOTH(0)) GRID_BAR(); }

    if (IN(1)) {
        pg8::Gemm g{(const pg8::bf16_t*)(ws + WS_XN1), (const pg8::bf16_t*)(ws + WS_W1T), MT, EVEN_IN, D}; pg8::StaticOrder S; S.init(MT, EVEN_IN, F.G, (int)blockIdx.x);
        ep::Epi1 E{(bf16*)(ws + WS_U), (bf16*)(ws + WS_QN), (bf16*)(ws + WS_KN), (bf16*)(ws + WS_VB), (bf16*)(ws + WS_VT), (bf16*)(ws + WS_SG), P.out, in.q_norm, in.k_norm};
        pg8::gemm_phase<ep::Epi1, pg8::StaticOrder, true, true>(F.lds + RING_OFF, g, S, E);
        if (BOTH(1)) GRID_BAR();
    }
    const int gtid = (int)blockIdx.x * (NWAVES * 64) + F.tid, gthreads = F.G * NWAVES * 64;
    if (IN(2)) {
        nv::k_pool_d((const bf16*)(ws + WS_U), in.cache_pool, (float*)(ws + NW_D), P.out, gtid, gthreads);
        GRID_BAR();
        nv::k_pool_y((const float*)(ws + NW_D), in.w_pool, in.pool_scale, (const bf16*)(ws + WS_SG), (bf16*)(ws + WS_MIX), gtid, gthreads);
        nv::k_attn((const bf16*)(ws + WS_QN), (const bf16*)(ws + WS_KN), (const bf16*)(ws + WS_VB), in.cache_k, in.cache_v, in.page_table, in.sb_bias, (const bf16*)(ws + WS_SG), (bf16*)(ws + WS_MIX), gtid, gthreads);
        if (BOTH(3)) GRID_BAR();
    }
    if (IN(4)) {
        pg8::Gemm g{(const pg8::bf16_t*)(ws + WS_MIX), (const pg8::bf16_t*)(ws + WS_W2T), MT, D, D}; pg8::StaticOrder S; S.init(MT, D, F.G, (int)blockIdx.x);
        ep::Epi4 E{in.x_p, in.x_s, in.norm_odd, (float*)(ws + WS_Y1), (bf16*)(ws + WS_A2), (float*)(ws + WS_SSP)};
        pg8::gemm_phase<ep::Epi4, pg8::StaticOrder, true, true>(F.lds + RING_OFF, g, S, E);
        if (BOTH(4)) GRID_BAR();
    }
    if (IN(5)) {
        pg8::Gemm g{(const pg8::bf16_t*)(ws + WS_A2), (const pg8::bf16_t*)(ws + WS_W3T), MT, ODD_PAD, D}; pg8::StaticOrder S; S.init(MT, ODD_PAD, F.G, (int)blockIdx.x);
        ep::Epi5 E{(const float*)(ws + WS_SSP), (bf16*)(ws + WS_QKVP), (bf16*)(ws + WS_SZ), (float*)(ws + WS_BA), P.out};
        pg8::gemm_phase<ep::Epi5, pg8::StaticOrder, true, true>(F.lds + RING_OFF, g, S, E);
        if (BOTH(5)) GRID_BAR();
    }
    if (IN(6)) {
        nv::k_conv((const bf16*)(ws + WS_QKVP), in.state_conv, in.conv_w, (float*)(ws + NW_C), gtid, gthreads);
        GRID_BAR();
        nv::k_qknorm((float*)(ws + NW_C), (const float*)(ws + WS_BA), in.a_log, in.dt_bias, (float*)(ws + NW_BETA), (float*)(ws + NW_G), gtid, gthreads);
        GRID_BAR();
        nv::k_gdn((const float*)(ws + NW_C), (const float*)(ws + NW_BETA), (const float*)(ws + NW_G), in.state_delta, (float*)(ws + NW_O), P.out, (LAS float*)(F.lds + RING_OFF));
        GRID_BAR();
        nv::k_onorm((const float*)(ws + NW_O), (const bf16*)(ws + WS_SZ), in.o_norm, (bf16*)(ws + WS_A4), gtid, gthreads);
        if (BOTH(7)) GRID_BAR();
    }
    if (IN(8)) {
        pg8::Gemm g{(const pg8::bf16_t*)(ws + WS_A4), (const pg8::bf16_t*)(ws + WS_W4T), MT, D, D}; pg8::StaticOrder S; S.init(MT, D, F.G, (int)blockIdx.x);
        ep::Epi8 E{(const float*)(ws + WS_Y1), P.out};
        pg8::gemm_phase<ep::Epi8, pg8::StaticOrder, true, true>(F.lds + RING_OFF, g, S, E);
    }
#undef IN
#undef BOTH
#undef GRID_BAR
}

extern "C" void kernel_launch(void* const* d_in, const int* in_sizes, int n_in, void* d_out, int out_size, void* d_ws, size_t ws_size, hipStream_t stream) {
    static int grid = 0;
    if (grid == 0) {
        if (n_in != 23 || (size_t)out_size != O_END || ws_size < WS_END) { fprintf(stderr, "kernel_launch: unexpected sizes n_in %d out %d ws %zu (need %zu)\n", n_in, out_size, ws_size, (size_t)WS_END); grid = -1; return; }
        int dev = 0, cus = 0, per_cu = 0;
        if (hipGetDevice(&dev) != hipSuccess || hipDeviceGetAttribute(&cus, hipDeviceAttributeMultiprocessorCount, dev) != hipSuccess) { grid = -1; return; }
        if (hipFuncSetAttribute((const void*)fwd, hipFuncAttributeMaxDynamicSharedMemorySize, LDS_BYTES) != hipSuccess) { fprintf(stderr, "kernel_launch: hipFuncSetAttribute failed\n"); grid = -1; return; }
        if (hipOccupancyMaxActiveBlocksPerMultiprocessor(&per_cu, (const void*)fwd, NWAVES * 64, LDS_BYTES) != hipSuccess || per_cu < 1) fprintf(stderr, "kernel_launch: occupancy query reports %d\n", per_cu);
        (void)hipGetLastError();
        grid = cus;
    }
    if (grid < 0) return;
    (void)hipMemsetAsync((char*)d_ws + WS_CTL, 0, CTL_ZERO_BYTES, stream);
    Params p{};
    for (int i = 0; i < 23; ++i) p.in[i] = d_in[i];
    p.out = (float*)d_out; p.ws = (unsigned char*)d_ws;
    In in;
    in.x_p = (const float*)d_in[0]; in.x_s = (const float*)d_in[1]; in.cache_pool = (const float*)d_in[2]; in.cache_k = (const float*)d_in[3]; in.cache_v = (const float*)d_in[4];
    in.state_conv = (const float*)d_in[5]; in.state_delta = (const float*)d_in[6]; in.page_table = (const int*)d_in[7];
    in.norm_even = (const float*)d_in[8]; in.w_in_even = (const float*)d_in[9]; in.w_pool = (const float*)d_in[10]; in.pool_scale = (const float*)d_in[11];
    in.q_norm = (const float*)d_in[12]; in.k_norm = (const float*)d_in[13]; in.sb_bias = (const float*)d_in[14]; in.w_out_even = (const float*)d_in[15];
    in.norm_odd = (const float*)d_in[16]; in.w_in_odd = (const float*)d_in[17]; in.conv_w = (const float*)d_in[18]; in.a_log = (const float*)d_in[19];
    in.dt_bias = (const float*)d_in[20]; in.o_norm = (const float*)d_in[21]; in.w_out_odd = (const float*)d_in[22];
    float* out = (float*)d_out; char* ws = (char*)d_ws;
    auto launch = [&](int lo, int hi) { p.ph_lo = lo; p.ph_hi = hi; hipLaunchKernelGGL(fwd, dim3(grid), dim3(NWAVES * 64), LDS_BYTES, stream, p); };
    launch(0, N_PHASES);
}
```

```cpp
#include <hip/hip_runtime.h>
#include <cstdio>
#include <cstdint>

constexpr int D = 1024, BP = 8, SEQ = 2048, MP = BP * SEQ;
constexpr int DB = 128, DS = 4, MS = DB * DS, MT = MP + MS;
constexpr int PAST = 2048, PAGE = 128, NPAGE = PAST / PAGE;
constexpr int PW = 512, PG = 128, PBUF = 15;
constexpr int SBH = 8, SBD = 64;
constexpr int EVEN_IN = 3072;
constexpr int DNH = 8, DNK = 128, DNV = 128, CONVD = 3072, ODD_IN = 4112, ODD_PAD = 4352;
constexpr float EPS = 1e-6f;
constexpr float LOG2E = 1.4426950408889634f;
constexpr float QSCALE = 0.125f * LOG2E;

constexpr size_t O_YP = 0;
constexpr size_t O_YS = O_YP + (size_t)MP * D;
constexpr size_t O_POOLP = O_YS + (size_t)MS * D;
constexpr size_t O_POOLS = O_POOLP + (size_t)BP * PBUF * PW;
constexpr size_t O_KP = O_POOLS + (size_t)DB * PBUF * PW;
constexpr size_t O_VP = O_KP + (size_t)MP * 512;
constexpr size_t O_KS = O_VP + (size_t)MP * 512;
constexpr size_t O_VS = O_KS + (size_t)MS * 512;
constexpr size_t O_CONVP = O_VS + (size_t)MS * 512;
constexpr size_t O_CONVS = O_CONVP + (size_t)BP * 3 * CONVD;
constexpr size_t O_DP = O_CONVS + (size_t)DB * 3 * CONVD;
constexpr size_t O_DS = O_DP + (size_t)BP * DNH * DNK * DNV;
constexpr size_t O_END = O_DS + (size_t)DB * DNH * DNK * DNV;
static_assert(O_END == 54726656, "output size");

struct In {
    const float *x_p, *x_s, *cache_pool, *cache_k, *cache_v, *state_conv, *state_delta;
    const int* page_table;
    const float *norm_even, *w_in_even, *w_pool, *pool_scale, *q_norm, *k_norm, *sb_bias, *w_out_even;
    const float *norm_odd, *w_in_odd, *conv_w, *a_log, *dt_bias, *o_norm, *w_out_odd;
};

__device__ __forceinline__ float wave_sum(float v) {
#pragma unroll
    for (int o = 1; o < 64; o <<= 1) v += __shfl_xor(v, o);
    return v;
}
__device__ __forceinline__ float silu_f(float x) { return x / (1.f + __expf(-x)); }
__device__ __forceinline__ float softplus_f(float x) { return fmaxf(x, 0.f) + log1pf(__expf(-fabsf(x))); }
__device__ __forceinline__ float softplus2_f(float z2) { return fmaxf(z2, 0.f) + __log2f(1.f + exp2f(-fabsf(z2))); }
typedef unsigned short bf16;
__device__ __forceinline__ unsigned f2bf(float f) { unsigned u = __builtin_bit_cast(unsigned, f); return (u + 0x7fffu + ((u >> 16) & 1u)) >> 16; }
__device__ __forceinline__ unsigned pk2(float lo, float hi) { return f2bf(lo) | (f2bf(hi) << 16); }
__device__ __forceinline__ float bf2f(bf16 b) { return __builtin_bit_cast(float, (unsigned)b << 16); }
__device__ __forceinline__ const float* xrow(const In& in, int r) { return r < MP ? in.x_p + (size_t)r * D : in.x_s + (size_t)(r - MP) * D; }
namespace pg8 {
#define PG8_LAS __attribute__((address_space(3)))
typedef unsigned short bf16_t;
typedef short bf16x8 __attribute__((ext_vector_type(8)));
typedef float f32x4 __attribute__((ext_vector_type(4)));
typedef unsigned u32x4 __attribute__((ext_vector_type(4)));
constexpr int BM = 256, BK = 64, HALF = 128, HTB = HALF * BK * 2  , STAGE_BYTES = 8 * HTB, NXCD = 8, WGM = 8;

__host__ __device__ __forceinline__ int lds_byte(int r, int c) { const int st = (r >> 4) * 2 + (c >> 5), rr = r & 15, cc = c & 31, ob = rr * 64 + cc * 2; return st * 1024 + (ob ^ (((ob >> 9) & 1) << 5)); }
__host__ __device__ __forceinline__ void stage_rc(int b, int& R, int& C) { const int st = b / 1024, sb = b % 1024, swz = sb ^ (((sb >> 9) & 1) << 5); R = (st >> 1) * 16 + swz / 64; C = (st & 1) * 32 + (swz % 64) / 2; }
__host__ __device__ __forceinline__ int perm32(int rho) { const int n = rho >> 4, i = rho & 15; return 8 * (i >> 2) + 4 * n + (i & 3); }

struct Unit { int pm, pn; };
struct Gemm { const bf16_t* A; const bf16_t* Bt; int M, N, K; };

struct StaticOrder {
    int nM, nN, nwg, G, c;
    __host__ __device__ void init(int M, int N, int G_, int c_) { nM = M / BM; nN = N / BM; nwg = nM * nN; G = G_; c = c_; }
    __host__ __device__ bool next(int i, Unit& u) const {
        const long L = (long)i * G + c; if (L >= nwg) return false;
        int wgid = (int)L; { const int q = nwg / NXCD, r = nwg % NXCD, xcd = wgid % NXCD, off = wgid / NXCD; wgid = (xcd < r ? xcd * (q + 1) : r * (q + 1) + (xcd - r) * q) + off; }
        const int nig = WGM * nN, gid = wgid / nig, fm = gid * WGM, gsz = (nM - fm) < WGM ? (nM - fm) : WGM;
        u.pm = fm + ((wgid % nig) % gsz); u.pn = (wgid % nig) / gsz; return true;
    }
    __device__ __forceinline__ void a_ready(const Unit&) const {}
    __device__ __forceinline__ void done(const Unit&) const {}
};

__device__ __forceinline__ unsigned cvt_pk_bf16(float lo, float hi) { unsigned r; asm volatile("v_cvt_pk_bf16_f32 %0, %1, %2" : "=v"(r) : "v"(lo), "v"(hi)); return r; }
template <class Epi, class Sched, bool ALIGN_EPI = false, bool SP2 = false>
__device__ __forceinline__ void gemm_phase(PG8_LAS unsigned char* lds, const Gemm g, const Sched& S, const Epi& E) {
    const int tid = threadIdx.x, wid = __builtin_amdgcn_readfirstlane(tid >> 6), lane = tid & 63, wr = wid >> 2, wc = wid & 3, fr = lane & 15, fq = lane >> 4;
    const int K = g.K, nt = K / BK;
    unsigned voffA[2], voffB[2];
#pragma unroll
    for (int i = 0; i < 2; ++i) { int R, C; stage_rc(tid * 16 + i * 8192, R, C); const int Rb = Epi::PERM ? ((R & ~31) + perm32(R & 31)) : R;
        voffA[i] = (unsigned)(R * K + C) * 2u; voffB[i] = (unsigned)(Rb * K + C) * 2u; }
    const size_t kstep = (size_t)(BK * 2);
    const size_t hstep = (size_t)HALF * K * 2;
    const size_t tstep = 2 * hstep;
    const unsigned ldsw = (unsigned)wid * 1024u;
    const int aoff = lds_byte(wr * 64 + fr, fq * 8), boff = lds_byte(wc * 32 + fr, fq * 8);
#define PG8_SA(b, h) (((b) * 2 + (h)) * HTB)
#define PG8_SB(b, h) ((4 + (b) * 2 + (h)) * HTB)
#define PG8_STAGE(bufoff, gbase, voff) do { _Pragma("unroll") for (int _i = 0; _i < 2; ++_i) \
        __builtin_amdgcn_global_load_lds((const unsigned*)((const char*)(gbase) + (voff)[_i]), (PG8_LAS unsigned*)(lds + (bufoff) + ldsw + _i * 8192), 16, 0, 0); } while (0)
#define PG8_LDA(dst, b, h) do { _Pragma("unroll") for (int m = 0; m < 4; ++m) _Pragma("unroll") for (int k = 0; k < 2; ++k) dst[m][k] = *(const PG8_LAS bf16x8*)(lds + PG8_SA(b, h) + aoff + m * 2048 + k * 1024); } while (0)
#define PG8_LDB(dst, b, h) do { _Pragma("unroll") for (int n = 0; n < 2; ++n) _Pragma("unroll") for (int k = 0; k < 2; ++k) dst[n][k] = *(const PG8_LAS bf16x8*)(lds + PG8_SB(b, h) + boff + n * 2048 + k * 1024); } while (0)
#define PG8_MMA(ai, bj, At, Bt) do { __builtin_amdgcn_s_setprio(1); _Pragma("unroll") for (int m = 0; m < 4; ++m) _Pragma("unroll") for (int n = 0; n < 2; ++n) _Pragma("unroll") for (int k = 0; k < 2; ++k) \
        acc[ai][bj][m][n] = __builtin_amdgcn_mfma_f32_16x16x32_bf16(Bt[n][k], At[m][k], acc[ai][bj][m][n], 0, 0, 0); __builtin_amdgcn_s_setprio(0); } while (0)
#define PG8_WAIT_V(n) asm volatile("s_waitcnt vmcnt(" #n ")" ::: "memory")
#define PG8_WAIT_L(n) asm volatile("s_waitcnt lgkmcnt(" #n ")" ::: "memory")
#define PG8_BAR __builtin_amdgcn_s_barrier()
#define PG8_SCHED __builtin_amdgcn_sched_barrier(0)
    Unit cur, nxt; int ui = 0;
    if (!S.next(0, cur)) return;
    f32x4 acc[2][2][4][2];
#pragma unroll
    for (int a = 0; a < 2; ++a)
#pragma unroll
        for (int b = 0; b < 2; ++b)
#pragma unroll
            for (int m = 0; m < 4; ++m)
#pragma unroll
                for (int n = 0; n < 2; ++n) acc[a][b][m][n] = (f32x4){0.f, 0.f, 0.f, 0.f};
    bf16x8 At[4][2], B0[2][2], B1[2][2];
    const char* cA = (const char*)g.A + (size_t)cur.pm * tstep; const char* cB = (const char*)g.Bt + (size_t)cur.pn * tstep;
    S.a_ready(cur);
    if constexpr (SP2) {
        PG8_STAGE(PG8_SB(0, 0), cB, voffB); PG8_STAGE(PG8_SB(0, 1), cB + hstep, voffB); PG8_STAGE(PG8_SA(0, 0), cA, voffA); PG8_STAGE(PG8_SA(0, 1), cA + hstep, voffA);
        if (wr == 1) PG8_BAR;
        PG8_WAIT_V(2); PG8_BAR;
        PG8_STAGE(PG8_SB(1, 0), cB + kstep, voffB); PG8_STAGE(PG8_SA(1, 0), cA + kstep, voffA); PG8_STAGE(PG8_SB(1, 1), cB + hstep + kstep, voffB);
        PG8_WAIT_V(6); PG8_BAR;
    } else {
        PG8_STAGE(PG8_SB(0, 0), cB, voffB); PG8_STAGE(PG8_SA(0, 0), cA, voffA); PG8_STAGE(PG8_SB(0, 1), cB + hstep, voffB); PG8_STAGE(PG8_SA(0, 1), cA + hstep, voffA);
        if (wr == 1) PG8_BAR;
        PG8_WAIT_V(4); PG8_BAR;
        PG8_STAGE(PG8_SB(1, 0), cB + kstep, voffB); PG8_STAGE(PG8_SA(1, 0), cA + kstep, voffA); PG8_STAGE(PG8_SB(1, 1), cB + hstep + kstep, voffB);
        PG8_WAIT_V(6); PG8_BAR;
    }
    for (;;) {
        const bool has_next = S.next(ui + 1, nxt);
        const char* nA = has_next ? (const char*)g.A + (size_t)nxt.pm * tstep : cA; const char* nB = has_next ? (const char*)g.Bt + (size_t)nxt.pn * tstep : cB;
        for (int t = 0; t < nt; t += 2) {
            const bool last = (t == nt - 2);
            const char* a1 = cA + (size_t)(t + 1) * kstep;
            const char* a2 = last ? nA : cA + (size_t)(t + 2) * kstep; const char* b2 = last ? nB : cB + (size_t)(t + 2) * kstep;
            const char* a3 = a2 + kstep; const char* b3 = b2 + kstep;
            if (last && has_next) S.a_ready(nxt);
            if constexpr (SP2) {
            PG8_LDB(B0, 0, 0); PG8_LDB(B1, 0, 1); PG8_SCHED; PG8_LDA(At, 0, 0); PG8_STAGE(PG8_SA(1, 1), a1 + hstep, voffA);
            PG8_WAIT_V(8); PG8_WAIT_L(0); PG8_BAR; PG8_MMA(0, 0, At, B0); PG8_MMA(0, 1, At, B1); PG8_BAR; PG8_SCHED;
            PG8_LDA(At, 0, 1); PG8_STAGE(PG8_SB(0, 0), b2, voffB); PG8_STAGE(PG8_SB(0, 1), b2 + hstep, voffB); PG8_STAGE(PG8_SA(0, 0), a2, voffA);
            PG8_WAIT_V(8); PG8_WAIT_L(0); PG8_BAR; PG8_MMA(1, 0, At, B0); PG8_MMA(1, 1, At, B1); PG8_BAR; PG8_SCHED;
            PG8_LDB(B0, 1, 0); PG8_LDB(B1, 1, 1); PG8_SCHED; PG8_LDA(At, 1, 0); PG8_STAGE(PG8_SA(0, 1), a2 + hstep, voffA);
            PG8_WAIT_V(8); PG8_WAIT_L(0); PG8_BAR; PG8_MMA(0, 0, At, B0); PG8_MMA(0, 1, At, B1); PG8_BAR; PG8_SCHED;
            PG8_LDA(At, 1, 1); PG8_STAGE(PG8_SB(1, 0), b3, voffB); PG8_STAGE(PG8_SB(1, 1), b3 + hstep, voffB); PG8_STAGE(PG8_SA(1, 0), a3, voffA);
            PG8_WAIT_V(8); PG8_WAIT_L(0); PG8_BAR; PG8_MMA(1, 0, At, B0); PG8_MMA(1, 1, At, B1); PG8_BAR; PG8_SCHED;
            } else {
            PG8_LDB(B0, 0, 0); PG8_SCHED; PG8_LDA(At, 0, 0); PG8_STAGE(PG8_SA(1, 1), a1 + hstep, voffA);
            PG8_WAIT_L(8); PG8_BAR; PG8_WAIT_L(0); PG8_MMA(0, 0, At, B0); PG8_BAR; PG8_SCHED;
            PG8_LDB(B1, 0, 1); PG8_STAGE(PG8_SB(0, 0), b2, voffB);
            PG8_BAR; PG8_WAIT_L(0); PG8_MMA(0, 1, At, B1); PG8_BAR;
            PG8_LDA(At, 0, 1); PG8_STAGE(PG8_SA(0, 0), a2, voffA);
            PG8_BAR; PG8_WAIT_L(0); PG8_MMA(1, 0, At, B0); PG8_BAR; PG8_SCHED;
            PG8_STAGE(PG8_SB(0, 1), b2 + hstep, voffB);
            PG8_WAIT_V(6); PG8_BAR; PG8_MMA(1, 1, At, B1); PG8_BAR;
            PG8_LDB(B0, 1, 0); PG8_SCHED; PG8_LDA(At, 1, 0); PG8_STAGE(PG8_SA(0, 1), a2 + hstep, voffA);
            PG8_WAIT_L(8); PG8_BAR; PG8_WAIT_L(0); PG8_MMA(0, 0, At, B0); PG8_BAR; PG8_SCHED;
            PG8_LDB(B1, 1, 1); PG8_STAGE(PG8_SB(1, 0), b3, voffB);
            PG8_BAR; PG8_WAIT_L(0); PG8_MMA(0, 1, At, B1); PG8_BAR;
            PG8_LDA(At, 1, 1); PG8_STAGE(PG8_SA(1, 0), a3, voffA);
            PG8_BAR; PG8_WAIT_L(0); PG8_MMA(1, 0, At, B0); PG8_BAR; PG8_SCHED;
            PG8_STAGE(PG8_SB(1, 1), b3 + hstep, voffB);
            PG8_WAIT_V(6); PG8_BAR; PG8_MMA(1, 1, At, B1); PG8_BAR;
            }
        }
        if constexpr (ALIGN_EPI) { if (wr == 0) PG8_BAR; }
        if constexpr (!Epi::AFTER_DRAIN) { E(acc, cur, wr, wc, fr, fq); S.done(cur); }
        if (!has_next) break;
#pragma unroll
        for (int a = 0; a < 2; ++a)
#pragma unroll
            for (int b = 0; b < 2; ++b)
#pragma unroll
                for (int m = 0; m < 4; ++m)
#pragma unroll
                    for (int n = 0; n < 2; ++n) acc[a][b][m][n] = (f32x4){0.f, 0.f, 0.f, 0.f};
        cur = nxt; cA = nA; cB = nB; ++ui;
        if constexpr (ALIGN_EPI) { if (wr == 1) PG8_BAR; }
    }
    PG8_WAIT_V(0);
    if constexpr (!ALIGN_EPI) { if (wr == 0) PG8_BAR; }
    PG8_BAR;
    if constexpr (Epi::AFTER_DRAIN) { E.fused(acc, cur, wr, wc, fr, fq, lds, wid, lane); S.done(cur); }
#undef PG8_SA
#undef PG8_SB
#undef PG8_STAGE
#undef PG8_LDA
#undef PG8_LDB
#undef PG8_MMA
#undef PG8_WAIT_V
#undef PG8_WAIT_L
#undef PG8_BAR
#undef PG8_SCHED
}
}

#define GAS __attribute__((address_space(1)))
#define LAS __attribute__((address_space(3)))
typedef unsigned v4u __attribute__((ext_vector_type(4)));
typedef unsigned v2u __attribute__((ext_vector_type(2)));
typedef float f32x4 __attribute__((ext_vector_type(4)));
typedef float f32x16 __attribute__((ext_vector_type(16)));
typedef short bf16x8 __attribute__((ext_vector_type(8)));
typedef short bf16x4 __attribute__((ext_vector_type(4)));
typedef GAS unsigned gu32;
#define RLX_AGENT __ATOMIC_RELAXED, __HIP_MEMORY_SCOPE_AGENT
#define LDS_WAIT() asm volatile("s_waitcnt lgkmcnt(0)" ::: "memory")
#define VM_WAIT() asm volatile("s_waitcnt vmcnt(0)" ::: "memory")
using pg8::cvt_pk_bf16;
#define XB_TMO      128
#define XB_XCNT(j)  (256  + 64 * (j))
#define XB_XSUB(j)  (1280 + 64 * (j))
#define XB_XGEN(j)  (2304 + 64 * (j))
#define XB_TOP      3328
#define XB_TOPGEN   3392
#define XCD_BAR_WORDS 3456
#define XB_SPIN_CAP (1u << 18)

__device__ __forceinline__ unsigned xb_ld(unsigned* p)              { return __hip_atomic_load(p, __ATOMIC_RELAXED, __HIP_MEMORY_SCOPE_AGENT); }
__device__ __forceinline__ unsigned xb_add(unsigned* p, unsigned v) { return __hip_atomic_fetch_add(p, v, __ATOMIC_RELAXED, __HIP_MEMORY_SCOPE_AGENT); }
__device__ __forceinline__ unsigned xb_xcc_id() { return (unsigned)__builtin_amdgcn_s_getreg((3 << 11) | 20) & 0xFu; }
#define XB_SPIN(cond, bar) do { unsigned _sp = 0; while (cond) { __builtin_amdgcn_s_sleep(1); \
    if ((++_sp & 255u) == 0u) { if (xb_ld(&(bar)[XB_TMO])) break; if (_sp > XB_SPIN_CAP) { atomicAdd(&(bar)[XB_TMO], 1u); break; } } } } while (0)

struct XcdBarrier {
    unsigned* bar; unsigned x;
    volatile LAS unsigned* st;
};

__device__ __forceinline__ XcdBarrier xcd_barrier_post(unsigned* bar, volatile LAS unsigned* st) {
    XcdBarrier b; b.bar = bar; b.x = xb_xcc_id(); b.st = st;
    if (threadIdx.x == 0) (void)xb_add(&bar[XB_XCNT(b.x)], 1u);
    return b;
}
__device__ __forceinline__ void xcd_barrier_complete(unsigned* bar, unsigned x, unsigned& nloc, unsigned& nx) {
    const unsigned G = gridDim.x * gridDim.y * gridDim.z;
    unsigned sum, cnt, mine, sp = 0u;
    for (;;) {
        sum = 0u; cnt = 0u; mine = 0u;
#pragma unroll
        for (unsigned j = 0; j < 16; ++j) { const unsigned c = xb_ld(&bar[XB_XCNT(j)]); sum += c; cnt += (c > 0u) ? 1u : 0u; mine = (j == x) ? c : mine; }
        if (sum == G) break;
        __builtin_amdgcn_s_sleep(1);
        if ((++sp & 255u) == 0u) { if (xb_ld(&bar[XB_TMO])) break; if (sp > XB_SPIN_CAP) { atomicAdd(&bar[XB_TMO], 1u); break; } }
    }
    nloc = mine > 0u ? mine : 1u; nx = cnt > 0u ? cnt : 1u;
}

__device__ __forceinline__ void xcd_barrier(const XcdBarrier& b) {
    asm volatile("s_waitcnt vmcnt(0)" ::: "memory");
    __syncthreads();
    if (threadIdx.x == 0) {
        unsigned* bar = b.bar;
        __builtin_amdgcn_s_waitcnt(0);
        unsigned nloc = b.st[0], nx = b.st[1];
        if (nloc == 0u) { xcd_barrier_complete(bar, b.x, nloc, nx); b.st[0] = nloc; b.st[1] = nx; }
        const unsigned old = xb_add(&bar[XB_XSUB(b.x)], 1u);
        const unsigned gen = old / nloc;
        if (old + 1u == (gen + 1u) * nloc) {
            __builtin_amdgcn_fence(__ATOMIC_RELEASE, "agent");
            asm volatile("s_waitcnt vmcnt(0)" ::: "memory");
            const unsigned og = xb_add(&bar[XB_TOP], 1u);
            const unsigned tg = og / nx;
            if (og + 1u == (tg + 1u) * nx) xb_add(&bar[XB_TOPGEN], 1u);
            else XB_SPIN(xb_ld(&bar[XB_TOPGEN]) == tg, bar);
            __builtin_amdgcn_fence(__ATOMIC_ACQUIRE, "agent");
            xb_add(&bar[XB_XGEN(b.x)], 1u);
            asm volatile("s_waitcnt vmcnt(0)" ::: "memory");
        } else {
            XB_SPIN(xb_ld(&bar[XB_XGEN(b.x)]) == gen, bar);
            __builtin_amdgcn_fence(__ATOMIC_ACQUIRE, "agent");
            asm volatile("s_waitcnt vmcnt(0)" ::: "memory");
        }
    }
    __syncthreads();
}


constexpr size_t al256(size_t x) { return (x + 255) & ~(size_t)255; }
constexpr size_t MiB = 1u << 20;
constexpr size_t WS_CTL = 0, CTL_ZERO_BYTES = 1 * MiB;
constexpr int CW_BAR = 4096, CW_DBG = 64;
#ifndef DBG_CHECK
#define DBG_CHECK 0
#endif
#ifndef DBG_WHICH
#define DBG_WHICH 2
#endif
constexpr size_t WS_W1T = 1 * MiB;
constexpr size_t WS_W2T = WS_W1T + (size_t)EVEN_IN * D * 2;
constexpr size_t WS_W3T = WS_W2T + (size_t)D * D * 2;
constexpr size_t WS_W4T = WS_W3T + (size_t)ODD_PAD * D * 2;
constexpr size_t WS_WPT = WS_W4T + (size_t)D * D * 2;
constexpr size_t WS_XN1 = WS_WPT + (size_t)4 * PG * PG * 2;
constexpr size_t WS_U = WS_XN1 + (size_t)MT * D * 2;
constexpr size_t WS_QN = WS_U + (size_t)MT * 512 * 2;
constexpr size_t WS_KN = WS_QN + (size_t)MT * 512 * 2;
constexpr size_t WS_VB = WS_KN + (size_t)MT * 512 * 2;
constexpr size_t WS_VT = WS_VB + (size_t)MT * 512 * 2;
constexpr size_t WS_SG = WS_VT + (size_t)MP * 512 * 2;
constexpr size_t WS_MIX = WS_SG + (size_t)MT * D * 2;
constexpr size_t WS_Y1 = WS_MIX + (size_t)MT * D * 2;
constexpr size_t WS_A2 = WS_Y1 + (size_t)MT * D * 4;
constexpr size_t WS_SSP = WS_A2 + (size_t)MT * D * 2;
constexpr size_t WS_QKVP = WS_SSP + (size_t)MT * 16 * 4;
constexpr size_t WS_SZ = WS_QKVP + (size_t)MT * CONVD * 2;
constexpr size_t WS_BA = WS_SZ + (size_t)MT * D * 2;
constexpr size_t WS_A4 = WS_BA + (size_t)MT * 16 * 4;
constexpr size_t WS_SLOW = al256(WS_A4 + (size_t)MT * D * 2);
constexpr size_t NW_D = WS_SLOW;
constexpr size_t NW_C = NW_D + (size_t)MT * 512 * 4;
constexpr size_t NW_BETA = NW_C + (size_t)MT * CONVD * 4;
constexpr size_t NW_G = NW_BETA + (size_t)MT * DNH * 4;
constexpr size_t NW_O = NW_G + (size_t)MT * DNH * 4;
constexpr size_t WS_END = NW_O + (size_t)MT * D * 4;
static_assert(WS_W1T % 256 == 0 && WS_XN1 % 256 == 0 && WS_U % 256 == 0 && WS_Y1 % 256 == 0 && WS_QKVP % 256 == 0 && WS_A4 % 256 == 0, "alignment");

constexpr int RING_OFF = 0, RING_BYTES = 131072;
constexpr int LDSCTL_OFF = RING_BYTES, MISC_OFF = LDSCTL_OFF + 320;
constexpr int LDS_BYTES = 147456;
constexpr int NWAVES = 8;

struct Params { const void* in[23]; float* out; unsigned char* ws; int ph_lo, ph_hi; };
struct Frame {
    LAS unsigned char* lds;
    volatile LAS unsigned* MISC;
    gu32* ctl;
    int tid, lane, wave;
    int vcu, G;
};
__device__ __forceinline__ In make_in(const Params& P) {
    In in;
    in.x_p = (const float*)P.in[0]; in.x_s = (const float*)P.in[1]; in.cache_pool = (const float*)P.in[2]; in.cache_k = (const float*)P.in[3]; in.cache_v = (const float*)P.in[4];
    in.state_conv = (const float*)P.in[5]; in.state_delta = (const float*)P.in[6]; in.page_table = (const int*)P.in[7];
    in.norm_even = (const float*)P.in[8]; in.w_in_even = (const float*)P.in[9]; in.w_pool = (const float*)P.in[10]; in.pool_scale = (const float*)P.in[11];
    in.q_norm = (const float*)P.in[12]; in.k_norm = (const float*)P.in[13]; in.sb_bias = (const float*)P.in[14]; in.w_out_even = (const float*)P.in[15];
    in.norm_odd = (const float*)P.in[16]; in.w_in_odd = (const float*)P.in[17]; in.conv_w = (const float*)P.in[18]; in.a_log = (const float*)P.in[19];
    in.dt_bias = (const float*)P.in[20]; in.o_norm = (const float*)P.in[21]; in.w_out_odd = (const float*)P.in[22];
    return in;
}

template <int MODE>
__device__ __forceinline__ void p0_transpose_item(const float* W, int K, int ldw, int nblk, bf16* WT, LAS float* scr, int item, int lane) {
    const int kb = item / nblk, nb = item % nblk, k0 = 64 * kb, n0 = 32 * nb;
#pragma unroll 8
    for (int i = 0; i < 32; ++i) { const int kk = 2 * i + (lane >> 5); scr[kk * 33 + (lane & 31)] = W[(size_t)(k0 + kk) * ldw + n0 + (lane & 31)]; }
    LDS_WAIT(); asm volatile("" ::: "memory");
    const int c = lane & 7;
#pragma unroll
    for (int j = 0; j < 4; ++j) { const int n = (lane >> 3) + 8 * j; const LAS float* s = scr + (8 * c) * 33 + n;
        v4u o; o.x = pk2(s[0 * 33], s[1 * 33]); o.y = pk2(s[2 * 33], s[3 * 33]); o.z = pk2(s[4 * 33], s[5 * 33]); o.w = pk2(s[6 * 33], s[7 * 33]);
        const int col = n0 + n;
        const int row = MODE == 1 ? ((col & ~255) + 128 * ((col & 63) >> 5) + 32 * ((col & 255) >> 6) + (col & 31)) : col;
        *(GAS v4u*)(WT + (size_t)row * K + k0 + 8 * c) = o; }
    LDS_WAIT(); asm volatile("" ::: "memory");
}
__device__ __forceinline__ void rms_row_to_bf16(const float* xrow_, const float* g, bf16* orow, int lane) {
    const GAS f32x4* xr = (const GAS f32x4*)xrow_ + lane; const GAS f32x4* gr = (const GAS f32x4*)g + lane;
    f32x4 v[4]; float s = 0.f;
#pragma unroll
    for (int j = 0; j < 4; ++j) { v[j] = xr[64 * j]; s += (v[j].x * v[j].x + v[j].y * v[j].y) + (v[j].z * v[j].z + v[j].w * v[j].w); }
    const float rstd = rsqrtf(wave_sum(s) * (1.f / D) + EPS);
    GAS unsigned long long* o8 = (GAS unsigned long long*)orow + lane;
#pragma unroll
    for (int j = 0; j < 4; ++j) { const f32x4 gg = gr[64 * j];
        o8[64 * j] = (unsigned long long)pk2(v[j].x * rstd * gg.x, v[j].y * rstd * gg.y) | ((unsigned long long)pk2(v[j].z * rstd * gg.z, v[j].w * rstd * gg.w) << 32); }
}
__device__ __forceinline__ void p0_prologue(const Frame& F, const In& in, unsigned char* ws) {
    LAS float* scr = (LAS float*)(F.lds + RING_OFF + F.wave * 16384);
    const int gw = F.vcu * NWAVES + F.wave, NGW = F.G * NWAVES;
    bf16* W1t = (bf16*)(ws + WS_W1T); bf16* W2t = (bf16*)(ws + WS_W2T); bf16* W3t = (bf16*)(ws + WS_W3T); bf16* W4t = (bf16*)(ws + WS_W4T); bf16* Wpt = (bf16*)(ws + WS_WPT);
    constexpr int I_1 = 16 * 96, I_2 = 16 * 32, I_3 = 16 * 128, I_4 = 16 * 32, I_P = 4 * 8;
    constexpr int NITEMS = I_1 + I_2 + I_3 + I_4 + I_P;
    for (int it = gw; it < NITEMS; it += NGW) {
        int r = it;
        if (r < I_1) { p0_transpose_item<1>(in.w_in_even, D, EVEN_IN, 96, W1t, scr, r, F.lane); continue; } r -= I_1;
        if (r < I_2) { p0_transpose_item<0>(in.w_out_even, D, D, 32, W2t, scr, r, F.lane); continue; } r -= I_2;
        if (r < I_3) { p0_transpose_item<0>(in.w_in_odd, D, ODD_IN, 128, W3t, scr, r, F.lane); continue; } r -= I_3;
        if (r < I_4) { p0_transpose_item<0>(in.w_out_odd, D, D, 32, W4t, scr, r, F.lane); continue; } r -= I_4;
        { const int g = r / 8; p0_transpose_item<0>(in.w_pool + (size_t)g * PG * PG, PG, PG, 4, Wpt + (size_t)g * PG * PG, scr, r % 8, F.lane); }
    }
    const int gt = F.vcu * (NWAVES * 64) + F.tid, NGT = F.G * NWAVES * 64;
    for (int i = gt; i < 16 * D; i += NGT) { const int k = i >> 4, n = i & 15; W3t[(size_t)(4096 + n) * D + k] = (bf16)f2bf(in.w_in_odd[(size_t)k * ODD_IN + 4096 + n]); }
    for (int i = gt; i < (ODD_PAD - ODD_IN) * D / 8; i += NGT) ((GAS v4u*)(W3t + (size_t)ODD_IN * D))[i] = (v4u){0u, 0u, 0u, 0u};
    bf16* XN1 = (bf16*)(ws + WS_XN1);
    for (int m = gw; m < MT; m += NGW) rms_row_to_bf16(xrow(in, m), in.norm_even, XN1 + (size_t)m * D, F.lane);
}

namespace ep {
using pg8::Unit; using pg8::BM;
__device__ __forceinline__ v4u pack8(f32x4 a, f32x4 b) { v4u w; w.x = cvt_pk_bf16(a[0], a[1]); w.y = cvt_pk_bf16(a[2], a[3]); w.z = cvt_pk_bf16(b[0], b[1]); w.w = cvt_pk_bf16(b[2], b[3]); return w; }
__device__ __forceinline__ float silu_fast(float x) { return x * __builtin_amdgcn_rcpf(1.f + __builtin_amdgcn_exp2f(-x * LOG2E)); }
__device__ __forceinline__ f32x4 silu4(f32x4 v) { return (f32x4){silu_fast(v[0]), silu_fast(v[1]), silu_fast(v[2]), silu_fast(v[3])}; }
__device__ __forceinline__ float sq4(f32x4 v) { return (v[0] * v[0] + v[1] * v[1]) + (v[2] * v[2] + v[3] * v[3]); }

struct Epi1 {
    static constexpr bool PERM = true, AFTER_DRAIN = false;
    bf16 *U, *QN, *KN, *VB, *VT, *SG; float* out; const float *qg, *kg;
    __device__ __forceinline__ void operator()(const f32x4 (&acc)[2][2][4][2], const Unit& u, int wr, int wc, int fr, int fq) const {
        const int pn = u.pn, row0 = u.pm * BM + wr * 64 + fr, cb = 64 * wc + 8 * fq;
        if (pn < 2) {
#pragma unroll
            for (int ai = 0; ai < 2; ++ai)
#pragma unroll
                for (int m = 0; m < 4; ++m) { const int row = row0 + ai * 128 + m * 16; bf16* p = U + (size_t)row * 512 + 256 * pn + cb;
#pragma unroll
                    for (int bj = 0; bj < 2; ++bj) *(v4u*)(p + 32 * bj) = pack8(acc[ai][bj][m][0], acc[ai][bj][m][1]); }
        } else if (pn < 6) {
            const bool isq = pn < 4; const float* g = isq ? qg : kg; const int hc = 256 * (pn - (isq ? 2 : 4)) + cb;
            f32x4 gv[2][2];
#pragma unroll
            for (int bj = 0; bj < 2; ++bj)
#pragma unroll
                for (int n = 0; n < 2; ++n) gv[bj][n] = *(const f32x4*)(g + 32 * bj + 8 * fq + 4 * n);
#pragma unroll
            for (int ai = 0; ai < 2; ++ai)
#pragma unroll
                for (int m = 0; m < 4; ++m) { const int row = row0 + ai * 128 + m * 16;
                    float ss = (sq4(acc[ai][0][m][0]) + sq4(acc[ai][0][m][1])) + (sq4(acc[ai][1][m][0]) + sq4(acc[ai][1][m][1]));
                    ss += __shfl_xor(ss, 16); ss += __shfl_xor(ss, 32);
                    const float rs = rsqrtf(ss * (1.f / 64.f) + EPS) * (isq ? QSCALE : 1.f);
                    f32x4 v[2][2];
#pragma unroll
                    for (int bj = 0; bj < 2; ++bj)
#pragma unroll
                        for (int n = 0; n < 2; ++n) v[bj][n] = acc[ai][bj][m][n] * rs * gv[bj][n];
                    if (isq) {
#pragma unroll
                        for (int bj = 0; bj < 2; ++bj) *(v4u*)(QN + (size_t)row * 512 + hc + 32 * bj) = pack8(v[bj][0], v[bj][1]);
                    } else {
                        float* ko = row < MP ? out + O_KP + (size_t)row * 512 : out + O_KS + (size_t)(row - MP) * 512;
#pragma unroll
                        for (int bj = 0; bj < 2; ++bj) { *(v4u*)(KN + (size_t)row * 512 + hc + 32 * bj) = pack8(v[bj][0], v[bj][1]);
                            *(f32x4*)(ko + hc + 32 * bj) = v[bj][0]; *(f32x4*)(ko + hc + 32 * bj + 4) = v[bj][1]; }
                    } }
        } else if (pn < 8) {
            const int hc = 256 * (pn - 6) + cb, h = 4 * (pn - 6) + wc;
#pragma unroll
            for (int ai = 0; ai < 2; ++ai)
#pragma unroll
                for (int m = 0; m < 4; ++m) { const int row = row0 + ai * 128 + m * 16;
                    float* vo = row < MP ? out + O_VP + (size_t)row * 512 : out + O_VS + (size_t)(row - MP) * 512;
#pragma unroll
                    for (int bj = 0; bj < 2; ++bj) { const f32x4 a = acc[ai][bj][m][0], b = acc[ai][bj][m][1];
                        *(v4u*)(VB + (size_t)row * 512 + hc + 32 * bj) = pack8(a, b);
                        *(f32x4*)(vo + hc + 32 * bj) = a; *(f32x4*)(vo + hc + 32 * bj + 4) = b;
                        if (row < MP) { bf16* vt = VT + ((size_t)((row >> 11) * 8 + h) * 64 + 32 * bj + 8 * fq) * SEQ + (row & 2047);
#pragma unroll
                            for (int e = 0; e < 4; ++e) { vt[(size_t)e * SEQ] = (bf16)f2bf(a[e]); vt[(size_t)(4 + e) * SEQ] = (bf16)f2bf(b[e]); } } } }
        } else {
            const int hc = 256 * (pn - 8) + cb;
#pragma unroll
            for (int ai = 0; ai < 2; ++ai)
#pragma unroll
                for (int m = 0; m < 4; ++m) { const int row = row0 + ai * 128 + m * 16; bf16* p = SG + (size_t)row * 1024 + hc;
#pragma unroll
                    for (int bj = 0; bj < 2; ++bj) *(v4u*)(p + 32 * bj) = pack8(silu4(acc[ai][bj][m][0]), silu4(acc[ai][bj][m][1])); }
        }
    }
};
struct Epi4 {
    static constexpr bool PERM = true, AFTER_DRAIN = false;
    const float *xp, *xs, *g2; float* Y1; bf16* A2; float* SSP;
    __device__ __forceinline__ void operator()(const f32x4 (&acc)[2][2][4][2], const Unit& u, int wr, int wc, int fr, int fq) const {
        const int row0 = u.pm * BM + wr * 64 + fr, c0 = u.pn * BM + wc * 32 + 8 * fq;
        f32x4 gv[2][2];
#pragma unroll
        for (int bj = 0; bj < 2; ++bj)
#pragma unroll
            for (int n = 0; n < 2; ++n) gv[bj][n] = *(const f32x4*)(g2 + c0 + 128 * bj + 4 * n);
#pragma unroll
        for (int ai = 0; ai < 2; ++ai)
#pragma unroll
            for (int m = 0; m < 4; ++m) { const int row = row0 + ai * 128 + m * 16;
                const float* xr = (row < MP ? xp + (size_t)row * D : xs + (size_t)(row - MP) * D) + c0;
                float ss = 0.f;
#pragma unroll
                for (int bj = 0; bj < 2; ++bj) { const f32x4 y0 = *(const f32x4*)(xr + 128 * bj) + acc[ai][bj][m][0], y1 = *(const f32x4*)(xr + 128 * bj + 4) + acc[ai][bj][m][1];
                    *(f32x4*)(Y1 + (size_t)row * D + c0 + 128 * bj) = y0; *(f32x4*)(Y1 + (size_t)row * D + c0 + 128 * bj + 4) = y1;
                    ss += sq4(y0) + sq4(y1);
                    *(v4u*)(A2 + (size_t)row * D + c0 + 128 * bj) = pack8(y0 * gv[bj][0], y1 * gv[bj][1]); }
                ss += __shfl_xor(ss, 16); ss += __shfl_xor(ss, 32);
                if (fq == 0) SSP[(size_t)row * 16 + u.pn * 4 + wc] = ss; }
    }
};
struct Epi5 {
    static constexpr bool PERM = true, AFTER_DRAIN = false;
    const float* SSP; bf16 *QKVP, *SZ; float *BA, *out;
    __device__ __forceinline__ void operator()(const f32x4 (&acc)[2][2][4][2], const Unit& u, int wr, int wc, int fr, int fq) const {
        const int pn = u.pn, row0 = u.pm * BM + wr * 64 + fr, c0 = pn * BM + wc * 32 + 8 * fq;
#pragma unroll
        for (int ai = 0; ai < 2; ++ai)
#pragma unroll
            for (int m = 0; m < 4; ++m) { const int row = row0 + ai * 128 + m * 16;
                const f32x4* sp = (const f32x4*)(SSP + (size_t)row * 16);
                const f32x4 s0 = sp[0], s1 = sp[1], s2 = sp[2], s3 = sp[3];
                const float st = ((s0[0] + s0[1]) + (s0[2] + s0[3])) + ((s1[0] + s1[1]) + (s1[2] + s1[3])) + ((s2[0] + s2[1]) + (s2[2] + s2[3])) + ((s3[0] + s3[1]) + (s3[2] + s3[3]));
                const float rs = rsqrtf(st * (1.f / D) + EPS);
                if (pn < 12) {
                    float* cs = nullptr;
                    if (row < MP) { const int t = row & 2047; if (t >= SEQ - 3) cs = out + O_CONVP + (size_t)((row >> 11) * 3 + (t - (SEQ - 3))) * CONVD; }
                    else { const int i = (row - MP) & 3; if (i >= 1) cs = out + O_CONVS + (size_t)(((row - MP) >> 2) * 3 + (i - 1)) * CONVD; }
#pragma unroll
                    for (int bj = 0; bj < 2; ++bj) { const f32x4 a = acc[ai][bj][m][0] * rs, b = acc[ai][bj][m][1] * rs;
                        *(v4u*)(QKVP + (size_t)row * CONVD + c0 + 128 * bj) = pack8(a, b);
                        if (cs) { *(f32x4*)(cs + c0 + 128 * bj) = a; *(f32x4*)(cs + c0 + 128 * bj + 4) = b; } }
                } else if (pn < 16) {
#pragma unroll
                    for (int bj = 0; bj < 2; ++bj) *(v4u*)(SZ + (size_t)row * D + (c0 - CONVD) + 128 * bj) = pack8(silu4(acc[ai][bj][m][0] * rs), silu4(acc[ai][bj][m][1] * rs));
                } else if (wc == 0 && fq < 2) {
                    *(f32x4*)(BA + (size_t)row * 16 + 8 * fq) = acc[ai][0][m][0] * rs; *(f32x4*)(BA + (size_t)row * 16 + 8 * fq + 4) = acc[ai][0][m][1] * rs;
                } }
    }
};
struct Epi8 {
    static constexpr bool PERM = true, AFTER_DRAIN = false;
    const float* Y1; float* out;
    __device__ __forceinline__ void operator()(const f32x4 (&acc)[2][2][4][2], const Unit& u, int wr, int wc, int fr, int fq) const {
        const int row0 = u.pm * BM + wr * 64 + fr, c0 = u.pn * BM + wc * 32 + 8 * fq;
#pragma unroll
        for (int ai = 0; ai < 2; ++ai)
#pragma unroll
            for (int m = 0; m < 4; ++m) { const int row = row0 + ai * 128 + m * 16;
                const float* yr = Y1 + (size_t)row * D + c0; float* o = (row < MP ? out + O_YP + (size_t)row * D : out + O_YS + (size_t)(row - MP) * D) + c0;
#pragma unroll
                for (int bj = 0; bj < 2; ++bj) { *(f32x4*)(o + 128 * bj) = *(const f32x4*)(yr + 128 * bj) + acc[ai][bj][m][0]; *(f32x4*)(o + 128 * bj + 4) = *(const f32x4*)(yr + 128 * bj + 4) + acc[ai][bj][m][1]; } }
    }
};
}

namespace at {
typedef float f32x2_t __attribute__((ext_vector_type(2))); typedef __bf16 bf16x2_t __attribute__((ext_vector_type(2)));
__device__ __forceinline__ unsigned cvtpk(float lo, float hi) { f32x2_t v = {lo, hi}; bf16x2_t b = __builtin_convertvector(v, bf16x2_t); return __builtin_bit_cast(unsigned, b); }
__device__ __forceinline__ int crow(int r, int h) { return (r & 3) + 8 * (r >> 2) + 4 * h; }
#define MFMA32(a, b, c) __builtin_amdgcn_mfma_f32_32x32x16_bf16((a), (b), (c), 0, 0, 0)
struct KVFrag { bf16x8 k[4]; bf16x4 v[2][2][2]; };
__device__ __forceinline__ void load_frags(KVFrag& f, const bf16* kbase, const bf16* vbase, int kb, int ql) {
    const bf16* kp = kbase + (size_t)(kb * 32 + ql) * 512;
#pragma unroll
    for (int c = 0; c < 4; ++c) f.k[c] = *(const bf16x8*)(kp + 16 * c);
    const bf16* vp = vbase + kb * 32;
#pragma unroll
    for (int db = 0; db < 2; ++db)
#pragma unroll
        for (int s = 0; s < 2; ++s)
#pragma unroll
            for (int p = 0; p < 2; ++p) f.v[db][s][p] = *(const bf16x4*)(vp + (size_t)db * 32 * SEQ + 16 * s + 8 * p);
}
__device__ __forceinline__ bf16x8 cat8(bf16x4 a, bf16x4 b) { return __builtin_shufflevector(a, b, 0, 1, 2, 3, 4, 5, 6, 7); }
__device__ __forceinline__ bf16x8 pack8r(const float (&x)[16], int s) {
    v4u p; p.x = cvtpk(x[8 * s], x[8 * s + 1]); p.y = cvtpk(x[8 * s + 2], x[8 * s + 3]); p.z = cvtpk(x[8 * s + 4], x[8 * s + 5]); p.w = cvtpk(x[8 * s + 6], x[8 * s + 7]);
    return __builtin_bit_cast(bf16x8, p);
}
template <bool DIAG>
__device__ __forceinline__ void step(const KVFrag& f, const bf16x8 (&qf)[4], const bf16x8 (&tm)[2], f32x16& o0, f32x16& o1, float& R, float bias2, int ql, int h) {
    f32x16 z;
#pragma unroll
    for (int r = 0; r < 16; ++r) z[r] = bias2;
#pragma unroll
    for (int c = 0; c < 4; ++c) z = MFMA32(f.k[c], qf[c], z);
    float lk[16], t[16];
#pragma unroll
    for (int r = 0; r < 16; ++r) {
        const float zz = z[r];
        const float sp = fmaxf(zz, 0.f) + __builtin_amdgcn_logf(1.f + __builtin_amdgcn_exp2f(-fabsf(zz)));
        const bool valid = !DIAG || (crow(r, h) < ql);
        lk[r] = valid ? -sp : 0.f; t[r] = zz - sp;
    }
    f32x16 sfx;
#pragma unroll
    for (int r = 0; r < 16; ++r) sfx[r] = R;
    sfx = MFMA32(tm[0], pack8r(lk, 0), sfx); sfx = MFMA32(tm[1], pack8r(lk, 1), sfx);
    float a[16];
#pragma unroll
    for (int r = 0; r < 16; ++r) { const bool valid = !DIAG || (crow(r, h) < ql); const float e = __builtin_amdgcn_exp2f(t[r] + sfx[r]); a[r] = valid ? e : 0.f; }
    { const float rn = sfx[0] + lk[0]; auto rr = __builtin_amdgcn_permlane32_swap(__float_as_uint(rn), __float_as_uint(rn), false, false); R = fminf(__uint_as_float(rr[0]), __uint_as_float(rr[1])); }
    const bf16x8 p0 = pack8r(a, 0), p1 = pack8r(a, 1);
    o0 = MFMA32(cat8(f.v[0][0][0], f.v[0][0][1]), p0, o0); o0 = MFMA32(cat8(f.v[0][1][0], f.v[0][1][1]), p1, o0);
    o1 = MFMA32(cat8(f.v[1][0][0], f.v[1][0][1]), p0, o1); o1 = MFMA32(cat8(f.v[1][1][0], f.v[1][1][1]), p1, o1);
}
__device__ __forceinline__ void prompt_wave(const bf16* QN, const bf16* KN, const bf16* VT, const bf16* SG, bf16* MIX, float bias2, int b, int hd, int q32, int lane) {
    const int ql = lane & 31, h = lane >> 5;
    const size_t rowbase = (size_t)b * SEQ;
    bf16x8 qf[4];
    { const bf16* qp = QN + (rowbase + q32 * 32 + ql) * 512 + hd * 64 + 8 * h;
#pragma unroll
      for (int c = 0; c < 4; ++c) qf[c] = *(const bf16x8*)(qp + 16 * c); }
    bf16x8 tm[2];
#pragma unroll
    for (int s = 0; s < 2; ++s)
#pragma unroll
        for (int j = 0; j < 8; ++j) tm[s][j] = (16 * s + 8 * (j >> 2) + 4 * h + (j & 3)) > ql ? (short)0x3F80 : (short)0;
    f32x16 o0, o1;
#pragma unroll
    for (int r = 0; r < 16; ++r) { o0[r] = 0.f; o1[r] = 0.f; }
    float R = 0.f;
    const bf16* kbase = KN + rowbase * 512 + hd * 64 + 8 * h;
    const bf16* vbase = VT + ((size_t)(b * 8 + hd) * 64 + ql) * SEQ + 4 * h;
    KVFrag fa, fb;
    load_frags(fa, kbase, vbase, q32, ql);
    int kb = q32;
    if (kb > 0) load_frags(fb, kbase, vbase, kb - 1, ql);
    step<true>(fa, qf, tm, o0, o1, R, bias2, ql, h);
    --kb;
    while (kb >= 0) {
        if (kb > 0) load_frags(fa, kbase, vbase, kb - 1, ql);
        step<false>(fb, qf, tm, o0, o1, R, bias2, ql, h);
        --kb;
        if (kb < 0) break;
        if (kb > 0) load_frags(fb, kbase, vbase, kb - 1, ql);
        step<false>(fa, qf, tm, o0, o1, R, bias2, ql, h);
        --kb;
    }
    const size_t row = rowbase + q32 * 32 + ql;
    const bf16* sg = SG + row * D + 512 + hd * 64 + 4 * h; bf16* mx = MIX + row * D + 512 + hd * 64 + 4 * h;
#pragma unroll
    for (int db = 0; db < 2; ++db)
#pragma unroll
        for (int g = 0; g < 4; ++g) {
            const bf16x4 sv = *(const bf16x4*)(sg + 32 * db + 8 * g);
            const f32x16& o = db ? o1 : o0;
            v2u w; w.x = cvtpk(o[4 * g] * bf2f((bf16)sv[0]), o[4 * g + 1] * bf2f((bf16)sv[1])); w.y = cvtpk(o[4 * g + 2] * bf2f((bf16)sv[2]), o[4 * g + 3] * bf2f((bf16)sv[3]));
            *(v2u*)(mx + 32 * db + 8 * g) = w;
        }
}
__device__ __forceinline__ void prompt_phase(const Frame& F, unsigned char* ws, const float* sb_bias) {
    const bf16* QN = (const bf16*)(ws + WS_QN); const bf16* KN = (const bf16*)(ws + WS_KN); const bf16* VT = (const bf16*)(ws + WS_VT); const bf16* SG = (const bf16*)(ws + WS_SG); bf16* MIX = (bf16*)(ws + WS_MIX);
    for (int c = F.vcu; c < 256; c += F.G) {
        const int bh = c >> 2, pair = c & 3, b = bh >> 3, hd = bh & 7;
        const float bias2 = sb_bias[hd] * LOG2E;
        prompt_wave(QN, KN, VT, SG, MIX, bias2, b, hd, 8 * pair + F.wave, F.lane);
        prompt_wave(QN, KN, VT, SG, MIX, bias2, b, hd, 8 * (7 - pair) + (7 - F.wave), F.lane);
    }
}
}

constexpr size_t WS_PO = WS_END;
constexpr size_t WS_PT = WS_PO + (size_t)DB * NPAGE * SBH * DS * SBD * 4;
constexpr size_t WS_MIXD = WS_PT + (size_t)DB * NPAGE * SBH * DS * 4;
constexpr size_t WS_END2 = WS_MIXD + (size_t)MT * D * 2;
namespace at {
template <bool DIAG>
__device__ __forceinline__ void step_core(const bf16x8 (&kf)[4], const bf16x8 (&vf)[2][2], const bf16x8 (&qf)[4], const bf16x8 (&tm)[2], f32x16& o0, f32x16& o1, float& R, float bias2, int ql, int h) {
    f32x16 z;
#pragma unroll
    for (int r = 0; r < 16; ++r) z[r] = bias2;
#pragma unroll
    for (int c = 0; c < 4; ++c) z = MFMA32(kf[c], qf[c], z);
    float lk[16], t[16];
#pragma unroll
    for (int r = 0; r < 16; ++r) {
        const float zz = z[r];
        const float sp = fmaxf(zz, 0.f) + __builtin_amdgcn_logf(1.f + __builtin_amdgcn_exp2f(-fabsf(zz)));
        const bool valid = !DIAG || (crow(r, h) < ql);
        lk[r] = valid ? -sp : 0.f; t[r] = zz - sp;
    }
    f32x16 sfx;
#pragma unroll
    for (int r = 0; r < 16; ++r) sfx[r] = R;
    sfx = MFMA32(tm[0], pack8r(lk, 0), sfx); sfx = MFMA32(tm[1], pack8r(lk, 1), sfx);
    float a[16];
#pragma unroll
    for (int r = 0; r < 16; ++r) { const bool valid = !DIAG || (crow(r, h) < ql); const float e = __builtin_amdgcn_exp2f(t[r] + sfx[r]); a[r] = valid ? e : 0.f; }
    { const float rn = sfx[0] + lk[0]; auto rr = __builtin_amdgcn_permlane32_swap(__float_as_uint(rn), __float_as_uint(rn), false, false); R = fminf(__uint_as_float(rr[0]), __uint_as_float(rr[1])); }
    const bf16x8 p0 = pack8r(a, 0), p1 = pack8r(a, 1);
    o0 = MFMA32(vf[0][0], p0, o0); o0 = MFMA32(vf[0][1], p1, o0);
    o1 = MFMA32(vf[1][0], p0, o1); o1 = MFMA32(vf[1][1], p1, o1);
}
__device__ __forceinline__ void decode_unit(const In& in, unsigned char* ws, int s, int p, int hd, int lane) {
    const int ql = lane & 31, h = lane >> 5;
    const bf16* QN = (const bf16*)(ws + WS_QN);
    const int pg = in.page_table[s * NPAGE + p];
    const float* kpage = in.cache_k + (size_t)pg * PAGE * 512 + hd * 64;
    const float* vpage = in.cache_v + (size_t)pg * PAGE * 512 + hd * 64;
    bf16x8 qf[4];
    { const bf16* qp = QN + (size_t)(MP + s * DS + (ql < DS ? ql : DS - 1)) * 512 + hd * 64 + 8 * h;
#pragma unroll
      for (int c = 0; c < 4; ++c) qf[c] = *(const bf16x8*)(qp + 16 * c); }
    bf16x8 tm[2];
#pragma unroll
    for (int sx = 0; sx < 2; ++sx)
#pragma unroll
        for (int j = 0; j < 8; ++j) tm[sx][j] = (16 * sx + 8 * (j >> 2) + 4 * h + (j & 3)) > ql ? (short)0x3F80 : (short)0;
    const float bias2 = in.sb_bias[hd] * LOG2E;
    f32x16 o0, o1;
#pragma unroll
    for (int r = 0; r < 16; ++r) { o0[r] = 0.f; o1[r] = 0.f; }
    float R = 0.f;
    for (int blk = PAGE / 32 - 1; blk >= 0; --blk) {
        f32x4 kr[4][2]; float vr[2][2][8];
        const float* kp = kpage + (size_t)(blk * 32 + ql) * 512 + 8 * h;
#pragma unroll
        for (int c = 0; c < 4; ++c) { kr[c][0] = *(const f32x4*)(kp + 16 * c); kr[c][1] = *(const f32x4*)(kp + 16 * c + 4); }
        const float* vp = vpage + (size_t)(blk * 32 + 4 * h) * 512 + ql;
#pragma unroll
        for (int db = 0; db < 2; ++db)
#pragma unroll
            for (int sx = 0; sx < 2; ++sx)
#pragma unroll
                for (int j = 0; j < 8; ++j) vr[db][sx][j] = vp[(size_t)(16 * sx + 8 * (j >> 2) + (j & 3)) * 512 + 32 * db];
        bf16x8 kf[4], vf[2][2];
#pragma unroll
        for (int c = 0; c < 4; ++c) { v4u w; w.x = cvtpk(kr[c][0][0], kr[c][0][1]); w.y = cvtpk(kr[c][0][2], kr[c][0][3]); w.z = cvtpk(kr[c][1][0], kr[c][1][1]); w.w = cvtpk(kr[c][1][2], kr[c][1][3]); kf[c] = __builtin_bit_cast(bf16x8, w); }
#pragma unroll
        for (int db = 0; db < 2; ++db)
#pragma unroll
            for (int sx = 0; sx < 2; ++sx) { v4u w; w.x = cvtpk(vr[db][sx][0], vr[db][sx][1]); w.y = cvtpk(vr[db][sx][2], vr[db][sx][3]); w.z = cvtpk(vr[db][sx][4], vr[db][sx][5]); w.w = cvtpk(vr[db][sx][6], vr[db][sx][7]); vf[db][sx] = __builtin_bit_cast(bf16x8, w); }
        step_core<false>(kf, vf, qf, tm, o0, o1, R, bias2, ql, h);
    }
    if (ql < DS) {
        float* po = (float*)(ws + WS_PO) + ((((size_t)s * NPAGE + p) * SBH + hd) * DS + ql) * SBD + 4 * h;
#pragma unroll
        for (int db = 0; db < 2; ++db)
#pragma unroll
            for (int g = 0; g < 4; ++g) { const f32x16& o = db ? o1 : o0; *(f32x4*)(po + 32 * db + 8 * g) = (f32x4){o[4 * g], o[4 * g + 1], o[4 * g + 2], o[4 * g + 3]}; }
        if (h == 0) ((float*)(ws + WS_PT))[(((size_t)s * NPAGE + p) * SBH + hd) * DS + ql] = R;
    }
}
__device__ __forceinline__ void decode_combine(const In& in, unsigned char* ws, int s, int hd, int lane) {
    const bf16* QN = (const bf16*)(ws + WS_QN); const bf16* KN = (const bf16*)(ws + WS_KN); const bf16* VB = (const bf16*)(ws + WS_VB); const bf16* SG = (const bf16*)(ws + WS_SG); bf16* MIX = (bf16*)(ws + WS_MIX);
    const float* PO = (const float*)(ws + WS_PO); const float* PT = (const float*)(ws + WS_PT);
    const float bias2 = in.sb_bias[hd] * LOG2E;
    float q[DS], k[DS], v[DS];
#pragma unroll
    for (int i = 0; i < DS; ++i) { const size_t o = (size_t)(MP + s * DS + i) * 512 + hd * 64 + lane; q[i] = bf2f(QN[o]); k[i] = bf2f(KN[o]); v[i] = bf2f(VB[o]); }
    const float Tl = PT[(((size_t)s * NPAGE + (lane >> 2)) * SBH + hd) * DS + (lane & 3)];
#pragma unroll
    for (int i = 0; i < DS; ++i) {
        float Rn = 0.f, out = 0.f;
#pragma unroll
        for (int j = DS - 1; j >= 0; --j) if (j < i) {
            const float z = wave_sum(q[i] * k[j]) + bias2;
            const float sp = softplus2_f(z);
            out += exp2f(z - sp + Rn) * v[j];
            Rn -= sp;
        }
        for (int p = NPAGE - 1; p >= 0; --p) {
            out += exp2f(Rn) * PO[((((size_t)s * NPAGE + p) * SBH + hd) * DS + i) * SBD + lane];
            Rn += __shfl(Tl, 4 * p + i);
        }
        const size_t o = (size_t)(MP + s * DS + i) * D + 512 + hd * 64 + lane;
        MIX[o] = (bf16)f2bf(out * bf2f(SG[o]));
    }
}
}

namespace pl {
using at::cvtpk;
__device__ __forceinline__ void pool_unit(const In& in, unsigned char* ws, int rb, int g, int lane) {
    const int ql = lane & 31, h = lane >> 5, w = 2 << g;
    const bf16* U = (const bf16*)(ws + WS_U); const bf16* Wpt = (const bf16*)(ws + WS_WPT) + (size_t)g * PG * PG; const bf16* SG = (const bf16*)(ws + WS_SG); bf16* MIX = (bf16*)(ws + WS_MIX);
    const int row = rb * 32 + ql;
    int t, s = 0; float inv;
    if (row < MP) { t = row & (SEQ - 1); inv = 1.f / (float)min(t + 1, w); } else { s = (row - MP) >> 2; t = (row - MP) & 3; inv = 1.f / (float)w; }
    f32x16 acc[4];
#pragma unroll
    for (int nb = 0; nb < 4; ++nb)
#pragma unroll
        for (int r = 0; r < 16; ++r) acc[nb][r] = 0.f;
#pragma unroll 1
    for (int c = 0; c < 8; ++c) {
        const int ch = PG * g + 16 * c + 8 * h;
        float sum[8], cur[8];
        { const bf16x8 u8 = *(const bf16x8*)(U + (size_t)row * PW + ch);
#pragma unroll
          for (int e = 0; e < 8; ++e) { cur[e] = bf2f((bf16)u8[e]); sum[e] = cur[e]; } }
        for (int j = 1; j < w; ++j) {
            const int tt = t - j;
            if (tt >= 0) { const bf16x8 u8 = *(const bf16x8*)(U + (size_t)(row - j) * PW + ch);
#pragma unroll
                for (int e = 0; e < 8; ++e) sum[e] += bf2f((bf16)u8[e]); }
            else if (row >= MP) { const float* cp = in.cache_pool + ((size_t)s * PBUF + (PBUF + tt)) * PW + ch;
#pragma unroll
                for (int e = 0; e < 8; ++e) sum[e] += cp[e]; }
        }
        v4u dp;
        dp.x = cvtpk(sum[0] * inv - cur[0], sum[1] * inv - cur[1]); dp.y = cvtpk(sum[2] * inv - cur[2], sum[3] * inv - cur[3]);
        dp.z = cvtpk(sum[4] * inv - cur[4], sum[5] * inv - cur[5]); dp.w = cvtpk(sum[6] * inv - cur[6], sum[7] * inv - cur[7]);
        const bf16x8 df = __builtin_bit_cast(bf16x8, dp);
#pragma unroll
        for (int nb = 0; nb < 4; ++nb) { const bf16x8 wf = *(const bf16x8*)(Wpt + (size_t)(32 * nb + ql) * PG + 16 * c + 8 * h); acc[nb] = MFMA32(wf, df, acc[nb]); }
    }
#pragma unroll
    for (int nb = 0; nb < 4; ++nb)
#pragma unroll
        for (int gg = 0; gg < 4; ++gg) {
            const int ch = PG * g + 32 * nb + 8 * gg + 4 * h;
            const f32x4 sc = *(const f32x4*)(in.pool_scale + ch);
            const bf16x4 sv = *(const bf16x4*)(SG + (size_t)row * D + ch);
            v2u o; o.x = cvtpk(acc[nb][4 * gg] * sc[0] * bf2f((bf16)sv[0]), acc[nb][4 * gg + 1] * sc[1] * bf2f((bf16)sv[1]));
            o.y = cvtpk(acc[nb][4 * gg + 2] * sc[2] * bf2f((bf16)sv[2]), acc[nb][4 * gg + 3] * sc[3] * bf2f((bf16)sv[3]));
            *(v2u*)(MIX + (size_t)row * D + ch) = o;
        }
}
__device__ __forceinline__ void pool_state_out(const In& in, unsigned char* ws, float* out, int gtid, int gthreads) {
    const bf16* U = (const bf16*)(ws + WS_U);
    for (int i = gtid; i < BP * PBUF * PW; i += gthreads) { const int c = i % PW, j = (i / PW) % PBUF, b = i / (PW * PBUF); out[O_POOLP + i] = bf2f(U[(size_t)(b * SEQ + SEQ - PBUF + j) * PW + c]); }
    for (int i = gtid; i < DB * PBUF * PW; i += gthreads) { const int c = i % PW, j = (i / PW) % PBUF, s = i / (PW * PBUF), e = j + DS;
        out[O_POOLS + i] = e < PBUF ? in.cache_pool[((size_t)s * PBUF + e) * PW + c] : bf2f(U[(size_t)(MP + s * DS + (e - PBUF)) * PW + c]); }
}
}

namespace nv {
__device__ __forceinline__ void k_pool_d(const bf16* U, const float* cache_pool, float* nD, float* out, int gtid, int gthreads) {
    const size_t n = (size_t)MT * PW;
    for (size_t i = (size_t)gtid; i < n; i += (size_t)gthreads) {
        const int r = (int)(i / PW), c = (int)(i % PW), g = c / PG, w = 2 << g;
        float sum = 0.f, cnt;
        if (r < MP) {
            const int t = r % SEQ;
            for (int j = 0; j < w; ++j) if (t - j >= 0) sum += bf2f(U[(size_t)(r - j) * PW + c]);
            cnt = (float)min(t + 1, w);
        } else {
            const int s = (r - MP) / DS, t = (r - MP) % DS;
            for (int j = 0; j < w; ++j) { const int tt = t - j; sum += tt >= 0 ? bf2f(U[(size_t)(r - j) * PW + c]) : cache_pool[((size_t)s * PBUF + (PBUF + tt)) * PW + c]; }
            cnt = (float)w;
        }
        nD[i] = sum / cnt - bf2f(U[(size_t)r * PW + c]);
    }
    const size_t n2 = (size_t)BP * PBUF * PW;
    for (size_t i = (size_t)gtid; i < n2; i += (size_t)gthreads) {
        const int c = (int)(i % PW), j = (int)((i / PW) % PBUF), b = (int)(i / ((size_t)PW * PBUF));
        out[O_POOLP + i] = bf2f(U[(size_t)(b * SEQ + SEQ - PBUF + j) * PW + c]);
    }
    const size_t n3 = (size_t)DB * PBUF * PW;
    for (size_t i = (size_t)gtid; i < n3; i += (size_t)gthreads) {
        const int c = (int)(i % PW), j = (int)((i / PW) % PBUF), s = (int)(i / ((size_t)PW * PBUF));
        const int e = j + DS;
        out[O_POOLS + i] = e < PBUF ? cache_pool[((size_t)s * PBUF + e) * PW + c] : bf2f(U[(size_t)(MP + s * DS + (e - PBUF)) * PW + c]);
    }
}
__device__ __forceinline__ void k_pool_y(const float* nD, const float* w_pool, const float* scale, const bf16* SG, bf16* mix, int gtid, int gthreads) {
    const size_t n = (size_t)MT * PW;
    for (size_t i = (size_t)gtid; i < n; i += (size_t)gthreads) {
        const int r = (int)(i / PW), c = (int)(i % PW), g = c / PG, dd = c % PG;
        const float* d = nD + (size_t)r * PW + g * PG; const float* wp = w_pool + (size_t)g * PG * PG + dd;
        float s = 0.f;
        for (int k = 0; k < PG; ++k) s += d[k] * wp[(size_t)k * PG];
        mix[(size_t)r * D + c] = (bf16)f2bf(s * scale[c] * bf2f(SG[(size_t)r * D + c]));
    }
}
__device__ __forceinline__ void k_attn(const bf16* QN, const bf16* KN, const bf16* VB, const float* cache_k, const float* cache_v, const int* page_table,
                                              const float* bias, const bf16* SG, bf16* mix, int gtid, int gthreads, long it0) {
    const int lane = threadIdx.x & 63;
    const long w = gtid >> 6, nw = gthreads >> 6;
    for (long it = it0 + w; it < (long)MT * SBH; it += nw) {
        const int r = (int)(it / SBH), h = (int)(it % SBH);
        const float q = bf2f(QN[(size_t)r * 512 + h * 64 + lane]);
        const float bh = bias[h] * LOG2E;
        int nkeys, s = 0, b = 0;
        if (r < MP) { b = r / SEQ; nkeys = r % SEQ; } else { s = (r - MP) / DS; nkeys = PAST + (r - MP) % DS; }
        float R = 0.f, o = 0.f;
        for (int blk = (nkeys - 1) / 64; blk >= 0 && nkeys > 0; --blk) {
            const int j0 = blk * 64 + lane; const bool valid = j0 < nkeys;
            const int j = valid ? j0 : nkeys - 1;
            const bool is16 = (r < MP) || (j >= PAST);
            const bf16* k16 = KN + (size_t)(r < MP ? b * SEQ + j : MP + s * DS + (is16 ? j - PAST : 0)) * 512 + h * 64;
            const float* k32 = cache_k + (((size_t)page_table[s * NPAGE + (is16 ? 0 : j / PAGE)] * PAGE + (is16 ? 0 : j % PAGE)) * SBH + h) * SBD;
            float dot = 0.f;
            for (int d = 0; d < 64; ++d) { const float qd = __shfl(q, d); dot += qd * (is16 ? bf2f(k16[d]) : k32[d]); }
            const float z = valid ? dot + bh : 0.f;
            const float sp = softplus2_f(z);
            const float lk = valid ? -sp : 0.f;
            float inc = lk;
#pragma unroll
            for (int off = 1; off < 64; off <<= 1) { const float t = __shfl_down(inc, off); if (lane + off < 64) inc += t; }
            const float suffix = inc - lk + R;
            const float a = valid ? exp2f(z - sp + suffix) : 0.f;
            R += __shfl(inc, 0);
            for (int k = 0; k < 64; ++k) {
                const int jj = blk * 64 + k;
                const float ak = __shfl(a, k);
                if (jj < nkeys) {
                    float vv;
                    if (r < MP) vv = bf2f(VB[(size_t)(b * SEQ + jj) * 512 + h * 64 + lane]);
                    else if (jj < PAST) vv = cache_v[(((size_t)page_table[s * NPAGE + jj / PAGE] * PAGE + jj % PAGE) * SBH + h) * SBD + lane];
                    else vv = bf2f(VB[(size_t)(MP + s * DS + (jj - PAST)) * 512 + h * 64 + lane]);
                    o += ak * vv;
                }
            }
        }
        mix[(size_t)r * D + 512 + h * 64 + lane] = (bf16)f2bf(o * bf2f(SG[(size_t)r * D + 512 + h * 64 + lane]));
    }
}
__device__ __forceinline__ void k_conv(const bf16* QKVP, const float* state_conv, const float* conv_w, float* nC, int gtid, int gthreads) {
    const size_t n = (size_t)MT * CONVD;
    for (size_t i = (size_t)gtid; i < n; i += (size_t)gthreads) {
        const int r = (int)(i / CONVD), c = (int)(i % CONVD);
        float acc = 0.f;
        for (int j = 0; j < 4; ++j) {
            float xv;
            if (r < MP) { const int t = r % SEQ, e = t + j; xv = e >= 3 ? bf2f(QKVP[(size_t)(r - 3 + j) * CONVD + c]) : 0.f; }
            else { const int s = (r - MP) / DS, t = (r - MP) % DS, e = t + j; xv = e >= 3 ? bf2f(QKVP[(size_t)(MP + s * DS + e - 3) * CONVD + c]) : state_conv[((size_t)s * 3 + e) * CONVD + c]; }
            acc += xv * conv_w[(size_t)j * CONVD + c];
        }
        nC[i] = silu_f(acc);
    }
}
__device__ __forceinline__ void k_qknorm(float* nC, const float* BA, const float* a_log, const float* dt_bias, float* nBeta, float* nG, int gtid, int gthreads) {
    const int lane = threadIdx.x & 63;
    const long w = gtid >> 6, nw = gthreads >> 6;
    for (long it = w; it < (long)MT * DNH; it += nw) {
        const int r = (int)(it / DNH), h = (int)(it % DNH);
        float* q = nC + (size_t)r * CONVD + h * 128; float* k = q + 1024;
        const float q0 = q[lane], q1 = q[lane + 64], k0 = k[lane], k1 = k[lane + 64];
        const float qs = wave_sum(q0 * q0 + q1 * q1), ks = wave_sum(k0 * k0 + k1 * k1);
        const float qr = rsqrtf(qs + EPS) * 0.08838834764831845f, kr = rsqrtf(ks + EPS);
        q[lane] = q0 * qr; q[lane + 64] = q1 * qr; k[lane] = k0 * kr; k[lane + 64] = k1 * kr;
        if (lane == 0) {
            const float bb = BA[(size_t)r * 16 + h], aa = BA[(size_t)r * 16 + 8 + h];
            nBeta[(size_t)r * DNH + h] = 1.f / (1.f + __expf(-bb));
            nG[(size_t)r * DNH + h] = -__expf(a_log[h]) * softplus_f(aa + dt_bias[h]);
        }
    }
}
__device__ __forceinline__ void k_gdn(const float* nC, const float* nBeta, const float* nG, const float* state_delta, float* nO, float* out, LAS float* sm) {
    LAS float* sq = sm; LAS float* sk = sm + 128; LAS float (*red)[128] = (LAS float (*)[128])(sm + 256); LAS float (*red2)[128] = (LAS float (*)[128])(sm + 768);
    const int tid = threadIdx.x, e = tid & 127, part = tid >> 7;
    for (int c = blockIdx.x; c < BP * DNH + DB * DNH; c += gridDim.x) {
        int base, L, h; const float* S0 = nullptr; float* Sout;
        if (c < BP * DNH) { const int b = c / DNH; h = c % DNH; base = b * SEQ; L = SEQ; Sout = out + O_DP + (size_t)c * DNK * DNV; }
        else { const int cc = c - BP * DNH, s = cc / DNH; h = cc % DNH; base = MP + s * DS; L = DS; S0 = state_delta + (size_t)cc * DNK * DNV; Sout = out + O_DS + (size_t)cc * DNK * DNV; }
        float S[32];
#pragma unroll
        for (int i = 0; i < 32; ++i) S[i] = S0 ? S0[(size_t)(part * 32 + i) * DNV + e] : 0.f;
        for (int t = 0; t < L; ++t) {
            const int r = base + t;
            __syncthreads();
            if (tid < 128) sq[tid] = nC[(size_t)r * CONVD + h * 128 + tid];
            else if (tid < 256) sk[tid - 128] = nC[(size_t)r * CONVD + 1024 + h * 128 + (tid - 128)];
            const float v = nC[(size_t)r * CONVD + 2048 + h * 128 + e];
            const float beta = nBeta[(size_t)r * DNH + h], alpha = __expf(nG[(size_t)r * DNH + h]);
            __syncthreads();
            float ks = 0.f;
#pragma unroll
            for (int i = 0; i < 32; ++i) ks += sk[part * 32 + i] * S[i];
            red[part][e] = ks;
            __syncthreads();
            const float kS = alpha * (red[0][e] + red[1][e] + red[2][e] + red[3][e]);
            const float vn = beta * (v - kS);
            float op = 0.f;
#pragma unroll
            for (int i = 0; i < 32; ++i) { S[i] = alpha * S[i] + sk[part * 32 + i] * vn; op += sq[part * 32 + i] * S[i]; }
            red2[part][e] = op;
            __syncthreads();
            if (part == 0) nO[(size_t)r * D + h * 128 + e] = red2[0][e] + red2[1][e] + red2[2][e] + red2[3][e];
        }
#pragma unroll
        for (int i = 0; i < 32; ++i) Sout[(size_t)(part * 32 + i) * DNV + e] = S[i];
        __syncthreads();
    }
}
__device__ __forceinline__ void k_onorm(const float* nO, const bf16* SZ, const float* og, bf16* A4, int gtid, int gthreads) {
    const int lane = threadIdx.x & 63;
    const long w = gtid >> 6, nw = gthreads >> 6;
    for (long it = w; it < (long)MT * DNH; it += nw) {
        const int r = (int)(it / DNH), h = (int)(it % DNH);
        const float* o = nO + (size_t)r * D + h * 128;
        const float o0 = o[lane], o1 = o[lane + 64];
        const float ss = wave_sum(o0 * o0 + o1 * o1);
        const float rs = rsqrtf(ss / 128.f + EPS);
        const bf16* z = SZ + (size_t)r * D + h * 128;
        A4[(size_t)r * D + h * 128 + lane] = (bf16)f2bf(o0 * rs * og[lane] * bf2f(z[lane]));
        A4[(size_t)r * D + h * 128 + lane + 64] = (bf16)f2bf(o1 * rs * og[lane + 64] * bf2f(z[lane + 64]));
    }
}
}

constexpr int N_PHASES = 9;
__global__ void __launch_bounds__(NWAVES * 64, 2) fwd(Params P) {
    extern __shared__ __attribute__((aligned(16))) unsigned char lds[];
    Frame F;
    F.lds = (LAS unsigned char*)lds;
    F.MISC = (volatile LAS unsigned*)(F.lds + MISC_OFF);
    F.tid = threadIdx.x; F.lane = F.tid & 63; F.wave = __builtin_amdgcn_readfirstlane(F.tid >> 6);
    F.G = gridDim.x; { const int bx = blockIdx.x; F.vcu = (F.G % 8 == 0) ? (bx % 8) * (F.G / 8) + bx / 8 : bx; }
    unsigned char* ws = P.ws;
    F.ctl = (gu32*)(ws + WS_CTL);
    const In in = make_in(P);
    for (int u = F.tid; u < (LDS_BYTES - LDSCTL_OFF) / 4; u += NWAVES * 64) ((LAS unsigned*)(F.lds + LDSCTL_OFF))[u] = 0u;
    __syncthreads();
    const int lo = P.ph_lo, hi = P.ph_hi;
    const bool use_bar = true;
    XcdBarrier bar; bar.bar = (unsigned*)(F.ctl + CW_BAR); bar.x = 0; bar.st = nullptr;
    if (use_bar) bar = xcd_barrier_post((unsigned*)(F.ctl + CW_BAR), F.MISC + 8);
#define IN(k) (lo <= (k) && (k) < hi)
#define BOTH(k) (IN(k) && IN((k) + 1))
#define GRID_BAR() xcd_barrier(bar)

    if (IN(0)) { p0_prologue(F, in, ws); if (BOTH(0)) GRID_BAR(); }

    if (IN(1)) {
        pg8::Gemm g{(const pg8::bf16_t*)(ws + WS_XN1), (const pg8::bf16_t*)(ws + WS_W1T), MT, EVEN_IN, D}; pg8::StaticOrder S; S.init(MT, EVEN_IN, F.G, (int)blockIdx.x);
        ep::Epi1 E{(bf16*)(ws + WS_U), (bf16*)(ws + WS_QN), (bf16*)(ws + WS_KN), (bf16*)(ws + WS_VB), (bf16*)(ws + WS_VT), (bf16*)(ws + WS_SG), P.out, in.q_norm, in.k_norm};
        pg8::gemm_phase<ep::Epi1, pg8::StaticOrder, true, true>(F.lds + RING_OFF, g, S, E);
        if (BOTH(1)) GRID_BAR();
    }
    const int gtid = (int)blockIdx.x * (NWAVES * 64) + F.tid, gthreads = F.G * NWAVES * 64;
    if (IN(2)) {
        const int gw = F.vcu * NWAVES + F.wave, NGW = F.G * NWAVES;
        if (F.wave < 4) at::prompt_phase(F, ws, in.sb_bias);
        for (int du = gw; du < DB * NPAGE * SBH; du += NGW) at::decode_unit(in, ws, du >> 7, (du >> 3) & 15, du & 7, F.lane);
        if (F.wave >= 4) at::prompt_phase(F, ws, in.sb_bias);
        for (int pu = gw; pu < (MT / 32) * 4; pu += NGW) pl::pool_unit(in, ws, pu >> 2, pu & 3, F.lane);
        pl::pool_state_out(in, ws, P.out, gtid, gthreads);
        if (BOTH(2)) GRID_BAR();
    }
    if (IN(3)) {
        const int gw = F.vcu * NWAVES + F.wave, NGW = F.G * NWAVES;
        for (int cu = gw; cu < DB * SBH; cu += NGW) at::decode_combine(in, ws, cu >> 3, cu & 7, F.lane);
#if DBG_CHECK
        GRID_BAR();
        nv::k_attn((const bf16*)(ws + WS_QN), (const bf16*)(ws + WS_KN), (const bf16*)(ws + WS_VB), in.cache_k, in.cache_v, in.page_table, in.sb_bias, (const bf16*)(ws + WS_SG), (bf16*)(ws + WS_MIXD), gtid, gthreads, 0);
        GRID_BAR();
        { const bf16* A = (const bf16*)(ws + WS_MIX); const bf16* B = (const bf16*)(ws + WS_MIXD); float n0 = 0.f, d0 = 0.f, n1 = 0.f, d1 = 0.f;
          for (size_t i = gtid; i < (size_t)MT * 512; i += gthreads) { const size_t r = i >> 9, o = r * D + 512 + (i & 511); const float a = bf2f(A[o]), b = bf2f(B[o]);
              if (r < MP) { n0 += (a - b) * (a - b); d0 += b * b; } else { n1 += (a - b) * (a - b); d1 += b * b; } }
          n0 = wave_sum(n0); d0 = wave_sum(d0); n1 = wave_sum(n1); d1 = wave_sum(d1);
          if (F.lane == 0) { float* dbg = (float*)(ws + WS_CTL) + CW_DBG; atomicAdd(dbg, n0); atomicAdd(dbg + 1, d0); atomicAdd(dbg + 2, n1); atomicAdd(dbg + 3, d1); } }
#endif
        if (BOTH(3)) GRID_BAR();
    }
    if (IN(4)) {
        pg8::Gemm g{(const pg8::bf16_t*)(ws + WS_MIX), (const pg8::bf16_t*)(ws + WS_W2T), MT, D, D}; pg8::StaticOrder S; S.init(MT, D, F.G, (int)blockIdx.x);
        ep::Epi4 E{in.x_p, in.x_s, in.norm_odd, (float*)(ws + WS_Y1), (bf16*)(ws + WS_A2), (float*)(ws + WS_SSP)};
        pg8::gemm_phase<ep::Epi4, pg8::StaticOrder, true, true>(F.lds + RING_OFF, g, S, E);
        if (BOTH(4)) GRID_BAR();
    }
    if (IN(5)) {
        pg8::Gemm g{(const pg8::bf16_t*)(ws + WS_A2), (const pg8::bf16_t*)(ws + WS_W3T), MT, ODD_PAD, D}; pg8::StaticOrder S; S.init(MT, ODD_PAD, F.G, (int)blockIdx.x);
        ep::Epi5 E{(const float*)(ws + WS_SSP), (bf16*)(ws + WS_QKVP), (bf16*)(ws + WS_SZ), (float*)(ws + WS_BA), P.out};
        pg8::gemm_phase<ep::Epi5, pg8::StaticOrder, true, true>(F.lds + RING_OFF, g, S, E);
        if (BOTH(5)) GRID_BAR();
    }
    if (IN(6)) {
        nv::k_conv((const bf16*)(ws + WS_QKVP), in.state_conv, in.conv_w, (float*)(ws + NW_C), gtid, gthreads);
        GRID_BAR();
        nv::k_qknorm((float*)(ws + NW_C), (const float*)(ws + WS_BA), in.a_log, in.dt_bias, (float*)(ws + NW_BETA), (float*)(ws + NW_G), gtid, gthreads);
        GRID_BAR();
        nv::k_gdn((const float*)(ws + NW_C), (const float*)(ws + NW_BETA), (const float*)(ws + NW_G), in.state_delta, (float*)(ws + NW_O), P.out, (LAS float*)(F.lds + RING_OFF));
        GRID_BAR();
        nv::k_onorm((const float*)(ws + NW_O), (const bf16*)(ws + WS_SZ), in.o_norm, (bf16*)(ws + WS_A4), gtid, gthreads);
        if (BOTH(7)) GRID_BAR();
    }
    if (IN(8)) {
        pg8::Gemm g{(const pg8::bf16_t*)(ws + WS_A4), (const pg8::bf16_t*)(ws + WS_W4T), MT, D, D}; pg8::StaticOrder S; S.init(MT, D, F.G, (int)blockIdx.x);
        ep::Epi8 E{(const float*)(ws + WS_Y1), P.out};
        pg8::gemm_phase<ep::Epi8, pg8::StaticOrder, true, true>(F.lds + RING_OFF, g, S, E);
#if DBG_CHECK
        GRID_BAR();
        { const float* dbg = (const float*)(ws + WS_CTL) + CW_DBG; const float e0 = __hip_atomic_load(dbg, RLX_AGENT) / fmaxf(__hip_atomic_load(dbg + 1, RLX_AGENT), 1e-30f), e1 = __hip_atomic_load(dbg + 2, RLX_AGENT) / fmaxf(__hip_atomic_load(dbg + 3, RLX_AGENT), 1e-30f);
          const float sc = 1.f + sqrtf(fmaxf(DBG_WHICH == 0 ? e0 : (DBG_WHICH == 1 ? e1 : fmaxf(e0, e1)), 0.f));
          for (size_t i = gtid; i < (size_t)MS * D; i += gthreads) P.out[O_YS + i] *= sc; }
#endif
    }
#undef IN
#undef BOTH
#undef GRID_BAR
}

extern "C" void kernel_launch(void* const* d_in, const int* in_sizes, int n_in, void* d_out, int out_size, void* d_ws, size_t ws_size, hipStream_t stream) {
    static int grid = 0;
    if (grid == 0) {
        if (n_in != 23 || (size_t)out_size != O_END || ws_size < WS_END2) { fprintf(stderr, "kernel_launch: unexpected sizes n_in %d out %d ws %zu (need %zu)\n", n_in, out_size, ws_size, (size_t)WS_END2); grid = -1; return; }
        int dev = 0, cus = 0, per_cu = 0;
        if (hipGetDevice(&dev) != hipSuccess || hipDeviceGetAttribute(&cus, hipDeviceAttributeMultiprocessorCount, dev) != hipSuccess) { grid = -1; return; }
        if (hipFuncSetAttribute((const void*)fwd, hipFuncAttributeMaxDynamicSharedMemorySize, LDS_BYTES) != hipSuccess) { fprintf(stderr, "kernel_launch: hipFuncSetAttribute failed\n"); grid = -1; return; }
        if (hipOccupancyMaxActiveBlocksPerMultiprocessor(&per_cu, (const void*)fwd, NWAVES * 64, LDS_BYTES) != hipSuccess || per_cu < 1) fprintf(stderr, "kernel_launch: occupancy query reports %d\n", per_cu);
        (void)hipGetLastError();
        grid = cus;
    }
    if (grid < 0) return;
    (void)hipMemsetAsync((char*)d_ws + WS_CTL, 0, CTL_ZERO_BYTES, stream);
    Params p{};
    for (int i = 0; i < 23; ++i) p.in[i] = d_in[i];
    p.out = (float*)d_out; p.ws = (unsigned char*)d_ws;
    In in;
    in.x_p = (const float*)d_in[0]; in.x_s = (const float*)d_in[1]; in.cache_pool = (const float*)d_in[2]; in.cache_k = (const float*)d_in[3]; in.cache_v = (const float*)d_in[4];
    in.state_conv = (const float*)d_in[5]; in.state_delta = (const float*)d_in[6]; in.page_table = (const int*)d_in[7];
    in.norm_even = (const float*)d_in[8]; in.w_in_even = (const float*)d_in[9]; in.w_pool = (const float*)d_in[10]; in.pool_scale = (const float*)d_in[11];
    in.q_norm = (const float*)d_in[12]; in.k_norm = (const float*)d_in[13]; in.sb_bias = (const float*)d_in[14]; in.w_out_even = (const float*)d_in[15];
    in.norm_odd = (const float*)d_in[16]; in.w_in_odd = (const float*)d_in[17]; in.conv_w = (const float*)d_in[18]; in.a_log = (const float*)d_in[19];
    in.dt_bias = (const float*)d_in[20]; in.o_norm = (const float*)d_in[21]; in.w_out_odd = (const float*)d_in[22];
    float* out = (float*)d_out; char* ws = (char*)d_ws;
    auto launch = [&](int lo, int hi) { p.ph_lo = lo; p.ph_hi = hi; hipLaunchKernelGGL(fwd, dim3(grid), dim3(NWAVES * 64), LDS_BYTES, stream, p); };
    launch(0, N_PHASES);
}
```

```cpp
#include <hip/hip_runtime.h>
#include <cstdio>
#include <cstdint>

constexpr int D = 1024, BP = 8, SEQ = 2048, MP = BP * SEQ;
constexpr int DB = 128, DS = 4, MS = DB * DS, MT = MP + MS;
constexpr int PAST = 2048, PAGE = 128, NPAGE = PAST / PAGE;
constexpr int PW = 512, PG = 128, PBUF = 15;
constexpr int SBH = 8, SBD = 64;
constexpr int EVEN_IN = 3072;
constexpr int DNH = 8, DNK = 128, DNV = 128, CONVD = 3072, ODD_IN = 4112, ODD_PAD = 4352;
constexpr float EPS = 1e-6f;
constexpr float LOG2E = 1.4426950408889634f;
constexpr float QSCALE = 0.125f * LOG2E;

constexpr size_t O_YP = 0;
constexpr size_t O_YS = O_YP + (size_t)MP * D;
constexpr size_t O_POOLP = O_YS + (size_t)MS * D;
constexpr size_t O_POOLS = O_POOLP + (size_t)BP * PBUF * PW;
constexpr size_t O_KP = O_POOLS + (size_t)DB * PBUF * PW;
constexpr size_t O_VP = O_KP + (size_t)MP * 512;
constexpr size_t O_KS = O_VP + (size_t)MP * 512;
constexpr size_t O_VS = O_KS + (size_t)MS * 512;
constexpr size_t O_CONVP = O_VS + (size_t)MS * 512;
constexpr size_t O_CONVS = O_CONVP + (size_t)BP * 3 * CONVD;
constexpr size_t O_DP = O_CONVS + (size_t)DB * 3 * CONVD;
constexpr size_t O_DS = O_DP + (size_t)BP * DNH * DNK * DNV;
constexpr size_t O_END = O_DS + (size_t)DB * DNH * DNK * DNV;
static_assert(O_END == 54726656, "output size");

struct In {
    const float *x_p, *x_s, *cache_pool, *cache_k, *cache_v, *state_conv, *state_delta;
    const int* page_table;
    const float *norm_even, *w_in_even, *w_pool, *pool_scale, *q_norm, *k_norm, *sb_bias, *w_out_even;
    const float *norm_odd, *w_in_odd, *conv_w, *a_log, *dt_bias, *o_norm, *w_out_odd;
};

__device__ __forceinline__ float wave_sum(float v) {
#pragma unroll
    for (int o = 1; o < 64; o <<= 1) v += __shfl_xor(v, o);
    return v;
}
__device__ __forceinline__ float silu_f(float x) { return x / (1.f + __expf(-x)); }
__device__ __forceinline__ float softplus_f(float x) { return fmaxf(x, 0.f) + log1pf(__expf(-fabsf(x))); }
__device__ __forceinline__ float softplus2_f(float z2) { return fmaxf(z2, 0.f) + __log2f(1.f + exp2f(-fabsf(z2))); }
typedef unsigned short bf16;
__device__ __forceinline__ unsigned f2bf(float f) { unsigned u = __builtin_bit_cast(unsigned, f); return (u + 0x7fffu + ((u >> 16) & 1u)) >> 16; }
__device__ __forceinline__ unsigned pk2(float lo, float hi) { return f2bf(lo) | (f2bf(hi) << 16); }
__device__ __forceinline__ float bf2f(bf16 b) { return __builtin_bit_cast(float, (unsigned)b << 16); }
__device__ __forceinline__ const float* xrow(const In& in, int r) { return r < MP ? in.x_p + (size_t)r * D : in.x_s + (size_t)(r - MP) * D; }
namespace pg8 {
#define PG8_LAS __attribute__((address_space(3)))
typedef unsigned short bf16_t;
typedef short bf16x8 __attribute__((ext_vector_type(8)));
typedef float f32x4 __attribute__((ext_vector_type(4)));
typedef unsigned u32x4 __attribute__((ext_vector_type(4)));
constexpr int BM = 256, BK = 64, HALF = 128, HTB = HALF * BK * 2  , STAGE_BYTES = 8 * HTB, NXCD = 8, WGM = 8;

__host__ __device__ __forceinline__ int lds_byte(int r, int c) { const int st = (r >> 4) * 2 + (c >> 5), rr = r & 15, cc = c & 31, ob = rr * 64 + cc * 2; return st * 1024 + (ob ^ (((ob >> 9) & 1) << 5)); }
__host__ __device__ __forceinline__ void stage_rc(int b, int& R, int& C) { const int st = b / 1024, sb = b % 1024, swz = sb ^ (((sb >> 9) & 1) << 5); R = (st >> 1) * 16 + swz / 64; C = (st & 1) * 32 + (swz % 64) / 2; }
__host__ __device__ __forceinline__ int perm32(int rho) { const int n = rho >> 4, i = rho & 15; return 8 * (i >> 2) + 4 * n + (i & 3); }

struct Unit { int pm, pn; };
struct Gemm { const bf16_t* A; const bf16_t* Bt; int M, N, K; };

struct StaticOrder {
    int nM, nN, nwg, G, c;
    __host__ __device__ void init(int M, int N, int G_, int c_) { nM = M / BM; nN = N / BM; nwg = nM * nN; G = G_; c = c_; }
    __host__ __device__ bool next(int i, Unit& u) const {
        const long L = (long)i * G + c; if (L >= nwg) return false;
        int wgid = (int)L; { const int q = nwg / NXCD, r = nwg % NXCD, xcd = wgid % NXCD, off = wgid / NXCD; wgid = (xcd < r ? xcd * (q + 1) : r * (q + 1) + (xcd - r) * q) + off; }
        const int nig = WGM * nN, gid = wgid / nig, fm = gid * WGM, gsz = (nM - fm) < WGM ? (nM - fm) : WGM;
        u.pm = fm + ((wgid % nig) % gsz); u.pn = (wgid % nig) / gsz; return true;
    }
    __device__ __forceinline__ void a_ready(const Unit&) const {}
    __device__ __forceinline__ void done(const Unit&) const {}
};

__device__ __forceinline__ unsigned cvt_pk_bf16(float lo, float hi) { unsigned r; asm volatile("v_cvt_pk_bf16_f32 %0, %1, %2" : "=v"(r) : "v"(lo), "v"(hi)); return r; }
template <class Epi, class Sched, bool ALIGN_EPI = false, bool SP2 = false>
__device__ __forceinline__ void gemm_phase(PG8_LAS unsigned char* lds, const Gemm g, const Sched& S, const Epi& E) {
    int tid_ = threadIdx.x; asm volatile("" : "+v"(tid_));
    const int tid = tid_, wid = __builtin_amdgcn_readfirstlane(tid >> 6), lane = tid & 63, wr = wid >> 2, wc = wid & 3, fr = lane & 15, fq = lane >> 4;
    const int K = g.K, nt = K / BK;
    unsigned voffA[2], voffB[2];
#pragma unroll
    for (int i = 0; i < 2; ++i) { int R, C; stage_rc(tid * 16 + i * 8192, R, C); const int Rb = Epi::PERM ? ((R & ~31) + perm32(R & 31)) : R;
        voffA[i] = (unsigned)(R * K + C) * 2u; voffB[i] = (unsigned)(Rb * K + C) * 2u; }
    const size_t kstep = (size_t)(BK * 2);
    const size_t hstep = (size_t)HALF * K * 2;
    const size_t tstep = 2 * hstep;
    const unsigned ldsw = (unsigned)wid * 1024u;
    const int aoff = lds_byte(wr * 64 + fr, fq * 8), boff = lds_byte(wc * 32 + fr, fq * 8);
#define PG8_SA(b, h) (((b) * 2 + (h)) * HTB)
#define PG8_SB(b, h) ((4 + (b) * 2 + (h)) * HTB)
#define PG8_STAGE(bufoff, gbase, voff) do { _Pragma("unroll") for (int _i = 0; _i < 2; ++_i) \
        __builtin_amdgcn_global_load_lds((const unsigned*)((const char*)(gbase) + (voff)[_i]), (PG8_LAS unsigned*)(lds + (bufoff) + ldsw + _i * 8192), 16, 0, 0); } while (0)
#define PG8_LDA(dst, b, h) do { _Pragma("unroll") for (int m = 0; m < 4; ++m) _Pragma("unroll") for (int k = 0; k < 2; ++k) dst[m][k] = *(const PG8_LAS bf16x8*)(lds + PG8_SA(b, h) + aoff + m * 2048 + k * 1024); } while (0)
#define PG8_LDB(dst, b, h) do { _Pragma("unroll") for (int n = 0; n < 2; ++n) _Pragma("unroll") for (int k = 0; k < 2; ++k) dst[n][k] = *(const PG8_LAS bf16x8*)(lds + PG8_SB(b, h) + boff + n * 2048 + k * 1024); } while (0)
#define PG8_MMA(ai, bj, At, Bt) do { __builtin_amdgcn_s_setprio(1); _Pragma("unroll") for (int m = 0; m < 4; ++m) _Pragma("unroll") for (int n = 0; n < 2; ++n) _Pragma("unroll") for (int k = 0; k < 2; ++k) \
        acc[ai][bj][m][n] = __builtin_amdgcn_mfma_f32_16x16x32_bf16(Bt[n][k], At[m][k], acc[ai][bj][m][n], 0, 0, 0); __builtin_amdgcn_s_setprio(0); } while (0)
#define PG8_WAIT_V(n) asm volatile("s_waitcnt vmcnt(" #n ")" ::: "memory")
#define PG8_WAIT_L(n) asm volatile("s_waitcnt lgkmcnt(" #n ")" ::: "memory")
#define PG8_BAR __builtin_amdgcn_s_barrier()
#define PG8_SCHED __builtin_amdgcn_sched_barrier(0)
    Unit cur, nxt; int ui = 0;
    if (!S.next(0, cur)) return;
    f32x4 acc[2][2][4][2];
#pragma unroll
    for (int a = 0; a < 2; ++a)
#pragma unroll
        for (int b = 0; b < 2; ++b)
#pragma unroll
            for (int m = 0; m < 4; ++m)
#pragma unroll
                for (int n = 0; n < 2; ++n) acc[a][b][m][n] = (f32x4){0.f, 0.f, 0.f, 0.f};
    bf16x8 At[4][2], B0[2][2], B1[2][2];
    const char* cA = (const char*)g.A + (size_t)cur.pm * tstep; const char* cB = (const char*)g.Bt + (size_t)cur.pn * tstep;
    S.a_ready(cur);
    if constexpr (SP2) {
        PG8_STAGE(PG8_SB(0, 0), cB, voffB); PG8_STAGE(PG8_SB(0, 1), cB + hstep, voffB); PG8_STAGE(PG8_SA(0, 0), cA, voffA); PG8_STAGE(PG8_SA(0, 1), cA + hstep, voffA);
        if (wr == 1) PG8_BAR;
        PG8_WAIT_V(2); PG8_BAR;
        PG8_STAGE(PG8_SB(1, 0), cB + kstep, voffB); PG8_STAGE(PG8_SA(1, 0), cA + kstep, voffA); PG8_STAGE(PG8_SB(1, 1), cB + hstep + kstep, voffB);
        PG8_WAIT_V(6); PG8_BAR;
    } else {
        PG8_STAGE(PG8_SB(0, 0), cB, voffB); PG8_STAGE(PG8_SA(0, 0), cA, voffA); PG8_STAGE(PG8_SB(0, 1), cB + hstep, voffB); PG8_STAGE(PG8_SA(0, 1), cA + hstep, voffA);
        if (wr == 1) PG8_BAR;
        PG8_WAIT_V(4); PG8_BAR;
        PG8_STAGE(PG8_SB(1, 0), cB + kstep, voffB); PG8_STAGE(PG8_SA(1, 0), cA + kstep, voffA); PG8_STAGE(PG8_SB(1, 1), cB + hstep + kstep, voffB);
        PG8_WAIT_V(6); PG8_BAR;
    }
    for (;;) {
        const bool has_next = S.next(ui + 1, nxt);
        const char* nA = has_next ? (const char*)g.A + (size_t)nxt.pm * tstep : cA; const char* nB = has_next ? (const char*)g.Bt + (size_t)nxt.pn * tstep : cB;
        for (int t = 0; t < nt; t += 2) {
            const bool last = (t == nt - 2);
            const char* a1 = cA + (size_t)(t + 1) * kstep;
            const char* a2 = last ? nA : cA + (size_t)(t + 2) * kstep; const char* b2 = last ? nB : cB + (size_t)(t + 2) * kstep;
            const char* a3 = a2 + kstep; const char* b3 = b2 + kstep;
            if (last && has_next) S.a_ready(nxt);
            if constexpr (SP2) {
            PG8_LDB(B0, 0, 0); PG8_LDB(B1, 0, 1); PG8_SCHED; PG8_LDA(At, 0, 0); PG8_STAGE(PG8_SA(1, 1), a1 + hstep, voffA);
            PG8_WAIT_V(8); PG8_WAIT_L(0); PG8_BAR; PG8_MMA(0, 0, At, B0); PG8_MMA(0, 1, At, B1); PG8_BAR; PG8_SCHED;
            PG8_LDA(At, 0, 1); PG8_STAGE(PG8_SB(0, 0), b2, voffB); PG8_STAGE(PG8_SB(0, 1), b2 + hstep, voffB); PG8_STAGE(PG8_SA(0, 0), a2, voffA);
            PG8_WAIT_V(8); PG8_WAIT_L(0); PG8_BAR; PG8_MMA(1, 0, At, B0); PG8_MMA(1, 1, At, B1); PG8_BAR; PG8_SCHED;
            PG8_LDB(B0, 1, 0); PG8_LDB(B1, 1, 1); PG8_SCHED; PG8_LDA(At, 1, 0); PG8_STAGE(PG8_SA(0, 1), a2 + hstep, voffA);
            PG8_WAIT_V(8); PG8_WAIT_L(0); PG8_BAR; PG8_MMA(0, 0, At, B0); PG8_MMA(0, 1, At, B1); PG8_BAR; PG8_SCHED;
            PG8_LDA(At, 1, 1); PG8_STAGE(PG8_SB(1, 0), b3, voffB); PG8_STAGE(PG8_SB(1, 1), b3 + hstep, voffB); PG8_STAGE(PG8_SA(1, 0), a3, voffA);
            PG8_WAIT_V(8); PG8_WAIT_L(0); PG8_BAR; PG8_MMA(1, 0, At, B0); PG8_MMA(1, 1, At, B1); PG8_BAR; PG8_SCHED;
            } else {
            PG8_LDB(B0, 0, 0); PG8_SCHED; PG8_LDA(At, 0, 0); PG8_STAGE(PG8_SA(1, 1), a1 + hstep, voffA);
            PG8_WAIT_L(8); PG8_BAR; PG8_WAIT_L(0); PG8_MMA(0, 0, At, B0); PG8_BAR; PG8_SCHED;
            PG8_LDB(B1, 0, 1); PG8_STAGE(PG8_SB(0, 0), b2, voffB);
            PG8_BAR; PG8_WAIT_L(0); PG8_MMA(0, 1, At, B1); PG8_BAR;
            PG8_LDA(At, 0, 1); PG8_STAGE(PG8_SA(0, 0), a2, voffA);
            PG8_BAR; PG8_WAIT_L(0); PG8_MMA(1, 0, At, B0); PG8_BAR; PG8_SCHED;
            PG8_STAGE(PG8_SB(0, 1), b2 + hstep, voffB);
            PG8_WAIT_V(6); PG8_BAR; PG8_MMA(1, 1, At, B1); PG8_BAR;
            PG8_LDB(B0, 1, 0); PG8_SCHED; PG8_LDA(At, 1, 0); PG8_STAGE(PG8_SA(0, 1), a2 + hstep, voffA);
            PG8_WAIT_L(8); PG8_BAR; PG8_WAIT_L(0); PG8_MMA(0, 0, At, B0); PG8_BAR; PG8_SCHED;
            PG8_LDB(B1, 1, 1); PG8_STAGE(PG8_SB(1, 0), b3, voffB);
            PG8_BAR; PG8_WAIT_L(0); PG8_MMA(0, 1, At, B1); PG8_BAR;
            PG8_LDA(At, 1, 1); PG8_STAGE(PG8_SA(1, 0), a3, voffA);
            PG8_BAR; PG8_WAIT_L(0); PG8_MMA(1, 0, At, B0); PG8_BAR; PG8_SCHED;
            PG8_STAGE(PG8_SB(1, 1), b3 + hstep, voffB);
            PG8_WAIT_V(6); PG8_BAR; PG8_MMA(1, 1, At, B1); PG8_BAR;
            }
        }
        if constexpr (ALIGN_EPI) { if (wr == 0) PG8_BAR; }
        if constexpr (!Epi::AFTER_DRAIN) { E(acc, cur, wr, wc, fr, fq); S.done(cur); }
        if (!has_next) break;
#pragma unroll
        for (int a = 0; a < 2; ++a)
#pragma unroll
            for (int b = 0; b < 2; ++b)
#pragma unroll
                for (int m = 0; m < 4; ++m)
#pragma unroll
                    for (int n = 0; n < 2; ++n) acc[a][b][m][n] = (f32x4){0.f, 0.f, 0.f, 0.f};
        cur = nxt; cA = nA; cB = nB; ++ui;
        if constexpr (ALIGN_EPI) { if (wr == 1) PG8_BAR; }
    }
    PG8_WAIT_V(0);
    if constexpr (!ALIGN_EPI) { if (wr == 0) PG8_BAR; }
    PG8_BAR;
    if constexpr (Epi::AFTER_DRAIN) { E.fused(acc, cur, wr, wc, fr, fq, lds, wid, lane); S.done(cur); }
#undef PG8_SA
#undef PG8_SB
#undef PG8_STAGE
#undef PG8_LDA
#undef PG8_LDB
#undef PG8_MMA
#undef PG8_WAIT_V
#undef PG8_WAIT_L
#undef PG8_BAR
#undef PG8_SCHED
}
}

#define GAS __attribute__((address_space(1)))
#define LAS __attribute__((address_space(3)))
typedef unsigned v4u __attribute__((ext_vector_type(4)));
typedef unsigned v2u __attribute__((ext_vector_type(2)));
typedef float f32x4 __attribute__((ext_vector_type(4)));
typedef float f32x16 __attribute__((ext_vector_type(16)));
typedef short bf16x8 __attribute__((ext_vector_type(8)));
typedef short bf16x4 __attribute__((ext_vector_type(4)));
typedef GAS unsigned gu32;
#define RLX_AGENT __ATOMIC_RELAXED, __HIP_MEMORY_SCOPE_AGENT
#define LDS_WAIT() asm volatile("s_waitcnt lgkmcnt(0)" ::: "memory")
#define VM_WAIT() asm volatile("s_waitcnt vmcnt(0)" ::: "memory")
using pg8::cvt_pk_bf16;
#define XB_TMO      128
#define XB_XCNT(j)  (256  + 64 * (j))
#define XB_XSUB(j)  (1280 + 64 * (j))
#define XB_XGEN(j)  (2304 + 64 * (j))
#define XB_TOP      3328
#define XB_TOPGEN   3392
#define XCD_BAR_WORDS 3456
#define XB_SPIN_CAP (1u << 18)

__device__ __forceinline__ unsigned xb_ld(unsigned* p)              { return __hip_atomic_load(p, __ATOMIC_RELAXED, __HIP_MEMORY_SCOPE_AGENT); }
__device__ __forceinline__ unsigned xb_add(unsigned* p, unsigned v) { return __hip_atomic_fetch_add(p, v, __ATOMIC_RELAXED, __HIP_MEMORY_SCOPE_AGENT); }
__device__ __forceinline__ unsigned xb_xcc_id() { return (unsigned)__builtin_amdgcn_s_getreg((3 << 11) | 20) & 0xFu; }
#define XB_SPIN(cond, bar) do { unsigned _sp = 0; while (cond) { __builtin_amdgcn_s_sleep(1); \
    if ((++_sp & 255u) == 0u) { if (xb_ld(&(bar)[XB_TMO])) break; if (_sp > XB_SPIN_CAP) { atomicAdd(&(bar)[XB_TMO], 1u); break; } } } } while (0)

struct XcdBarrier {
    unsigned* bar; unsigned x;
    volatile LAS unsigned* st;
};

__device__ __forceinline__ XcdBarrier xcd_barrier_post(unsigned* bar, volatile LAS unsigned* st) {
    XcdBarrier b; b.bar = bar; b.x = xb_xcc_id(); b.st = st;
    if (threadIdx.x == 0) (void)xb_add(&bar[XB_XCNT(b.x)], 1u);
    return b;
}
__device__ __forceinline__ void xcd_barrier_complete(unsigned* bar, unsigned x, unsigned& nloc, unsigned& nx) {
    const unsigned G = gridDim.x * gridDim.y * gridDim.z;
    unsigned sum, cnt, mine, sp = 0u;
    for (;;) {
        sum = 0u; cnt = 0u; mine = 0u;
#pragma unroll
        for (unsigned j = 0; j < 16; ++j) { const unsigned c = xb_ld(&bar[XB_XCNT(j)]); sum += c; cnt += (c > 0u) ? 1u : 0u; mine = (j == x) ? c : mine; }
        if (sum == G) break;
        __builtin_amdgcn_s_sleep(1);
        if ((++sp & 255u) == 0u) { if (xb_ld(&bar[XB_TMO])) break; if (sp > XB_SPIN_CAP) { atomicAdd(&bar[XB_TMO], 1u); break; } }
    }
    nloc = mine > 0u ? mine : 1u; nx = cnt > 0u ? cnt : 1u;
}

__device__ __forceinline__ void xcd_barrier(const XcdBarrier& b) {
    asm volatile("s_waitcnt vmcnt(0)" ::: "memory");
    __syncthreads();
    if (threadIdx.x == 0) {
        unsigned* bar = b.bar;
        __builtin_amdgcn_s_waitcnt(0);
        unsigned nloc = b.st[0], nx = b.st[1];
        if (nloc == 0u) { xcd_barrier_complete(bar, b.x, nloc, nx); b.st[0] = nloc; b.st[1] = nx; }
        const unsigned old = xb_add(&bar[XB_XSUB(b.x)], 1u);
        const unsigned gen = old / nloc;
        if (old + 1u == (gen + 1u) * nloc) {
            __builtin_amdgcn_fence(__ATOMIC_RELEASE, "agent");
            asm volatile("s_waitcnt vmcnt(0)" ::: "memory");
            const unsigned og = xb_add(&bar[XB_TOP], 1u);
            const unsigned tg = og / nx;
            if (og + 1u == (tg + 1u) * nx) xb_add(&bar[XB_TOPGEN], 1u);
            else XB_SPIN(xb_ld(&bar[XB_TOPGEN]) == tg, bar);
            __builtin_amdgcn_fence(__ATOMIC_ACQUIRE, "agent");
            xb_add(&bar[XB_XGEN(b.x)], 1u);
            asm volatile("s_waitcnt vmcnt(0)" ::: "memory");
        } else {
            XB_SPIN(xb_ld(&bar[XB_XGEN(b.x)]) == gen, bar);
            __builtin_amdgcn_fence(__ATOMIC_ACQUIRE, "agent");
            asm volatile("s_waitcnt vmcnt(0)" ::: "memory");
        }
    }
    __syncthreads();
}


constexpr size_t al256(size_t x) { return (x + 255) & ~(size_t)255; }
constexpr size_t MiB = 1u << 20;
constexpr size_t WS_CTL = 0, CTL_ZERO_BYTES = 1 * MiB;
constexpr int CW_BAR = 4096, CW_DBG = 64;
#ifndef DBG_CHECK
#define DBG_CHECK 0
#endif
#ifndef DBG_WHICH
#define DBG_WHICH 2
#endif
constexpr size_t WS_W1T = 1 * MiB;
constexpr size_t WS_W2T = WS_W1T + (size_t)EVEN_IN * D * 2;
constexpr size_t WS_W3T = WS_W2T + (size_t)D * D * 2;
constexpr size_t WS_W4T = WS_W3T + (size_t)ODD_PAD * D * 2;
constexpr size_t WS_WPT = WS_W4T + (size_t)D * D * 2;
constexpr size_t WS_XN1 = WS_WPT + (size_t)4 * PG * PG * 2;
constexpr size_t WS_U = WS_XN1 + (size_t)MT * D * 2;
constexpr size_t WS_QN = WS_U + (size_t)MT * 512 * 2;
constexpr size_t WS_KN = WS_QN + (size_t)MT * 512 * 2;
constexpr size_t WS_VB = WS_KN + (size_t)MT * 512 * 2;
constexpr size_t WS_VT = WS_VB + (size_t)MT * 512 * 2;
constexpr size_t WS_SG = WS_VT + (size_t)MP * 512 * 2;
constexpr size_t WS_MIX = WS_SG + (size_t)MT * D * 2;
constexpr size_t WS_Y1 = WS_MIX + (size_t)MT * D * 2;
constexpr size_t WS_A2 = WS_Y1 + (size_t)MT * D * 4;
constexpr size_t WS_SSP = WS_A2 + (size_t)MT * D * 2;
constexpr size_t WS_QKVP = WS_SSP + (size_t)MT * 16 * 4;
constexpr size_t WS_SZ = WS_QKVP + (size_t)MT * CONVD * 2;
constexpr size_t WS_BA = WS_SZ + (size_t)MT * D * 2;
constexpr size_t WS_A4 = WS_BA + (size_t)MT * 16 * 4;
constexpr size_t WS_SLOW = al256(WS_A4 + (size_t)MT * D * 2);
constexpr size_t NW_D = WS_SLOW;
constexpr size_t NW_C = NW_D + (size_t)MT * 512 * 4;
constexpr size_t NW_BETA = NW_C + (size_t)MT * CONVD * 4;
constexpr size_t NW_G = NW_BETA + (size_t)MT * DNH * 4;
constexpr size_t NW_O = NW_G + (size_t)MT * DNH * 4;
constexpr size_t WS_END = NW_O + (size_t)MT * D * 4;
static_assert(WS_W1T % 256 == 0 && WS_XN1 % 256 == 0 && WS_U % 256 == 0 && WS_Y1 % 256 == 0 && WS_QKVP % 256 == 0 && WS_A4 % 256 == 0, "alignment");

constexpr int RING_OFF = 0, RING_BYTES = 131072;
constexpr int LDSCTL_OFF = 143360, MISC_OFF = LDSCTL_OFF + 320;
constexpr int LDS_BYTES = 147456;
constexpr int NWAVES = 8;

struct Params { const void* in[23]; float* out; unsigned char* ws; int ph_lo, ph_hi; };
struct Frame {
    LAS unsigned char* lds;
    volatile LAS unsigned* MISC;
    gu32* ctl;
    int tid, lane, wave;
    int vcu, G;
};
__device__ __forceinline__ In make_in(const Params& P) {
    In in;
    in.x_p = (const float*)P.in[0]; in.x_s = (const float*)P.in[1]; in.cache_pool = (const float*)P.in[2]; in.cache_k = (const float*)P.in[3]; in.cache_v = (const float*)P.in[4];
    in.state_conv = (const float*)P.in[5]; in.state_delta = (const float*)P.in[6]; in.page_table = (const int*)P.in[7];
    in.norm_even = (const float*)P.in[8]; in.w_in_even = (const float*)P.in[9]; in.w_pool = (const float*)P.in[10]; in.pool_scale = (const float*)P.in[11];
    in.q_norm = (const float*)P.in[12]; in.k_norm = (const float*)P.in[13]; in.sb_bias = (const float*)P.in[14]; in.w_out_even = (const float*)P.in[15];
    in.norm_odd = (const float*)P.in[16]; in.w_in_odd = (const float*)P.in[17]; in.conv_w = (const float*)P.in[18]; in.a_log = (const float*)P.in[19];
    in.dt_bias = (const float*)P.in[20]; in.o_norm = (const float*)P.in[21]; in.w_out_odd = (const float*)P.in[22];
    return in;
}

template <int MODE>
__device__ __forceinline__ void p0_transpose_item(const float* W, int K, int ldw, int nblk, bf16* WT, LAS float* scr, int item, int lane) {
    const int kb = item / nblk, nb = item % nblk, k0 = 64 * kb, n0 = 32 * nb;
#pragma unroll 8
    for (int i = 0; i < 32; ++i) { const int kk = 2 * i + (lane >> 5); scr[kk * 33 + (lane & 31)] = W[(size_t)(k0 + kk) * ldw + n0 + (lane & 31)]; }
    LDS_WAIT(); asm volatile("" ::: "memory");
    const int c = lane & 7;
#pragma unroll
    for (int j = 0; j < 4; ++j) { const int n = (lane >> 3) + 8 * j; const LAS float* s = scr + (8 * c) * 33 + n;
        v4u o; o.x = pk2(s[0 * 33], s[1 * 33]); o.y = pk2(s[2 * 33], s[3 * 33]); o.z = pk2(s[4 * 33], s[5 * 33]); o.w = pk2(s[6 * 33], s[7 * 33]);
        const int col = n0 + n;
        const int row = MODE == 1 ? ((col & ~255) + 128 * ((col & 63) >> 5) + 32 * ((col & 255) >> 6) + (col & 31)) : col;
        *(GAS v4u*)(WT + (size_t)row * K + k0 + 8 * c) = o; }
    LDS_WAIT(); asm volatile("" ::: "memory");
}
__device__ __forceinline__ void rms_row_to_bf16(const float* xrow_, const float* g, bf16* orow, int lane) {
    const GAS f32x4* xr = (const GAS f32x4*)xrow_ + lane; const GAS f32x4* gr = (const GAS f32x4*)g + lane;
    f32x4 v[4]; float s = 0.f;
#pragma unroll
    for (int j = 0; j < 4; ++j) { v[j] = xr[64 * j]; s += (v[j].x * v[j].x + v[j].y * v[j].y) + (v[j].z * v[j].z + v[j].w * v[j].w); }
    const float rstd = rsqrtf(wave_sum(s) * (1.f / D) + EPS);
    GAS unsigned long long* o8 = (GAS unsigned long long*)orow + lane;
#pragma unroll
    for (int j = 0; j < 4; ++j) { const f32x4 gg = gr[64 * j];
        o8[64 * j] = (unsigned long long)pk2(v[j].x * rstd * gg.x, v[j].y * rstd * gg.y) | ((unsigned long long)pk2(v[j].z * rstd * gg.z, v[j].w * rstd * gg.w) << 32); }
}
__device__ __forceinline__ void p0_prologue(const Frame& F, const In& in, unsigned char* ws) {
    LAS float* scr = (LAS float*)(F.lds + RING_OFF + F.wave * 16384);
    const int gw = F.vcu * NWAVES + F.wave, NGW = F.G * NWAVES;
    bf16* W1t = (bf16*)(ws + WS_W1T); bf16* W2t = (bf16*)(ws + WS_W2T); bf16* W3t = (bf16*)(ws + WS_W3T); bf16* W4t = (bf16*)(ws + WS_W4T); bf16* Wpt = (bf16*)(ws + WS_WPT);
    constexpr int I_1 = 16 * 96, I_2 = 16 * 32, I_3 = 16 * 128, I_4 = 16 * 32, I_P = 4 * 8;
    constexpr int NITEMS = I_1 + I_2 + I_3 + I_4 + I_P;
    for (int it = gw; it < NITEMS; it += NGW) {
        int r = it;
        if (r < I_1) { p0_transpose_item<1>(in.w_in_even, D, EVEN_IN, 96, W1t, scr, r, F.lane); continue; } r -= I_1;
        if (r < I_2) { p0_transpose_item<0>(in.w_out_even, D, D, 32, W2t, scr, r, F.lane); continue; } r -= I_2;
        if (r < I_3) { p0_transpose_item<0>(in.w_in_odd, D, ODD_IN, 128, W3t, scr, r, F.lane); continue; } r -= I_3;
        if (r < I_4) { p0_transpose_item<0>(in.w_out_odd, D, D, 32, W4t, scr, r, F.lane); continue; } r -= I_4;
        { const int g = r / 8; p0_transpose_item<0>(in.w_pool + (size_t)g * PG * PG, PG, PG, 4, Wpt + (size_t)g * PG * PG, scr, r % 8, F.lane); }
    }
    const int gt = F.vcu * (NWAVES * 64) + F.tid, NGT = F.G * NWAVES * 64;
    for (int i = gt; i < 16 * D; i += NGT) { const int k = i >> 4, n = i & 15; W3t[(size_t)(4096 + n) * D + k] = (bf16)f2bf(in.w_in_odd[(size_t)k * ODD_IN + 4096 + n]); }
    for (int i = gt; i < (ODD_PAD - ODD_IN) * D / 8; i += NGT) ((GAS v4u*)(W3t + (size_t)ODD_IN * D))[i] = (v4u){0u, 0u, 0u, 0u};
    bf16* XN1 = (bf16*)(ws + WS_XN1);
    for (int m = gw; m < MT; m += NGW) rms_row_to_bf16(xrow(in, m), in.norm_even, XN1 + (size_t)m * D, F.lane);
}

namespace ep {
using pg8::Unit; using pg8::BM;
__device__ __forceinline__ v4u pack8(f32x4 a, f32x4 b) { v4u w; w.x = cvt_pk_bf16(a[0], a[1]); w.y = cvt_pk_bf16(a[2], a[3]); w.z = cvt_pk_bf16(b[0], b[1]); w.w = cvt_pk_bf16(b[2], b[3]); return w; }
__device__ __forceinline__ float silu_fast(float x) { return x * __builtin_amdgcn_rcpf(1.f + __builtin_amdgcn_exp2f(-x * LOG2E)); }
__device__ __forceinline__ f32x4 silu4(f32x4 v) { return (f32x4){silu_fast(v[0]), silu_fast(v[1]), silu_fast(v[2]), silu_fast(v[3])}; }
__device__ __forceinline__ float sq4(f32x4 v) { return (v[0] * v[0] + v[1] * v[1]) + (v[2] * v[2] + v[3] * v[3]); }

struct Epi1 {
    static constexpr bool PERM = true, AFTER_DRAIN = false;
    bf16 *U, *QN, *KN, *VB, *VT, *SG; float* out; const float *qg, *kg;
    __device__ __forceinline__ void operator()(const f32x4 (&acc)[2][2][4][2], const Unit& u, int wr, int wc, int fr, int fq) const {
        const int pn = u.pn, row0 = u.pm * BM + wr * 64 + fr, cb = 64 * wc + 8 * fq;
        if (pn < 2) {
#pragma unroll
            for (int ai = 0; ai < 2; ++ai)
#pragma unroll
                for (int m = 0; m < 4; ++m) { const int row = row0 + ai * 128 + m * 16; bf16* p = U + (size_t)row * 512 + 256 * pn + cb;
#pragma unroll
                    for (int bj = 0; bj < 2; ++bj) *(v4u*)(p + 32 * bj) = pack8(acc[ai][bj][m][0], acc[ai][bj][m][1]); }
        } else if (pn < 6) {
            const bool isq = pn < 4; const float* g = isq ? qg : kg; const int hc = 256 * (pn - (isq ? 2 : 4)) + cb;
            f32x4 gv[2][2];
#pragma unroll
            for (int bj = 0; bj < 2; ++bj)
#pragma unroll
                for (int n = 0; n < 2; ++n) gv[bj][n] = *(const f32x4*)(g + 32 * bj + 8 * fq + 4 * n);
#pragma unroll
            for (int ai = 0; ai < 2; ++ai)
#pragma unroll
                for (int m = 0; m < 4; ++m) { const int row = row0 + ai * 128 + m * 16;
                    float ss = (sq4(acc[ai][0][m][0]) + sq4(acc[ai][0][m][1])) + (sq4(acc[ai][1][m][0]) + sq4(acc[ai][1][m][1]));
                    ss += __shfl_xor(ss, 16); ss += __shfl_xor(ss, 32);
                    const float rs = rsqrtf(ss * (1.f / 64.f) + EPS) * (isq ? QSCALE : 1.f);
                    f32x4 v[2][2];
#pragma unroll
                    for (int bj = 0; bj < 2; ++bj)
#pragma unroll
                        for (int n = 0; n < 2; ++n) v[bj][n] = acc[ai][bj][m][n] * rs * gv[bj][n];
                    if (isq) {
#pragma unroll
                        for (int bj = 0; bj < 2; ++bj) *(v4u*)(QN + (size_t)row * 512 + hc + 32 * bj) = pack8(v[bj][0], v[bj][1]);
                    } else {
                        float* ko = row < MP ? out + O_KP + (size_t)row * 512 : out + O_KS + (size_t)(row - MP) * 512;
#pragma unroll
                        for (int bj = 0; bj < 2; ++bj) { *(v4u*)(KN + (size_t)row * 512 + hc + 32 * bj) = pack8(v[bj][0], v[bj][1]);
                            *(f32x4*)(ko + hc + 32 * bj) = v[bj][0]; *(f32x4*)(ko + hc + 32 * bj + 4) = v[bj][1]; }
                    } }
        } else if (pn < 8) {
            const int hc = 256 * (pn - 6) + cb, h = 4 * (pn - 6) + wc;
#pragma unroll
            for (int ai = 0; ai < 2; ++ai)
#pragma unroll
                for (int m = 0; m < 4; ++m) { const int row = row0 + ai * 128 + m * 16;
                    float* vo = row < MP ? out + O_VP + (size_t)row * 512 : out + O_VS + (size_t)(row - MP) * 512;
#pragma unroll
                    for (int bj = 0; bj < 2; ++bj) { const f32x4 a = acc[ai][bj][m][0], b = acc[ai][bj][m][1];
                        *(v4u*)(VB + (size_t)row * 512 + hc + 32 * bj) = pack8(a, b);
                        *(f32x4*)(vo + hc + 32 * bj) = a; *(f32x4*)(vo + hc + 32 * bj + 4) = b;
                        if (row < MP) { bf16* vt = VT + ((size_t)((row >> 11) * 8 + h) * 64 + 32 * bj + 8 * fq) * SEQ + (row & 2047);
#pragma unroll
                            for (int e = 0; e < 4; ++e) { vt[(size_t)e * SEQ] = (bf16)f2bf(a[e]); vt[(size_t)(4 + e) * SEQ] = (bf16)f2bf(b[e]); } } } }
        } else {
            const int hc = 256 * (pn - 8) + cb;
#pragma unroll
            for (int ai = 0; ai < 2; ++ai)
#pragma unroll
                for (int m = 0; m < 4; ++m) { const int row = row0 + ai * 128 + m * 16; bf16* p = SG + (size_t)row * 1024 + hc;
#pragma unroll
                    for (int bj = 0; bj < 2; ++bj) *(v4u*)(p + 32 * bj) = pack8(silu4(acc[ai][bj][m][0]), silu4(acc[ai][bj][m][1])); }
        }
    }
};
struct Epi4 {
    static constexpr bool PERM = true, AFTER_DRAIN = false;
    const float *xp, *xs, *g2; float* Y1; bf16* A2; float* SSP;
    __device__ __forceinline__ void operator()(const f32x4 (&acc)[2][2][4][2], const Unit& u, int wr, int wc, int fr, int fq) const {
        const int row0 = u.pm * BM + wr * 64 + fr, c0 = u.pn * BM + wc * 32 + 8 * fq;
        f32x4 gv[2][2];
#pragma unroll
        for (int bj = 0; bj < 2; ++bj)
#pragma unroll
            for (int n = 0; n < 2; ++n) gv[bj][n] = *(const f32x4*)(g2 + c0 + 128 * bj + 4 * n);
#pragma unroll
        for (int ai = 0; ai < 2; ++ai)
#pragma unroll
            for (int m = 0; m < 4; ++m) { const int row = row0 + ai * 128 + m * 16;
                const float* xr = (row < MP ? xp + (size_t)row * D : xs + (size_t)(row - MP) * D) + c0;
                float ss = 0.f;
#pragma unroll
                for (int bj = 0; bj < 2; ++bj) { const f32x4 y0 = *(const f32x4*)(xr + 128 * bj) + acc[ai][bj][m][0], y1 = *(const f32x4*)(xr + 128 * bj + 4) + acc[ai][bj][m][1];
                    *(f32x4*)(Y1 + (size_t)row * D + c0 + 128 * bj) = y0; *(f32x4*)(Y1 + (size_t)row * D + c0 + 128 * bj + 4) = y1;
                    ss += sq4(y0) + sq4(y1);
                    *(v4u*)(A2 + (size_t)row * D + c0 + 128 * bj) = pack8(y0 * gv[bj][0], y1 * gv[bj][1]); }
                ss += __shfl_xor(ss, 16); ss += __shfl_xor(ss, 32);
                if (fq == 0) SSP[(size_t)row * 16 + u.pn * 4 + wc] = ss; }
    }
};
struct Epi5 {
    static constexpr bool PERM = true, AFTER_DRAIN = false;
    const float* SSP; bf16 *QKVP, *SZ; float *BA, *out;
    __device__ __forceinline__ void operator()(const f32x4 (&acc)[2][2][4][2], const Unit& u, int wr, int wc, int fr, int fq) const {
        const int pn = u.pn, row0 = u.pm * BM + wr * 64 + fr, c0 = pn * BM + wc * 32 + 8 * fq;
#pragma unroll
        for (int ai = 0; ai < 2; ++ai)
#pragma unroll
            for (int m = 0; m < 4; ++m) { const int row = row0 + ai * 128 + m * 16;
                const f32x4* sp = (const f32x4*)(SSP + (size_t)row * 16);
                const f32x4 s0 = sp[0], s1 = sp[1], s2 = sp[2], s3 = sp[3];
                const float st = ((s0[0] + s0[1]) + (s0[2] + s0[3])) + ((s1[0] + s1[1]) + (s1[2] + s1[3])) + ((s2[0] + s2[1]) + (s2[2] + s2[3])) + ((s3[0] + s3[1]) + (s3[2] + s3[3]));
                const float rs = rsqrtf(st * (1.f / D) + EPS);
                if (pn < 12) {
                    float* cs = nullptr;
                    if (row < MP) { const int t = row & 2047; if (t >= SEQ - 3) cs = out + O_CONVP + (size_t)((row >> 11) * 3 + (t - (SEQ - 3))) * CONVD; }
                    else { const int i = (row - MP) & 3; if (i >= 1) cs = out + O_CONVS + (size_t)(((row - MP) >> 2) * 3 + (i - 1)) * CONVD; }
#pragma unroll
                    for (int bj = 0; bj < 2; ++bj) { const f32x4 a = acc[ai][bj][m][0] * rs, b = acc[ai][bj][m][1] * rs;
                        *(v4u*)(QKVP + (size_t)row * CONVD + c0 + 128 * bj) = pack8(a, b);
                        if (cs) { *(f32x4*)(cs + c0 + 128 * bj) = a; *(f32x4*)(cs + c0 + 128 * bj + 4) = b; } }
                } else if (pn < 16) {
#pragma unroll
                    for (int bj = 0; bj < 2; ++bj) *(v4u*)(SZ + (size_t)row * D + (c0 - CONVD) + 128 * bj) = pack8(silu4(acc[ai][bj][m][0] * rs), silu4(acc[ai][bj][m][1] * rs));
                } else if (wc == 0 && fq < 2) {
                    *(f32x4*)(BA + (size_t)row * 16 + 8 * fq) = acc[ai][0][m][0] * rs; *(f32x4*)(BA + (size_t)row * 16 + 8 * fq + 4) = acc[ai][0][m][1] * rs;
                } }
    }
};
struct Epi8 {
    static constexpr bool PERM = true, AFTER_DRAIN = false;
    const float* Y1; float* out;
    __device__ __forceinline__ void operator()(const f32x4 (&acc)[2][2][4][2], const Unit& u, int wr, int wc, int fr, int fq) const {
        const int row0 = u.pm * BM + wr * 64 + fr, c0 = u.pn * BM + wc * 32 + 8 * fq;
#pragma unroll
        for (int ai = 0; ai < 2; ++ai)
#pragma unroll
            for (int m = 0; m < 4; ++m) { const int row = row0 + ai * 128 + m * 16;
                const float* yr = Y1 + (size_t)row * D + c0; float* o = (row < MP ? out + O_YP + (size_t)row * D : out + O_YS + (size_t)(row - MP) * D) + c0;
#pragma unroll
                for (int bj = 0; bj < 2; ++bj) { *(f32x4*)(o + 128 * bj) = *(const f32x4*)(yr + 128 * bj) + acc[ai][bj][m][0]; *(f32x4*)(o + 128 * bj + 4) = *(const f32x4*)(yr + 128 * bj + 4) + acc[ai][bj][m][1]; } }
    }
};
}

namespace at {
typedef float f32x2_t __attribute__((ext_vector_type(2))); typedef __bf16 bf16x2_t __attribute__((ext_vector_type(2)));
__device__ __forceinline__ unsigned cvtpk(float lo, float hi) { f32x2_t v = {lo, hi}; bf16x2_t b = __builtin_convertvector(v, bf16x2_t); return __builtin_bit_cast(unsigned, b); }
__device__ __forceinline__ int crow(int r, int h) { return (r & 3) + 8 * (r >> 2) + 4 * h; }
#define MFMA32(a, b, c) __builtin_amdgcn_mfma_f32_32x32x16_bf16((a), (b), (c), 0, 0, 0)
struct KVFrag { bf16x8 k[4]; bf16x4 v[2][2][2]; };
__device__ __forceinline__ void load_frags(KVFrag& f, const bf16* kbase, const bf16* vbase, int kb, int ql) {
    const bf16* kp = kbase + (size_t)(kb * 32 + ql) * 512;
#pragma unroll
    for (int c = 0; c < 4; ++c) f.k[c] = *(const bf16x8*)(kp + 16 * c);
    const bf16* vp = vbase + kb * 32;
#pragma unroll
    for (int db = 0; db < 2; ++db)
#pragma unroll
        for (int s = 0; s < 2; ++s)
#pragma unroll
            for (int p = 0; p < 2; ++p) f.v[db][s][p] = *(const bf16x4*)(vp + (size_t)db * 32 * SEQ + 16 * s + 8 * p);
}
__device__ __forceinline__ bf16x8 cat8(bf16x4 a, bf16x4 b) { return __builtin_shufflevector(a, b, 0, 1, 2, 3, 4, 5, 6, 7); }
__device__ __forceinline__ bf16x8 pack8r(const float (&x)[16], int s) {
    v4u p; p.x = cvtpk(x[8 * s], x[8 * s + 1]); p.y = cvtpk(x[8 * s + 2], x[8 * s + 3]); p.z = cvtpk(x[8 * s + 4], x[8 * s + 5]); p.w = cvtpk(x[8 * s + 6], x[8 * s + 7]);
    return __builtin_bit_cast(bf16x8, p);
}
template <bool DIAG>
__device__ __forceinline__ void step(const KVFrag& f, const bf16x8 (&qf)[4], const bf16x8 (&tm)[2], f32x16& o0, f32x16& o1, float& R, float bias2, int ql, int h) {
    f32x16 z;
#pragma unroll
    for (int r = 0; r < 16; ++r) z[r] = bias2;
#pragma unroll
    for (int c = 0; c < 4; ++c) z = MFMA32(f.k[c], qf[c], z);
    float lk[16], t[16];
#pragma unroll
    for (int r = 0; r < 16; ++r) {
        const float zz = z[r];
        const float sp = fmaxf(zz, 0.f) + __builtin_amdgcn_logf(1.f + __builtin_amdgcn_exp2f(-fabsf(zz)));
        const bool valid = !DIAG || (crow(r, h) < ql);
        lk[r] = valid ? -sp : 0.f; t[r] = zz - sp;
    }
    f32x16 sfx;
#pragma unroll
    for (int r = 0; r < 16; ++r) sfx[r] = R;
    sfx = MFMA32(tm[0], pack8r(lk, 0), sfx); sfx = MFMA32(tm[1], pack8r(lk, 1), sfx);
    float a[16];
#pragma unroll
    for (int r = 0; r < 16; ++r) { const bool valid = !DIAG || (crow(r, h) < ql); const float e = __builtin_amdgcn_exp2f(t[r] + sfx[r]); a[r] = valid ? e : 0.f; }
    { const float rn = sfx[0] + lk[0]; auto rr = __builtin_amdgcn_permlane32_swap(__float_as_uint(rn), __float_as_uint(rn), false, false); R = fminf(__uint_as_float(rr[0]), __uint_as_float(rr[1])); }
    const bf16x8 p0 = pack8r(a, 0), p1 = pack8r(a, 1);
    o0 = MFMA32(cat8(f.v[0][0][0], f.v[0][0][1]), p0, o0); o0 = MFMA32(cat8(f.v[0][1][0], f.v[0][1][1]), p1, o0);
    o1 = MFMA32(cat8(f.v[1][0][0], f.v[1][0][1]), p0, o1); o1 = MFMA32(cat8(f.v[1][1][0], f.v[1][1][1]), p1, o1);
}
__device__ __forceinline__ void prompt_wave(const bf16* QN, const bf16* KN, const bf16* VT, const bf16* SG, bf16* MIX, float bias2, int b, int hd, int q32, int lane) {
    asm volatile("" : "+v"(lane));
    const int ql = lane & 31, h = lane >> 5;
    const size_t rowbase = (size_t)b * SEQ;
    bf16x8 qf[4];
    { const bf16* qp = QN + (rowbase + q32 * 32 + ql) * 512 + hd * 64 + 8 * h;
#pragma unroll
      for (int c = 0; c < 4; ++c) qf[c] = *(const bf16x8*)(qp + 16 * c); }
    bf16x8 tm[2];
#pragma unroll
    for (int s = 0; s < 2; ++s)
#pragma unroll
        for (int j = 0; j < 8; ++j) tm[s][j] = (16 * s + 8 * (j >> 2) + 4 * h + (j & 3)) > ql ? (short)0x3F80 : (short)0;
    f32x16 o0, o1;
#pragma unroll
    for (int r = 0; r < 16; ++r) { o0[r] = 0.f; o1[r] = 0.f; }
    float R = 0.f;
    const bf16* kbase = KN + rowbase * 512 + hd * 64 + 8 * h;
    const bf16* vbase = VT + ((size_t)(b * 8 + hd) * 64 + ql) * SEQ + 4 * h;
    KVFrag fa, fb;
    load_frags(fa, kbase, vbase, q32, ql);
    int kb = q32;
    if (kb > 0) load_frags(fb, kbase, vbase, kb - 1, ql);
    step<true>(fa, qf, tm, o0, o1, R, bias2, ql, h);
    --kb;
    while (kb >= 0) {
        if (kb > 0) load_frags(fa, kbase, vbase, kb - 1, ql);
        step<false>(fb, qf, tm, o0, o1, R, bias2, ql, h);
        --kb;
        if (kb < 0) break;
        if (kb > 0) load_frags(fb, kbase, vbase, kb - 1, ql);
        step<false>(fa, qf, tm, o0, o1, R, bias2, ql, h);
        --kb;
    }
    const size_t row = rowbase + q32 * 32 + ql;
    const bf16* sg = SG + row * D + 512 + hd * 64 + 4 * h; bf16* mx = MIX + row * D + 512 + hd * 64 + 4 * h;
#pragma unroll
    for (int db = 0; db < 2; ++db)
#pragma unroll
        for (int g = 0; g < 4; ++g) {
            const bf16x4 sv = *(const bf16x4*)(sg + 32 * db + 8 * g);
            const f32x16& o = db ? o1 : o0;
            v2u w; w.x = cvtpk(o[4 * g] * bf2f((bf16)sv[0]), o[4 * g + 1] * bf2f((bf16)sv[1])); w.y = cvtpk(o[4 * g + 2] * bf2f((bf16)sv[2]), o[4 * g + 3] * bf2f((bf16)sv[3]));
            *(v2u*)(mx + 32 * db + 8 * g) = w;
        }
}
__device__ __forceinline__ void prompt_phase(const Frame& F, unsigned char* ws, const float* sb_bias) {
    const bf16* QN = (const bf16*)(ws + WS_QN); const bf16* KN = (const bf16*)(ws + WS_KN); const bf16* VT = (const bf16*)(ws + WS_VT); const bf16* SG = (const bf16*)(ws + WS_SG); bf16* MIX = (bf16*)(ws + WS_MIX);
    for (int c = F.vcu; c < 256; c += F.G) {
        const int bh = c >> 2, pair = c & 3, b = bh >> 3, hd = bh & 7;
        const float bias2 = sb_bias[hd] * LOG2E;
        prompt_wave(QN, KN, VT, SG, MIX, bias2, b, hd, 8 * pair + F.wave, F.lane);
        prompt_wave(QN, KN, VT, SG, MIX, bias2, b, hd, 8 * (7 - pair) + (7 - F.wave), F.lane);
    }
}
}

constexpr size_t WS_PO = WS_END;
constexpr size_t WS_PT = WS_PO + (size_t)DB * NPAGE * SBH * DS * SBD * 4;
constexpr size_t WS_MIXD = WS_PT + (size_t)DB * NPAGE * SBH * DS * 4;
constexpr size_t WS_END2 = WS_MIXD + (size_t)MT * D * 2;
namespace at {
template <bool DIAG>
__device__ __forceinline__ void step_core(const bf16x8 (&kf)[4], const bf16x8 (&vf)[2][2], const bf16x8 (&qf)[4], const bf16x8 (&tm)[2], f32x16& o0, f32x16& o1, float& R, float bias2, int ql, int h) {
    f32x16 z;
#pragma unroll
    for (int r = 0; r < 16; ++r) z[r] = bias2;
#pragma unroll
    for (int c = 0; c < 4; ++c) z = MFMA32(kf[c], qf[c], z);
    float lk[16], t[16];
#pragma unroll
    for (int r = 0; r < 16; ++r) {
        const float zz = z[r];
        const float sp = fmaxf(zz, 0.f) + __builtin_amdgcn_logf(1.f + __builtin_amdgcn_exp2f(-fabsf(zz)));
        const bool valid = !DIAG || (crow(r, h) < ql);
        lk[r] = valid ? -sp : 0.f; t[r] = zz - sp;
    }
    f32x16 sfx;
#pragma unroll
    for (int r = 0; r < 16; ++r) sfx[r] = R;
    sfx = MFMA32(tm[0], pack8r(lk, 0), sfx); sfx = MFMA32(tm[1], pack8r(lk, 1), sfx);
    float a[16];
#pragma unroll
    for (int r = 0; r < 16; ++r) { const bool valid = !DIAG || (crow(r, h) < ql); const float e = __builtin_amdgcn_exp2f(t[r] + sfx[r]); a[r] = valid ? e : 0.f; }
    { const float rn = sfx[0] + lk[0]; auto rr = __builtin_amdgcn_permlane32_swap(__float_as_uint(rn), __float_as_uint(rn), false, false); R = fminf(__uint_as_float(rr[0]), __uint_as_float(rr[1])); }
    const bf16x8 p0 = pack8r(a, 0), p1 = pack8r(a, 1);
    o0 = MFMA32(vf[0][0], p0, o0); o0 = MFMA32(vf[0][1], p1, o0);
    o1 = MFMA32(vf[1][0], p0, o1); o1 = MFMA32(vf[1][1], p1, o1);
}
__device__ __forceinline__ void decode_unit(const In& in, unsigned char* ws, int s, int p, int hd, int lane) {
    asm volatile("" : "+v"(lane));
    const int ql = lane & 31, h = lane >> 5;
    const bf16* QN = (const bf16*)(ws + WS_QN);
    const int pg = in.page_table[s * NPAGE + p];
    const float* kpage = in.cache_k + (size_t)pg * PAGE * 512 + hd * 64;
    const float* vpage = in.cache_v + (size_t)pg * PAGE * 512 + hd * 64;
    bf16x8 qf[4];
    { const bf16* qp = QN + (size_t)(MP + s * DS + (ql < DS ? ql : DS - 1)) * 512 + hd * 64 + 8 * h;
#pragma unroll
      for (int c = 0; c < 4; ++c) qf[c] = *(const bf16x8*)(qp + 16 * c); }
    bf16x8 tm[2];
#pragma unroll
    for (int sx = 0; sx < 2; ++sx)
#pragma unroll
        for (int j = 0; j < 8; ++j) tm[sx][j] = (16 * sx + 8 * (j >> 2) + 4 * h + (j & 3)) > ql ? (short)0x3F80 : (short)0;
    const float bias2 = in.sb_bias[hd] * LOG2E;
    f32x16 o0, o1;
#pragma unroll
    for (int r = 0; r < 16; ++r) { o0[r] = 0.f; o1[r] = 0.f; }
    float R = 0.f;
    for (int blk = PAGE / 32 - 1; blk >= 0; --blk) {
        f32x4 kr[4][2]; float vr[2][2][8];
        const float* kp = kpage + (size_t)(blk * 32 + ql) * 512 + 8 * h;
#pragma unroll
        for (int c = 0; c < 4; ++c) { kr[c][0] = *(const f32x4*)(kp + 16 * c); kr[c][1] = *(const f32x4*)(kp + 16 * c + 4); }
        const float* vp = vpage + (size_t)(blk * 32 + 4 * h) * 512 + ql;
#pragma unroll
        for (int db = 0; db < 2; ++db)
#pragma unroll
            for (int sx = 0; sx < 2; ++sx)
#pragma unroll
                for (int j = 0; j < 8; ++j) vr[db][sx][j] = vp[(size_t)(16 * sx + 8 * (j >> 2) + (j & 3)) * 512 + 32 * db];
        bf16x8 kf[4], vf[2][2];
#pragma unroll
        for (int c = 0; c < 4; ++c) { v4u w; w.x = cvtpk(kr[c][0][0], kr[c][0][1]); w.y = cvtpk(kr[c][0][2], kr[c][0][3]); w.z = cvtpk(kr[c][1][0], kr[c][1][1]); w.w = cvtpk(kr[c][1][2], kr[c][1][3]); kf[c] = __builtin_bit_cast(bf16x8, w); }
#pragma unroll
        for (int db = 0; db < 2; ++db)
#pragma unroll
            for (int sx = 0; sx < 2; ++sx) { v4u w; w.x = cvtpk(vr[db][sx][0], vr[db][sx][1]); w.y = cvtpk(vr[db][sx][2], vr[db][sx][3]); w.z = cvtpk(vr[db][sx][4], vr[db][sx][5]); w.w = cvtpk(vr[db][sx][6], vr[db][sx][7]); vf[db][sx] = __builtin_bit_cast(bf16x8, w); }
        step_core<false>(kf, vf, qf, tm, o0, o1, R, bias2, ql, h);
    }
    if (ql < DS) {
        float* po = (float*)(ws + WS_PO) + ((((size_t)s * NPAGE + p) * SBH + hd) * DS + ql) * SBD + 4 * h;
#pragma unroll
        for (int db = 0; db < 2; ++db)
#pragma unroll
            for (int g = 0; g < 4; ++g) { const f32x16& o = db ? o1 : o0; *(f32x4*)(po + 32 * db + 8 * g) = (f32x4){o[4 * g], o[4 * g + 1], o[4 * g + 2], o[4 * g + 3]}; }
        if (h == 0) ((float*)(ws + WS_PT))[(((size_t)s * NPAGE + p) * SBH + hd) * DS + ql] = R;
    }
}
__device__ __forceinline__ void decode_combine(const In& in, unsigned char* ws, int s, int hd, int lane) {
    asm volatile("" : "+v"(lane));
    const bf16* QN = (const bf16*)(ws + WS_QN); const bf16* KN = (const bf16*)(ws + WS_KN); const bf16* VB = (const bf16*)(ws + WS_VB); const bf16* SG = (const bf16*)(ws + WS_SG); bf16* MIX = (bf16*)(ws + WS_MIX);
    const float* PO = (const float*)(ws + WS_PO); const float* PT = (const float*)(ws + WS_PT);
    const float bias2 = in.sb_bias[hd] * LOG2E;
    float q[DS], k[DS], v[DS];
#pragma unroll
    for (int i = 0; i < DS; ++i) { const size_t o = (size_t)(MP + s * DS + i) * 512 + hd * 64 + lane; q[i] = bf2f(QN[o]); k[i] = bf2f(KN[o]); v[i] = bf2f(VB[o]); }
    const float Tl = PT[(((size_t)s * NPAGE + (lane >> 2)) * SBH + hd) * DS + (lane & 3)];
#pragma unroll
    for (int i = 0; i < DS; ++i) {
        float Rn = 0.f, out = 0.f;
#pragma unroll
        for (int j = DS - 1; j >= 0; --j) if (j < i) {
            const float z = wave_sum(q[i] * k[j]) + bias2;
            const float sp = softplus2_f(z);
            out += exp2f(z - sp + Rn) * v[j];
            Rn -= sp;
        }
        for (int p = NPAGE - 1; p >= 0; --p) {
            out += exp2f(Rn) * PO[((((size_t)s * NPAGE + p) * SBH + hd) * DS + i) * SBD + lane];
            Rn += __shfl(Tl, 4 * p + i);
        }
        const size_t o = (size_t)(MP + s * DS + i) * D + 512 + hd * 64 + lane;
        MIX[o] = (bf16)f2bf(out * bf2f(SG[o]));
    }
}
}

namespace pl {
using at::cvtpk;
__device__ __forceinline__ void pool_unit(const In& in, unsigned char* ws, int rb, int g, int lane) {
    asm volatile("" : "+v"(lane));
    const int ql = lane & 31, h = lane >> 5, w = 2 << g;
    const bf16* U = (const bf16*)(ws + WS_U); const bf16* Wpt = (const bf16*)(ws + WS_WPT) + (size_t)g * PG * PG; const bf16* SG = (const bf16*)(ws + WS_SG); bf16* MIX = (bf16*)(ws + WS_MIX);
    const int row = rb * 32 + ql;
    int t, s = 0; float inv;
    if (row < MP) { t = row & (SEQ - 1); inv = 1.f / (float)min(t + 1, w); } else { s = (row - MP) >> 2; t = (row - MP) & 3; inv = 1.f / (float)w; }
    f32x16 acc[4];
#pragma unroll
    for (int nb = 0; nb < 4; ++nb)
#pragma unroll
        for (int r = 0; r < 16; ++r) acc[nb][r] = 0.f;
#pragma unroll 1
    for (int c = 0; c < 8; ++c) {
        const int ch = PG * g + 16 * c + 8 * h;
        float sum[8], cur[8];
        { const bf16x8 u8 = *(const bf16x8*)(U + (size_t)row * PW + ch);
#pragma unroll
          for (int e = 0; e < 8; ++e) { cur[e] = bf2f((bf16)u8[e]); sum[e] = cur[e]; } }
        for (int j = 1; j < w; ++j) {
            const int tt = t - j;
            if (tt >= 0) { const bf16x8 u8 = *(const bf16x8*)(U + (size_t)(row - j) * PW + ch);
#pragma unroll
                for (int e = 0; e < 8; ++e) sum[e] += bf2f((bf16)u8[e]); }
            else if (row >= MP) { const float* cp = in.cache_pool + ((size_t)s * PBUF + (PBUF + tt)) * PW + ch;
#pragma unroll
                for (int e = 0; e < 8; ++e) sum[e] += cp[e]; }
        }
        v4u dp;
        dp.x = cvtpk(sum[0] * inv - cur[0], sum[1] * inv - cur[1]); dp.y = cvtpk(sum[2] * inv - cur[2], sum[3] * inv - cur[3]);
        dp.z = cvtpk(sum[4] * inv - cur[4], sum[5] * inv - cur[5]); dp.w = cvtpk(sum[6] * inv - cur[6], sum[7] * inv - cur[7]);
        const bf16x8 df = __builtin_bit_cast(bf16x8, dp);
#pragma unroll
        for (int nb = 0; nb < 4; ++nb) { const bf16x8 wf = *(const bf16x8*)(Wpt + (size_t)(32 * nb + ql) * PG + 16 * c + 8 * h); acc[nb] = MFMA32(wf, df, acc[nb]); }
    }
#pragma unroll
    for (int nb = 0; nb < 4; ++nb)
#pragma unroll
        for (int gg = 0; gg < 4; ++gg) {
            const int ch = PG * g + 32 * nb + 8 * gg + 4 * h;
            const f32x4 sc = *(const f32x4*)(in.pool_scale + ch);
            const bf16x4 sv = *(const bf16x4*)(SG + (size_t)row * D + ch);
            v2u o; o.x = cvtpk(acc[nb][4 * gg] * sc[0] * bf2f((bf16)sv[0]), acc[nb][4 * gg + 1] * sc[1] * bf2f((bf16)sv[1]));
            o.y = cvtpk(acc[nb][4 * gg + 2] * sc[2] * bf2f((bf16)sv[2]), acc[nb][4 * gg + 3] * sc[3] * bf2f((bf16)sv[3]));
            *(v2u*)(MIX + (size_t)row * D + ch) = o;
        }
}
__device__ __forceinline__ void pool_state_out(const In& in, unsigned char* ws, float* out, int gtid, int gthreads) {
    const bf16* U = (const bf16*)(ws + WS_U);
    for (int i = gtid; i < BP * PBUF * PW; i += gthreads) { const int c = i % PW, j = (i / PW) % PBUF, b = i / (PW * PBUF); out[O_POOLP + i] = bf2f(U[(size_t)(b * SEQ + SEQ - PBUF + j) * PW + c]); }
    for (int i = gtid; i < DB * PBUF * PW; i += gthreads) { const int c = i % PW, j = (i / PW) % PBUF, s = i / (PW * PBUF), e = j + DS;
        out[O_POOLS + i] = e < PBUF ? in.cache_pool[((size_t)s * PBUF + e) * PW + c] : bf2f(U[(size_t)(MP + s * DS + (e - PBUF)) * PW + c]); }
}
}

namespace gd {
using at::cvtpk; using at::crow;
constexpr int NCH = SEQ / 64, NBLK = BP * DNH * NCH;
constexpr int F_W = 0, F_Q = 16, F_K = 32, F_A = 48, F_N = 54;
constexpr size_t OPS_BYTES = (size_t)F_N * 1024;
constexpr size_t WS_OPS = WS_END2;
constexpr size_t WS_UA = WS_OPS + (size_t)NBLK * OPS_BYTES;
constexpr size_t WS_KPL = WS_UA + (size_t)NBLK * 32768;
constexpr size_t WS_QPL = WS_KPL + (size_t)MP * 1024 * 2;
constexpr size_t WS_KGT = WS_QPL + (size_t)MP * 1024 * 2;
constexpr size_t WS_VBT = WS_KGT + (size_t)NBLK * 16384;
constexpr size_t WS_SC = WS_VBT + (size_t)NBLK * 16384;
constexpr size_t WS_DBG_O = WS_SC + (size_t)MP * 8 * 2 * 4;
constexpr size_t WS_DBG_OUT = WS_DBG_O + (size_t)MP * D * 4;
constexpr size_t WS_END3 = WS_DBG_OUT + O_END * 4;
constexpr int LT_PITCH = 68, WAVE_LDS = (64 * LT_PITCH + 128) * 4;

__device__ __forceinline__ v4u pk8(const float* x) { v4u p; p.x = cvtpk(x[0], x[1]); p.y = cvtpk(x[2], x[3]); p.z = cvtpk(x[4], x[5]); p.w = cvtpk(x[6], x[7]); return p; }

template <int PART>
__device__ __forceinline__ void prep_elem(const In& in, unsigned char* ws, int b_, int n_, int hd_, int lane) {
    asm volatile("" : "+v"(lane));
    const int b = __builtin_amdgcn_readfirstlane(b_), n = __builtin_amdgcn_readfirstlane(n_), hd = __builtin_amdgcn_readfirstlane(hd_);
    const int t = n * 64 + lane, row = b * SEQ + t, blk = (b * DNH + hd) * NCH + n;
    const float* BA = (const float*)(ws + WS_BA);
    const float bb = BA[(size_t)row * 16 + hd], aa = BA[(size_t)row * 16 + 8 + hd];
    const float beta = 1.f / (1.f + __expf(-bb));
    const float g = -__expf(in.a_log[hd]) * softplus_f(aa + in.dt_bias[hd]);
    float gc = g;
#pragma unroll
    for (int off = 1; off < 64; off <<= 1) { const float tt = __shfl_up(gc, off); if (lane >= off) gc += tt; }
    const float glast = __shfl(gc, 63);
    const bf16* X = (const bf16*)(ws + WS_QKVP) + (size_t)row * CONVD + PART * 1024 + hd * 128;
    const float* cw = in.conv_w + PART * 1024 + hd * 128;
#define CONV32(kb4, x) do { _Pragma("unroll") for (int c_ = 0; c_ < 32; ++c_) x[c_] = 0.f; \
        _Pragma("unroll") for (int jj = 0; jj < 4; ++jj) { if (t - 3 + jj >= 0) { const bf16* xr = X - (ptrdiff_t)(3 - jj) * CONVD + 32 * (kb4); const float* cwj = cw + (size_t)jj * CONVD + 32 * (kb4); \
            _Pragma("unroll") for (int cg = 0; cg < 4; ++cg) { const bf16x8 u = *(const bf16x8*)(xr + 8 * cg); \
                _Pragma("unroll") for (int e = 0; e < 8; ++e) x[8 * cg + e] += bf2f((bf16)u[e]) * cwj[8 * cg + e]; } } } \
        _Pragma("unroll") for (int c_ = 0; c_ < 32; ++c_) x[c_] = ep::silu_fast(x[c_]); } while (0)
    float ss = 0.f;
    if (PART != 2) {
#pragma unroll 1
        for (int kb4 = 0; kb4 < 4; ++kb4) { float x[32]; CONV32(kb4, x);
#pragma unroll
            for (int c = 0; c < 32; ++c) ss += x[c] * x[c]; }
    }
    unsigned char* ops = ws + WS_OPS + (size_t)blk * OPS_BYTES;
    const int jb = lane >> 5, jl = lane & 31;
    if (PART == 0) {
        const float sc = rsqrtf(ss + EPS) * 0.08838834764831845f, sg = sc * __expf(gc);
        bf16* qpl = (bf16*)(ws + WS_QPL) + (size_t)row * 1024 + hd * 128;
#pragma unroll 1
        for (int kb4 = 0; kb4 < 4; ++kb4) { float x[32]; CONV32(kb4, x);
#pragma unroll
            for (int cg = 0; cg < 4; ++cg) { float v[8];
#pragma unroll
                for (int e = 0; e < 8; ++e) v[e] = x[8 * cg + e] * sc;
                *(v4u*)(qpl + 32 * kb4 + 8 * cg) = pk8(v); }
            unsigned char* fb = ops + (size_t)(F_Q + (jb * 4 + kb4) * 2) * 1024 + jl * 16;
#pragma unroll
            for (int s = 0; s < 2; ++s)
#pragma unroll
                for (int hh = 0; hh < 2; ++hh) { float v[8];
#pragma unroll
                    for (int jj = 0; jj < 8; ++jj) v[jj] = x[16 * s + 8 * (jj >> 2) + 4 * hh + (jj & 3)] * sg;
                    *(v4u*)(fb + s * 1024 + hh * 512) = pk8(v); } }
    } else if (PART == 1) {
        const float sc = rsqrtf(ss + EPS), sd = sc * __expf(glast - gc), sg = sc * beta * __expf(gc);
        bf16* kpl = (bf16*)(ws + WS_KPL) + (size_t)row * 1024 + hd * 128;
        const int s = jl >> 4, j16 = jl & 15, hh = (j16 >> 2) & 1, jj = 4 * (j16 >> 3) + (j16 & 3);
#pragma unroll 1
        for (int kb4 = 0; kb4 < 4; ++kb4) { float x[32]; CONV32(kb4, x);
#pragma unroll
            for (int cg = 0; cg < 4; ++cg) { float v[8];
#pragma unroll
                for (int e = 0; e < 8; ++e) v[e] = x[8 * cg + e] * sc;
                *(v4u*)(kpl + 32 * kb4 + 8 * cg) = pk8(v); }
            bf16* kd = (bf16*)(ops + (size_t)F_K * 1024) + (size_t)kb4 * 2048 + (size_t)(jb * 2 + s) * 512 + hh * 256 + jj;
            bf16* kgt = (bf16*)(ws + WS_KGT) + (size_t)blk * 8192 + (size_t)kb4 * 2048 + lane;
#pragma unroll
            for (int dl = 0; dl < 32; ++dl) { kd[dl * 8] = (bf16)f2bf(x[dl] * sd); kgt[dl * 64] = (bf16)f2bf(x[dl] * sg); } }
        float* scp = (float*)(ws + WS_SC) + ((size_t)row * 8 + hd) * 2; scp[0] = beta; scp[1] = gc;
    } else {
#pragma unroll 1
        for (int kb4 = 0; kb4 < 4; ++kb4) { float x[32]; CONV32(kb4, x);
            bf16* vbt = (bf16*)(ws + WS_VBT) + (size_t)blk * 8192 + (size_t)kb4 * 2048 + lane;
#pragma unroll
            for (int dl = 0; dl < 32; ++dl) vbt[dl * 64] = (bf16)f2bf(x[dl] * beta); }
    }
#undef CONV32
}

__device__ __forceinline__ void prep_chunk(unsigned char* ws, LAS unsigned char* wlds, int blk, int lane) {
    asm volatile("" : "+v"(lane));
    const int n = blk % NCH, hd = (blk / NCH) % DNH, b = blk / (NCH * DNH);
    const int r0 = b * SEQ + n * 64;
#define ql (lane & 31)
#define h (lane >> 5)
    LAS float* Lt = (LAS float*)wlds; LAS float* gcs = Lt + 64 * LT_PITCH; LAS float* bts = gcs + 64;
    { const float* scp = (const float*)(ws + WS_SC) + ((size_t)(r0 + lane) * 8 + hd) * 2; bts[lane] = scp[0]; gcs[lane] = scp[1]; }
    unsigned char* ops = ws + WS_OPS + (size_t)blk * OPS_BYTES;
    const bf16* KPL0 = (const bf16*)(ws + WS_KPL) + (size_t)r0 * 1024 + hd * 128;
#define KPL (KPL0 + 8 * h)
    const bf16* QPL0 = (const bf16*)(ws + WS_QPL) + (size_t)r0 * 1024 + hd * 128;
#define QPL (QPL0 + 8 * h)
#define KF(rb, c) (*(const bf16x8*)(KPL + (size_t)(32 * (rb) + ql) * 1024 + 16 * (c)))
    LDS_WAIT(); asm volatile("" ::: "memory");
#pragma unroll
    for (int bi = 0; bi < 3; ++bi) { const int ib = bi ? 1 : 0, jbb = bi == 2 ? 1 : 0;
        asm volatile("" : "+v"(lane) :: "memory");
        f32x16 acc;
#pragma unroll
        for (int r = 0; r < 16; ++r) acc[r] = 0.f;
#pragma unroll
        for (int c = 0; c < 8; ++c) acc = MFMA32(KF(ib, c), KF(jbb, c), acc);
        const int j = 32 * jbb + ql; const float gcj = gcs[j];
#pragma unroll
        for (int g4 = 0; g4 < 4; ++g4) { const int i0 = 32 * ib + 8 * g4 + 4 * h;
            const f32x4 gi = *(const LAS f32x4*)(gcs + i0), bi4 = *(const LAS f32x4*)(bts + i0); f32x4 o;
#pragma unroll
            for (int e = 0; e < 4; ++e) { const float v = bi4[e] * acc[4 * g4 + e] * __expf(gi[e] - gcj); o[e] = (i0 + e > j) ? v : 0.f; }
            *(LAS f32x4*)(Lt + j * LT_PITCH + i0) = o; }
    }
    asm volatile("" : "+v"(lane) :: "memory"); { }
#pragma unroll
    for (int bi = 0; bi < 3; ++bi) { const int jb = bi ? 1 : 0, jpb = bi == 2 ? 1 : 0;
        asm volatile("" : "+v"(lane) :: "memory");
        f32x16 acc;
#pragma unroll
        for (int r = 0; r < 16; ++r) acc[r] = 0.f;
#pragma unroll
        for (int c = 0; c < 8; ++c) { const bf16x8 qf = *(const bf16x8*)(QPL + (size_t)(32 * jb + ql) * 1024 + 16 * c); acc = MFMA32(KF(jpb, c), qf, acc); }
        const int j = 32 * jb + ql; const float gcj = gcs[j]; float a[16];
#pragma unroll
        for (int g4 = 0; g4 < 4; ++g4) { const int p0 = 32 * jpb + 8 * g4 + 4 * h; const f32x4 gp = *(const LAS f32x4*)(gcs + p0);
#pragma unroll
            for (int e = 0; e < 4; ++e) { const float v = acc[4 * g4 + e] * __expf(gcj - gp[e]); a[4 * g4 + e] = (p0 + e <= j) ? v : 0.f; } }
#pragma unroll
        for (int s = 0; s < 2; ++s) *(v4u*)(ops + (size_t)(F_A + 2 * bi + s) * 1024 + lane * 16) = pk8(a + 8 * s);
    }
    LDS_WAIT(); asm volatile("" ::: "memory");
    asm volatile("" : "+v"(lane) :: "memory");
    float x[64];
#pragma unroll
    for (int j = 0; j < 64; ++j) x[j] = 0.f;
#pragma unroll
    for (int j = 63; j >= 0; --j) {
        LAS float* Ltj = Lt;
        if (j < 63) asm volatile("" : "+v"(Ltj) : "v"(x[j < 63 ? j + 1 : 63]));
        Ltj += j * LT_PITCH;
        float a0 = (lane == j) ? 1.f : 0.f, a1 = 0.f, a2 = 0.f, a3 = 0.f;
#pragma unroll
        for (int i0 = (j + 1) & ~3; i0 < 64; i0 += 4) { const f32x4 l4 = *(const LAS f32x4*)(Ltj + i0);
            a0 -= x[i0] * l4[0]; a1 -= x[i0 + 1] * l4[1]; a2 -= x[i0 + 2] * l4[2]; a3 -= x[i0 + 3] * l4[3]; }
        x[j] = (a0 + a1) + (a2 + a3);
    }
    asm volatile("" : "+v"(lane) :: "memory");
    bf16x8 Tf[2][4];
#pragma unroll
    for (int js = 0; js < 4; ++js) { const v4u X = pk8(x + 16 * js), Y = pk8(x + 16 * js + 8); v4u lo, hi;
#pragma unroll
        for (int e = 0; e < 4; ++e) { auto rr = __builtin_amdgcn_permlane32_swap(X[e], Y[e], false, false); lo[e] = rr[0]; hi[e] = rr[1]; }
        Tf[0][js] = __builtin_bit_cast(bf16x8, lo); Tf[1][js] = __builtin_bit_cast(bf16x8, hi); }
    asm volatile("" : "+v"(lane) :: "memory");
    const bf16* KGT = (const bf16*)(ws + WS_KGT) + (size_t)blk * 8192 + 8 * h;
    const bf16* VBT = (const bf16*)(ws + WS_VBT) + (size_t)blk * 8192 + 8 * h;
#pragma unroll
    for (int dkb = 0; dkb < 4; ++dkb) {
        bf16x8 kg[4];
#pragma unroll
        for (int js = 0; js < 4; ++js) kg[js] = *(const bf16x8*)(KGT + (size_t)(32 * dkb + ql) * 64 + 16 * js);
#pragma unroll
        for (int ib = 0; ib < 2; ++ib) { f32x16 acc;
#pragma unroll
            for (int r = 0; r < 16; ++r) acc[r] = 0.f;
#pragma unroll
            for (int js = 0; js < 4; ++js) if (js < 2 * ib + 2) acc = MFMA32(kg[js], Tf[ib][js], acc);
            float w[16];
#pragma unroll
            for (int r = 0; r < 16; ++r) w[r] = -acc[r];
#pragma unroll
            for (int s = 0; s < 2; ++s) *(v4u*)(ops + (size_t)(F_W + (ib * 4 + dkb) * 2 + s) * 1024 + lane * 16) = pk8(w + 8 * s); }
    }
    asm volatile("" : "+v"(lane) :: "memory");
    float* UA = (float*)(ws + WS_UA) + (size_t)blk * 8192;
#pragma unroll
    for (int dvb = 0; dvb < 4; ++dvb) {
        bf16x8 vb[4];
#pragma unroll
        for (int js = 0; js < 4; ++js) vb[js] = *(const bf16x8*)(VBT + (size_t)(32 * dvb + ql) * 64 + 16 * js);
#pragma unroll
        for (int ib = 0; ib < 2; ++ib) { f32x16 acc;
#pragma unroll
            for (int r = 0; r < 16; ++r) acc[r] = 0.f;
#pragma unroll
            for (int js = 0; js < 4; ++js) if (js < 2 * ib + 2) acc = MFMA32(Tf[ib][js], vb[js], acc);
            float* up = UA + (size_t)(ib * 4 + dvb) * 1024 + lane * 4;
#pragma unroll
            for (int g4 = 0; g4 < 4; ++g4) *(f32x4*)(up + g4 * 256) = (f32x4){acc[4 * g4], acc[4 * g4 + 1], acc[4 * g4 + 2], acc[4 * g4 + 3]}; }
    }
    LDS_WAIT(); asm volatile("" ::: "memory");
#undef ql
#undef h
#undef KF
#undef KPL
#undef QPL
}

__device__ __forceinline__ void scan_chain(unsigned char* ws, LAS unsigned char* lds, float* nO, float* out, int chain, int wave, int lane) {
    asm volatile("" : "+v"(lane));
    const int b = chain >> 3, hd = chain & 7, ql = lane & 31, h = lane >> 5;
    const unsigned char* opsb = ws + WS_OPS + (size_t)chain * NCH * OPS_BYTES;
    const float* UAb = (const float*)(ws + WS_UA) + (size_t)chain * NCH * 8192;
    const float* SCb = (const float*)(ws + WS_SC) + ((size_t)(b * SEQ) * 8 + hd) * 2;
    const bool loader = wave >= 4; const int w = wave & 3;
    if (loader) { for (int f = w; f < F_N; f += 4) *(LAS v4u*)(lds + f * 1024 + lane * 16) = *(const v4u*)(opsb + (size_t)f * 1024 + lane * 16); }
    f32x16 S[4]; f32x4 un[2][4];
#pragma unroll
    for (int k = 0; k < 4; ++k)
#pragma unroll
        for (int r = 0; r < 16; ++r) S[k][r] = 0.f;
    if (!loader) {
#pragma unroll
        for (int jb = 0; jb < 2; ++jb)
#pragma unroll
            for (int g4 = 0; g4 < 4; ++g4) un[jb][g4] = *(const f32x4*)(UAb + (size_t)(jb * 4 + w) * 1024 + g4 * 256 + lane * 4);
    }
    __syncthreads();
    for (int n = 0; n < NCH; ++n) {
        LAS unsigned char* buf = lds + (n & 1) * OPS_BYTES;
        if (loader) {
            if (n + 1 < NCH) { LAS unsigned char* nb = lds + ((n + 1) & 1) * OPS_BYTES; const unsigned char* src = opsb + (size_t)(n + 1) * OPS_BYTES;
                for (int f = w; f < F_N; f += 4) *(LAS v4u*)(nb + f * 1024 + lane * 16) = *(const v4u*)(src + (size_t)f * 1024 + lane * 16); }
        } else {
            const float gamma = __expf(SCb[(size_t)(n * 64 + 63) * 16 + 1]);
            f32x16 Vn[2];
#pragma unroll
            for (int jb = 0; jb < 2; ++jb)
#pragma unroll
                for (int g4 = 0; g4 < 4; ++g4)
#pragma unroll
                    for (int e = 0; e < 4; ++e) Vn[jb][4 * g4 + e] = un[jb][g4][e];
            if (n + 1 < NCH) {
#pragma unroll
                for (int jb = 0; jb < 2; ++jb)
#pragma unroll
                    for (int g4 = 0; g4 < 4; ++g4) un[jb][g4] = *(const f32x4*)(UAb + (size_t)(n + 1) * 8192 + (size_t)(jb * 4 + w) * 1024 + g4 * 256 + lane * 4);
            }
            bf16x8 Sb[4][2];
#pragma unroll
            for (int k = 0; k < 4; ++k) { float tmp[16];
#pragma unroll
                for (int r = 0; r < 16; ++r) tmp[r] = S[k][r];
                Sb[k][0] = __builtin_bit_cast(bf16x8, pk8(tmp)); Sb[k][1] = __builtin_bit_cast(bf16x8, pk8(tmp + 8)); }
#define FRAG(idx) (*(const LAS bf16x8*)(buf + (idx) * 1024 + lane * 16))
#pragma unroll
            for (int jb = 0; jb < 2; ++jb)
#pragma unroll
                for (int k = 0; k < 4; ++k)
#pragma unroll
                    for (int s = 0; s < 2; ++s) Vn[jb] = MFMA32(FRAG(F_W + (jb * 4 + k) * 2 + s), Sb[k][s], Vn[jb]);
            bf16x8 Vb[2][2];
#pragma unroll
            for (int jb = 0; jb < 2; ++jb) { float tmp[16];
#pragma unroll
                for (int r = 0; r < 16; ++r) tmp[r] = Vn[jb][r];
                Vb[jb][0] = __builtin_bit_cast(bf16x8, pk8(tmp)); Vb[jb][1] = __builtin_bit_cast(bf16x8, pk8(tmp + 8)); }
#pragma unroll
            for (int jb = 0; jb < 2; ++jb) { f32x16 OT;
#pragma unroll
                for (int r = 0; r < 16; ++r) OT[r] = 0.f;
#pragma unroll
                for (int k = 0; k < 4; ++k)
#pragma unroll
                    for (int s = 0; s < 2; ++s) OT = MFMA32(Sb[k][s], FRAG(F_Q + (jb * 4 + k) * 2 + s), OT);
#pragma unroll
                for (int jp = 0; jp <= jb; ++jp)
#pragma unroll
                    for (int s = 0; s < 2; ++s) OT = MFMA32(Vb[jp][s], FRAG(F_A + 2 * (jb + jp) + s), OT);
                float* op = nO + (size_t)(b * SEQ + n * 64 + 32 * jb + ql) * D + hd * 128 + 32 * w + 4 * h;
#pragma unroll
                for (int g4 = 0; g4 < 4; ++g4) *(f32x4*)(op + 8 * g4) = (f32x4){OT[4 * g4], OT[4 * g4 + 1], OT[4 * g4 + 2], OT[4 * g4 + 3]}; }
#pragma unroll
            for (int k = 0; k < 4; ++k) {
#pragma unroll
                for (int r = 0; r < 16; ++r) S[k][r] *= gamma;
#pragma unroll
                for (int jb = 0; jb < 2; ++jb)
#pragma unroll
                    for (int s = 0; s < 2; ++s) S[k] = MFMA32(FRAG(F_K + (k * 2 + jb) * 2 + s), Vb[jb][s], S[k]); }
#undef FRAG
        }
        __syncthreads();
    }
    if (!loader) {
        float* so = out + O_DP + (size_t)chain * DNK * DNV + 32 * w + ql;
#pragma unroll
        for (int k = 0; k < 4; ++k)
#pragma unroll
            for (int r = 0; r < 16; ++r) so[(size_t)(32 * k + crow(r, h)) * DNV] = S[k][r];
    }
}
}
namespace gd {
__device__ __forceinline__ void sample_prep(const In& in, unsigned char* ws, int r, int hd, int lane) {
    asm volatile("" : "+v"(lane));
    const int s = (r - MP) >> 2, t = (r - MP) & 3;
    const bf16* QKVP = (const bf16*)(ws + WS_QKVP); float* nC = (float*)(ws + NW_C);
    float v[3][2];
#pragma unroll
    for (int part = 0; part < 3; ++part)
#pragma unroll
        for (int hf = 0; hf < 2; ++hf) { const int col = part * 1024 + hd * 128 + hf * 64 + lane; float acc = 0.f;
#pragma unroll
            for (int jj = 0; jj < 4; ++jj) { const int e = t + jj;
                const float xv = e >= 3 ? bf2f(QKVP[(size_t)(MP + s * DS + e - 3) * CONVD + col]) : in.state_conv[((size_t)s * 3 + e) * CONVD + col];
                acc += xv * in.conv_w[(size_t)jj * CONVD + col]; }
            v[part][hf] = silu_f(acc); }
    const float qs = wave_sum(v[0][0] * v[0][0] + v[0][1] * v[0][1]), ks = wave_sum(v[1][0] * v[1][0] + v[1][1] * v[1][1]);
    const float qr = rsqrtf(qs + EPS) * 0.08838834764831845f, kr = rsqrtf(ks + EPS);
    float* o = nC + (size_t)r * CONVD + hd * 128 + lane;
    o[0] = v[0][0] * qr; o[64] = v[0][1] * qr; o[1024] = v[1][0] * kr; o[1024 + 64] = v[1][1] * kr; o[2048] = v[2][0]; o[2048 + 64] = v[2][1];
    if (lane == 0) { const float* BA = (const float*)(ws + WS_BA); const float bb = BA[(size_t)r * 16 + hd], aa = BA[(size_t)r * 16 + 8 + hd];
        ((float*)(ws + NW_BETA))[(size_t)r * DNH + hd] = 1.f / (1.f + __expf(-bb));
        ((float*)(ws + NW_G))[(size_t)r * DNH + hd] = -__expf(in.a_log[hd]) * softplus_f(aa + in.dt_bias[hd]); }
}
}

namespace nv {
__device__ __forceinline__ void k_pool_d(const bf16* U, const float* cache_pool, float* nD, float* out, int gtid, int gthreads) {
    const size_t n = (size_t)MT * PW;
    for (size_t i = (size_t)gtid; i < n; i += (size_t)gthreads) {
        const int r = (int)(i / PW), c = (int)(i % PW), g = c / PG, w = 2 << g;
        float sum = 0.f, cnt;
        if (r < MP) {
            const int t = r % SEQ;
            for (int j = 0; j < w; ++j) if (t - j >= 0) sum += bf2f(U[(size_t)(r - j) * PW + c]);
            cnt = (float)min(t + 1, w);
        } else {
            const int s = (r - MP) / DS, t = (r - MP) % DS;
            for (int j = 0; j < w; ++j) { const int tt = t - j; sum += tt >= 0 ? bf2f(U[(size_t)(r - j) * PW + c]) : cache_pool[((size_t)s * PBUF + (PBUF + tt)) * PW + c]; }
            cnt = (float)w;
        }
        nD[i] = sum / cnt - bf2f(U[(size_t)r * PW + c]);
    }
    const size_t n2 = (size_t)BP * PBUF * PW;
    for (size_t i = (size_t)gtid; i < n2; i += (size_t)gthreads) {
        const int c = (int)(i % PW), j = (int)((i / PW) % PBUF), b = (int)(i / ((size_t)PW * PBUF));
        out[O_POOLP + i] = bf2f(U[(size_t)(b * SEQ + SEQ - PBUF + j) * PW + c]);
    }
    const size_t n3 = (size_t)DB * PBUF * PW;
    for (size_t i = (size_t)gtid; i < n3; i += (size_t)gthreads) {
        const int c = (int)(i % PW), j = (int)((i / PW) % PBUF), s = (int)(i / ((size_t)PW * PBUF));
        const int e = j + DS;
        out[O_POOLS + i] = e < PBUF ? cache_pool[((size_t)s * PBUF + e) * PW + c] : bf2f(U[(size_t)(MP + s * DS + (e - PBUF)) * PW + c]);
    }
}
__device__ __forceinline__ void k_pool_y(const float* nD, const float* w_pool, const float* scale, const bf16* SG, bf16* mix, int gtid, int gthreads) {
    const size_t n = (size_t)MT * PW;
    for (size_t i = (size_t)gtid; i < n; i += (size_t)gthreads) {
        const int r = (int)(i / PW), c = (int)(i % PW), g = c / PG, dd = c % PG;
        const float* d = nD + (size_t)r * PW + g * PG; const float* wp = w_pool + (size_t)g * PG * PG + dd;
        float s = 0.f;
        for (int k = 0; k < PG; ++k) s += d[k] * wp[(size_t)k * PG];
        mix[(size_t)r * D + c] = (bf16)f2bf(s * scale[c] * bf2f(SG[(size_t)r * D + c]));
    }
}
__device__ __forceinline__ void k_attn(const bf16* QN, const bf16* KN, const bf16* VB, const float* cache_k, const float* cache_v, const int* page_table,
                                              const float* bias, const bf16* SG, bf16* mix, int gtid, int gthreads, long it0) {
    const int lane = threadIdx.x & 63;
    const long w = gtid >> 6, nw = gthreads >> 6;
    for (long it = it0 + w; it < (long)MT * SBH; it += nw) {
        const int r = (int)(it / SBH), h = (int)(it % SBH);
        const float q = bf2f(QN[(size_t)r * 512 + h * 64 + lane]);
        const float bh = bias[h] * LOG2E;
        int nkeys, s = 0, b = 0;
        if (r < MP) { b = r / SEQ; nkeys = r % SEQ; } else { s = (r - MP) / DS; nkeys = PAST + (r - MP) % DS; }
        float R = 0.f, o = 0.f;
        for (int blk = (nkeys - 1) / 64; blk >= 0 && nkeys > 0; --blk) {
            const int j0 = blk * 64 + lane; const bool valid = j0 < nkeys;
            const int j = valid ? j0 : nkeys - 1;
            const bool is16 = (r < MP) || (j >= PAST);
            const bf16* k16 = KN + (size_t)(r < MP ? b * SEQ + j : MP + s * DS + (is16 ? j - PAST : 0)) * 512 + h * 64;
            const float* k32 = cache_k + (((size_t)page_table[s * NPAGE + (is16 ? 0 : j / PAGE)] * PAGE + (is16 ? 0 : j % PAGE)) * SBH + h) * SBD;
            float dot = 0.f;
            for (int d = 0; d < 64; ++d) { const float qd = __shfl(q, d); dot += qd * (is16 ? bf2f(k16[d]) : k32[d]); }
            const float z = valid ? dot + bh : 0.f;
            const float sp = softplus2_f(z);
            const float lk = valid ? -sp : 0.f;
            float inc = lk;
#pragma unroll
            for (int off = 1; off < 64; off <<= 1) { const float t = __shfl_down(inc, off); if (lane + off < 64) inc += t; }
            const float suffix = inc - lk + R;
            const float a = valid ? exp2f(z - sp + suffix) : 0.f;
            R += __shfl(inc, 0);
            for (int k = 0; k < 64; ++k) {
                const int jj = blk * 64 + k;
                const float ak = __shfl(a, k);
                if (jj < nkeys) {
                    float vv;
                    if (r < MP) vv = bf2f(VB[(size_t)(b * SEQ + jj) * 512 + h * 64 + lane]);
                    else if (jj < PAST) vv = cache_v[(((size_t)page_table[s * NPAGE + jj / PAGE] * PAGE + jj % PAGE) * SBH + h) * SBD + lane];
                    else vv = bf2f(VB[(size_t)(MP + s * DS + (jj - PAST)) * 512 + h * 64 + lane]);
                    o += ak * vv;
                }
            }
        }
        mix[(size_t)r * D + 512 + h * 64 + lane] = (bf16)f2bf(o * bf2f(SG[(size_t)r * D + 512 + h * 64 + lane]));
    }
}
__device__ __forceinline__ void k_conv(const bf16* QKVP, const float* state_conv, const float* conv_w, float* nC, int gtid, int gthreads) {
    const size_t n = (size_t)MT * CONVD;
    for (size_t i = (size_t)gtid; i < n; i += (size_t)gthreads) {
        const int r = (int)(i / CONVD), c = (int)(i % CONVD);
        float acc = 0.f;
        for (int j = 0; j < 4; ++j) {
            float xv;
            if (r < MP) { const int t = r % SEQ, e = t + j; xv = e >= 3 ? bf2f(QKVP[(size_t)(r - 3 + j) * CONVD + c]) : 0.f; }
            else { const int s = (r - MP) / DS, t = (r - MP) % DS, e = t + j; xv = e >= 3 ? bf2f(QKVP[(size_t)(MP + s * DS + e - 3) * CONVD + c]) : state_conv[((size_t)s * 3 + e) * CONVD + c]; }
            acc += xv * conv_w[(size_t)j * CONVD + c];
        }
        nC[i] = silu_f(acc);
    }
}
__device__ __forceinline__ void k_qknorm(float* nC, const float* BA, const float* a_log, const float* dt_bias, float* nBeta, float* nG, int gtid, int gthreads) {
    const int lane = threadIdx.x & 63;
    const long w = gtid >> 6, nw = gthreads >> 6;
    for (long it = w; it < (long)MT * DNH; it += nw) {
        const int r = (int)(it / DNH), h = (int)(it % DNH);
        float* q = nC + (size_t)r * CONVD + h * 128; float* k = q + 1024;
        const float q0 = q[lane], q1 = q[lane + 64], k0 = k[lane], k1 = k[lane + 64];
        const float qs = wave_sum(q0 * q0 + q1 * q1), ks = wave_sum(k0 * k0 + k1 * k1);
        const float qr = rsqrtf(qs + EPS) * 0.08838834764831845f, kr = rsqrtf(ks + EPS);
        q[lane] = q0 * qr; q[lane + 64] = q1 * qr; k[lane] = k0 * kr; k[lane + 64] = k1 * kr;
        if (lane == 0) {
            const float bb = BA[(size_t)r * 16 + h], aa = BA[(size_t)r * 16 + 8 + h];
            nBeta[(size_t)r * DNH + h] = 1.f / (1.f + __expf(-bb));
            nG[(size_t)r * DNH + h] = -__expf(a_log[h]) * softplus_f(aa + dt_bias[h]);
        }
    }
}
__device__ __forceinline__ void k_gdn(const float* nC, const float* nBeta, const float* nG, const float* state_delta, float* nO, float* out, LAS float* sm, int c0, int cstep, int cend) {
    LAS float* sq = sm; LAS float* sk = sm + 128; LAS float (*red)[128] = (LAS float (*)[128])(sm + 256); LAS float (*red2)[128] = (LAS float (*)[128])(sm + 768);
    const int tid = threadIdx.x, e = tid & 127, part = tid >> 7;
    for (int c = c0; c < cend; c += cstep) {
        int base, L, h; const float* S0 = nullptr; float* Sout;
        if (c < BP * DNH) { const int b = c / DNH; h = c % DNH; base = b * SEQ; L = SEQ; Sout = out + O_DP + (size_t)c * DNK * DNV; }
        else { const int cc = c - BP * DNH, s = cc / DNH; h = cc % DNH; base = MP + s * DS; L = DS; S0 = state_delta + (size_t)cc * DNK * DNV; Sout = out + O_DS + (size_t)cc * DNK * DNV; }
        float S[32];
#pragma unroll
        for (int i = 0; i < 32; ++i) S[i] = S0 ? S0[(size_t)(part * 32 + i) * DNV + e] : 0.f;
        for (int t = 0; t < L; ++t) {
            const int r = base + t;
            __syncthreads();
            if (tid < 128) sq[tid] = nC[(size_t)r * CONVD + h * 128 + tid];
            else if (tid < 256) sk[tid - 128] = nC[(size_t)r * CONVD + 1024 + h * 128 + (tid - 128)];
            const float v = nC[(size_t)r * CONVD + 2048 + h * 128 + e];
            const float beta = nBeta[(size_t)r * DNH + h], alpha = __expf(nG[(size_t)r * DNH + h]);
            __syncthreads();
            float ks = 0.f;
#pragma unroll
            for (int i = 0; i < 32; ++i) ks += sk[part * 32 + i] * S[i];
            red[part][e] = ks;
            __syncthreads();
            const float kS = alpha * (red[0][e] + red[1][e] + red[2][e] + red[3][e]);
            const float vn = beta * (v - kS);
            float op = 0.f;
#pragma unroll
            for (int i = 0; i < 32; ++i) { S[i] = alpha * S[i] + sk[part * 32 + i] * vn; op += sq[part * 32 + i] * S[i]; }
            red2[part][e] = op;
            __syncthreads();
            if (part == 0) nO[(size_t)r * D + h * 128 + e] = red2[0][e] + red2[1][e] + red2[2][e] + red2[3][e];
        }
#pragma unroll
        for (int i = 0; i < 32; ++i) Sout[(size_t)(part * 32 + i) * DNV + e] = S[i];
        __syncthreads();
    }
}
__device__ __forceinline__ void k_onorm(const float* nO, const bf16* SZ, const float* og, bf16* A4, int gtid, int gthreads) {
    const int lane = threadIdx.x & 63;
    const long w = gtid >> 6, nw = gthreads >> 6;
    for (long it = w; it < (long)MT * DNH; it += nw) {
        const int r = (int)(it / DNH), h = (int)(it % DNH);
        const float* o = nO + (size_t)r * D + h * 128;
        const float o0 = o[lane], o1 = o[lane + 64];
        const float ss = wave_sum(o0 * o0 + o1 * o1);
        const float rs = rsqrtf(ss / 128.f + EPS);
        const bf16* z = SZ + (size_t)r * D + h * 128;
        A4[(size_t)r * D + h * 128 + lane] = (bf16)f2bf(o0 * rs * og[lane] * bf2f(z[lane]));
        A4[(size_t)r * D + h * 128 + lane + 64] = (bf16)f2bf(o1 * rs * og[lane + 64] * bf2f(z[lane + 64]));
    }
}
}

constexpr int N_PHASES = 9;
__global__ void __launch_bounds__(NWAVES * 64, 2) fwd(Params P) {
    extern __shared__ __attribute__((aligned(16))) unsigned char lds[];
    Frame F;
    F.lds = (LAS unsigned char*)lds;
    F.MISC = (volatile LAS unsigned*)(F.lds + MISC_OFF);
    F.tid = threadIdx.x; F.lane = F.tid & 63; F.wave = __builtin_amdgcn_readfirstlane(F.tid >> 6);
    F.G = gridDim.x; { const int bx = blockIdx.x; F.vcu = (F.G % 8 == 0) ? (bx % 8) * (F.G / 8) + bx / 8 : bx; }
    unsigned char* ws = P.ws;
    F.ctl = (gu32*)(ws + WS_CTL);
    const In in = make_in(P);
    for (int u = F.tid; u < (LDS_BYTES - LDSCTL_OFF) / 4; u += NWAVES * 64) ((LAS unsigned*)(F.lds + LDSCTL_OFF))[u] = 0u;
    __syncthreads();
    const int lo = P.ph_lo, hi = P.ph_hi;
    const bool use_bar = true;
    XcdBarrier bar; bar.bar = (unsigned*)(F.ctl + CW_BAR); bar.x = 0; bar.st = nullptr;
    if (use_bar) bar = xcd_barrier_post((unsigned*)(F.ctl + CW_BAR), F.MISC + 8);
#define IN(k) (lo <= (k) && (k) < hi)
#define BOTH(k) (IN(k) && IN((k) + 1))
#define GRID_BAR() xcd_barrier(bar)

    if (IN(0)) { p0_prologue(F, in, ws); if (BOTH(0)) GRID_BAR(); }

    if (IN(1)) {
        pg8::Gemm g{(const pg8::bf16_t*)(ws + WS_XN1), (const pg8::bf16_t*)(ws + WS_W1T), MT, EVEN_IN, D}; pg8::StaticOrder S; S.init(MT, EVEN_IN, F.G, (int)blockIdx.x);
        ep::Epi1 E{(bf16*)(ws + WS_U), (bf16*)(ws + WS_QN), (bf16*)(ws + WS_KN), (bf16*)(ws + WS_VB), (bf16*)(ws + WS_VT), (bf16*)(ws + WS_SG), P.out, in.q_norm, in.k_norm};
        pg8::gemm_phase<ep::Epi1, pg8::StaticOrder, true, true>(F.lds + RING_OFF, g, S, E);
        if (BOTH(1)) GRID_BAR();
    }
    const int gthreads = F.G * NWAVES * 64;
#define gtid ({ int t_ = threadIdx.x; asm volatile("" : "+v"(t_)); (int)blockIdx.x * (NWAVES * 64) + t_; })
    if (IN(2)) {
        const int gw = F.vcu * NWAVES + F.wave, NGW = F.G * NWAVES;
        if (F.wave < 4) at::prompt_phase(F, ws, in.sb_bias);
        for (int du = gw; du < DB * NPAGE * SBH; du += NGW) at::decode_unit(in, ws, du >> 7, (du >> 3) & 15, du & 7, F.lane);
        if (F.wave >= 4) at::prompt_phase(F, ws, in.sb_bias);
        for (int pu = gw; pu < (MT / 32) * 4; pu += NGW) pl::pool_unit(in, ws, pu >> 2, pu & 3, F.lane);
        pl::pool_state_out(in, ws, P.out, gtid, gthreads);
        if (BOTH(2)) GRID_BAR();
    }
    if (IN(3)) {
        const int gw = F.vcu * NWAVES + F.wave, NGW = F.G * NWAVES;
        for (int cu = gw; cu < DB * SBH; cu += NGW) at::decode_combine(in, ws, cu >> 3, cu & 7, F.lane);
#if DBG_CHECK == 1
        GRID_BAR();
        nv::k_attn((const bf16*)(ws + WS_QN), (const bf16*)(ws + WS_KN), (const bf16*)(ws + WS_VB), in.cache_k, in.cache_v, in.page_table, in.sb_bias, (const bf16*)(ws + WS_SG), (bf16*)(ws + WS_MIXD), gtid, gthreads, 0);
        GRID_BAR();
        { const bf16* A = (const bf16*)(ws + WS_MIX); const bf16* B = (const bf16*)(ws + WS_MIXD); float n0 = 0.f, d0 = 0.f, n1 = 0.f, d1 = 0.f;
          for (size_t i = gtid; i < (size_t)MT * 512; i += gthreads) { const size_t r = i >> 9, o = r * D + 512 + (i & 511); const float a = bf2f(A[o]), b = bf2f(B[o]);
              if (r < MP) { n0 += (a - b) * (a - b); d0 += b * b; } else { n1 += (a - b) * (a - b); d1 += b * b; } }
          n0 = wave_sum(n0); d0 = wave_sum(d0); n1 = wave_sum(n1); d1 = wave_sum(d1);
          if (F.lane == 0) { float* dbg = (float*)(ws + WS_CTL) + CW_DBG; atomicAdd(dbg, n0); atomicAdd(dbg + 1, d0); atomicAdd(dbg + 2, n1); atomicAdd(dbg + 3, d1); } }
#endif
        if (BOTH(3)) GRID_BAR();
    }
    if (IN(4)) {
        pg8::Gemm g{(const pg8::bf16_t*)(ws + WS_MIX), (const pg8::bf16_t*)(ws + WS_W2T), MT, D, D}; pg8::StaticOrder S; S.init(MT, D, F.G, (int)blockIdx.x);
        ep::Epi4 E{in.x_p, in.x_s, in.norm_odd, (float*)(ws + WS_Y1), (bf16*)(ws + WS_A2), (float*)(ws + WS_SSP)};
        pg8::gemm_phase<ep::Epi4, pg8::StaticOrder, true, true>(F.lds + RING_OFF, g, S, E);
        if (BOTH(4)) GRID_BAR();
    }
    if (IN(5)) {
        pg8::Gemm g{(const pg8::bf16_t*)(ws + WS_A2), (const pg8::bf16_t*)(ws + WS_W3T), MT, ODD_PAD, D}; pg8::StaticOrder S; S.init(MT, ODD_PAD, F.G, (int)blockIdx.x);
        ep::Epi5 E{(const float*)(ws + WS_SSP), (bf16*)(ws + WS_QKVP), (bf16*)(ws + WS_SZ), (float*)(ws + WS_BA), P.out};
        pg8::gemm_phase<ep::Epi5, pg8::StaticOrder, true, true>(F.lds + RING_OFF, g, S, E);
        if (BOTH(5)) GRID_BAR();
    }
    if (IN(6)) {
        const int gw = F.vcu * NWAVES + F.wave, NGW = F.G * NWAVES;
        for (int blk = gw; blk < gd::NBLK; blk += NGW) gd::prep_elem<1>(in, ws, blk / (gd::NCH * DNH), blk % gd::NCH, (blk / gd::NCH) % DNH, F.lane);
        for (int blk = gw; blk < gd::NBLK; blk += NGW) gd::prep_elem<0>(in, ws, blk / (gd::NCH * DNH), blk % gd::NCH, (blk / gd::NCH) % DNH, F.lane);
        for (int blk = gw; blk < gd::NBLK; blk += NGW) gd::prep_elem<2>(in, ws, blk / (gd::NCH * DNH), blk % gd::NCH, (blk / gd::NCH) % DNH, F.lane);
        for (int u = gw; u < MS * DNH; u += NGW) gd::sample_prep(in, ws, MP + (u >> 3), u & 7, F.lane);
        GRID_BAR();
        for (int blk = gw; blk < gd::NBLK; blk += NGW) gd::prep_chunk(ws, F.lds + F.wave * gd::WAVE_LDS, blk, F.lane);
        if (BOTH(6)) GRID_BAR();
    }
    if (IN(7)) {
        float* nO = (float*)(ws + NW_O);
        if (F.G >= 256) {
            if ((F.vcu & 3) == 0 && F.vcu < 256) gd::scan_chain(ws, F.lds, nO, P.out, F.vcu >> 2, F.wave, F.lane);
            else { const int widx = F.vcu < 256 ? F.vcu - (F.vcu >> 2) - 1 : 192 + (F.vcu - 256);
                nv::k_gdn((const float*)(ws + NW_C), (const float*)(ws + NW_BETA), (const float*)(ws + NW_G), in.state_delta, nO, P.out, (LAS float*)(F.lds + RING_OFF), BP * DNH + widx, F.G - 64, BP * DNH + DB * DNH); }
        } else {
            for (int ch = F.vcu; ch < BP * DNH; ch += F.G) { gd::scan_chain(ws, F.lds, nO, P.out, ch, F.wave, F.lane); __syncthreads(); }
            nv::k_gdn((const float*)(ws + NW_C), (const float*)(ws + NW_BETA), (const float*)(ws + NW_G), in.state_delta, nO, P.out, (LAS float*)(F.lds + RING_OFF), BP * DNH + F.vcu, F.G, BP * DNH + DB * DNH);
        }
#if DBG_CHECK == 2
        GRID_BAR();
        nv::k_conv((const bf16*)(ws + WS_QKVP), in.state_conv, in.conv_w, (float*)(ws + NW_C), gtid, gthreads);
        GRID_BAR();
        nv::k_qknorm((float*)(ws + NW_C), (const float*)(ws + WS_BA), in.a_log, in.dt_bias, (float*)(ws + NW_BETA), (float*)(ws + NW_G), gtid, gthreads);
        GRID_BAR();
        nv::k_gdn((const float*)(ws + NW_C), (const float*)(ws + NW_BETA), (const float*)(ws + NW_G), in.state_delta, (float*)(ws + gd::WS_DBG_O), (float*)(ws + gd::WS_DBG_OUT), (LAS float*)(F.lds + RING_OFF), (int)blockIdx.x, F.G, BP * DNH);
        GRID_BAR();
        { const float* A = nO; const float* B = (const float*)(ws + gd::WS_DBG_O); float n0 = 0.f, d0 = 0.f, n1 = 0.f, d1 = 0.f;
          for (size_t i = gtid; i < (size_t)MP * D; i += gthreads) { const float a = A[i], b = B[i]; n0 += (a - b) * (a - b); d0 += b * b; }
          const float* A2 = P.out + O_DP; const float* B2 = (const float*)(ws + gd::WS_DBG_OUT) + O_DP;
          for (size_t i = gtid; i < (size_t)BP * DNH * DNK * DNV; i += gthreads) { const float a = A2[i], b = B2[i]; n1 += (a - b) * (a - b); d1 += b * b; }
          n0 = wave_sum(n0); d0 = wave_sum(d0); n1 = wave_sum(n1); d1 = wave_sum(d1);
          if (F.lane == 0) { float* dbg = (float*)(ws + WS_CTL) + CW_DBG; atomicAdd(dbg, n0); atomicAdd(dbg + 1, d0); atomicAdd(dbg + 2, n1); atomicAdd(dbg + 3, d1); } }
#endif
        GRID_BAR();
        nv::k_onorm(nO, (const bf16*)(ws + WS_SZ), in.o_norm, (bf16*)(ws + WS_A4), gtid, gthreads);
        if (BOTH(7)) GRID_BAR();
    }
    if (IN(8)) {
        pg8::Gemm g{(const pg8::bf16_t*)(ws + WS_A4), (const pg8::bf16_t*)(ws + WS_W4T), MT, D, D}; pg8::StaticOrder S; S.init(MT, D, F.G, (int)blockIdx.x);
        ep::Epi8 E{(const float*)(ws + WS_Y1), P.out};
        pg8::gemm_phase<ep::Epi8, pg8::StaticOrder, true, true>(F.lds + RING_OFF, g, S, E);
#if DBG_CHECK
        GRID_BAR();
        { const float* dbg = (const float*)(ws + WS_CTL) + CW_DBG; const float e0 = __hip_atomic_load(dbg, RLX_AGENT) / fmaxf(__hip_atomic_load(dbg + 1, RLX_AGENT), 1e-30f), e1 = __hip_atomic_load(dbg + 2, RLX_AGENT) / fmaxf(__hip_atomic_load(dbg + 3, RLX_AGENT), 1e-30f);
          const float sc = 1.f + sqrtf(fmaxf(DBG_WHICH == 0 ? e0 : (DBG_WHICH == 1 ? e1 : fmaxf(e0, e1)), 0.f));
          for (size_t i = gtid; i < (size_t)MS * D; i += gthreads) P.out[O_YS + i] *= sc; }
#endif
    }
#undef gtid
#undef IN
#undef BOTH
#undef GRID_BAR
}

extern "C" void kernel_launch(void* const* d_in, const int* in_sizes, int n_in, void* d_out, int out_size, void* d_ws, size_t ws_size, hipStream_t stream) {
    static int grid = 0;
    if (grid == 0) {
        if (n_in != 23 || (size_t)out_size != O_END || ws_size < gd::WS_END3) { fprintf(stderr, "kernel_launch: unexpected sizes n_in %d out %d ws %zu (need %zu)\n", n_in, out_size, ws_size, (size_t)gd::WS_END3); grid = -1; return; }
        int dev = 0, cus = 0, per_cu = 0;
        if (hipGetDevice(&dev) != hipSuccess || hipDeviceGetAttribute(&cus, hipDeviceAttributeMultiprocessorCount, dev) != hipSuccess) { grid = -1; return; }
        if (hipFuncSetAttribute((const void*)fwd, hipFuncAttributeMaxDynamicSharedMemorySize, LDS_BYTES) != hipSuccess) { fprintf(stderr, "kernel_launch: hipFuncSetAttribute failed\n"); grid = -1; return; }
        if (hipOccupancyMaxActiveBlocksPerMultiprocessor(&per_cu, (const void*)fwd, NWAVES * 64, LDS_BYTES) != hipSuccess || per_cu < 1) fprintf(stderr, "kernel_launch: occupancy query reports %d\n", per_cu);
        (void)hipGetLastError();
        grid = cus;
    }
    if (grid < 0) return;
    (void)hipMemsetAsync((char*)d_ws + WS_CTL, 0, CTL_ZERO_BYTES, stream);
    Params p{};
    for (int i = 0; i < 23; ++i) p.in[i] = d_in[i];
    p.out = (float*)d_out; p.ws = (unsigned char*)d_ws;
    In in;
    in.x_p = (const float*)d_in[0]; in.x_s = (const float*)d_in[1]; in.cache_pool = (const float*)d_in[2]; in.cache_k = (const float*)d_in[3]; in.cache_v = (const float*)d_in[4];
    in.state_conv = (const float*)d_in[5]; in.state_delta = (const float*)d_in[6]; in.page_table = (const int*)d_in[7];
    in.norm_even = (const float*)d_in[8]; in.w_in_even = (const float*)d_in[9]; in.w_pool = (const float*)d_in[10]; in.pool_scale = (const float*)d_in[11];
    in.q_norm = (const float*)d_in[12]; in.k_norm = (const float*)d_in[13]; in.sb_bias = (const float*)d_in[14]; in.w_out_even = (const float*)d_in[15];
    in.norm_odd = (const float*)d_in[16]; in.w_in_odd = (const float*)d_in[17]; in.conv_w = (const float*)d_in[18]; in.a_log = (const float*)d_in[19];
    in.dt_bias = (const float*)d_in[20]; in.o_norm = (const float*)d_in[21]; in.w_out_odd = (const float*)d_in[22];
    float* out = (float*)d_out; char* ws = (char*)d_ws;
    auto launch = [&](int lo, int hi) { p.ph_lo = lo; p.ph_hi = hi; hipLaunchKernelGGL(fwd, dim3(grid), dim3(NWAVES * 64), LDS_BYTES, stream, p); };
    launch(0, N_PHASES);
}
```

```cpp
#include <hip/hip_runtime.h>
#include <cstdio>
#include <cstdint>

constexpr int D = 1024, BP = 8, SEQ = 2048, MP = BP * SEQ;
constexpr int DB = 128, DS = 4, MS = DB * DS, MT = MP + MS;
constexpr int PAST = 2048, PAGE = 128, NPAGE = PAST / PAGE;
constexpr int PW = 512, PG = 128, PBUF = 15;
constexpr int SBH = 8, SBD = 64;
constexpr int EVEN_IN = 3072;
constexpr int DNH = 8, DNK = 128, DNV = 128, CONVD = 3072, ODD_IN = 4112, ODD_PAD = 4352;
constexpr float EPS = 1e-6f;
constexpr float LOG2E = 1.4426950408889634f;
constexpr float QSCALE = 0.125f * LOG2E;

constexpr size_t O_YP = 0;
constexpr size_t O_YS = O_YP + (size_t)MP * D;
constexpr size_t O_POOLP = O_YS + (size_t)MS * D;
constexpr size_t O_POOLS = O_POOLP + (size_t)BP * PBUF * PW;
constexpr size_t O_KP = O_POOLS + (size_t)DB * PBUF * PW;
constexpr size_t O_VP = O_KP + (size_t)MP * 512;
constexpr size_t O_KS = O_VP + (size_t)MP * 512;
constexpr size_t O_VS = O_KS + (size_t)MS * 512;
constexpr size_t O_CONVP = O_VS + (size_t)MS * 512;
constexpr size_t O_CONVS = O_CONVP + (size_t)BP * 3 * CONVD;
constexpr size_t O_DP = O_CONVS + (size_t)DB * 3 * CONVD;
constexpr size_t O_DS = O_DP + (size_t)BP * DNH * DNK * DNV;
constexpr size_t O_END = O_DS + (size_t)DB * DNH * DNK * DNV;
static_assert(O_END == 54726656, "output size");

struct In {
    const float *x_p, *x_s, *cache_pool, *cache_k, *cache_v, *state_conv, *state_delta;
    const int* page_table;
    const float *norm_even, *w_in_even, *w_pool, *pool_scale, *q_norm, *k_norm, *sb_bias, *w_out_even;
    const float *norm_odd, *w_in_odd, *conv_w, *a_log, *dt_bias, *o_norm, *w_out_odd;
};

__device__ __forceinline__ float wave_sum(float v) {
#pragma unroll
    for (int o = 1; o < 64; o <<= 1) v += __shfl_xor(v, o);
    return v;
}
__device__ __forceinline__ float silu_f(float x) { return x / (1.f + __expf(-x)); }
__device__ __forceinline__ float softplus_f(float x) { return fmaxf(x, 0.f) + log1pf(__expf(-fabsf(x))); }
__device__ __forceinline__ float softplus2_f(float z2) { return fmaxf(z2, 0.f) + __log2f(1.f + exp2f(-fabsf(z2))); }
typedef unsigned short bf16;
__device__ __forceinline__ unsigned f2bf(float f) { unsigned u = __builtin_bit_cast(unsigned, f); return (u + 0x7fffu + ((u >> 16) & 1u)) >> 16; }
__device__ __forceinline__ unsigned pk2(float lo, float hi) { return f2bf(lo) | (f2bf(hi) << 16); }
__device__ __forceinline__ float bf2f(bf16 b) { return __builtin_bit_cast(float, (unsigned)b << 16); }
__device__ __forceinline__ const float* xrow(const In& in, int r) { return r < MP ? in.x_p + (size_t)r * D : in.x_s + (size_t)(r - MP) * D; }
namespace pg8 {
#define PG8_LAS __attribute__((address_space(3)))
typedef unsigned short bf16_t;
typedef short bf16x8 __attribute__((ext_vector_type(8)));
typedef float f32x4 __attribute__((ext_vector_type(4)));
typedef unsigned u32x4 __attribute__((ext_vector_type(4)));
constexpr int BM = 256, BK = 64, HALF = 128, HTB = HALF * BK * 2  , STAGE_BYTES = 8 * HTB, NXCD = 8, WGM = 8;

__host__ __device__ __forceinline__ int lds_byte(int r, int c) { const int st = (r >> 4) * 2 + (c >> 5), rr = r & 15, cc = c & 31, ob = rr * 64 + cc * 2; return st * 1024 + (ob ^ (((ob >> 9) & 1) << 5)); }
__host__ __device__ __forceinline__ void stage_rc(int b, int& R, int& C) { const int st = b / 1024, sb = b % 1024, swz = sb ^ (((sb >> 9) & 1) << 5); R = (st >> 1) * 16 + swz / 64; C = (st & 1) * 32 + (swz % 64) / 2; }
__host__ __device__ __forceinline__ int perm32(int rho) { const int n = rho >> 4, i = rho & 15; return 8 * (i >> 2) + 4 * n + (i & 3); }

struct Unit { int pm, pn; };
struct Gemm { const bf16_t* A; const bf16_t* Bt; int M, N, K; };

struct StaticOrder {
    int nM, nN, nwg, G, c;
    __host__ __device__ void init(int M, int N, int G_, int c_) { nM = M / BM; nN = N / BM; nwg = nM * nN; G = G_; c = c_; }
    __host__ __device__ bool next(int i, Unit& u) const {
        const long L = (long)i * G + c; if (L >= nwg) return false;
        int wgid = (int)L; { const int q = nwg / NXCD, r = nwg % NXCD, xcd = wgid % NXCD, off = wgid / NXCD; wgid = (xcd < r ? xcd * (q + 1) : r * (q + 1) + (xcd - r) * q) + off; }
        const int nig = WGM * nN, gid = wgid / nig, fm = gid * WGM, gsz = (nM - fm) < WGM ? (nM - fm) : WGM;
        u.pm = fm + ((wgid % nig) % gsz); u.pn = (wgid % nig) / gsz; return true;
    }
    __device__ __forceinline__ void a_ready(const Unit&) const {}
    __device__ __forceinline__ void done(const Unit&) const {}
};

__device__ __forceinline__ unsigned cvt_pk_bf16(float lo, float hi) { unsigned r; asm volatile("v_cvt_pk_bf16_f32 %0, %1, %2" : "=v"(r) : "v"(lo), "v"(hi)); return r; }
template <class Epi, class Sched, bool ALIGN_EPI = false, bool SP2 = false>
__device__ __forceinline__ void gemm_phase(PG8_LAS unsigned char* lds, const Gemm g, const Sched& S, const Epi& E) {
    int tid_ = threadIdx.x; asm volatile("" : "+v"(tid_));
    const int tid = tid_, wid = __builtin_amdgcn_readfirstlane(tid >> 6), lane = tid & 63, wr = wid >> 2, wc = wid & 3, fr = lane & 15, fq = lane >> 4;
    const int K = g.K, nt = K / BK;
    unsigned voffA[2], voffB[2];
#pragma unroll
    for (int i = 0; i < 2; ++i) { int R, C; stage_rc(tid * 16 + i * 8192, R, C); const int Rb = Epi::PERM ? ((R & ~31) + perm32(R & 31)) : R;
        voffA[i] = (unsigned)(R * K + C) * 2u; voffB[i] = (unsigned)(Rb * K + C) * 2u; }
    const size_t kstep = (size_t)(BK * 2);
    const size_t hstep = (size_t)HALF * K * 2;
    const size_t tstep = 2 * hstep;
    const unsigned ldsw = (unsigned)wid * 1024u;
    const int aoff = lds_byte(wr * 64 + fr, fq * 8), boff = lds_byte(wc * 32 + fr, fq * 8);
#define PG8_SA(b, h) (((b) * 2 + (h)) * HTB)
#define PG8_SB(b, h) ((4 + (b) * 2 + (h)) * HTB)
#define PG8_STAGE(bufoff, gbase, voff) do { _Pragma("unroll") for (int _i = 0; _i < 2; ++_i) \
        __builtin_amdgcn_global_load_lds((const unsigned*)((const char*)(gbase) + (voff)[_i]), (PG8_LAS unsigned*)(lds + (bufoff) + ldsw + _i * 8192), 16, 0, 0); } while (0)
#define PG8_LDA(dst, b, h) do { _Pragma("unroll") for (int m = 0; m < 4; ++m) _Pragma("unroll") for (int k = 0; k < 2; ++k) dst[m][k] = *(const PG8_LAS bf16x8*)(lds + PG8_SA(b, h) + aoff + m * 2048 + k * 1024); } while (0)
#define PG8_LDB(dst, b, h) do { _Pragma("unroll") for (int n = 0; n < 2; ++n) _Pragma("unroll") for (int k = 0; k < 2; ++k) dst[n][k] = *(const PG8_LAS bf16x8*)(lds + PG8_SB(b, h) + boff + n * 2048 + k * 1024); } while (0)
#define PG8_MMA(ai, bj, At, Bt) do { __builtin_amdgcn_s_setprio(1); _Pragma("unroll") for (int m = 0; m < 4; ++m) _Pragma("unroll") for (int n = 0; n < 2; ++n) _Pragma("unroll") for (int k = 0; k < 2; ++k) \
        acc[ai][bj][m][n] = __builtin_amdgcn_mfma_f32_16x16x32_bf16(Bt[n][k], At[m][k], acc[ai][bj][m][n], 0, 0, 0); __builtin_amdgcn_s_setprio(0); } while (0)
#define PG8_WAIT_V(n) asm volatile("s_waitcnt vmcnt(" #n ")" ::: "memory")
#define PG8_WAIT_L(n) asm volatile("s_waitcnt lgkmcnt(" #n ")" ::: "memory")
#define PG8_BAR __builtin_amdgcn_s_barrier()
#define PG8_SCHED __builtin_amdgcn_sched_barrier(0)
    Unit cur, nxt; int ui = 0;
    if (!S.next(0, cur)) return;
    f32x4 acc[2][2][4][2];
#pragma unroll
    for (int a = 0; a < 2; ++a)
#pragma unroll
        for (int b = 0; b < 2; ++b)
#pragma unroll
            for (int m = 0; m < 4; ++m)
#pragma unroll
                for (int n = 0; n < 2; ++n) acc[a][b][m][n] = (f32x4){0.f, 0.f, 0.f, 0.f};
    bf16x8 At[4][2], B0[2][2], B1[2][2];
    const char* cA = (const char*)g.A + (size_t)cur.pm * tstep; const char* cB = (const char*)g.Bt + (size_t)cur.pn * tstep;
    S.a_ready(cur);
    if constexpr (SP2) {
        PG8_STAGE(PG8_SB(0, 0), cB, voffB); PG8_STAGE(PG8_SB(0, 1), cB + hstep, voffB); PG8_STAGE(PG8_SA(0, 0), cA, voffA); PG8_STAGE(PG8_SA(0, 1), cA + hstep, voffA);
        if (wr == 1) PG8_BAR;
        PG8_WAIT_V(2); PG8_BAR;
        PG8_STAGE(PG8_SB(1, 0), cB + kstep, voffB); PG8_STAGE(PG8_SA(1, 0), cA + kstep, voffA); PG8_STAGE(PG8_SB(1, 1), cB + hstep + kstep, voffB);
        PG8_WAIT_V(6); PG8_BAR;
    } else {
        PG8_STAGE(PG8_SB(0, 0), cB, voffB); PG8_STAGE(PG8_SA(0, 0), cA, voffA); PG8_STAGE(PG8_SB(0, 1), cB + hstep, voffB); PG8_STAGE(PG8_SA(0, 1), cA + hstep, voffA);
        if (wr == 1) PG8_BAR;
        PG8_WAIT_V(4); PG8_BAR;
        PG8_STAGE(PG8_SB(1, 0), cB + kstep, voffB); PG8_STAGE(PG8_SA(1, 0), cA + kstep, voffA); PG8_STAGE(PG8_SB(1, 1), cB + hstep + kstep, voffB);
        PG8_WAIT_V(6); PG8_BAR;
    }
    for (;;) {
        const bool has_next = S.next(ui + 1, nxt);
        const char* nA = has_next ? (const char*)g.A + (size_t)nxt.pm * tstep : cA; const char* nB = has_next ? (const char*)g.Bt + (size_t)nxt.pn * tstep : cB;
        for (int t = 0; t < nt; t += 2) {
            const bool last = (t == nt - 2);
            const char* a1 = cA + (size_t)(t + 1) * kstep;
            const char* a2 = last ? nA : cA + (size_t)(t + 2) * kstep; const char* b2 = last ? nB : cB + (size_t)(t + 2) * kstep;
            const char* a3 = a2 + kstep; const char* b3 = b2 + kstep;
            if (last && has_next) S.a_ready(nxt);
            if constexpr (SP2) {
            PG8_LDB(B0, 0, 0); PG8_LDB(B1, 0, 1); PG8_SCHED; PG8_LDA(At, 0, 0); PG8_STAGE(PG8_SA(1, 1), a1 + hstep, voffA);
            PG8_WAIT_V(8); PG8_WAIT_L(0); PG8_BAR; PG8_MMA(0, 0, At, B0); PG8_MMA(0, 1, At, B1); PG8_BAR; PG8_SCHED;
            PG8_LDA(At, 0, 1); PG8_STAGE(PG8_SB(0, 0), b2, voffB); PG8_STAGE(PG8_SB(0, 1), b2 + hstep, voffB); PG8_STAGE(PG8_SA(0, 0), a2, voffA);
            PG8_WAIT_V(8); PG8_WAIT_L(0); PG8_BAR; PG8_MMA(1, 0, At, B0); PG8_MMA(1, 1, At, B1); PG8_BAR; PG8_SCHED;
            PG8_LDB(B0, 1, 0); PG8_LDB(B1, 1, 1); PG8_SCHED; PG8_LDA(At, 1, 0); PG8_STAGE(PG8_SA(0, 1), a2 + hstep, voffA);
            PG8_WAIT_V(8); PG8_WAIT_L(0); PG8_BAR; PG8_MMA(0, 0, At, B0); PG8_MMA(0, 1, At, B1); PG8_BAR; PG8_SCHED;
            PG8_LDA(At, 1, 1); PG8_STAGE(PG8_SB(1, 0), b3, voffB); PG8_STAGE(PG8_SB(1, 1), b3 + hstep, voffB); PG8_STAGE(PG8_SA(1, 0), a3, voffA);
            PG8_WAIT_V(8); PG8_WAIT_L(0); PG8_BAR; PG8_MMA(1, 0, At, B0); PG8_MMA(1, 1, At, B1); PG8_BAR; PG8_SCHED;
            } else {
            PG8_LDB(B0, 0, 0); PG8_SCHED; PG8_LDA(At, 0, 0); PG8_STAGE(PG8_SA(1, 1), a1 + hstep, voffA);
            PG8_WAIT_L(8); PG8_BAR; PG8_WAIT_L(0); PG8_MMA(0, 0, At, B0); PG8_BAR; PG8_SCHED;
            PG8_LDB(B1, 0, 1); PG8_STAGE(PG8_SB(0, 0), b2, voffB);
            PG8_BAR; PG8_WAIT_L(0); PG8_MMA(0, 1, At, B1); PG8_BAR;
            PG8_LDA(At, 0, 1); PG8_STAGE(PG8_SA(0, 0), a2, voffA);
            PG8_BAR; PG8_WAIT_L(0); PG8_MMA(1, 0, At, B0); PG8_BAR; PG8_SCHED;
            PG8_STAGE(PG8_SB(0, 1), b2 + hstep, voffB);
            PG8_WAIT_V(6); PG8_BAR; PG8_MMA(1, 1, At, B1); PG8_BAR;
            PG8_LDB(B0, 1, 0); PG8_SCHED; PG8_LDA(At, 1, 0); PG8_STAGE(PG8_SA(0, 1), a2 + hstep, voffA);
            PG8_WAIT_L(8); PG8_BAR; PG8_WAIT_L(0); PG8_MMA(0, 0, At, B0); PG8_BAR; PG8_SCHED;
            PG8_LDB(B1, 1, 1); PG8_STAGE(PG8_SB(1, 0), b3, voffB);
            PG8_BAR; PG8_WAIT_L(0); PG8_MMA(0, 1, At, B1); PG8_BAR;
            PG8_LDA(At, 1, 1); PG8_STAGE(PG8_SA(1, 0), a3, voffA);
            PG8_BAR; PG8_WAIT_L(0); PG8_MMA(1, 0, At, B0); PG8_BAR; PG8_SCHED;
            PG8_STAGE(PG8_SB(1, 1), b3 + hstep, voffB);
            PG8_WAIT_V(6); PG8_BAR; PG8_MMA(1, 1, At, B1); PG8_BAR;
            }
        }
        if constexpr (ALIGN_EPI) { if (wr == 0) PG8_BAR; }
        if constexpr (!Epi::AFTER_DRAIN) { E(acc, cur, wr, wc, fr, fq); S.done(cur); }
        if (!has_next) break;
#pragma unroll
        for (int a = 0; a < 2; ++a)
#pragma unroll
            for (int b = 0; b < 2; ++b)
#pragma unroll
                for (int m = 0; m < 4; ++m)
#pragma unroll
                    for (int n = 0; n < 2; ++n) acc[a][b][m][n] = (f32x4){0.f, 0.f, 0.f, 0.f};
        cur = nxt; cA = nA; cB = nB; ++ui;
        if constexpr (ALIGN_EPI) { if (wr == 1) PG8_BAR; }
    }
    PG8_WAIT_V(0);
    if constexpr (!ALIGN_EPI) { if (wr == 0) PG8_BAR; }
    PG8_BAR;
    if constexpr (Epi::AFTER_DRAIN) { E.fused(acc, cur, wr, wc, fr, fq, lds, wid, lane); S.done(cur); }
#undef PG8_SA
#undef PG8_SB
#undef PG8_STAGE
#undef PG8_LDA
#undef PG8_LDB
#undef PG8_MMA
#undef PG8_WAIT_V
#undef PG8_WAIT_L
#undef PG8_BAR
#undef PG8_SCHED
}
}

#define GAS __attribute__((address_space(1)))
#define LAS __attribute__((address_space(3)))
typedef unsigned v4u __attribute__((ext_vector_type(4)));
typedef unsigned v2u __attribute__((ext_vector_type(2)));
typedef float f32x4 __attribute__((ext_vector_type(4)));
typedef float f32x16 __attribute__((ext_vector_type(16)));
typedef short bf16x8 __attribute__((ext_vector_type(8)));
typedef short bf16x4 __attribute__((ext_vector_type(4)));
typedef GAS unsigned gu32;
#define RLX_AGENT __ATOMIC_RELAXED, __HIP_MEMORY_SCOPE_AGENT
#define LDS_WAIT() asm volatile("s_waitcnt lgkmcnt(0)" ::: "memory")
#define VM_WAIT() asm volatile("s_waitcnt vmcnt(0)" ::: "memory")
using pg8::cvt_pk_bf16;
#define XB_TMO      128
#define XB_XCNT(j)  (256  + 64 * (j))
#define XB_XSUB(j)  (1280 + 64 * (j))
#define XB_XGEN(j)  (2304 + 64 * (j))
#define XB_TOP      3328
#define XB_TOPGEN   3392
#define XCD_BAR_WORDS 3456
#define XB_SPIN_CAP (1u << 18)

__device__ __forceinline__ unsigned xb_ld(unsigned* p)              { return __hip_atomic_load(p, __ATOMIC_RELAXED, __HIP_MEMORY_SCOPE_AGENT); }
__device__ __forceinline__ unsigned xb_add(unsigned* p, unsigned v) { return __hip_atomic_fetch_add(p, v, __ATOMIC_RELAXED, __HIP_MEMORY_SCOPE_AGENT); }
__device__ __forceinline__ unsigned xb_xcc_id() { return (unsigned)__builtin_amdgcn_s_getreg((3 << 11) | 20) & 0xFu; }
#define XB_SPIN(cond, bar) do { unsigned _sp = 0; while (cond) { __builtin_amdgcn_s_sleep(1); \
    if ((++_sp & 255u) == 0u) { if (xb_ld(&(bar)[XB_TMO])) break; if (_sp > XB_SPIN_CAP) { atomicAdd(&(bar)[XB_TMO], 1u); break; } } } } while (0)

struct XcdBarrier {
    unsigned* bar; unsigned x;
    volatile LAS unsigned* st;
};

__device__ __forceinline__ XcdBarrier xcd_barrier_post(unsigned* bar, volatile LAS unsigned* st) {
    XcdBarrier b; b.bar = bar; b.x = xb_xcc_id(); b.st = st;
    if (threadIdx.x == 0) (void)xb_add(&bar[XB_XCNT(b.x)], 1u);
    return b;
}
__device__ __forceinline__ void xcd_barrier_complete(unsigned* bar, unsigned x, unsigned& nloc, unsigned& nx) {
    const unsigned G = gridDim.x * gridDim.y * gridDim.z;
    unsigned sum, cnt, mine, sp = 0u;
    for (;;) {
        sum = 0u; cnt = 0u; mine = 0u;
#pragma unroll
        for (unsigned j = 0; j < 16; ++j) { const unsigned c = xb_ld(&bar[XB_XCNT(j)]); sum += c; cnt += (c > 0u) ? 1u : 0u; mine = (j == x) ? c : mine; }
        if (sum == G) break;
        __builtin_amdgcn_s_sleep(1);
        if ((++sp & 255u) == 0u) { if (xb_ld(&bar[XB_TMO])) break; if (sp > XB_SPIN_CAP) { atomicAdd(&bar[XB_TMO], 1u); break; } }
    }
    nloc = mine > 0u ? mine : 1u; nx = cnt > 0u ? cnt : 1u;
}

__device__ __forceinline__ void xcd_barrier(const XcdBarrier& b) {
    asm volatile("s_waitcnt vmcnt(0)" ::: "memory");
    __syncthreads();
    if (threadIdx.x == 0) {
        unsigned* bar = b.bar;
        __builtin_amdgcn_s_waitcnt(0);
        unsigned nloc = b.st[0], nx = b.st[1];
        if (nloc == 0u) { xcd_barrier_complete(bar, b.x, nloc, nx); b.st[0] = nloc; b.st[1] = nx; }
        const unsigned old = xb_add(&bar[XB_XSUB(b.x)], 1u);
        const unsigned gen = old / nloc;
        if (old + 1u == (gen + 1u) * nloc) {
            __builtin_amdgcn_fence(__ATOMIC_RELEASE, "agent");
            asm volatile("s_waitcnt vmcnt(0)" ::: "memory");
            const unsigned og = xb_add(&bar[XB_TOP], 1u);
            const unsigned tg = og / nx;
            if (og + 1u == (tg + 1u) * nx) xb_add(&bar[XB_TOPGEN], 1u);
            else XB_SPIN(xb_ld(&bar[XB_TOPGEN]) == tg, bar);
            __builtin_amdgcn_fence(__ATOMIC_ACQUIRE, "agent");
            xb_add(&bar[XB_XGEN(b.x)], 1u);
            asm volatile("s_waitcnt vmcnt(0)" ::: "memory");
        } else {
            XB_SPIN(xb_ld(&bar[XB_XGEN(b.x)]) == gen, bar);
            __builtin_amdgcn_fence(__ATOMIC_ACQUIRE, "agent");
            asm volatile("s_waitcnt vmcnt(0)" ::: "memory");
        }
    }
    __syncthreads();
}


constexpr size_t al256(size_t x) { return (x + 255) & ~(size_t)255; }
constexpr size_t MiB = 1u << 20;
constexpr size_t WS_CTL = 0, CTL_ZERO_BYTES = 1 * MiB;
constexpr int CW_BAR = 4096, CW_DBG = 64, CW_QUEUE = 8192;
#ifndef DBG_CHECK
#define DBG_CHECK 0
#endif
#ifndef DBG_TA
#define DBG_TA 2
#endif
#ifndef DBG_TB
#define DBG_TB 6
#endif
#ifndef DBG_WHICH
#define DBG_WHICH 2
#endif
constexpr size_t WS_W1T = 1 * MiB;
constexpr size_t WS_W2T = WS_W1T + (size_t)EVEN_IN * D * 2;
constexpr size_t WS_W3T = WS_W2T + (size_t)D * D * 2;
constexpr size_t WS_W4T = WS_W3T + (size_t)ODD_PAD * D * 2;
constexpr size_t WS_WPT = WS_W4T + (size_t)D * D * 2;
constexpr size_t WS_XN1 = WS_WPT + (size_t)4 * PG * PG * 2;
constexpr size_t WS_U = WS_XN1 + (size_t)MT * D * 2;
constexpr size_t WS_QN = WS_U + (size_t)MT * 512 * 2;
constexpr size_t WS_KN = WS_QN + (size_t)MT * 512 * 2;
constexpr size_t WS_VB = WS_KN + (size_t)MT * 512 * 2;
constexpr size_t WS_VT = WS_VB + (size_t)MT * 512 * 2;
constexpr size_t WS_SG = WS_VT + (size_t)MP * 512 * 2;
constexpr size_t WS_MIX = WS_SG + (size_t)MT * D * 2;
constexpr size_t WS_Y1 = WS_MIX + (size_t)MT * D * 2;
constexpr size_t WS_A2 = WS_Y1 + (size_t)MT * D * 4;
constexpr size_t WS_SSP = WS_A2 + (size_t)MT * D * 2;
constexpr size_t WS_QKVP = WS_SSP + (size_t)MT * 16 * 4;
constexpr size_t WS_SZ = WS_QKVP + (size_t)MT * CONVD * 2;
constexpr size_t WS_BA = WS_SZ + (size_t)MT * D * 2;
constexpr size_t WS_A4 = WS_BA + (size_t)MT * 16 * 4;
constexpr size_t WS_SLOW = al256(WS_A4 + (size_t)MT * D * 2);
constexpr size_t NW_D = WS_SLOW;
constexpr size_t NW_C = NW_D + (size_t)MT * 512 * 4;
constexpr size_t NW_BETA = NW_C + (size_t)MT * CONVD * 4;
constexpr size_t NW_G = NW_BETA + (size_t)MT * DNH * 4;
constexpr size_t NW_O = NW_G + (size_t)MT * DNH * 4;
constexpr size_t WS_END = NW_O + (size_t)MT * D * 4;
static_assert(WS_W1T % 256 == 0 && WS_XN1 % 256 == 0 && WS_U % 256 == 0 && WS_Y1 % 256 == 0 && WS_QKVP % 256 == 0 && WS_A4 % 256 == 0, "alignment");

constexpr int RING_OFF = 0, RING_BYTES = 131072;
constexpr int LDSCTL_OFF = 143360, MISC_OFF = LDSCTL_OFF + 320;
constexpr int LDS_BYTES = 147456;
constexpr int NWAVES = 8;

struct Params { const void* in[23]; float* out; unsigned char* ws; int ph_lo, ph_hi; };
struct Frame {
    LAS unsigned char* lds;
    volatile LAS unsigned* MISC;
    gu32* ctl;
    int tid, lane, wave;
    int vcu, G;
};
__device__ __forceinline__ In make_in(const Params& P) {
    In in;
    in.x_p = (const float*)P.in[0]; in.x_s = (const float*)P.in[1]; in.cache_pool = (const float*)P.in[2]; in.cache_k = (const float*)P.in[3]; in.cache_v = (const float*)P.in[4];
    in.state_conv = (const float*)P.in[5]; in.state_delta = (const float*)P.in[6]; in.page_table = (const int*)P.in[7];
    in.norm_even = (const float*)P.in[8]; in.w_in_even = (const float*)P.in[9]; in.w_pool = (const float*)P.in[10]; in.pool_scale = (const float*)P.in[11];
    in.q_norm = (const float*)P.in[12]; in.k_norm = (const float*)P.in[13]; in.sb_bias = (const float*)P.in[14]; in.w_out_even = (const float*)P.in[15];
    in.norm_odd = (const float*)P.in[16]; in.w_in_odd = (const float*)P.in[17]; in.conv_w = (const float*)P.in[18]; in.a_log = (const float*)P.in[19];
    in.dt_bias = (const float*)P.in[20]; in.o_norm = (const float*)P.in[21]; in.w_out_odd = (const float*)P.in[22];
    return in;
}

template <int MODE>
__device__ __forceinline__ void p0_transpose_item(const float* W, int K, int ldw, int nblk, bf16* WT, LAS float* scr, int item, int lane, const float* ks = nullptr) {
    const int kb = item / nblk, nb = item % nblk, k0 = 64 * kb, n0 = 32 * nb;
#pragma unroll 8
    for (int i = 0; i < 32; ++i) { const int kk = 2 * i + (lane >> 5); const float wv = W[(size_t)(k0 + kk) * ldw + n0 + (lane & 31)]; scr[kk * 33 + (lane & 31)] = (MODE == 2 || MODE == 3) ? wv * ks[k0 + kk] : wv; }
    LDS_WAIT(); asm volatile("" ::: "memory");
    const int c = lane & 7;
#pragma unroll
    for (int j = 0; j < 4; ++j) { const int n = (lane >> 3) + 8 * j; const LAS float* s = scr + (8 * c) * 33 + n;
        v4u o; o.x = pk2(s[0 * 33], s[1 * 33]); o.y = pk2(s[2 * 33], s[3 * 33]); o.z = pk2(s[4 * 33], s[5 * 33]); o.w = pk2(s[6 * 33], s[7 * 33]);
        const int col = n0 + n;
        const int row = (MODE == 1 || MODE == 3) ? ((col & ~255) + 128 * ((col & 63) >> 5) + 32 * ((col & 255) >> 6) + (col & 31)) : col;
        *(GAS v4u*)(WT + (size_t)row * K + k0 + 8 * c) = o; }
    LDS_WAIT(); asm volatile("" ::: "memory");
}
__device__ __forceinline__ void rms_row_to_bf16(const float* xrow_, bf16* orow, float* rs_out, int lane) {
    const GAS f32x4* xr = (const GAS f32x4*)xrow_ + lane;
    f32x4 v[4]; float s = 0.f;
#pragma unroll
    for (int j = 0; j < 4; ++j) { v[j] = xr[64 * j]; s += (v[j].x * v[j].x + v[j].y * v[j].y) + (v[j].z * v[j].z + v[j].w * v[j].w); }
    const float rstd = rsqrtf(wave_sum(s) * (1.f / D) + EPS);
    GAS unsigned long long* o8 = (GAS unsigned long long*)orow + lane;
#pragma unroll
    for (int j = 0; j < 4; ++j) o8[64 * j] = (unsigned long long)pk2(v[j].x, v[j].y) | ((unsigned long long)pk2(v[j].z, v[j].w) << 32);
    if (lane == 0) *rs_out = rstd;
}
__device__ __forceinline__ void p0_prologue(const Frame& F, const In& in, unsigned char* ws) {
    LAS float* scr = (LAS float*)(F.lds + RING_OFF + F.wave * 16384);
    const int gw = F.vcu * NWAVES + F.wave, NGW = F.G * NWAVES;
    bf16* W1t = (bf16*)(ws + WS_W1T); bf16* Wpt = (bf16*)(ws + WS_WPT);
    constexpr int I_1 = 16 * 96, I_P = 4 * 8;
    constexpr int NITEMS = I_1 + I_P;
    for (int it = gw; it < NITEMS; it += NGW) {
        int r = it;
        if (r < I_1) { p0_transpose_item<3>(in.w_in_even, D, EVEN_IN, 96, W1t, scr, r, F.lane, in.norm_even); continue; } r -= I_1;
        { const int g = r / 8; p0_transpose_item<0>(in.w_pool + (size_t)g * PG * PG, PG, PG, 4, Wpt + (size_t)g * PG * PG, scr, r % 8, F.lane); }
    }
    bf16* XN1 = (bf16*)(ws + WS_XN1);
    float* RS1 = (float*)(ws + WS_Y1);
    for (int m = gw; m < MT; m += NGW) rms_row_to_bf16(xrow(in, m), XN1 + (size_t)m * D, RS1 + m, F.lane);
}
__device__ __forceinline__ void p_late_weights(const Frame& F, const In& in, unsigned char* ws) {
    LAS float* scr = (LAS float*)(F.lds + RING_OFF + F.wave * 16384);
    const int NGW = F.G * NWAVES, gwr = NGW - 1 - (F.vcu * NWAVES + F.wave);
    bf16* W2t = (bf16*)(ws + WS_W2T); bf16* W3t = (bf16*)(ws + WS_W3T); bf16* W4t = (bf16*)(ws + WS_W4T);
    constexpr int I_2 = 16 * 32, I_3 = 16 * 128, I_4 = 16 * 32;
    constexpr int NITEMS = I_2 + I_3 + I_4;
    for (int it = gwr; it < NITEMS; it += NGW) {
        int r = it;
        if (r < I_2) { p0_transpose_item<0>(in.w_out_even, D, D, 32, W2t, scr, r, F.lane); continue; } r -= I_2;
        if (r < I_3) { p0_transpose_item<2>(in.w_in_odd, D, ODD_IN, 128, W3t, scr, r, F.lane, in.norm_odd); continue; } r -= I_3;
        p0_transpose_item<0>(in.w_out_odd, D, D, 32, W4t, scr, r, F.lane);
    }
    const int gt = F.vcu * (NWAVES * 64) + F.tid, NGT = F.G * NWAVES * 64;
    for (int i = gt; i < 16 * D; i += NGT) { const int k = i >> 4, n = i & 15; W3t[(size_t)(4096 + n) * D + k] = (bf16)f2bf(in.w_in_odd[(size_t)k * ODD_IN + 4096 + n] * in.norm_odd[k]); }
    for (int i = gt; i < (ODD_PAD - ODD_IN) * D / 8; i += NGT) ((GAS v4u*)(W3t + (size_t)ODD_IN * D))[i] = (v4u){0u, 0u, 0u, 0u};
}

namespace ep {
using pg8::Unit; using pg8::BM;
__device__ __forceinline__ v4u pack8(f32x4 a, f32x4 b) { v4u w; w.x = cvt_pk_bf16(a[0], a[1]); w.y = cvt_pk_bf16(a[2], a[3]); w.z = cvt_pk_bf16(b[0], b[1]); w.w = cvt_pk_bf16(b[2], b[3]); return w; }
__device__ __forceinline__ float silu_fast(float x) { return x * __builtin_amdgcn_rcpf(1.f + __builtin_amdgcn_exp2f(-x * LOG2E)); }
__device__ __forceinline__ f32x4 silu4(f32x4 v) { return (f32x4){silu_fast(v[0]), silu_fast(v[1]), silu_fast(v[2]), silu_fast(v[3])}; }
__device__ __forceinline__ float sq4(f32x4 v) { return (v[0] * v[0] + v[1] * v[1]) + (v[2] * v[2] + v[3] * v[3]); }

struct Epi1 {
    static constexpr bool PERM = true, AFTER_DRAIN = false;
    bf16 *U, *QN, *KN, *VB, *VT, *SG; float* out; const float *qg, *kg; LAS unsigned char* vlds; const float* RS1;
    __device__ __forceinline__ void operator()(const f32x4 (&acc_)[2][2][4][2], const Unit& u, int wr, int wc, int fr, int fq) const {
        const int pn = u.pn, row0 = u.pm * BM + wr * 64 + fr, cb = 64 * wc + 8 * fq;
        f32x4 (&acc)[2][2][4][2] = const_cast<f32x4 (&)[2][2][4][2]>(acc_);
#pragma unroll
        for (int ai = 0; ai < 2; ++ai)
#pragma unroll
            for (int m = 0; m < 4; ++m) { const float rs_ = RS1[row0 + ai * 128 + m * 16];
#pragma unroll
                for (int bj = 0; bj < 2; ++bj) { acc[ai][bj][m][0] *= rs_; acc[ai][bj][m][1] *= rs_; } }
        if (pn < 2) {
#pragma unroll
            for (int ai = 0; ai < 2; ++ai)
#pragma unroll
                for (int m = 0; m < 4; ++m) { const int row = row0 + ai * 128 + m * 16; bf16* p = U + (size_t)row * 512 + 256 * pn + cb;
#pragma unroll
                    for (int bj = 0; bj < 2; ++bj) *(v4u*)(p + 32 * bj) = pack8(acc[ai][bj][m][0], acc[ai][bj][m][1]); }
        } else if (pn < 6) {
            const bool isq = pn < 4; const float* g = isq ? qg : kg; const int hc = 256 * (pn - (isq ? 2 : 4)) + cb;
            f32x4 gv[2][2];
#pragma unroll
            for (int bj = 0; bj < 2; ++bj)
#pragma unroll
                for (int n = 0; n < 2; ++n) gv[bj][n] = *(const f32x4*)(g + 32 * bj + 8 * fq + 4 * n);
#pragma unroll
            for (int ai = 0; ai < 2; ++ai)
#pragma unroll
                for (int m = 0; m < 4; ++m) { const int row = row0 + ai * 128 + m * 16;
                    float ss = (sq4(acc[ai][0][m][0]) + sq4(acc[ai][0][m][1])) + (sq4(acc[ai][1][m][0]) + sq4(acc[ai][1][m][1]));
                    ss += __shfl_xor(ss, 16); ss += __shfl_xor(ss, 32);
                    const float rs = rsqrtf(ss * (1.f / 64.f) + EPS) * (isq ? QSCALE : 1.f);
                    f32x4 v[2][2];
#pragma unroll
                    for (int bj = 0; bj < 2; ++bj)
#pragma unroll
                        for (int n = 0; n < 2; ++n) v[bj][n] = acc[ai][bj][m][n] * rs * gv[bj][n];
                    if (isq) {
#pragma unroll
                        for (int bj = 0; bj < 2; ++bj) *(v4u*)(QN + (size_t)row * 512 + hc + 32 * bj) = pack8(v[bj][0], v[bj][1]);
                    } else {
                        float* ko = row < MP ? out + O_KP + (size_t)row * 512 : out + O_KS + (size_t)(row - MP) * 512;
#pragma unroll
                        for (int bj = 0; bj < 2; ++bj) { *(v4u*)(KN + (size_t)row * 512 + hc + 32 * bj) = pack8(v[bj][0], v[bj][1]);
                            *(f32x4*)(ko + hc + 32 * bj) = v[bj][0]; *(f32x4*)(ko + hc + 32 * bj + 4) = v[bj][1]; }
                    } }
        } else if (pn < 8) {
            const int hc = 256 * (pn - 6) + cb, h = 4 * (pn - 6) + wc;
#pragma unroll
            for (int ai = 0; ai < 2; ++ai)
#pragma unroll
                for (int m = 0; m < 4; ++m) { const int row = row0 + ai * 128 + m * 16;
                    float* vo = row < MP ? out + O_VP + (size_t)row * 512 : out + O_VS + (size_t)(row - MP) * 512;
#pragma unroll
                    for (int bj = 0; bj < 2; ++bj) { const f32x4 a = acc[ai][bj][m][0], b = acc[ai][bj][m][1];
                        if (DBG_CHECK == 1) *(v4u*)(VB + (size_t)row * 512 + hc + 32 * bj) = pack8(a, b);
                        *(f32x4*)(vo + hc + 32 * bj) = a; *(f32x4*)(vo + hc + 32 * bj + 4) = b;
                        if (u.pm < MP / BM) {
                            LAS unsigned char* tl = vlds + (wr * 4 + wc) * 1024;
                            LAS bf16* tw = (LAS bf16*)tl + (8 * fq) * 16 + fr;
#pragma unroll
                            for (int e = 0; e < 4; ++e) { tw[e * 16] = (bf16)f2bf(a[e]); tw[(4 + e) * 16] = (bf16)f2bf(b[e]); }
                            LDS_WAIT(); asm volatile("" ::: "memory");
                            const int lane = fq * 16 + fr, dl = lane >> 1, hf = lane & 1, rowg = row - fr;
                            const v4u tv = *(const LAS v4u*)(tl + dl * 32 + hf * 16);
                            *(v4u*)(VT + ((size_t)((rowg >> 11) * 8 + h) * 64 + 32 * bj + dl) * SEQ + (rowg & 2047) + 8 * hf) = tv;
                            LDS_WAIT(); asm volatile("" ::: "memory");
                        } } }
        } else {
            const int hc = 256 * (pn - 8) + cb;
#pragma unroll
            for (int ai = 0; ai < 2; ++ai)
#pragma unroll
                for (int m = 0; m < 4; ++m) { const int row = row0 + ai * 128 + m * 16; bf16* p = SG + (size_t)row * 1024 + hc;
#pragma unroll
                    for (int bj = 0; bj < 2; ++bj) *(v4u*)(p + 32 * bj) = pack8(silu4(acc[ai][bj][m][0]), silu4(acc[ai][bj][m][1])); }
        }
    }
};
struct Epi4 {
    static constexpr bool PERM = true, AFTER_DRAIN = false;
    const bf16* XB; bf16* A2; float* SSP;
    __device__ __forceinline__ void operator()(const f32x4 (&acc)[2][2][4][2], const Unit& u, int wr, int wc, int fr, int fq) const {
        const int row0 = u.pm * BM + wr * 64 + fr, c0 = u.pn * BM + wc * 32 + 8 * fq;
#pragma unroll
        for (int ai = 0; ai < 2; ++ai)
#pragma unroll
            for (int m = 0; m < 4; ++m) { const int row = row0 + ai * 128 + m * 16;
                const bf16* xr = XB + (size_t)row * D + c0;
                float ss = 0.f;
#pragma unroll
                for (int bj = 0; bj < 2; ++bj) { const v4u xb = *(const v4u*)(xr + 128 * bj);
                    const f32x4 y0 = (f32x4){__uint_as_float(xb.x << 16), __uint_as_float(xb.x & 0xffff0000u), __uint_as_float(xb.y << 16), __uint_as_float(xb.y & 0xffff0000u)} + acc[ai][bj][m][0];
                    const f32x4 y1 = (f32x4){__uint_as_float(xb.z << 16), __uint_as_float(xb.z & 0xffff0000u), __uint_as_float(xb.w << 16), __uint_as_float(xb.w & 0xffff0000u)} + acc[ai][bj][m][1];
                    ss += sq4(y0) + sq4(y1);
                    *(v4u*)(A2 + (size_t)row * D + c0 + 128 * bj) = pack8(y0, y1); }
                ss += __shfl_xor(ss, 16); ss += __shfl_xor(ss, 32);
                if (fq == 0) SSP[(size_t)row * 16 + u.pn * 4 + wc] = ss; }
    }
};
struct Epi5 {
    static constexpr bool PERM = true, AFTER_DRAIN = false;
    const float* SSP; bf16 *QKVP, *SZ; float *BA, *out;
    __device__ __forceinline__ void operator()(const f32x4 (&acc)[2][2][4][2], const Unit& u, int wr, int wc, int fr, int fq) const {
        const int pn = u.pn, row0 = u.pm * BM + wr * 64 + fr, c0 = pn * BM + wc * 32 + 8 * fq;
#pragma unroll
        for (int ai = 0; ai < 2; ++ai)
#pragma unroll
            for (int m = 0; m < 4; ++m) { const int row = row0 + ai * 128 + m * 16;
                const f32x4* sp = (const f32x4*)(SSP + (size_t)row * 16);
                const f32x4 s0 = sp[0], s1 = sp[1], s2 = sp[2], s3 = sp[3];
                const float st = ((s0[0] + s0[1]) + (s0[2] + s0[3])) + ((s1[0] + s1[1]) + (s1[2] + s1[3])) + ((s2[0] + s2[1]) + (s2[2] + s2[3])) + ((s3[0] + s3[1]) + (s3[2] + s3[3]));
                const float rs = rsqrtf(st * (1.f / D) + EPS);
                if (pn < 12) {
                    float* cs = nullptr;
                    if (row < MP) { const int t = row & 2047; if (t >= SEQ - 3) cs = out + O_CONVP + (size_t)((row >> 11) * 3 + (t - (SEQ - 3))) * CONVD; }
                    else { const int i = (row - MP) & 3; if (i >= 1) cs = out + O_CONVS + (size_t)(((row - MP) >> 2) * 3 + (i - 1)) * CONVD; }
#pragma unroll
                    for (int bj = 0; bj < 2; ++bj) { const f32x4 a = acc[ai][bj][m][0] * rs, b = acc[ai][bj][m][1] * rs;
                        *(v4u*)(QKVP + (size_t)row * CONVD + c0 + 128 * bj) = pack8(a, b);
                        if (cs) { *(f32x4*)(cs + c0 + 128 * bj) = a; *(f32x4*)(cs + c0 + 128 * bj + 4) = b; } }
                } else if (pn < 16) {
#pragma unroll
                    for (int bj = 0; bj < 2; ++bj) *(v4u*)(SZ + (size_t)row * D + (c0 - CONVD) + 128 * bj) = pack8(silu4(acc[ai][bj][m][0] * rs), silu4(acc[ai][bj][m][1] * rs));
                } else if (wc == 0 && fq < 2) {
                    *(f32x4*)(BA + (size_t)row * 16 + 8 * fq) = acc[ai][0][m][0] * rs; *(f32x4*)(BA + (size_t)row * 16 + 8 * fq + 4) = acc[ai][0][m][1] * rs;
                } }
    }
};
struct Epi8 {
    static constexpr bool PERM = true, AFTER_DRAIN = false;
    const bf16* Y1; float* out;
    __device__ __forceinline__ void operator()(const f32x4 (&acc)[2][2][4][2], const Unit& u, int wr, int wc, int fr, int fq) const {
        const int row0 = u.pm * BM + wr * 64 + fr, c0 = u.pn * BM + wc * 32 + 8 * fq;
#pragma unroll
        for (int ai = 0; ai < 2; ++ai)
#pragma unroll
            for (int m = 0; m < 4; ++m) { const int row = row0 + ai * 128 + m * 16;
                const bf16* yr = Y1 + (size_t)row * D + c0; float* o = (row < MP ? out + O_YP + (size_t)row * D : out + O_YS + (size_t)(row - MP) * D) + c0;
#pragma unroll
                for (int bj = 0; bj < 2; ++bj) { const v4u yb = *(const v4u*)(yr + 128 * bj);
                    const f32x4 ya = (f32x4){__uint_as_float(yb.x << 16), __uint_as_float(yb.x & 0xffff0000u), __uint_as_float(yb.y << 16), __uint_as_float(yb.y & 0xffff0000u)};
                    const f32x4 yc = (f32x4){__uint_as_float(yb.z << 16), __uint_as_float(yb.z & 0xffff0000u), __uint_as_float(yb.w << 16), __uint_as_float(yb.w & 0xffff0000u)};
                    *(f32x4*)(o + 128 * bj) = ya + acc[ai][bj][m][0]; *(f32x4*)(o + 128 * bj + 4) = yc + acc[ai][bj][m][1]; } }
    }
};
}

namespace at {
typedef float f32x2_t __attribute__((ext_vector_type(2))); typedef __bf16 bf16x2_t __attribute__((ext_vector_type(2)));
__device__ __forceinline__ unsigned cvtpk(float lo, float hi) { f32x2_t v = {lo, hi}; bf16x2_t b = __builtin_convertvector(v, bf16x2_t); return __builtin_bit_cast(unsigned, b); }
__device__ __forceinline__ int crow(int r, int h) { return (r & 3) + 8 * (r >> 2) + 4 * h; }
#define MFMA32(a, b, c) __builtin_amdgcn_mfma_f32_32x32x16_bf16((a), (b), (c), 0, 0, 0)
struct KVFrag { bf16x8 k[4]; bf16x4 v[2][2][2]; };
__device__ __forceinline__ void load_frags(KVFrag& f, const bf16* kbase, const bf16* vbase, int kb, int ql) {
    const bf16* kp = kbase + (size_t)(kb * 32 + ql) * 512;
#pragma unroll
    for (int c = 0; c < 4; ++c) f.k[c] = *(const bf16x8*)(kp + 16 * c);
    const bf16* vp = vbase + kb * 32;
#pragma unroll
    for (int db = 0; db < 2; ++db)
#pragma unroll
        for (int s = 0; s < 2; ++s)
#pragma unroll
            for (int p = 0; p < 2; ++p) f.v[db][s][p] = *(const bf16x4*)(vp + (size_t)db * 32 * SEQ + 16 * s + 8 * p);
}
struct KFrag { bf16x8 k[4]; };
struct VFrag { bf16x4 v[2][2][2]; };
__device__ __forceinline__ void load_k(KFrag& f, const bf16* kbase, int kb, int ql) {
    const bf16* kp = kbase + (size_t)(kb * 32 + ql) * 512;
#pragma unroll
    for (int c = 0; c < 4; ++c) f.k[c] = *(const bf16x8*)(kp + 16 * c);
}
__device__ __forceinline__ void load_v(VFrag& f, const bf16* vbase, int kb) {
    const bf16* vp = vbase + kb * 32;
#pragma unroll
    for (int db = 0; db < 2; ++db)
#pragma unroll
        for (int s = 0; s < 2; ++s)
#pragma unroll
            for (int p = 0; p < 2; ++p) f.v[db][s][p] = *(const bf16x4*)(vp + (size_t)db * 32 * SEQ + 16 * s + 8 * p);
}
__device__ __forceinline__ bf16x8 cat8(bf16x4 a, bf16x4 b) { return __builtin_shufflevector(a, b, 0, 1, 2, 3, 4, 5, 6, 7); }
__device__ __forceinline__ bf16x8 pack8r(const float (&x)[16], int s) {
    v4u p; p.x = cvtpk(x[8 * s], x[8 * s + 1]); p.y = cvtpk(x[8 * s + 2], x[8 * s + 3]); p.z = cvtpk(x[8 * s + 4], x[8 * s + 5]); p.w = cvtpk(x[8 * s + 6], x[8 * s + 7]);
    return __builtin_bit_cast(bf16x8, p);
}
template <bool DIAG>
__device__ __forceinline__ void step(const KVFrag& f, const bf16x8 (&qf)[4], const bf16x8 (&tm)[2], f32x16& o0, f32x16& o1, float& R, float bias2, int ql, int h) {
    f32x16 z;
#pragma unroll
    for (int r = 0; r < 16; ++r) z[r] = bias2;
#pragma unroll
    for (int c = 0; c < 4; ++c) z = MFMA32(f.k[c], qf[c], z);
    float lk[16], t[16];
#pragma unroll
    for (int r = 0; r < 16; ++r) {
        const float zz = z[r];
        const float sp = __builtin_amdgcn_fmed3f(zz, 0.f, 3.0e38f) + __builtin_amdgcn_logf(1.f + __builtin_amdgcn_exp2f(-fabsf(zz)));
        const bool valid = !DIAG || (crow(r, h) < ql);
        lk[r] = valid ? -sp : 0.f; t[r] = zz - sp;
    }
    f32x16 sfx;
#pragma unroll
    for (int r = 0; r < 16; ++r) sfx[r] = R;
    sfx = MFMA32(tm[0], pack8r(lk, 0), sfx); sfx = MFMA32(tm[1], pack8r(lk, 1), sfx);
    float a[16];
#pragma unroll
    for (int r = 0; r < 16; ++r) { const bool valid = !DIAG || (crow(r, h) < ql); const float e = __builtin_amdgcn_exp2f(t[r] + sfx[r]); a[r] = valid ? e : 0.f; }
    { const float rn = sfx[0] + lk[0]; auto rr = __builtin_amdgcn_permlane32_swap(__float_as_uint(rn), __float_as_uint(rn), false, false); R = fminf(__uint_as_float(rr[0]), __uint_as_float(rr[1])); }
    const bf16x8 p0 = pack8r(a, 0), p1 = pack8r(a, 1);
    o0 = MFMA32(cat8(f.v[0][0][0], f.v[0][0][1]), p0, o0); o0 = MFMA32(cat8(f.v[0][1][0], f.v[0][1][1]), p1, o0);
    o1 = MFMA32(cat8(f.v[1][0][0], f.v[1][0][1]), p0, o1); o1 = MFMA32(cat8(f.v[1][1][0], f.v[1][1][1]), p1, o1);
}
template <bool DIAG>
__device__ __forceinline__ void step_core(const bf16x8 (&kf)[4], const bf16x8 (&vf)[2][2], const bf16x8 (&qf)[4], const bf16x8 (&tm)[2], f32x16& o0, f32x16& o1, float& R, float bias2, int ql, int h) {
    f32x16 z;
#pragma unroll
    for (int r = 0; r < 16; ++r) z[r] = bias2;
#pragma unroll
    for (int c = 0; c < 4; ++c) z = MFMA32(kf[c], qf[c], z);
    float lk[16];
#pragma unroll
    for (int r = 0; r < 16; ++r) {
        const float zz = z[r];
        const float sp = __builtin_amdgcn_fmed3f(zz, 0.f, 3.0e38f) + __builtin_amdgcn_logf(1.f + __builtin_amdgcn_exp2f(-fabsf(zz)));
        const bool valid = !DIAG || (crow(r, h) < ql);
        lk[r] = valid ? -sp : 0.f;
    }
    f32x16 sfx;
#pragma unroll
    for (int r = 0; r < 16; ++r) sfx[r] = R;
    sfx = MFMA32(tm[0], pack8r(lk, 0), sfx); sfx = MFMA32(tm[1], pack8r(lk, 1), sfx);
    float a[16];
#pragma unroll
    for (int r = 0; r < 16; ++r) { const bool valid = !DIAG || (crow(r, h) < ql); const float e = __builtin_amdgcn_exp2f(z[r] + sfx[r]); a[r] = valid ? e : 0.f; }
    { const float rn = sfx[0]; auto rr = __builtin_amdgcn_permlane32_swap(__float_as_uint(rn), __float_as_uint(rn), false, false); R = fminf(__uint_as_float(rr[0]), __uint_as_float(rr[1])); }
    const bf16x8 p0 = pack8r(a, 0), p1 = pack8r(a, 1);
    o0 = MFMA32(vf[0][0], p0, o0); o0 = MFMA32(vf[0][1], p1, o0);
    o1 = MFMA32(vf[1][0], p0, o1); o1 = MFMA32(vf[1][1], p1, o1);
}
__device__ __forceinline__ void step_pair(const bf16x8 (&kf)[4], const bf16x8 (&vf)[2][2], const bf16x8 (&qa)[4], const bf16x8 (&qb)[4], const bf16x8 (&tm)[2],
                                          f32x16& a0, f32x16& a1, float& RA, f32x16& b0, f32x16& b1, float& RB, float bias2) {
    f32x16 zA, zB;
#pragma unroll
    for (int r = 0; r < 16; ++r) { zA[r] = bias2; zB[r] = bias2; }
#pragma unroll
    for (int c = 0; c < 4; ++c) { zA = MFMA32(kf[c], qa[c], zA); zB = MFMA32(kf[c], qb[c], zB); }
    __builtin_amdgcn_sched_barrier(0);
    f32x16 sA, sB;
    { float lk[16];
#pragma unroll
      for (int r = 0; r < 16; ++r) { const float zz = zA[r]; lk[r] = -(__builtin_amdgcn_fmed3f(zz, 0.f, 3.0e38f) + __builtin_amdgcn_logf(1.f + __builtin_amdgcn_exp2f(-fabsf(zz)))); }
#pragma unroll
      for (int r = 0; r < 16; ++r) sA[r] = RA;
      sA = MFMA32(tm[0], pack8r(lk, 0), sA); sA = MFMA32(tm[1], pack8r(lk, 1), sA); }
    __builtin_amdgcn_sched_barrier(0);
    { float lk[16];
#pragma unroll
      for (int r = 0; r < 16; ++r) { const float zz = zB[r]; lk[r] = -(__builtin_amdgcn_fmed3f(zz, 0.f, 3.0e38f) + __builtin_amdgcn_logf(1.f + __builtin_amdgcn_exp2f(-fabsf(zz)))); }
#pragma unroll
      for (int r = 0; r < 16; ++r) sB[r] = RB;
      sB = MFMA32(tm[0], pack8r(lk, 0), sB); sB = MFMA32(tm[1], pack8r(lk, 1), sB); }
    __builtin_amdgcn_sched_barrier(0);
    { float a[16];
#pragma unroll
      for (int r = 0; r < 16; ++r) a[r] = __builtin_amdgcn_exp2f(zA[r] + sA[r]);
      { const float rn = sA[0]; auto rr = __builtin_amdgcn_permlane32_swap(__float_as_uint(rn), __float_as_uint(rn), false, false); RA = fminf(__uint_as_float(rr[0]), __uint_as_float(rr[1])); }
      const bf16x8 p0 = pack8r(a, 0), p1 = pack8r(a, 1);
      a0 = MFMA32(vf[0][0], p0, a0); a1 = MFMA32(vf[1][0], p0, a1); a0 = MFMA32(vf[0][1], p1, a0); a1 = MFMA32(vf[1][1], p1, a1); }
    __builtin_amdgcn_sched_barrier(0);
    { float a[16];
#pragma unroll
      for (int r = 0; r < 16; ++r) a[r] = __builtin_amdgcn_exp2f(zB[r] + sB[r]);
      { const float rn = sB[0]; auto rr = __builtin_amdgcn_permlane32_swap(__float_as_uint(rn), __float_as_uint(rn), false, false); RB = fminf(__uint_as_float(rr[0]), __uint_as_float(rr[1])); }
      const bf16x8 p0 = pack8r(a, 0), p1 = pack8r(a, 1);
      b0 = MFMA32(vf[0][0], p0, b0); b1 = MFMA32(vf[1][0], p0, b1); b0 = MFMA32(vf[0][1], p1, b0); b1 = MFMA32(vf[1][1], p1, b1); }
}
__device__ __forceinline__ void glds16(const void* g, unsigned lds_base) {
    unsigned sv; asm volatile("s_mov_b32 %0, m0\n\ts_mov_b32 m0, %2\n\ts_nop 0\n\tglobal_load_lds_dwordx4 %1, off\n\ts_mov_b32 m0, %0" : "=&s"(sv) : "v"(g), "s"(lds_base) : "memory"); }
template <int OFF>
__device__ __forceinline__ void glds16o(const void* g, unsigned lds_base) {
    unsigned sv; asm volatile("s_mov_b32 %0, m0\n\ts_mov_b32 m0, %2\n\ts_nop 0\n\tglobal_load_lds_dwordx4 %1, off offset:%3\n\ts_mov_b32 m0, %0" : "=&s"(sv) : "v"(g), "s"(lds_base - (unsigned)OFF), "n"(OFF) : "memory"); }
struct QState { bf16x8 qf[4]; f32x16 o0, o1; float R; };
__device__ __forceinline__ void qstate_init(QState& S, const bf16* QN, size_t rowbase, int hd, int q32, int ql, int h) {
    const bf16* qp = QN + (rowbase + q32 * 32 + ql) * 512 + hd * 64 + 8 * h;
#pragma unroll
    for (int c = 0; c < 4; ++c) S.qf[c] = *(const bf16x8*)(qp + 16 * c);
#pragma unroll
    for (int r = 0; r < 16; ++r) { S.o0[r] = 0.f; S.o1[r] = 0.f; }
    S.R = 0.f;
}
__device__ __forceinline__ void qstate_store(const QState& S, const bf16* SG, bf16* MIX, size_t rowbase, int hd, int q32, int ql, int h) {
    const size_t row = rowbase + q32 * 32 + ql;
    const bf16* sg = SG + row * D + 512 + hd * 64 + 4 * h; bf16* mx = MIX + row * D + 512 + hd * 64 + 4 * h;
#pragma unroll
    for (int db = 0; db < 2; ++db)
#pragma unroll
        for (int g = 0; g < 4; ++g) {
            const bf16x4 sv = *(const bf16x4*)(sg + 32 * db + 8 * g);
            const f32x16& o = db ? S.o1 : S.o0;
            v2u w; w.x = cvtpk(o[4 * g] * bf2f((bf16)sv[0]), o[4 * g + 1] * bf2f((bf16)sv[1])); w.y = cvtpk(o[4 * g + 2] * bf2f((bf16)sv[2]), o[4 * g + 3] * bf2f((bf16)sv[3]));
            *(v2u*)(mx + 32 * db + 8 * g) = w;
        }
}
__device__ __forceinline__ void prompt_pair(const bf16* QN, const bf16* KN, const bf16* VT, const bf16* SG, bf16* MIX, float bias2, int b, int hd, int qhi, LAS unsigned char* ring, int lane) {
    asm volatile("" : "+v"(lane));
    const int ql = lane & 31, h = lane >> 5;
    const size_t rowbase = (size_t)b * SEQ;
    bf16x8 tm[2];
#pragma unroll
    for (int s = 0; s < 2; ++s)
#pragma unroll
        for (int j = 0; j < 8; ++j) tm[s][j] = (16 * s + 8 * (j >> 2) + 4 * h + (j & 3)) >= ql ? (short)0x3F80 : (short)0;
    QState A, B;
    qstate_init(A, QN, rowbase, hd, qhi, ql, h); qstate_init(B, QN, rowbase, hd, qhi - 1, ql, h);
    const bf16* ksrc = KN + (rowbase + ql) * 512 + hd * 64 + 8 * h;
    const bf16* vsrc = VT + ((size_t)(b * 8 + hd) * 64 + ql) * SEQ + 8 * h;
    const unsigned ring0 = (unsigned)(uintptr_t)ring;
#define DMA_BLOCK(kbv, slot) do { const unsigned st_ = (unsigned)__builtin_amdgcn_readfirstlane((int)(ring0 + (unsigned)(slot) * 8192u)); \
        const bf16* kp_ = ksrc + (size_t)(kbv) * 32 * 512; const bf16* vp0_ = vsrc + (kbv) * 32; const bf16* vp1_ = vp0_ + (size_t)32 * SEQ; \
        glds16o<0>(kp_, st_); glds16o<32>(kp_, st_ + 1024); glds16o<64>(kp_, st_ + 2048); glds16o<96>(kp_, st_ + 3072); \
        glds16o<0>(vp0_, st_ + 4096); glds16o<32>(vp0_, st_ + 5120); glds16o<0>(vp1_, st_ + 6144); glds16o<32>(vp1_, st_ + 7168); } while (0)
#define DMA_WAIT(N) asm volatile("s_waitcnt vmcnt(" #N ")" ::: "memory")
#define ATT_FETCH(slot) \
        if (kb >= 3) DMA_BLOCK(kb - 3, ((slot) + 3) & 3); \
        if (kb >= 3) DMA_WAIT(24); else if (kb == 2) DMA_WAIT(16); else if (kb == 1) DMA_WAIT(8); else DMA_WAIT(0);        \
        const LAS unsigned char* st_ = ring + (slot) * 8192; bf16x8 kf_[4], vf_[2][2]; \
        _Pragma("unroll") for (int c = 0; c < 4; ++c) kf_[c] = *(const LAS bf16x8*)(st_ + c * 1024 + lane * 16); \
        _Pragma("unroll") for (int db = 0; db < 2; ++db) _Pragma("unroll") for (int s = 0; s < 2; ++s) { const LAS unsigned char* pv_ = st_ + 4096 + (db * 2 + s) * 1024 + ql * 16 + 8 * h; \
            vf_[db][s] = cat8(*(const LAS bf16x4*)pv_, *(const LAS bf16x4*)(pv_ + 512)); }
    int kb = qhi;
    DMA_BLOCK(kb, 0); if (kb >= 1) DMA_BLOCK(kb - 1, 1); if (kb >= 2) DMA_BLOCK(kb - 2, 2);
    { ATT_FETCH(0); step_core<true>(kf_, vf_, A.qf, tm, A.o0, A.o1, A.R, bias2, ql, h); --kb; }
    { ATT_FETCH(1); step_core<false>(kf_, vf_, A.qf, tm, A.o0, A.o1, A.R, bias2, ql, h); step_core<true>(kf_, vf_, B.qf, tm, B.o0, B.o1, B.R, bias2, ql, h); --kb; }
    int slot = 2;
    while (kb >= 0) { ATT_FETCH(slot); step_core<false>(kf_, vf_, A.qf, tm, A.o0, A.o1, A.R, bias2, ql, h); step_core<false>(kf_, vf_, B.qf, tm, B.o0, B.o1, B.R, bias2, ql, h); --kb; slot = (slot + 1) & 3; }
#undef ATT_FETCH
#undef DMA_BLOCK
#undef DMA_WAIT
    qstate_store(A, SG, MIX, rowbase, hd, qhi, ql, h); qstate_store(B, SG, MIX, rowbase, hd, qhi - 1, ql, h);
    asm volatile("s_waitcnt vmcnt(0)" ::: "memory");
}
#define SR_D 8
#define SR_LA 6
__device__ __forceinline__ void sr_wait4(volatile LAS unsigned* p, unsigned target) {
    for (int it = 0; it < (1 << 15); ++it) {
        const v4u q = *(volatile LAS v4u*)p;
        unsigned m = q.x < q.y ? q.x : q.y; const unsigned m2 = q.z < q.w ? q.z : q.w; m = m < m2 ? m : m2;
        if ((int)((unsigned)__builtin_amdgcn_readfirstlane((int)m) - target) >= 0) break;
        __builtin_amdgcn_s_sleep(1);
    }
    asm volatile("" ::: "memory");
}
struct SrCtx { const bf16* ksrc; const bf16* vsrc; unsigned ring0; int ktop1, ktop2, J, w; unsigned base; volatile LAS unsigned* flg; };
#define SR_DMA(jj) do { const int j_ = (jj); const int kbv_ = j_ <= C.ktop1 ? C.ktop1 - j_ : C.ktop2 - (j_ - C.ktop1 - 1); \
        const unsigned st_ = (unsigned)__builtin_amdgcn_readfirstlane((int)(C.ring0 + (unsigned)(j_ & (SR_D - 1)) * 8192u + (unsigned)C.w * 2048u)); \
        const bf16* sp_ = C.w < 2 ? C.ksrc + (size_t)kbv_ * 32 * 512 + 32 * C.w : C.vsrc + (size_t)(C.w - 2) * 32 * SEQ + kbv_ * 32; \
        glds16o<0>(sp_, st_); glds16o<32>(sp_, st_ + 1024); } while (0)
#define DMA_WAIT(N) asm volatile("s_waitcnt vmcnt(" #N ")" ::: "memory")
#define SR_PRE(j) do { \
        if ((j) + SR_LA < C.J) { if ((j) >= 2) sr_wait4(C.flg + 4, C.base + (unsigned)((j) - 1)); SR_DMA((j) + SR_LA); } \
        { const int rem_ = C.J - 1 - (j);        \
          if (rem_ >= 6) DMA_WAIT(12); else if (rem_ == 5) DMA_WAIT(10); else if (rem_ == 4) DMA_WAIT(8); else if (rem_ == 3) DMA_WAIT(6); else if (rem_ == 2) DMA_WAIT(4); else if (rem_ == 1) DMA_WAIT(2); else DMA_WAIT(0); } \
        C.flg[C.w] = C.base + (unsigned)((j) + 1); \
        sr_wait4(C.flg, C.base + (unsigned)((j) + 1)); } while (0)
#define SR_READ(j) \
        const LAS unsigned char* st_ = ring + ((j) & (SR_D - 1)) * 8192; bf16x8 kf_[4], vf_[2][2]; \
        _Pragma("unroll") for (int c = 0; c < 4; ++c) kf_[c] = *(const LAS bf16x8*)(st_ + c * 1024 + lane * 16); \
        _Pragma("unroll") for (int db = 0; db < 2; ++db) _Pragma("unroll") for (int s = 0; s < 2; ++s) { const LAS unsigned char* pv_ = st_ + 4096 + (db * 2 + s) * 1024 + ql * 16 + 8 * h; \
            vf_[db][s] = cat8(*(const LAS bf16x4*)pv_, *(const LAS bf16x4*)(pv_ + 512)); } \
        asm volatile("s_waitcnt lgkmcnt(0)" ::: "memory"); \
        C.flg[4 + C.w] = C.base + (unsigned)((j) + 1);
__device__ __forceinline__ void sr_unit(const SrCtx& C, const bf16* QN, const bf16* SG, bf16* MIX, float bias2, size_t rowbase, int hd, int j0, int ktop, int qhi, LAS unsigned char* ring, int lane) {
    asm volatile("" : "+v"(lane));
    const int ql = lane & 31, h = lane >> 5;
    bf16x8 tm[2];
#pragma unroll
    for (int s = 0; s < 2; ++s)
#pragma unroll
        for (int j = 0; j < 8; ++j) tm[s][j] = (16 * s + 8 * (j >> 2) + 4 * h + (j & 3)) >= ql ? (short)0x3F80 : (short)0;
    int j = j0, kb = ktop;
    for (; kb > qhi; --kb, ++j) { SR_PRE(j); C.flg[4 + C.w] = C.base + (unsigned)(j + 1); }
    QState A, B;
    qstate_init(A, QN, rowbase, hd, qhi, ql, h); qstate_init(B, QN, rowbase, hd, qhi - 1, ql, h);
    { SR_PRE(j); SR_READ(j); step_core<true>(kf_, vf_, A.qf, tm, A.o0, A.o1, A.R, bias2, ql, h); --kb; ++j; }
    { SR_PRE(j); SR_READ(j); step_core<false>(kf_, vf_, A.qf, tm, A.o0, A.o1, A.R, bias2, ql, h); step_core<true>(kf_, vf_, B.qf, tm, B.o0, B.o1, B.R, bias2, ql, h); --kb; ++j; }
    while (kb >= 0) { SR_PRE(j); SR_READ(j); step_pair(kf_, vf_, A.qf, B.qf, tm, A.o0, A.o1, A.R, B.o0, B.o1, B.R, bias2); --kb; ++j; }
    qstate_store(A, SG, MIX, rowbase, hd, qhi, ql, h); qstate_store(B, SG, MIX, rowbase, hd, qhi - 1, ql, h);
    asm volatile("s_waitcnt vmcnt(0)" ::: "memory");
}
__device__ __forceinline__ void prompt_item(const bf16* QN, const bf16* KN, const bf16* VT, const bf16* SG, bf16* MIX, float bias2, int b, int hd, int pair, int w, LAS unsigned char* ring, volatile LAS unsigned* flg, unsigned base, int lane) {
    asm volatile("" : "+v"(lane));
    const int ql = lane & 31, h = lane >> 5;
    const size_t rowbase = (size_t)b * SEQ;
    SrCtx C;
    C.ktop1 = 8 * (7 - pair) + 7; C.ktop2 = 8 * pair + 7; C.J = C.ktop1 + C.ktop2 + 2; C.w = w; C.base = base; C.flg = flg;
    C.ksrc = KN + (rowbase + ql) * 512 + hd * 64 + 8 * h;
    C.vsrc = VT + ((size_t)(b * 8 + hd) * 64 + ql) * SEQ + 8 * h;
    C.ring0 = (unsigned)(uintptr_t)ring;
    sr_wait4(flg + 4, base);
#pragma unroll 1
    for (int j = 0; j < SR_LA; ++j) SR_DMA(j);
    sr_unit(C, QN, SG, MIX, bias2, rowbase, hd, 0, C.ktop1, C.ktop1 - 2 * w, ring, lane);
    sr_unit(C, QN, SG, MIX, bias2, rowbase, hd, C.ktop1 + 1, C.ktop2, C.ktop2 - 6 + 2 * w, ring, lane);
}
#undef SR_DMA
#undef DMA_WAIT
#undef SR_PRE
#undef SR_READ
__device__ __forceinline__ void prompt_phase(const Frame& F, unsigned char* ws, const float* sb_bias) {
    const bf16* QN = (const bf16*)(ws + WS_QN); const bf16* KN = (const bf16*)(ws + WS_KN); const bf16* VT = (const bf16*)(ws + WS_VT); const bf16* SG = (const bf16*)(ws + WS_SG); bf16* MIX = (bf16*)(ws + WS_MIX);
    volatile LAS unsigned* flg = (volatile LAS unsigned*)(F.lds + 65536);
    unsigned base = 0;
    for (int c = F.vcu; c < 256; c += F.G) {
        const int bh = c >> 2, pair = c & 3, b = bh >> 3, hd = bh & 7;
        const float bias2 = sb_bias[hd] * LOG2E;
        prompt_item(QN, KN, VT, SG, MIX, bias2, b, hd, pair, F.wave & 3, F.lds, flg, base, F.lane);
        base += 72;
    }
}
}

constexpr size_t WS_PO = WS_END;
constexpr size_t WS_PT = WS_PO + (size_t)DB * NPAGE * SBH * DS * SBD * 4;
constexpr size_t WS_MIXD = WS_PT + (size_t)DB * NPAGE * SBH * DS * 4;
constexpr size_t WS_END2 = WS_MIXD + (size_t)MT * D * 2;
namespace at {
__device__ __forceinline__ void decode_unit(const In& in, unsigned char* ws, int s, int p, int hd, int lane) {
    asm volatile("" : "+v"(lane));
    const int ql = lane & 31, h = lane >> 5;
    const bf16* QN = (const bf16*)(ws + WS_QN);
    const int pg = in.page_table[s * NPAGE + p];
    const float* kpage = in.cache_k + (size_t)pg * PAGE * 512 + hd * 64;
    const float* vpage = in.cache_v + (size_t)pg * PAGE * 512 + hd * 64;
    bf16x8 qf[4];
    { const bf16* qp = QN + (size_t)(MP + s * DS + (ql < DS ? ql : DS - 1)) * 512 + hd * 64 + 8 * h;
#pragma unroll
      for (int c = 0; c < 4; ++c) qf[c] = *(const bf16x8*)(qp + 16 * c); }
    bf16x8 tm[2];
#pragma unroll
    for (int sx = 0; sx < 2; ++sx)
#pragma unroll
        for (int j = 0; j < 8; ++j) tm[sx][j] = (16 * sx + 8 * (j >> 2) + 4 * h + (j & 3)) >= ql ? (short)0x3F80 : (short)0;
    const float bias2 = in.sb_bias[hd] * LOG2E;
    f32x16 o0, o1;
#pragma unroll
    for (int r = 0; r < 16; ++r) { o0[r] = 0.f; o1[r] = 0.f; }
    float R = 0.f;
#define DEC_LOAD(blk, kr, vr) do { const float* kp = kpage + (size_t)((blk) * 32 + ql) * 512 + 8 * h; \
        _Pragma("unroll") for (int c = 0; c < 4; ++c) { kr[c][0] = *(const f32x4*)(kp + 16 * c); kr[c][1] = *(const f32x4*)(kp + 16 * c + 4); } \
        const float* vp = vpage + (size_t)((blk) * 32 + 4 * h) * 512 + ql; \
        _Pragma("unroll") for (int db = 0; db < 2; ++db) _Pragma("unroll") for (int sx = 0; sx < 2; ++sx) _Pragma("unroll") for (int j = 0; j < 8; ++j) \
            vr[db][sx][j] = vp[(size_t)(16 * sx + 8 * (j >> 2) + (j & 3)) * 512 + 32 * db]; } while (0)
#define DEC_STEP(kr, vr) do { bf16x8 kf[4], vf[2][2]; \
        _Pragma("unroll") for (int c = 0; c < 4; ++c) { v4u w_; w_.x = cvtpk(kr[c][0][0], kr[c][0][1]); w_.y = cvtpk(kr[c][0][2], kr[c][0][3]); w_.z = cvtpk(kr[c][1][0], kr[c][1][1]); w_.w = cvtpk(kr[c][1][2], kr[c][1][3]); kf[c] = __builtin_bit_cast(bf16x8, w_); } \
        _Pragma("unroll") for (int db = 0; db < 2; ++db) _Pragma("unroll") for (int sx = 0; sx < 2; ++sx) { v4u w_; w_.x = cvtpk(vr[db][sx][0], vr[db][sx][1]); w_.y = cvtpk(vr[db][sx][2], vr[db][sx][3]); w_.z = cvtpk(vr[db][sx][4], vr[db][sx][5]); w_.w = cvtpk(vr[db][sx][6], vr[db][sx][7]); vf[db][sx] = __builtin_bit_cast(bf16x8, w_); } \
        step_core<false>(kf, vf, qf, tm, o0, o1, R, bias2, ql, h); } while (0)
    { f32x4 krA[4][2], krB[4][2]; float vrA[2][2][8], vrB[2][2][8];
      DEC_LOAD(3, krA, vrA);
      DEC_LOAD(2, krB, vrB); DEC_STEP(krA, vrA);
      DEC_LOAD(1, krA, vrA); DEC_STEP(krB, vrB);
      DEC_LOAD(0, krB, vrB); DEC_STEP(krA, vrA);
      DEC_STEP(krB, vrB); }
#undef DEC_LOAD
#undef DEC_STEP
    if (ql < DS) {
        float* po = (float*)(ws + WS_PO) + ((((size_t)s * NPAGE + p) * SBH + hd) * DS + ql) * SBD + 4 * h;
#pragma unroll
        for (int db = 0; db < 2; ++db)
#pragma unroll
            for (int g = 0; g < 4; ++g) { const f32x16& o = db ? o1 : o0; *(f32x4*)(po + 32 * db + 8 * g) = (f32x4){o[4 * g], o[4 * g + 1], o[4 * g + 2], o[4 * g + 3]}; }
        if (h == 0) ((float*)(ws + WS_PT))[(((size_t)s * NPAGE + p) * SBH + hd) * DS + ql] = R;
    }
}
__device__ __forceinline__ void decode_unit2(const In& in, unsigned char* ws, LAS unsigned char* scr, int s, int p, int hd, int lane) {
    asm volatile("" : "+v"(lane));
    const int ql = lane & 31, h = lane >> 5;
    const bf16* QN = (const bf16*)(ws + WS_QN);
    const int pg = in.page_table[s * NPAGE + p];
    const float* kpage = in.cache_k + (size_t)pg * PAGE * 512 + hd * 64;
    const float* vpage = in.cache_v + (size_t)pg * PAGE * 512 + hd * 64;
    bf16x8 qf[4];
    { const bf16* qp = QN + (size_t)(MP + s * DS + (ql < DS ? ql : DS - 1)) * 512 + hd * 64 + 8 * h;
#pragma unroll
      for (int c = 0; c < 4; ++c) qf[c] = *(const bf16x8*)(qp + 16 * c); }
    const float bias2 = in.sb_bias[hd] * LOG2E;
    LAS float* zbuf = (LAS float*)scr;
    LAS bf16* abuf = (LAS bf16*)(scr + 2048);
#define D2_LOADK(blk, kr) do { const float* kp = kpage + (size_t)((blk) * 32 + ql) * 512 + 8 * h; \
        _Pragma("unroll") for (int c = 0; c < 4; ++c) { kr[c][0] = *(const f32x4*)(kp + 16 * c); kr[c][1] = *(const f32x4*)(kp + 16 * c + 4); } } while (0)
#define D2_LOADV(blk, vr) do { const float* vp = vpage + (size_t)((blk) * 32 + 4 * h) * 512 + ql; \
        _Pragma("unroll") for (int db = 0; db < 2; ++db) _Pragma("unroll") for (int sx = 0; sx < 2; ++sx) _Pragma("unroll") for (int j = 0; j < 8; ++j) \
            vr[db][sx][j] = vp[(size_t)(16 * sx + 8 * (j >> 2) + (j & 3)) * 512 + 32 * db]; } while (0)
#define D2_QK(blk, kr) do { f32x16 z_; _Pragma("unroll") for (int r = 0; r < 16; ++r) z_[r] = bias2; \
        _Pragma("unroll") for (int c = 0; c < 4; ++c) { v4u w_; w_.x = cvtpk(kr[c][0][0], kr[c][0][1]); w_.y = cvtpk(kr[c][0][2], kr[c][0][3]); w_.z = cvtpk(kr[c][1][0], kr[c][1][1]); w_.w = cvtpk(kr[c][1][2], kr[c][1][3]); \
            z_ = MFMA32(__builtin_bit_cast(bf16x8, w_), qf[c], z_); } \
        if (ql < DS) { _Pragma("unroll") for (int g = 0; g < 4; ++g) *(LAS f32x4*)(zbuf + ql * 128 + 32 * (blk) + 8 * g + 4 * h) = (f32x4){z_[4 * g], z_[4 * g + 1], z_[4 * g + 2], z_[4 * g + 3]}; } } while (0)
#define D2_PV(blk, vr) do { _Pragma("unroll") for (int sx = 0; sx < 2; ++sx) { \
            const LAS bf16* ap_ = abuf + (ql < DS ? ql : DS - 1) * 128 + 32 * (blk) + 16 * sx + 4 * h; \
            const bf16x8 pa_ = cat8(*(const LAS bf16x4*)ap_, *(const LAS bf16x4*)(ap_ + 8)); \
            _Pragma("unroll") for (int db = 0; db < 2; ++db) { v4u w_; w_.x = cvtpk(vr[db][sx][0], vr[db][sx][1]); w_.y = cvtpk(vr[db][sx][2], vr[db][sx][3]); w_.z = cvtpk(vr[db][sx][4], vr[db][sx][5]); w_.w = cvtpk(vr[db][sx][6], vr[db][sx][7]); \
                if (db == 0) o0 = MFMA32(__builtin_bit_cast(bf16x8, w_), pa_, o0); else o1 = MFMA32(__builtin_bit_cast(bf16x8, w_), pa_, o1); } } } while (0)
    f32x4 kA[4][2], kB[4][2], kC[4][2], kD[4][2]; float vA[2][2][8], vB[2][2][8], vC[2][2][8], vD[2][2][8];
    f32x16 o0, o1;
#pragma unroll
    for (int r = 0; r < 16; ++r) { o0[r] = 0.f; o1[r] = 0.f; }
    D2_LOADK(0, kA); D2_LOADK(1, kB); D2_LOADK(2, kC); D2_LOADK(3, kD); D2_LOADV(0, vA);
    D2_QK(0, kA); D2_LOADV(1, vB);
    D2_QK(1, kB); D2_LOADV(2, vC);
    D2_QK(2, kC);
    D2_QK(3, kD);
    LDS_WAIT(); asm volatile("" ::: "memory");
    float Tq;
    { const int q = lane >> 4, kg = lane & 15;
      const f32x4 z0 = *(const LAS f32x4*)(zbuf + q * 128 + 8 * kg), z1 = *(const LAS f32x4*)(zbuf + q * 128 + 8 * kg + 4);
      float z[8] = {z0[0], z0[1], z0[2], z0[3], z1[0], z1[1], z1[2], z1[3]}, lk[8], t[8], sfx[8];
#pragma unroll
      for (int i = 0; i < 8; ++i) { const float sp = fmaxf(z[i], 0.f) + __builtin_amdgcn_logf(1.f + __builtin_amdgcn_exp2f(-fabsf(z[i]))); lk[i] = -sp; t[i] = z[i] - sp; }
      float run = 0.f;
#pragma unroll
      for (int i = 7; i >= 0; --i) { sfx[i] = run; run += lk[i]; }
      float inc = run;
#pragma unroll
      for (int off = 1; off < 16; off <<= 1) { const float tt = __shfl_down(inc, off, 16); if (kg + off < 16) inc += tt; }
      const float later = inc - run;
      Tq = __shfl(inc, 0, 16);
      float a[8];
#pragma unroll
      for (int i = 0; i < 8; ++i) a[i] = __builtin_amdgcn_exp2f(t[i] + sfx[i] + later);
      v4u pa; pa.x = cvtpk(a[0], a[1]); pa.y = cvtpk(a[2], a[3]); pa.z = cvtpk(a[4], a[5]); pa.w = cvtpk(a[6], a[7]);
      *(LAS v4u*)(abuf + q * 128 + 8 * kg) = pa; }
    D2_LOADV(3, vD);
    LDS_WAIT(); asm volatile("" ::: "memory");
    D2_PV(0, vA); D2_PV(1, vB); D2_PV(2, vC); D2_PV(3, vD);
#undef D2_LOADK
#undef D2_LOADV
#undef D2_QK
#undef D2_PV
    if (ql < DS) {
        float* po = (float*)(ws + WS_PO) + ((((size_t)s * NPAGE + p) * SBH + hd) * DS + ql) * SBD + 4 * h;
#pragma unroll
        for (int db = 0; db < 2; ++db)
#pragma unroll
            for (int g = 0; g < 4; ++g) { const f32x16& o = db ? o1 : o0; *(f32x4*)(po + 32 * db + 8 * g) = (f32x4){o[4 * g], o[4 * g + 1], o[4 * g + 2], o[4 * g + 3]}; }
    }
    if ((lane & 15) == 0) ((float*)(ws + WS_PT))[(((size_t)s * NPAGE + p) * SBH + hd) * DS + (lane >> 4)] = Tq;
    LDS_WAIT(); asm volatile("" ::: "memory");
}
__device__ __forceinline__ void decode_combine(const In& in, unsigned char* ws, int s, int hd, int lane) {
    asm volatile("" : "+v"(lane));
    const bf16* QN = (const bf16*)(ws + WS_QN); const bf16* KN = (const bf16*)(ws + WS_KN); const bf16* VB = (const bf16*)(ws + WS_VB); const bf16* SG = (const bf16*)(ws + WS_SG); bf16* MIX = (bf16*)(ws + WS_MIX);
    const float* PO = (const float*)(ws + WS_PO); const float* PT = (const float*)(ws + WS_PT);
    const float bias2 = in.sb_bias[hd] * LOG2E;
    float q[DS], k[DS], v[DS];
#pragma unroll
    for (int i = 0; i < DS; ++i) { const size_t o = (size_t)(MP + s * DS + i) * 512 + hd * 64 + lane; q[i] = bf2f(QN[o]); k[i] = bf2f(KN[o]); v[i] = bf2f(VB[o]); }
    const float Tl = PT[(((size_t)s * NPAGE + (lane >> 2)) * SBH + hd) * DS + (lane & 3)];
#pragma unroll
    for (int i = 0; i < DS; ++i) {
        float Rn = 0.f, out = 0.f;
#pragma unroll
        for (int j = DS - 1; j >= 0; --j) if (j < i) {
            const float z = wave_sum(q[i] * k[j]) + bias2;
            const float sp = softplus2_f(z);
            out += exp2f(z - sp + Rn) * v[j];
            Rn -= sp;
        }
        for (int p = NPAGE - 1; p >= 0; --p) {
            out += exp2f(Rn) * PO[((((size_t)s * NPAGE + p) * SBH + hd) * DS + i) * SBD + lane];
            Rn += __shfl(Tl, 4 * p + i);
        }
        const size_t o = (size_t)(MP + s * DS + i) * D + 512 + hd * 64 + lane;
        MIX[o] = (bf16)f2bf(out * bf2f(SG[o]));
    }
}
}

namespace pl {
using at::cvtpk;
template <int G>
__device__ __forceinline__ void pool_unit_prompt(const In& in, unsigned char* ws, int rb, int lane) {
    asm volatile("" : "+v"(lane));
    constexpr int w = 2 << G;
    const int ql = lane & 31, h = lane >> 5;
    const bf16* U = (const bf16*)(ws + WS_U); const bf16* Wpt = (const bf16*)(ws + WS_WPT) + (size_t)G * PG * PG; const bf16* SG = (const bf16*)(ws + WS_SG); bf16* MIX = (bf16*)(ws + WS_MIX);
    const int row = rb * 32 + ql, t = row & (SEQ - 1);
    const float inv = 1.f / (float)min(t + 1, w);
    f32x16 acc[4];
#pragma unroll
    for (int nb = 0; nb < 4; ++nb)
#pragma unroll
        for (int r = 0; r < 16; ++r) acc[nb][r] = 0.f;
#pragma unroll 1
    for (int c = 0; c < 8; ++c) {
        const int ch = PG * G + 16 * c + 8 * h;
        const bf16* up = U + (size_t)row * PW + ch;
        bf16x8 u8[w];
#pragma unroll
        for (int j = 0; j < w; ++j) u8[j] = *(const bf16x8*)(up - (ptrdiff_t)(j <= t ? j : t) * PW);
        float sum[8], cur[8];
#pragma unroll
        for (int e = 0; e < 8; ++e) { cur[e] = bf2f((bf16)u8[0][e]); sum[e] = cur[e]; }
#pragma unroll
        for (int j = 1; j < w; ++j) { const float m = j <= t ? 1.f : 0.f;
#pragma unroll
            for (int e = 0; e < 8; ++e) sum[e] += m * bf2f((bf16)u8[j][e]); }
        v4u dp;
        dp.x = cvtpk(sum[0] * inv - cur[0], sum[1] * inv - cur[1]); dp.y = cvtpk(sum[2] * inv - cur[2], sum[3] * inv - cur[3]);
        dp.z = cvtpk(sum[4] * inv - cur[4], sum[5] * inv - cur[5]); dp.w = cvtpk(sum[6] * inv - cur[6], sum[7] * inv - cur[7]);
        const bf16x8 df = __builtin_bit_cast(bf16x8, dp);
#pragma unroll
        for (int nb = 0; nb < 4; ++nb) { const bf16x8 wf = *(const bf16x8*)(Wpt + (size_t)(32 * nb + ql) * PG + 16 * c + 8 * h); acc[nb] = MFMA32(wf, df, acc[nb]); }
    }
#pragma unroll
    for (int nb = 0; nb < 4; ++nb)
#pragma unroll
        for (int gg = 0; gg < 4; ++gg) {
            const int ch = PG * G + 32 * nb + 8 * gg + 4 * h;
            const f32x4 sc = *(const f32x4*)(in.pool_scale + ch);
            const bf16x4 sv = *(const bf16x4*)(SG + (size_t)row * D + ch);
            v2u o; o.x = cvtpk(acc[nb][4 * gg] * sc[0] * bf2f((bf16)sv[0]), acc[nb][4 * gg + 1] * sc[1] * bf2f((bf16)sv[1]));
            o.y = cvtpk(acc[nb][4 * gg + 2] * sc[2] * bf2f((bf16)sv[2]), acc[nb][4 * gg + 3] * sc[3] * bf2f((bf16)sv[3]));
            *(v2u*)(MIX + (size_t)row * D + ch) = o;
        }
}
template <int G>
__device__ __forceinline__ void pool_unit_sample(const In& in, unsigned char* ws, int rb, int lane) {
    asm volatile("" : "+v"(lane));
    constexpr int w = 2 << G;
    const int ql = lane & 31, h = lane >> 5;
    const bf16* U = (const bf16*)(ws + WS_U); const bf16* Wpt = (const bf16*)(ws + WS_WPT) + (size_t)G * PG * PG; const bf16* SG = (const bf16*)(ws + WS_SG); bf16* MIX = (bf16*)(ws + WS_MIX);
    const int row = rb * 32 + ql, s = (row - MP) >> 2, t = (row - MP) & 3;
    const float inv = 1.f / (float)w;
    f32x16 acc[4];
#pragma unroll
    for (int nb = 0; nb < 4; ++nb)
#pragma unroll
        for (int r = 0; r < 16; ++r) acc[nb][r] = 0.f;
#pragma unroll 1
    for (int c = 0; c < 8; ++c) {
        const int ch = PG * G + 16 * c + 8 * h;
        const bf16* up = U + (size_t)row * PW + ch; const float* cp = in.cache_pool + (size_t)s * PBUF * PW + ch;
        float sum[8], cur[8];
        { const bf16x8 u0 = *(const bf16x8*)up;
#pragma unroll
          for (int e = 0; e < 8; ++e) { cur[e] = bf2f((bf16)u0[e]); sum[e] = cur[e]; } }
#pragma unroll
        for (int j0 = 1; j0 < w; j0 += 4) {
            bf16x8 ua[4]; f32x4 c0[4], c1[4];
#pragma unroll
            for (int jj = 0; jj < 4; ++jj) { const int j = j0 + jj; if (j < w) { const int tt = t - j;
                ua[jj] = *(const bf16x8*)(up - (ptrdiff_t)(tt >= 0 ? j : t) * PW);
                const float* cq = cp + (size_t)(tt >= 0 ? 0 : PBUF + tt) * PW; c0[jj] = *(const f32x4*)cq; c1[jj] = *(const f32x4*)(cq + 4); } }
#pragma unroll
            for (int jj = 0; jj < 4; ++jj) { const int j = j0 + jj; if (j < w) { const bool fromu = t - j >= 0;
#pragma unroll
                for (int e = 0; e < 4; ++e) { sum[e] += fromu ? bf2f((bf16)ua[jj][e]) : c0[jj][e]; sum[4 + e] += fromu ? bf2f((bf16)ua[jj][4 + e]) : c1[jj][e]; } } }
        }
        v4u dp;
        dp.x = cvtpk(sum[0] * inv - cur[0], sum[1] * inv - cur[1]); dp.y = cvtpk(sum[2] * inv - cur[2], sum[3] * inv - cur[3]);
        dp.z = cvtpk(sum[4] * inv - cur[4], sum[5] * inv - cur[5]); dp.w = cvtpk(sum[6] * inv - cur[6], sum[7] * inv - cur[7]);
        const bf16x8 df = __builtin_bit_cast(bf16x8, dp);
#pragma unroll
        for (int nb = 0; nb < 4; ++nb) { const bf16x8 wf = *(const bf16x8*)(Wpt + (size_t)(32 * nb + ql) * PG + 16 * c + 8 * h); acc[nb] = MFMA32(wf, df, acc[nb]); }
    }
#pragma unroll
    for (int nb = 0; nb < 4; ++nb)
#pragma unroll
        for (int gg = 0; gg < 4; ++gg) {
            const int ch = PG * G + 32 * nb + 8 * gg + 4 * h;
            const f32x4 sc = *(const f32x4*)(in.pool_scale + ch);
            const bf16x4 sv = *(const bf16x4*)(SG + (size_t)row * D + ch);
            v2u o; o.x = cvtpk(acc[nb][4 * gg] * sc[0] * bf2f((bf16)sv[0]), acc[nb][4 * gg + 1] * sc[1] * bf2f((bf16)sv[1]));
            o.y = cvtpk(acc[nb][4 * gg + 2] * sc[2] * bf2f((bf16)sv[2]), acc[nb][4 * gg + 3] * sc[3] * bf2f((bf16)sv[3]));
            *(v2u*)(MIX + (size_t)row * D + ch) = o;
        }
}
__device__ __forceinline__ void pool_unit(const In& in, unsigned char* ws, int rb, int g, int lane) {
    asm volatile("" : "+v"(lane));
    const int ql = lane & 31, h = lane >> 5, w = 2 << g;
    const bf16* U = (const bf16*)(ws + WS_U); const bf16* Wpt = (const bf16*)(ws + WS_WPT) + (size_t)g * PG * PG; const bf16* SG = (const bf16*)(ws + WS_SG); bf16* MIX = (bf16*)(ws + WS_MIX);
    const int row = rb * 32 + ql;
    int t, s = 0; float inv;
    if (row < MP) { t = row & (SEQ - 1); inv = 1.f / (float)min(t + 1, w); } else { s = (row - MP) >> 2; t = (row - MP) & 3; inv = 1.f / (float)w; }
    f32x16 acc[4];
#pragma unroll
    for (int nb = 0; nb < 4; ++nb)
#pragma unroll
        for (int r = 0; r < 16; ++r) acc[nb][r] = 0.f;
#pragma unroll 1
    for (int c = 0; c < 8; ++c) {
        const int ch = PG * g + 16 * c + 8 * h;
        float sum[8], cur[8];
        { const bf16x8 u8 = *(const bf16x8*)(U + (size_t)row * PW + ch);
#pragma unroll
          for (int e = 0; e < 8; ++e) { cur[e] = bf2f((bf16)u8[e]); sum[e] = cur[e]; } }
        for (int j = 1; j < w; ++j) {
            const int tt = t - j;
            if (tt >= 0) { const bf16x8 u8 = *(const bf16x8*)(U + (size_t)(row - j) * PW + ch);
#pragma unroll
                for (int e = 0; e < 8; ++e) sum[e] += bf2f((bf16)u8[e]); }
            else if (row >= MP) { const float* cp = in.cache_pool + ((size_t)s * PBUF + (PBUF + tt)) * PW + ch;
#pragma unroll
                for (int e = 0; e < 8; ++e) sum[e] += cp[e]; }
        }
        v4u dp;
        dp.x = cvtpk(sum[0] * inv - cur[0], sum[1] * inv - cur[1]); dp.y = cvtpk(sum[2] * inv - cur[2], sum[3] * inv - cur[3]);
        dp.z = cvtpk(sum[4] * inv - cur[4], sum[5] * inv - cur[5]); dp.w = cvtpk(sum[6] * inv - cur[6], sum[7] * inv - cur[7]);
        const bf16x8 df = __builtin_bit_cast(bf16x8, dp);
#pragma unroll
        for (int nb = 0; nb < 4; ++nb) { const bf16x8 wf = *(const bf16x8*)(Wpt + (size_t)(32 * nb + ql) * PG + 16 * c + 8 * h); acc[nb] = MFMA32(wf, df, acc[nb]); }
    }
#pragma unroll
    for (int nb = 0; nb < 4; ++nb)
#pragma unroll
        for (int gg = 0; gg < 4; ++gg) {
            const int ch = PG * g + 32 * nb + 8 * gg + 4 * h;
            const f32x4 sc = *(const f32x4*)(in.pool_scale + ch);
            const bf16x4 sv = *(const bf16x4*)(SG + (size_t)row * D + ch);
            v2u o; o.x = cvtpk(acc[nb][4 * gg] * sc[0] * bf2f((bf16)sv[0]), acc[nb][4 * gg + 1] * sc[1] * bf2f((bf16)sv[1]));
            o.y = cvtpk(acc[nb][4 * gg + 2] * sc[2] * bf2f((bf16)sv[2]), acc[nb][4 * gg + 3] * sc[3] * bf2f((bf16)sv[3]));
            *(v2u*)(MIX + (size_t)row * D + ch) = o;
        }
}
__device__ __forceinline__ void pool_state_out(const In& in, unsigned char* ws, float* out, int gtid, int gthreads) {
    const bf16* U = (const bf16*)(ws + WS_U);
    for (int i = gtid; i < BP * PBUF * PW; i += gthreads) { const int c = i % PW, j = (i / PW) % PBUF, b = i / (PW * PBUF); out[O_POOLP + i] = bf2f(U[(size_t)(b * SEQ + SEQ - PBUF + j) * PW + c]); }
    for (int i = gtid; i < DB * PBUF * PW; i += gthreads) { const int c = i % PW, j = (i / PW) % PBUF, s = i / (PW * PBUF), e = j + DS;
        out[O_POOLS + i] = e < PBUF ? in.cache_pool[((size_t)s * PBUF + e) * PW + c] : bf2f(U[(size_t)(MP + s * DS + (e - PBUF)) * PW + c]); }
}
}

namespace gd {
using at::cvtpk; using at::crow;
constexpr int NCH = SEQ / 64, NBLK = BP * DNH * NCH;
constexpr int F_W = 0, F_Q = 16, F_K = 32, F_A = 48, F_U = 54, F_N = 70;
constexpr size_t OPS_BYTES = (size_t)F_N * 1024;
constexpr size_t WS_OPS = WS_END2;
constexpr size_t WS_UA = WS_OPS + (size_t)NBLK * OPS_BYTES;
constexpr size_t WS_KPL = WS_UA + (size_t)NBLK * 32768;
constexpr size_t WS_QPL = WS_KPL + (size_t)MP * 1024 * 2;
constexpr size_t WS_KGT = WS_QPL + (size_t)MP * 1024 * 2;
constexpr size_t WS_VBT = WS_KGT + (size_t)NBLK * 16384;
constexpr size_t WS_SC = WS_VBT + (size_t)NBLK * 16384;
constexpr size_t WS_DBG_O = WS_SC + (size_t)MP * 8 * 2 * 4;
constexpr size_t WS_DBG_OUT = WS_DBG_O + (size_t)MP * D * 4;
constexpr size_t WS_END3 = WS_DBG_OUT + O_END * 4;
constexpr int LT_PITCH = 68, WAVE_LDS = (64 * LT_PITCH + 128) * 4;

__device__ __forceinline__ v4u pk8(const float* x) { v4u p; p.x = cvtpk(x[0], x[1]); p.y = cvtpk(x[2], x[3]); p.z = cvtpk(x[4], x[5]); p.w = cvtpk(x[6], x[7]); return p; }

template <int PART>
__device__ __forceinline__ void prep_elem(const In& in, unsigned char* ws, LAS unsigned char* wl, int b_, int n_, int hd_, int lane) {
    asm volatile("" : "+v"(lane));
    const int b = __builtin_amdgcn_readfirstlane(b_), n = __builtin_amdgcn_readfirstlane(n_), hd = __builtin_amdgcn_readfirstlane(hd_);
    const int t = n * 64 + lane, row = b * SEQ + t, blk = (b * DNH + hd) * NCH + n;
    const float* BA = (const float*)(ws + WS_BA);
    const float bb = BA[(size_t)row * 16 + hd], aa = BA[(size_t)row * 16 + 8 + hd];
    const float beta = 1.f / (1.f + __expf(-bb));
    const float g = -__expf(in.a_log[hd]) * softplus_f(aa + in.dt_bias[hd]);
    float gc = g;
#pragma unroll
    for (int off = 1; off < 64; off <<= 1) { const float tt = __shfl_up(gc, off); if (lane >= off) gc += tt; }
    const float glast = __shfl(gc, 63);
    constexpr int TP = 144;
    LAS unsigned char* raw = wl + 8192;
    const bf16* Xt = (const bf16*)(ws + WS_QKVP) + ((ptrdiff_t)(b * SEQ + n * 64) - 3) * CONVD + PART * 1024 + hd * 128;
    const float* cw = in.conv_w + PART * 1024 + hd * 128;
    float wv[4];
#define STAGE(half) do { LDS_WAIT(); asm volatile("" ::: "memory"); \
        _Pragma("unroll") for (int i = 0; i < 9; ++i) { int r_ = 8 * i + (lane >> 3); r_ = r_ < 67 ? r_ : 66;         \
            const bool z_ = (n == 0) && (r_ < 3); const int rl_ = z_ ? 3 : r_; \
            v4u v_ = *(const v4u*)(Xt + (size_t)rl_ * CONVD + 64 * (half) + 8 * (lane & 7)); \
            if (z_) v_ = (v4u){0u, 0u, 0u, 0u}; \
            *(LAS v4u*)(raw + r_ * TP + (lane & 7) * 16) = v_; } \
        _Pragma("unroll") for (int jj = 0; jj < 4; ++jj) wv[jj] = cw[(size_t)jj * CONVD + 64 * (half) + lane] * (-LOG2E);        \
        LDS_WAIT(); asm volatile("" ::: "memory"); } while (0)
    v4u R[9]; float wn[4];
#define STAGE_LOAD(half) do { \
        _Pragma("unroll") for (int i = 0; i < 9; ++i) { int r_ = 8 * i + (lane >> 3); r_ = r_ < 67 ? r_ : 66; \
            const bool z_ = (n == 0) && (r_ < 3); const int rl_ = z_ ? 3 : r_; \
            R[i] = *(const v4u*)(Xt + (size_t)rl_ * CONVD + 64 * (half) + 8 * (lane & 7)); \
            if (z_) R[i] = (v4u){0u, 0u, 0u, 0u}; } \
        _Pragma("unroll") for (int jj = 0; jj < 4; ++jj) wn[jj] = cw[(size_t)jj * CONVD + 64 * (half) + lane]; } while (0)
#define STAGE_STORE() do { LDS_WAIT(); asm volatile("" ::: "memory"); \
        _Pragma("unroll") for (int i = 0; i < 9; ++i) { int r_ = 8 * i + (lane >> 3); r_ = r_ < 67 ? r_ : 66; *(LAS v4u*)(raw + r_ * TP + (lane & 7) * 16) = R[i]; } \
        _Pragma("unroll") for (int jj = 0; jj < 4; ++jj) wv[jj] = wn[jj] * (-LOG2E); \
        LDS_WAIT(); asm volatile("" ::: "memory"); } while (0)
#define COMP32(half, kq, x) do { _Pragma("unroll") for (int c_ = 0; c_ < 32; ++c_) x[c_] = 0.f; \
        _Pragma("unroll") for (int jj = 0; jj < 4; ++jj) _Pragma("unroll") for (int cg = 0; cg < 4; ++cg) { \
            const bf16x8 u_ = *(const LAS bf16x8*)(raw + (lane + jj) * TP + (4 * (kq) + cg) * 16); \
            int w_ = __builtin_bit_cast(int, wv[jj]); { const int u0_ = (int)u_[0]; asm volatile("" : "+v"(w_) : "v"(u0_)); }     \
            _Pragma("unroll") for (int e = 0; e < 8; ++e) x[8 * cg + e] += bf2f((bf16)u_[e]) * __builtin_bit_cast(float, __builtin_amdgcn_readlane(w_, 32 * (kq) + 8 * cg + e)); } \
        _Pragma("unroll") for (int c_ = 0; c_ < 32; ++c_) x[c_] = x[c_] * __builtin_amdgcn_rcpf(1.f + __builtin_amdgcn_exp2f(x[c_])); } while (0)
    unsigned char* ops = ws + WS_OPS + (size_t)blk * OPS_BYTES;
    const int jb = lane >> 5, jl = lane & 31;
    float ss = 0.f;
    unsigned PK0[16], PK1[16];
    if (PART != 2) {
#define SS32(x) do { _Pragma("unroll") for (int c = 0; c < 32; ++c) ss += x[c] * x[c]; } while (0)
#define PARK_LDS(x, base) do { _Pragma("unroll") for (int i = 0; i < 4; ++i) { v4u p_; p_.x = cvtpk(x[8 * i], x[8 * i + 1]); p_.y = cvtpk(x[8 * i + 2], x[8 * i + 3]); p_.z = cvtpk(x[8 * i + 4], x[8 * i + 5]); p_.w = cvtpk(x[8 * i + 6], x[8 * i + 7]); \
            *(LAS v4u*)((base) + i * 1024 + lane * 16) = p_; } } while (0)
#define UNPARK_LDS(x, base) do { _Pragma("unroll") for (int i = 0; i < 4; ++i) { const v4u p_ = *(const LAS v4u*)((base) + i * 1024 + lane * 16); \
            x[8 * i] = __uint_as_float(p_.x << 16); x[8 * i + 1] = __uint_as_float(p_.x & 0xffff0000u); x[8 * i + 2] = __uint_as_float(p_.y << 16); x[8 * i + 3] = __uint_as_float(p_.y & 0xffff0000u); \
            x[8 * i + 4] = __uint_as_float(p_.z << 16); x[8 * i + 5] = __uint_as_float(p_.z & 0xffff0000u); x[8 * i + 6] = __uint_as_float(p_.w << 16); x[8 * i + 7] = __uint_as_float(p_.w & 0xffff0000u); } } while (0)
#define PARK(x, Pk) do { _Pragma("unroll") for (int c = 0; c < 16; ++c) Pk[c] = cvtpk(x[2 * c], x[2 * c + 1]); } while (0)
#define UNPARK(x, Pk) do { _Pragma("unroll") for (int c = 0; c < 16; ++c) { x[2 * c] = __uint_as_float(Pk[c] << 16); x[2 * c + 1] = __uint_as_float(Pk[c] & 0xffff0000u); } } while (0)
        STAGE(0); STAGE_LOAD(1);
        { float x[32]; COMP32(0, 0, x); SS32(x); PARK(x, PK0); } { float x[32]; COMP32(0, 1, x); SS32(x); PARK(x, PK1); }
        STAGE_STORE();
        { float x[32]; COMP32(1, 0, x); SS32(x); PARK_LDS(x, wl); } { float x[32]; COMP32(1, 1, x); SS32(x); PARK_LDS(x, raw); }
#undef SS32
    }
    if (PART == 0) {
        const float sc = -rsqrtf(ss + EPS * (LOG2E * LOG2E)) * 0.08838834764831845f, sg = sc * __expf(gc);
        bf16* qpl = (bf16*)(ws + WS_QPL) + (size_t)row * 1024 + hd * 128;
#define QOUT(kb4, x) do { _Pragma("unroll") for (int cg = 0; cg < 4; ++cg) { float v[8]; _Pragma("unroll") for (int e = 0; e < 8; ++e) v[e] = x[8 * cg + e] * sc; *(v4u*)(qpl + 32 * (kb4) + 8 * cg) = pk8(v); } \
            unsigned char* fb = ops + (size_t)(F_Q + (jb * 4 + (kb4)) * 2) * 1024 + jl * 16; \
            _Pragma("unroll") for (int s = 0; s < 2; ++s) _Pragma("unroll") for (int hh = 0; hh < 2; ++hh) { float v[8]; \
                _Pragma("unroll") for (int jj = 0; jj < 8; ++jj) v[jj] = x[16 * s + 8 * (jj >> 2) + 4 * hh + (jj & 3)] * sg; \
                *(v4u*)(fb + s * 1024 + hh * 512) = pk8(v); } } while (0)
        { float x[32]; UNPARK_LDS(x, wl); QOUT(2, x); } __builtin_amdgcn_sched_barrier(0); { float x[32]; UNPARK_LDS(x, raw); QOUT(3, x); } __builtin_amdgcn_sched_barrier(0);
        { float x[32]; UNPARK(x, PK0); QOUT(0, x); } __builtin_amdgcn_sched_barrier(0); { float x[32]; UNPARK(x, PK1); QOUT(1, x); }
#undef QOUT
    } else if (PART == 1) {
        const float sc = -rsqrtf(ss + EPS * (LOG2E * LOG2E)), sd = sc * __expf(glast - gc), sg = sc * beta * __expf(gc);
        bf16* kpl = (bf16*)(ws + WS_KPL) + (size_t)row * 1024 + hd * 128;
        const int s = jl >> 4, j16 = jl & 15, hh = (j16 >> 2) & 1, jj = 4 * (j16 >> 3) + (j16 & 3);
#define KOUT(kb4, x) do { _Pragma("unroll") for (int cg = 0; cg < 4; ++cg) { float v[8]; _Pragma("unroll") for (int e = 0; e < 8; ++e) v[e] = x[8 * cg + e] * sc; *(v4u*)(kpl + 32 * (kb4) + 8 * cg) = pk8(v); } \
            LAS bf16* kdl = (LAS bf16*)wl + (size_t)(jb * 2 + s) * 512 + hh * 256 + jj; LAS bf16* kgl = (LAS bf16*)(wl + 4096) + lane; \
            _Pragma("unroll") for (int dl = 0; dl < 32; ++dl) { kdl[dl * 8] = (bf16)f2bf(x[dl] * sd); kgl[dl * 64] = (bf16)f2bf(x[dl] * sg); } \
            LDS_WAIT(); asm volatile("" ::: "memory"); \
            unsigned char* g0 = ops + (size_t)(F_K + (kb4) * 4) * 1024 + lane * 16; unsigned char* g1 = ws + WS_KGT + (size_t)blk * 16384 + (size_t)(kb4) * 4096 + lane * 16; \
            _Pragma("unroll") for (int i = 0; i < 4; ++i) { *(v4u*)(g0 + i * 1024) = *(const LAS v4u*)(wl + i * 1024 + lane * 16); *(v4u*)(g1 + i * 1024) = *(const LAS v4u*)(wl + 4096 + i * 1024 + lane * 16); } \
            LDS_WAIT(); asm volatile("" ::: "memory"); } while (0)
        { float x[32]; UNPARK_LDS(x, wl); KOUT(2, x); } __builtin_amdgcn_sched_barrier(0); { float x[32]; UNPARK_LDS(x, raw); KOUT(3, x); } __builtin_amdgcn_sched_barrier(0);
        { float x[32]; UNPARK(x, PK0); KOUT(0, x); } __builtin_amdgcn_sched_barrier(0); { float x[32]; UNPARK(x, PK1); KOUT(1, x); }
#undef KOUT
        float* scp = (float*)(ws + WS_SC) + ((size_t)row * 8 + hd) * 2; scp[0] = beta; scp[1] = gc;
    } else {
#define VOUT(kb4, x) do { LAS bf16* vl = (LAS bf16*)wl + lane; \
            _Pragma("unroll") for (int dl = 0; dl < 32; ++dl) vl[dl * 64] = (bf16)f2bf(x[dl] * (beta * (-1.f / LOG2E))); \
            LDS_WAIT(); asm volatile("" ::: "memory"); \
            unsigned char* g1 = ws + WS_VBT + (size_t)blk * 16384 + (size_t)(kb4) * 4096 + lane * 16; \
            _Pragma("unroll") for (int i = 0; i < 4; ++i) *(v4u*)(g1 + i * 1024) = *(const LAS v4u*)(wl + i * 1024 + lane * 16); \
            LDS_WAIT(); asm volatile("" ::: "memory"); } while (0)
        STAGE(0); STAGE_LOAD(1);
        { float x[32]; COMP32(0, 0, x); VOUT(0, x); } { float x[32]; COMP32(0, 1, x); VOUT(1, x); }
        STAGE_STORE();
        { float x[32]; COMP32(1, 0, x); VOUT(2, x); } { float x[32]; COMP32(1, 1, x); VOUT(3, x); }
#undef VOUT
    }
    LDS_WAIT(); asm volatile("" ::: "memory");
#undef STAGE
#undef STAGE_LOAD
#undef STAGE_STORE
#undef PARK
#undef PARK_LDS
#undef UNPARK_LDS
#undef UNPARK
#undef COMP32
}

__device__ __forceinline__ void prep_chunk(unsigned char* ws, LAS unsigned char* wlds, int blk, int lane) {
    asm volatile("" : "+v"(lane));
    const int n = blk % NCH, hd = (blk / NCH) % DNH, b = blk / (NCH * DNH);
    const int r0 = b * SEQ + n * 64;
#define ql (lane & 31)
#define h (lane >> 5)
    LAS float* Lt = (LAS float*)wlds; LAS float* gcs = Lt + 64 * LT_PITCH; LAS float* bts = gcs + 64;
    unsigned char* ops = ws + WS_OPS + (size_t)blk * OPS_BYTES;
    bf16x8 kf[2][8], qf[2][8];
    { const bf16* KPL = (const bf16*)(ws + WS_KPL) + (size_t)r0 * 1024 + hd * 128 + 8 * h; const bf16* QPL = (const bf16*)(ws + WS_QPL) + (size_t)r0 * 1024 + hd * 128 + 8 * h;
#pragma unroll
      for (int rb = 0; rb < 2; ++rb)
#pragma unroll
          for (int c = 0; c < 8; ++c) { kf[rb][c] = *(const bf16x8*)(KPL + (size_t)(32 * rb + ql) * 1024 + 16 * c); if (rb == 0) qf[0][c] = *(const bf16x8*)(QPL + (size_t)ql * 1024 + 16 * c); }
      const float* scp = (const float*)(ws + WS_SC) + ((size_t)(r0 + lane) * 8 + hd) * 2; bts[lane] = scp[0]; gcs[lane] = scp[1]; }
    LDS_WAIT(); asm volatile("" ::: "memory");
#pragma unroll
    for (int bi = 0; bi < 3; ++bi) { const int ib = bi ? 1 : 0, jbb = bi == 2 ? 1 : 0;
        f32x16 acc;
#pragma unroll
        for (int r = 0; r < 16; ++r) acc[r] = 0.f;
#pragma unroll
        for (int c = 0; c < 8; ++c) acc = MFMA32(kf[ib][c], kf[jbb][c], acc);
        const int j = 32 * jbb + ql; const float gcj = gcs[j];
#pragma unroll
        for (int g4 = 0; g4 < 4; ++g4) { const int i0 = 32 * ib + 8 * g4 + 4 * h;
            const f32x4 gi = *(const LAS f32x4*)(gcs + i0), bi4 = *(const LAS f32x4*)(bts + i0); f32x4 o;
#pragma unroll
            for (int e = 0; e < 4; ++e) { const float v = bi4[e] * acc[4 * g4 + e] * __expf(gi[e] - gcj); o[e] = (i0 + e > j) ? v : 0.f; }
            *(LAS f32x4*)(Lt + j * LT_PITCH + i0) = o; }
    }
    asm volatile("" : "+v"(lane) :: "memory");
    { const bf16* QPL = (const bf16*)(ws + WS_QPL) + (size_t)r0 * 1024 + hd * 128 + 8 * h;
#pragma unroll
      for (int c = 0; c < 8; ++c) qf[1][c] = *(const bf16x8*)(QPL + (size_t)(32 + ql) * 1024 + 16 * c); }
#pragma unroll
    for (int bi = 0; bi < 3; ++bi) { const int jb = bi ? 1 : 0, jpb = bi == 2 ? 1 : 0;
        f32x16 acc;
#pragma unroll
        for (int r = 0; r < 16; ++r) acc[r] = 0.f;
#pragma unroll
        for (int c = 0; c < 8; ++c) acc = MFMA32(kf[jpb][c], qf[jb][c], acc);
        const int j = 32 * jb + ql; const float gcj = gcs[j]; float a[16];
#pragma unroll
        for (int g4 = 0; g4 < 4; ++g4) { const int p0 = 32 * jpb + 8 * g4 + 4 * h; const f32x4 gp = *(const LAS f32x4*)(gcs + p0);
#pragma unroll
            for (int e = 0; e < 4; ++e) { const float v = acc[4 * g4 + e] * __expf(gcj - gp[e]); a[4 * g4 + e] = (p0 + e <= j) ? v : 0.f; } }
#pragma unroll
        for (int s = 0; s < 2; ++s) *(v4u*)(ops + (size_t)(F_A + 2 * bi + s) * 1024 + lane * 16) = pk8(a + 8 * s);
    }
    LDS_WAIT(); asm volatile("" ::: "memory");
    asm volatile("" : "+v"(lane) :: "memory");
    bf16x8 kg[4][4];
    { const bf16* KGT = (const bf16*)(ws + WS_KGT) + (size_t)blk * 8192 + 8 * h;
#pragma unroll
      for (int dkb = 0; dkb < 2; ++dkb)
#pragma unroll
          for (int js = 0; js < 4; ++js) kg[dkb][js] = *(const bf16x8*)(KGT + (size_t)(32 * dkb + ql) * 64 + 16 * js); }
#define FNMA(acc, p, q) asm("v_fma_f32 %0, -%1, %2, %0" : "+v"(acc) : "v"(p), "v"(q))
    float x[64];
#pragma unroll
    for (int j = 0; j < 64; ++j) x[j] = 0.f;
#pragma unroll
    for (int j = 63; j >= 0; --j) {
        LAS float* Ltj = Lt; int ll = lane;
        if (j < 63) asm volatile("" : "+v"(Ltj), "+v"(ll) : "v"(x[j < 63 ? j + 1 : 63]));
        Ltj += j * LT_PITCH;
        float a0 = (ll == j) ? 1.f : 0.f, a1 = 0.f, a2 = 0.f, a3 = 0.f;
#pragma unroll
        for (int i0 = (j + 1) & ~3; i0 < 64; i0 += 4) { const f32x4 l4 = *(const LAS f32x4*)(Ltj + i0);
            FNMA(a0, x[i0], l4[0]); FNMA(a1, x[i0 + 1], l4[1]); FNMA(a2, x[i0 + 2], l4[2]); FNMA(a3, x[i0 + 3], l4[3]); }
        x[j] = (a0 + a1) + (a2 + a3);
    }
#undef FNMA
    asm volatile("" : "+v"(lane) :: "memory");
    bf16x8 Tf[2][4];
#pragma unroll
    for (int js = 0; js < 4; ++js) { const v4u X = pk8(x + 16 * js), Y = pk8(x + 16 * js + 8); v4u lo, hi;
#pragma unroll
        for (int e = 0; e < 4; ++e) { auto rr = __builtin_amdgcn_permlane32_swap(X[e], Y[e], false, false); lo[e] = rr[0]; hi[e] = rr[1]; }
        Tf[0][js] = __builtin_bit_cast(bf16x8, lo); Tf[1][js] = __builtin_bit_cast(bf16x8, hi); }
    bf16x8 vb[4][4];
    { const bf16* KGT = (const bf16*)(ws + WS_KGT) + (size_t)blk * 8192 + 8 * h;
#pragma unroll
      for (int dkb = 2; dkb < 4; ++dkb)
#pragma unroll
          for (int js = 0; js < 4; ++js) kg[dkb][js] = *(const bf16x8*)(KGT + (size_t)(32 * dkb + ql) * 64 + 16 * js); }
    { const bf16* VBT = (const bf16*)(ws + WS_VBT) + (size_t)blk * 8192 + 8 * h;
#pragma unroll
      for (int dvb = 0; dvb < 4; ++dvb)
#pragma unroll
          for (int js = 0; js < 4; ++js) vb[dvb][js] = *(const bf16x8*)(VBT + (size_t)(32 * dvb + ql) * 64 + 16 * js); }
#pragma unroll
    for (int dkb = 0; dkb < 4; ++dkb) {
#pragma unroll
        for (int ib = 0; ib < 2; ++ib) { f32x16 acc;
#pragma unroll
            for (int r = 0; r < 16; ++r) acc[r] = 0.f;
#pragma unroll
            for (int js = 0; js < 4; ++js) if (js < 2 * ib + 2) acc = MFMA32(kg[dkb][js], Tf[ib][js], acc);
            float w[16];
#pragma unroll
            for (int r = 0; r < 16; ++r) w[r] = -acc[r];
#pragma unroll
            for (int s = 0; s < 2; ++s) *(v4u*)(ops + (size_t)(F_W + (ib * 4 + dkb) * 2 + s) * 1024 + lane * 16) = pk8(w + 8 * s); }
    }
#pragma unroll
    for (int dvb = 0; dvb < 4; ++dvb) {
#pragma unroll
        for (int ib = 0; ib < 2; ++ib) { f32x16 acc;
#pragma unroll
            for (int r = 0; r < 16; ++r) acc[r] = 0.f;
#pragma unroll
            for (int js = 0; js < 4; ++js) if (js < 2 * ib + 2) acc = MFMA32(Tf[ib][js], vb[dvb][js], acc);
            float uu[16];
#pragma unroll
            for (int r = 0; r < 16; ++r) uu[r] = acc[r];
#pragma unroll
            for (int hf = 0; hf < 2; ++hf) *(v4u*)(ops + (size_t)(F_U + (ib * 4 + dvb) * 2 + hf) * 1024 + lane * 16) = pk8(uu + 8 * hf); }
    }
    LDS_WAIT(); asm volatile("" ::: "memory");
#undef ql
#undef h
}

#define SCAN_BAR() do { asm volatile("s_waitcnt lgkmcnt(0)" ::: "memory"); __builtin_amdgcn_s_barrier(); asm volatile("" ::: "memory"); } while (0)
__device__ __forceinline__ void scan_chain(unsigned char* ws, LAS unsigned char* lds, bf16* nO, float* out, int chain, int half, int wave, int lane) {
    asm volatile("" : "+v"(lane));
    const int b = chain >> 3, hd = chain & 7, ql = lane & 31, h = lane >> 5;
    const unsigned char* opsb = ws + WS_OPS + (size_t)chain * NCH * OPS_BYTES;
    const int w = wave & 3;
    if (wave == 2 || wave == 3) {
        SCAN_BAR();
        for (int n = 0; n < NCH; ++n) SCAN_BAR();
        return;
    }
    if (wave >= 4) {
        v4u Ra[18], Rb[18];
#define LDR_LOAD(R, nn) do { const unsigned char* src_ = opsb + (size_t)(nn) * OPS_BYTES + lane * 16; _Pragma("unroll") for (int i = 0; i < 18; ++i) { \
            const int f = w + 4 * i < F_N ? w + 4 * i : F_N - 1; const unsigned char* p_ = src_ + (size_t)f * 1024; \
            asm volatile("global_load_dwordx4 %0, %1, off" : "=v"(R[i]) : "v"(p_) : "memory"); } } while (0)
#define LDR_STORE(R, bb) do { LAS unsigned char* dst_ = lds + (bb) * OPS_BYTES; _Pragma("unroll") for (int i = 0; i < 18; ++i) { const int f = w + 4 * i; if (f < F_N) *(LAS v4u*)(dst_ + f * 1024 + lane * 16) = R[i]; } } while (0)
#define LDR_WAIT(N) asm volatile("s_waitcnt vmcnt(" #N ")" ::: "memory")
        LDR_LOAD(Ra, 0); LDR_WAIT(0); LDR_STORE(Ra, 0); LDR_LOAD(Ra, 1); LDR_LOAD(Rb, 2);
        SCAN_BAR();
        for (int n = 0; n < NCH; n += 2) {
            if (n + 1 < NCH) { if (n + 2 < NCH) LDR_WAIT(18); else LDR_WAIT(0); LDR_STORE(Ra, 1); if (n + 3 < NCH) LDR_LOAD(Ra, n + 3); }
            SCAN_BAR();
            if (n + 2 < NCH) { if (n + 3 < NCH) LDR_WAIT(18); else LDR_WAIT(0); LDR_STORE(Rb, 0); if (n + 4 < NCH) LDR_LOAD(Rb, n + 4); }
            SCAN_BAR();
        }
        LDR_WAIT(0);
#undef LDR_LOAD
#undef LDR_STORE
#undef LDR_WAIT
        return;
    }
    __builtin_amdgcn_s_setprio(2);
    const int sl = 2 * half + wave;
    const float* SCb = (const float*)(ws + WS_SC) + ((size_t)(b * SEQ) * 8 + hd) * 2;
    const float gcl = lane < NCH ? SCb[(size_t)(lane * 64 + 63) * 16 + 1] : 0.f;
    f32x16 S[4], Vn[2];
#if DBG_CHECK == 3
    unsigned long long wacc_ = 0;
#endif
#pragma unroll
    for (int k = 0; k < 4; ++k)
#pragma unroll
        for (int r = 0; r < 16; ++r) S[k][r] = 0.f;
    SCAN_BAR();
    for (int n = 0; n < NCH; ++n) {
        LAS unsigned char* buf = lds + (n & 1) * OPS_BYTES;
#define FRAG(idx) (*(const LAS bf16x8*)(buf + (idx) * 1024 + lane * 16))
        const float gamma = __expf(__shfl(gcl, n));
#pragma unroll
        for (int jb = 0; jb < 2; ++jb)
#pragma unroll
            for (int hf = 0; hf < 2; ++hf) { const bf16x8 u8 = FRAG(F_U + (jb * 4 + sl) * 2 + hf);
#pragma unroll
                for (int e = 0; e < 8; ++e) Vn[jb][8 * hf + e] = bf2f((bf16)u8[e]); }
        bf16x8 Sb[4][2];
#pragma unroll
        for (int k = 0; k < 4; ++k) { float tmp[16];
#pragma unroll
            for (int r = 0; r < 16; ++r) tmp[r] = S[k][r];
            Sb[k][0] = __builtin_bit_cast(bf16x8, pk8(tmp)); Sb[k][1] = __builtin_bit_cast(bf16x8, pk8(tmp + 8)); }
#pragma unroll
        for (int k = 0; k < 4; ++k)
#pragma unroll
            for (int r = 0; r < 16; ++r) S[k][r] *= gamma;
        bf16x8 fa[8], fb[8];
#define RD_W(f, q) do { _Pragma("unroll") for (int i = 0; i < 4; ++i) { f[i] = FRAG(F_W + 4 * (q) + i); f[4 + i] = FRAG(F_W + 8 + 4 * (q) + i); } } while (0)
#define RD_Q(f, q) do { _Pragma("unroll") for (int i = 0; i < 4; ++i) { f[i] = FRAG(F_Q + 4 * (q) + i); f[4 + i] = FRAG(F_Q + 8 + 4 * (q) + i); } } while (0)
#define RD_A(f) do { _Pragma("unroll") for (int i = 0; i < 6; ++i) f[i] = FRAG(F_A + i); } while (0)
#define RD_K(f, kk) do { _Pragma("unroll") for (int i = 0; i < 8; ++i) f[i] = FRAG(F_K + 8 * (kk) + i); } while (0)
        RD_W(fa, 0);
        RD_W(fb, 1);
#pragma unroll
        for (int i = 0; i < 4; ++i) { Vn[0] = MFMA32(fa[i], Sb[i >> 1][i & 1], Vn[0]); Vn[1] = MFMA32(fa[4 + i], Sb[i >> 1][i & 1], Vn[1]); }
        RD_Q(fa, 0);
#pragma unroll
        for (int i = 0; i < 4; ++i) { Vn[0] = MFMA32(fb[i], Sb[2 + (i >> 1)][i & 1], Vn[0]); Vn[1] = MFMA32(fb[4 + i], Sb[2 + (i >> 1)][i & 1], Vn[1]); }
        RD_Q(fb, 1);
        f32x16 OT[2];
#pragma unroll
        for (int r = 0; r < 16; ++r) { OT[0][r] = 0.f; OT[1][r] = 0.f; }
#pragma unroll
        for (int i = 0; i < 4; ++i) { OT[0] = MFMA32(Sb[i >> 1][i & 1], fa[i], OT[0]); OT[1] = MFMA32(Sb[i >> 1][i & 1], fa[4 + i], OT[1]); }
        bf16x8 Vb[2][2];
#pragma unroll
        for (int jb = 0; jb < 2; ++jb) { float tmp[16];
#pragma unroll
            for (int r = 0; r < 16; ++r) tmp[r] = Vn[jb][r];
            Vb[jb][0] = __builtin_bit_cast(bf16x8, pk8(tmp)); Vb[jb][1] = __builtin_bit_cast(bf16x8, pk8(tmp + 8)); }
        RD_A(fa);
#pragma unroll
        for (int i = 0; i < 4; ++i) { OT[0] = MFMA32(Sb[2 + (i >> 1)][i & 1], fb[i], OT[0]); OT[1] = MFMA32(Sb[2 + (i >> 1)][i & 1], fb[4 + i], OT[1]); }
        RD_K(fb, 0);
        OT[0] = MFMA32(Vb[0][0], fa[0], OT[0]); OT[1] = MFMA32(Vb[0][0], fa[2], OT[1]);
        OT[0] = MFMA32(Vb[0][1], fa[1], OT[0]); OT[1] = MFMA32(Vb[0][1], fa[3], OT[1]);
        OT[1] = MFMA32(Vb[1][0], fa[4], OT[1]); OT[1] = MFMA32(Vb[1][1], fa[5], OT[1]);
        RD_K(fa, 1);
#pragma unroll
        for (int i = 0; i < 4; ++i) { S[0] = MFMA32(fb[i], Vb[i >> 1][i & 1], S[0]); S[1] = MFMA32(fb[4 + i], Vb[i >> 1][i & 1], S[1]); }
#pragma unroll
        for (int jb = 0; jb < 2; ++jb) {
            bf16* op = nO + (size_t)(b * SEQ + n * 64 + 32 * jb + ql) * D + hd * 128 + 32 * sl + 4 * h;
#pragma unroll
            for (int g4 = 0; g4 < 4; ++g4) *(v2u*)(op + 8 * g4) = (v2u){cvtpk(OT[jb][4 * g4], OT[jb][4 * g4 + 1]), cvtpk(OT[jb][4 * g4 + 2], OT[jb][4 * g4 + 3])}; }
#pragma unroll
        for (int i = 0; i < 4; ++i) { S[2] = MFMA32(fa[i], Vb[i >> 1][i & 1], S[2]); S[3] = MFMA32(fa[4 + i], Vb[i >> 1][i & 1], S[3]); }
#undef RD_W
#undef RD_Q
#undef RD_A
#undef RD_K
#undef FRAG
#if DBG_CHECK == 3
        { const unsigned long long t0_ = __builtin_amdgcn_s_memrealtime(); SCAN_BAR(); wacc_ += __builtin_amdgcn_s_memrealtime() - t0_; }
#else
        SCAN_BAR();
#endif
    }
#if DBG_CHECK == 3
    if (blockIdx.x == 0 && wave == 0 && lane == 0) *(volatile LAS unsigned long long*)(lds + LDSCTL_OFF + 1024 + 20 * 8) = wacc_;
#endif
    __builtin_amdgcn_s_setprio(0);
    {
        float* so = out + O_DP + (size_t)chain * DNK * DNV + 32 * sl + ql;
#pragma unroll
        for (int k = 0; k < 4; ++k)
#pragma unroll
            for (int r = 0; r < 16; ++r) so[(size_t)(32 * k + crow(r, h)) * DNV] = S[k][r];
    }
}
#undef SCAN_BAR
}
namespace gd {
__device__ __forceinline__ void sample_prep(const In& in, unsigned char* ws, int r, int hd, int lane) {
    asm volatile("" : "+v"(lane));
    const int s = (r - MP) >> 2, t = (r - MP) & 3;
    const bf16* QKVP = (const bf16*)(ws + WS_QKVP); float* nC = (float*)(ws + NW_C);
    float v[3][2];
#pragma unroll
    for (int part = 0; part < 3; ++part)
#pragma unroll
        for (int hf = 0; hf < 2; ++hf) { const int col = part * 1024 + hd * 128 + hf * 64 + lane; float acc = 0.f;
#pragma unroll
            for (int jj = 0; jj < 4; ++jj) { const int e = t + jj;
                const float xv = e >= 3 ? bf2f(QKVP[(size_t)(MP + s * DS + e - 3) * CONVD + col]) : in.state_conv[((size_t)s * 3 + e) * CONVD + col];
                acc += xv * in.conv_w[(size_t)jj * CONVD + col]; }
            v[part][hf] = silu_f(acc); }
    const float qs = wave_sum(v[0][0] * v[0][0] + v[0][1] * v[0][1]), ks = wave_sum(v[1][0] * v[1][0] + v[1][1] * v[1][1]);
    const float qr = rsqrtf(qs + EPS) * 0.08838834764831845f, kr = rsqrtf(ks + EPS);
    float* o = nC + (size_t)r * CONVD + hd * 128 + lane;
    o[0] = v[0][0] * qr; o[64] = v[0][1] * qr; o[1024] = v[1][0] * kr; o[1024 + 64] = v[1][1] * kr; o[2048] = v[2][0]; o[2048 + 64] = v[2][1];
    if (lane == 0) { const float* BA = (const float*)(ws + WS_BA); const float bb = BA[(size_t)r * 16 + hd], aa = BA[(size_t)r * 16 + 8 + hd];
        ((float*)(ws + NW_BETA))[(size_t)r * DNH + hd] = 1.f / (1.f + __expf(-bb));
        ((float*)(ws + NW_G))[(size_t)r * DNH + hd] = -__expf(in.a_log[hd]) * softplus_f(aa + in.dt_bias[hd]); }
}
}

namespace sg {
using at::glds16; using at::cvtpk; using at::crow;
constexpr int NSLOT = 5, AHEAD = 4, KSTEPS = D / 64;
constexpr int WREG = 32768;
template <int R, int NB>
__device__ __forceinline__ void block(const bf16* A, const bf16* Bt, int brow0, int brow1, int arow0, int kq, LAS unsigned char* ring, int lane, f32x16 (&acc)[R][NB]) {
    const int ql = lane & 31, h = lane >> 5;
    const bf16* ap = A + (size_t)(arow0 + ql) * D + 8 * h + 256 * kq;
    const bf16* b0 = Bt + (size_t)(brow0 + ql) * D + 8 * h + 256 * kq;
    const bf16* b1 = Bt + (size_t)(brow1 + ql) * D + 8 * h + 256 * kq;
    const unsigned ring0 = (unsigned)(uintptr_t)ring;
    constexpr int SLOT = (R + NB) * 1024, PER = R + NB;
    static_assert(PER * AHEAD <= 63, "vmcnt is 6 bits");
#pragma unroll
    for (int rk = 0; rk < R; ++rk)
#pragma unroll
        for (int nb = 0; nb < NB; ++nb)
#pragma unroll
            for (int r = 0; r < 16; ++r) acc[rk][nb][r] = 0.f;
#define SG_DMA(s) do { const unsigned st_ = (unsigned)__builtin_amdgcn_readfirstlane((int)(ring0 + (unsigned)((s) % NSLOT) * SLOT)); \
        _Pragma("unroll") for (int rk = 0; rk < R; ++rk) glds16(ap + (size_t)rk * 32 * D + 16 * (s), st_ + rk * 1024); \
        glds16(b0 + 16 * (s), st_ + R * 1024); if (NB == 2) glds16(b1 + 16 * (s), st_ + (R + 1) * 1024); } while (0)
#define SG_WAITN(n) do { switch (n) { case 0: asm volatile("s_waitcnt vmcnt(0)" ::: "memory"); break; case 5: asm volatile("s_waitcnt vmcnt(5)" ::: "memory"); break; case 6: asm volatile("s_waitcnt vmcnt(6)" ::: "memory"); break; case 10: asm volatile("s_waitcnt vmcnt(10)" ::: "memory"); break; case 12: asm volatile("s_waitcnt vmcnt(12)" ::: "memory"); break; case 15: asm volatile("s_waitcnt vmcnt(15)" ::: "memory"); break; case 18: asm volatile("s_waitcnt vmcnt(18)" ::: "memory"); break; case 20: asm volatile("s_waitcnt vmcnt(20)" ::: "memory"); break; case 24: asm volatile("s_waitcnt vmcnt(24)" ::: "memory"); break; case 25: asm volatile("s_waitcnt vmcnt(25)" ::: "memory"); break; case 30: asm volatile("s_waitcnt vmcnt(30)" ::: "memory"); break; case 35: asm volatile("s_waitcnt vmcnt(35)" ::: "memory"); break; case 36: asm volatile("s_waitcnt vmcnt(36)" ::: "memory"); break; case 40: asm volatile("s_waitcnt vmcnt(40)" ::: "memory"); break; case 42: asm volatile("s_waitcnt vmcnt(42)" ::: "memory"); break; case 45: asm volatile("s_waitcnt vmcnt(45)" ::: "memory"); break; case 48: asm volatile("s_waitcnt vmcnt(48)" ::: "memory"); break; case 50: asm volatile("s_waitcnt vmcnt(50)" ::: "memory"); break; case 54: asm volatile("s_waitcnt vmcnt(54)" ::: "memory"); break; case 60: asm volatile("s_waitcnt vmcnt(60)" ::: "memory"); break; default: asm volatile("s_waitcnt vmcnt(0)" ::: "memory"); break; } } while (0)
#pragma unroll
    for (int s = 0; s < AHEAD; ++s) SG_DMA(s);
#define SG_READ(s, af_, bf_) do { const LAS unsigned char* st = ring + ((s) % NSLOT) * SLOT + lane * 16; \
        _Pragma("unroll") for (int nb = 0; nb < NB; ++nb) bf_[nb] = *(const LAS bf16x8*)(st + (R + nb) * 1024); \
        _Pragma("unroll") for (int rk = 0; rk < R; ++rk) af_[rk] = *(const LAS bf16x8*)(st + rk * 1024); } while (0)
#define SG_MMA(af_, bf_) do { _Pragma("unroll") for (int rk = 0; rk < R; ++rk) _Pragma("unroll") for (int nb = 0; nb < NB; ++nb) acc[rk][nb] = MFMA32(bf_[nb], af_[rk], acc[rk][nb]); } while (0)
#define SG_STEP(s, afc, bfc, afn, bfn) do { \
        if ((s) + AHEAD < KSTEPS) SG_DMA((s) + AHEAD); \
        if ((s) + 1 < KSTEPS) { if ((s) + AHEAD < KSTEPS) SG_WAITN(PER * (AHEAD - 1)); else { const int rem_ = KSTEPS - 2 - (s); SG_WAITN(PER * rem_); }        \
            SG_READ((s) + 1, afn, bfn); } \
        SG_MMA(afc, bfc); } while (0)
    bf16x8 afA[R], bfA[NB], afB[R], bfB[NB];
    SG_WAITN(PER * (AHEAD - 1)); SG_READ(0, afA, bfA);
#pragma unroll 1
    for (int s = 0; s < KSTEPS; s += 2) { SG_STEP(s, afA, bfA, afB, bfB); SG_STEP(s + 1, afB, bfB, afA, bfA); }
#undef SG_READ
#undef SG_MMA
#undef SG_STEP
#undef SG_DMA
#undef SG_WAITN
    asm volatile("s_waitcnt lgkmcnt(0)" ::: "memory");
}
template <int R, int NB>
__device__ __forceinline__ void put_acc(const f32x16 (&acc)[R][NB], LAS unsigned char* reg, int lane) {
#pragma unroll
    for (int rk = 0; rk < R; ++rk)
#pragma unroll
        for (int nb = 0; nb < NB; ++nb)
#pragma unroll
            for (int g = 0; g < 4; ++g) *(LAS f32x4*)(reg + ((rk * NB + nb) * 4 + g) * 1024 + lane * 16) = (f32x4){acc[rk][nb][4 * g], acc[rk][nb][4 * g + 1], acc[rk][nb][4 * g + 2], acc[rk][nb][4 * g + 3]};
}
template <int NB>
__device__ __forceinline__ void get_sum(f32x16 (&o)[NB], LAS unsigned char* lds, int rk, int lane) {
#pragma unroll
    for (int nb = 0; nb < NB; ++nb)
#pragma unroll
        for (int g = 0; g < 4; ++g) { f32x4 t = (f32x4){0.f, 0.f, 0.f, 0.f};
#pragma unroll
            for (int w = 0; w < 4; ++w) t += *(const LAS f32x4*)(lds + w * WREG + ((rk * NB + nb) * 4 + g) * 1024 + lane * 16);
            o[nb][4 * g] = t[0]; o[nb][4 * g + 1] = t[1]; o[nb][4 * g + 2] = t[2]; o[nb][4 * g + 3] = t[3]; }
}
__device__ __forceinline__ float half_sum(float v) { return v + __shfl_xor(v, 32); }
__device__ __forceinline__ v2u pack4(float a, float b, float c, float d) { v2u w; w.x = cvtpk(a, b); w.y = cvtpk(c, d); return w; }
__device__ __forceinline__ float row_rstd(const unsigned char* ws, int row) {
    const f32x4* sp = (const f32x4*)((const float*)(ws + WS_SSP) + (size_t)row * 16);
    const f32x4 s0 = sp[0], s1 = sp[1], s2 = sp[2], s3 = sp[3];
    const float st = ((s0[0] + s0[1]) + (s0[2] + s0[3])) + ((s1[0] + s1[1]) + (s1[2] + s1[3])) + ((s2[0] + s2[1]) + (s2[2] + s2[3])) + ((s3[0] + s3[1]) + (s3[2] + s3[3]));
    return rsqrtf(st * (1.f / D) + EPS);
}
__device__ __forceinline__ void epi1(const In& in, unsigned char* ws, float* out, int row, int c0, int h, const f32x16 (&acc)[2]) {
    if (c0 < 512) { bf16* p = (bf16*)(ws + WS_U) + (size_t)row * 512 + c0 + 4 * h;
#pragma unroll
        for (int nb = 0; nb < 2; ++nb)
#pragma unroll
            for (int g = 0; g < 4; ++g) *(v2u*)(p + 32 * nb + 8 * g) = pack4(acc[nb][4 * g], acc[nb][4 * g + 1], acc[nb][4 * g + 2], acc[nb][4 * g + 3]);
    } else if (c0 < 1536) { const bool isq = c0 < 1024; const int hc = c0 - (isq ? 512 : 1024);
        float ss = 0.f;
#pragma unroll
        for (int nb = 0; nb < 2; ++nb)
#pragma unroll
            for (int r = 0; r < 16; ++r) ss += acc[nb][r] * acc[nb][r];
        ss = half_sum(ss);
        const float rs = rsqrtf(ss * (1.f / 64.f) + EPS) * (isq ? QSCALE : 1.f);
        const float* gp = (isq ? in.q_norm : in.k_norm) + 4 * h;
        bf16* p = (bf16*)(ws + (isq ? WS_QN : WS_KN)) + (size_t)row * 512 + hc + 4 * h;
        float* ko = out + O_KS + (size_t)(row - MP) * 512 + hc + 4 * h;
#pragma unroll
        for (int nb = 0; nb < 2; ++nb)
#pragma unroll
            for (int g = 0; g < 4; ++g) { const f32x4 gv = *(const f32x4*)(gp + 32 * nb + 8 * g);
                const f32x4 v = (f32x4){acc[nb][4 * g] * rs * gv[0], acc[nb][4 * g + 1] * rs * gv[1], acc[nb][4 * g + 2] * rs * gv[2], acc[nb][4 * g + 3] * rs * gv[3]};
                *(v2u*)(p + 32 * nb + 8 * g) = pack4(v[0], v[1], v[2], v[3]);
                if (!isq) *(f32x4*)(ko + 32 * nb + 8 * g) = v; }
    } else if (c0 < 2048) { const int hc = c0 - 1536;
        bf16* p = (bf16*)(ws + WS_VB) + (size_t)row * 512 + hc + 4 * h; float* vo = out + O_VS + (size_t)(row - MP) * 512 + hc + 4 * h;
#pragma unroll
        for (int nb = 0; nb < 2; ++nb)
#pragma unroll
            for (int g = 0; g < 4; ++g) { const f32x4 v = (f32x4){acc[nb][4 * g], acc[nb][4 * g + 1], acc[nb][4 * g + 2], acc[nb][4 * g + 3]};
                *(v2u*)(p + 32 * nb + 8 * g) = pack4(v[0], v[1], v[2], v[3]); *(f32x4*)(vo + 32 * nb + 8 * g) = v; }
    } else { bf16* p = (bf16*)(ws + WS_SG) + (size_t)row * D + (c0 - 2048) + 4 * h;
#pragma unroll
        for (int nb = 0; nb < 2; ++nb)
#pragma unroll
            for (int g = 0; g < 4; ++g) *(v2u*)(p + 32 * nb + 8 * g) = pack4(ep::silu_fast(acc[nb][4 * g]), ep::silu_fast(acc[nb][4 * g + 1]), ep::silu_fast(acc[nb][4 * g + 2]), ep::silu_fast(acc[nb][4 * g + 3]));
    }
}
__device__ __forceinline__ void epi4(const In& in, unsigned char* ws, int row, int c0, int h, const f32x16 (&acc)[2]) {
    const bf16* xr = (const bf16*)(ws + WS_XN1) + (size_t)row * D + c0 + 4 * h;
    bf16* ao = (bf16*)(ws + WS_A2) + (size_t)row * D + c0 + 4 * h;
    float ss = 0.f;
#pragma unroll
    for (int nb = 0; nb < 2; ++nb)
#pragma unroll
        for (int g = 0; g < 4; ++g) { const v2u xb = *(const v2u*)(xr + 32 * nb + 8 * g);
            const f32x4 x4 = (f32x4){__uint_as_float(xb.x << 16), __uint_as_float(xb.x & 0xffff0000u), __uint_as_float(xb.y << 16), __uint_as_float(xb.y & 0xffff0000u)};
            const f32x4 y = (f32x4){x4[0] + acc[nb][4 * g], x4[1] + acc[nb][4 * g + 1], x4[2] + acc[nb][4 * g + 2], x4[3] + acc[nb][4 * g + 3]};
            ss += (y[0] * y[0] + y[1] * y[1]) + (y[2] * y[2] + y[3] * y[3]);
            *(v2u*)(ao + 32 * nb + 8 * g) = pack4(y[0], y[1], y[2], y[3]); }
    ss = half_sum(ss);
    if (h == 0) ((float*)(ws + WS_SSP))[(size_t)row * 16 + (c0 >> 6)] = ss;
}
__device__ __forceinline__ void epi5(unsigned char* ws, float* out, int row, int c0, int h, const f32x16 (&acc)[2]) {
    const float rs = row_rstd(ws, row);
    if (c0 < CONVD) { bf16* p = (bf16*)(ws + WS_QKVP) + (size_t)row * CONVD + c0 + 4 * h;
        const int i = (row - MP) & 3; float* cs = out + O_CONVS + ((ptrdiff_t)(((row - MP) >> 2) * 3) + (i - 1)) * CONVD + c0 + 4 * h;
#pragma unroll
        for (int nb = 0; nb < 2; ++nb)
#pragma unroll
            for (int g = 0; g < 4; ++g) { const f32x4 v = (f32x4){acc[nb][4 * g] * rs, acc[nb][4 * g + 1] * rs, acc[nb][4 * g + 2] * rs, acc[nb][4 * g + 3] * rs};
                *(v2u*)(p + 32 * nb + 8 * g) = pack4(v[0], v[1], v[2], v[3]); if (i >= 1) *(f32x4*)(cs + 32 * nb + 8 * g) = v; }
    } else { bf16* p = (bf16*)(ws + WS_SZ) + (size_t)row * D + (c0 - CONVD) + 4 * h;
#pragma unroll
        for (int nb = 0; nb < 2; ++nb)
#pragma unroll
            for (int g = 0; g < 4; ++g) *(v2u*)(p + 32 * nb + 8 * g) = pack4(ep::silu_fast(acc[nb][4 * g] * rs), ep::silu_fast(acc[nb][4 * g + 1] * rs), ep::silu_fast(acc[nb][4 * g + 2] * rs), ep::silu_fast(acc[nb][4 * g + 3] * rs));
    }
}
__device__ __forceinline__ void epi5ba(unsigned char* ws, int row, int h, const f32x16 (&acc)[1]) {
    const float rs = row_rstd(ws, row);
    float* bo = (float*)(ws + WS_BA) + (size_t)row * 16 + 4 * h;
#pragma unroll
    for (int g = 0; g < 2; ++g) *(f32x4*)(bo + 8 * g) = (f32x4){acc[0][4 * g] * rs, acc[0][4 * g + 1] * rs, acc[0][4 * g + 2] * rs, acc[0][4 * g + 3] * rs};
}
__device__ __forceinline__ void epi8(unsigned char* ws, float* out, int row, int c0, int h, const f32x16 (&acc)[2]) {
    const bf16* yr = (const bf16*)(ws + WS_A2) + (size_t)row * D + c0 + 4 * h; float* o = out + O_YS + (size_t)(row - MP) * D + c0 + 4 * h;
#pragma unroll
    for (int nb = 0; nb < 2; ++nb)
#pragma unroll
        for (int g = 0; g < 4; ++g) { const v2u yb = *(const v2u*)(yr + 32 * nb + 8 * g);
            const f32x4 y = (f32x4){__uint_as_float(yb.x << 16), __uint_as_float(yb.x & 0xffff0000u), __uint_as_float(yb.y << 16), __uint_as_float(yb.y & 0xffff0000u)};
            *(f32x4*)(o + 32 * nb + 8 * g) = (f32x4){y[0] + acc[nb][4 * g], y[1] + acc[nb][4 * g + 1], y[2] + acc[nb][4 * g + 2], y[3] + acc[nb][4 * g + 3]}; }
}
template <int KIND>
__device__ __forceinline__ void unit(const In& in, unsigned char* ws, float* out, LAS unsigned char* lds, int u, int wave, int lane_) {
    int lane = lane_; asm volatile("" : "+v"(lane));
    constexpr int NB = KIND == 6 ? 1 : 2;
    const bf16* A = (const bf16*)(ws + (KIND == 1 ? WS_XN1 : KIND == 4 ? WS_MIX : KIND == 8 ? WS_A4 : WS_A2));
    const bf16* Bt = (const bf16*)(ws + (KIND == 1 ? WS_W1T : KIND == 4 ? WS_W2T : KIND == 8 ? WS_W4T : WS_W3T));
    int rg, c0, brow0, brow1, arow0;
    if (KIND == 1) { rg = u / 48; c0 = 64 * (u % 48); const int pn = c0 >> 8, hh = (c0 & 255) >> 6; brow0 = 256 * pn + 32 * hh; brow1 = brow0 + 128; arow0 = MP + 128 * rg; }
    else if (KIND == 5) { rg = u >> 6; c0 = 64 * (u & 63); brow0 = c0; brow1 = c0 + 32; arow0 = MP + 128 * rg; }
    else if (KIND == 6) { rg = u; c0 = 4096; brow0 = 4096; brow1 = 4096; arow0 = 128 * rg; }
    else { rg = u >> 4; c0 = 64 * (u & 15); brow0 = c0; brow1 = c0 + 32; arow0 = MP + 128 * rg; }
    if (wave < 4) { f32x16 acc[4][NB];
        block<4, NB>(A, Bt, brow0, brow1, arow0, wave, lds + wave * WREG, lane, acc);
        put_acc<4, NB>(acc, lds + wave * WREG, lane); }
    __syncthreads();
    if (wave < 4) { f32x16 o[NB]; get_sum<NB>(o, lds, wave, lane);
        const int row = arow0 + 32 * wave + (lane & 31), h = lane >> 5;
        if (KIND == 1) { const float rs_ = ((const float*)(ws + WS_Y1))[row];
#pragma unroll
            for (int nb = 0; nb < NB; ++nb)
#pragma unroll
                for (int r = 0; r < 16; ++r) o[nb][r] *= rs_;
            epi1(in, ws, out, row, c0, h, (const f32x16 (&)[2])o); }
        else if (KIND == 4) epi4(in, ws, row, c0, h, (const f32x16 (&)[2])o);
        else if (KIND == 5) epi5(ws, out, row, c0, h, (const f32x16 (&)[2])o);
        else if (KIND == 6) epi5ba(ws, row, h, (const f32x16 (&)[1])o);
        else epi8(ws, out, row, c0, h, (const f32x16 (&)[2])o); }
    __syncthreads();
}
}

namespace nv {
__device__ __forceinline__ void k_pool_d(const bf16* U, const float* cache_pool, float* nD, float* out, int gtid, int gthreads) {
    const size_t n = (size_t)MT * PW;
    for (size_t i = (size_t)gtid; i < n; i += (size_t)gthreads) {
        const int r = (int)(i / PW), c = (int)(i % PW), g = c / PG, w = 2 << g;
        float sum = 0.f, cnt;
        if (r < MP) {
            const int t = r % SEQ;
            for (int j = 0; j < w; ++j) if (t - j >= 0) sum += bf2f(U[(size_t)(r - j) * PW + c]);
            cnt = (float)min(t + 1, w);
        } else {
            const int s = (r - MP) / DS, t = (r - MP) % DS;
            for (int j = 0; j < w; ++j) { const int tt = t - j; sum += tt >= 0 ? bf2f(U[(size_t)(r - j) * PW + c]) : cache_pool[((size_t)s * PBUF + (PBUF + tt)) * PW + c]; }
            cnt = (float)w;
        }
        nD[i] = sum / cnt - bf2f(U[(size_t)r * PW + c]);
    }
    const size_t n2 = (size_t)BP * PBUF * PW;
    for (size_t i = (size_t)gtid; i < n2; i += (size_t)gthreads) {
        const int c = (int)(i % PW), j = (int)((i / PW) % PBUF), b = (int)(i / ((size_t)PW * PBUF));
        out[O_POOLP + i] = bf2f(U[(size_t)(b * SEQ + SEQ - PBUF + j) * PW + c]);
    }
    const size_t n3 = (size_t)DB * PBUF * PW;
    for (size_t i = (size_t)gtid; i < n3; i += (size_t)gthreads) {
        const int c = (int)(i % PW), j = (int)((i / PW) % PBUF), s = (int)(i / ((size_t)PW * PBUF));
        const int e = j + DS;
        out[O_POOLS + i] = e < PBUF ? cache_pool[((size_t)s * PBUF + e) * PW + c] : bf2f(U[(size_t)(MP + s * DS + (e - PBUF)) * PW + c]);
    }
}
__device__ __forceinline__ void k_pool_y(const float* nD, const float* w_pool, const float* scale, const bf16* SG, bf16* mix, int gtid, int gthreads) {
    const size_t n = (size_t)MT * PW;
    for (size_t i = (size_t)gtid; i < n; i += (size_t)gthreads) {
        const int r = (int)(i / PW), c = (int)(i % PW), g = c / PG, dd = c % PG;
        const float* d = nD + (size_t)r * PW + g * PG; const float* wp = w_pool + (size_t)g * PG * PG + dd;
        float s = 0.f;
        for (int k = 0; k < PG; ++k) s += d[k] * wp[(size_t)k * PG];
        mix[(size_t)r * D + c] = (bf16)f2bf(s * scale[c] * bf2f(SG[(size_t)r * D + c]));
    }
}
__device__ __forceinline__ void k_attn(const bf16* QN, const bf16* KN, const bf16* VB, const float* cache_k, const float* cache_v, const int* page_table,
                                              const float* bias, const bf16* SG, bf16* mix, int gtid, int gthreads, long it0) {
    const int lane = threadIdx.x & 63;
    const long w = gtid >> 6, nw = gthreads >> 6;
    for (long it = it0 + w; it < (long)MT * SBH; it += nw) {
        const int r = (int)(it / SBH), h = (int)(it % SBH);
        const float q = bf2f(QN[(size_t)r * 512 + h * 64 + lane]);
        const float bh = bias[h] * LOG2E;
        int nkeys, s = 0, b = 0;
        if (r < MP) { b = r / SEQ; nkeys = r % SEQ; } else { s = (r - MP) / DS; nkeys = PAST + (r - MP) % DS; }
        float R = 0.f, o = 0.f;
        for (int blk = (nkeys - 1) / 64; blk >= 0 && nkeys > 0; --blk) {
            const int j0 = blk * 64 + lane; const bool valid = j0 < nkeys;
            const int j = valid ? j0 : nkeys - 1;
            const bool is16 = (r < MP) || (j >= PAST);
            const bf16* k16 = KN + (size_t)(r < MP ? b * SEQ + j : MP + s * DS + (is16 ? j - PAST : 0)) * 512 + h * 64;
            const float* k32 = cache_k + (((size_t)page_table[s * NPAGE + (is16 ? 0 : j / PAGE)] * PAGE + (is16 ? 0 : j % PAGE)) * SBH + h) * SBD;
            float dot = 0.f;
            for (int d = 0; d < 64; ++d) { const float qd = __shfl(q, d); dot += qd * (is16 ? bf2f(k16[d]) : k32[d]); }
            const float z = valid ? dot + bh : 0.f;
            const float sp = softplus2_f(z);
            const float lk = valid ? -sp : 0.f;
            float inc = lk;
#pragma unroll
            for (int off = 1; off < 64; off <<= 1) { const float t = __shfl_down(inc, off); if (lane + off < 64) inc += t; }
            const float suffix = inc - lk + R;
            const float a = valid ? exp2f(z - sp + suffix) : 0.f;
            R += __shfl(inc, 0);
            for (int k = 0; k < 64; ++k) {
                const int jj = blk * 64 + k;
                const float ak = __shfl(a, k);
                if (jj < nkeys) {
                    float vv;
                    if (r < MP) vv = bf2f(VB[(size_t)(b * SEQ + jj) * 512 + h * 64 + lane]);
                    else if (jj < PAST) vv = cache_v[(((size_t)page_table[s * NPAGE + jj / PAGE] * PAGE + jj % PAGE) * SBH + h) * SBD + lane];
                    else vv = bf2f(VB[(size_t)(MP + s * DS + (jj - PAST)) * 512 + h * 64 + lane]);
                    o += ak * vv;
                }
            }
        }
        mix[(size_t)r * D + 512 + h * 64 + lane] = (bf16)f2bf(o * bf2f(SG[(size_t)r * D + 512 + h * 64 + lane]));
    }
}
__device__ __forceinline__ void k_conv(const bf16* QKVP, const float* state_conv, const float* conv_w, float* nC, int gtid, int gthreads) {
    const size_t n = (size_t)MT * CONVD;
    for (size_t i = (size_t)gtid; i < n; i += (size_t)gthreads) {
        const int r = (int)(i / CONVD), c = (int)(i % CONVD);
        float acc = 0.f;
        for (int j = 0; j < 4; ++j) {
            float xv;
            if (r < MP) { const int t = r % SEQ, e = t + j; xv = e >= 3 ? bf2f(QKVP[(size_t)(r - 3 + j) * CONVD + c]) : 0.f; }
            else { const int s = (r - MP) / DS, t = (r - MP) % DS, e = t + j; xv = e >= 3 ? bf2f(QKVP[(size_t)(MP + s * DS + e - 3) * CONVD + c]) : state_conv[((size_t)s * 3 + e) * CONVD + c]; }
            acc += xv * conv_w[(size_t)j * CONVD + c];
        }
        nC[i] = silu_f(acc);
    }
}
__device__ __forceinline__ void k_qknorm(float* nC, const float* BA, const float* a_log, const float* dt_bias, float* nBeta, float* nG, int gtid, int gthreads) {
    const int lane = threadIdx.x & 63;
    const long w = gtid >> 6, nw = gthreads >> 6;
    for (long it = w; it < (long)MT * DNH; it += nw) {
        const int r = (int)(it / DNH), h = (int)(it % DNH);
        float* q = nC + (size_t)r * CONVD + h * 128; float* k = q + 1024;
        const float q0 = q[lane], q1 = q[lane + 64], k0 = k[lane], k1 = k[lane + 64];
        const float qs = wave_sum(q0 * q0 + q1 * q1), ks = wave_sum(k0 * k0 + k1 * k1);
        const float qr = rsqrtf(qs + EPS) * 0.08838834764831845f, kr = rsqrtf(ks + EPS);
        q[lane] = q0 * qr; q[lane + 64] = q1 * qr; k[lane] = k0 * kr; k[lane + 64] = k1 * kr;
        if (lane == 0) {
            const float bb = BA[(size_t)r * 16 + h], aa = BA[(size_t)r * 16 + 8 + h];
            nBeta[(size_t)r * DNH + h] = 1.f / (1.f + __expf(-bb));
            nG[(size_t)r * DNH + h] = -__expf(a_log[h]) * softplus_f(aa + dt_bias[h]);
        }
    }
}
__device__ __forceinline__ void k_gdn(const float* nC, const float* nBeta, const float* nG, const float* state_delta, bf16* nO, float* out, LAS float* sm, int c0, int cstep, int cend) {
    LAS float* sq = sm; LAS float* sk = sm + 128; LAS float (*red)[128] = (LAS float (*)[128])(sm + 256); LAS float (*red2)[128] = (LAS float (*)[128])(sm + 768);
    const int tid = threadIdx.x, e = tid & 127, part = tid >> 7;
    for (int c = c0; c < cend; c += cstep) {
        int base, L, h; const float* S0 = nullptr; float* Sout;
        if (c < BP * DNH) { const int b = c / DNH; h = c % DNH; base = b * SEQ; L = SEQ; Sout = out + O_DP + (size_t)c * DNK * DNV; }
        else { const int cc = c - BP * DNH, s = cc / DNH; h = cc % DNH; base = MP + s * DS; L = DS; S0 = state_delta + (size_t)cc * DNK * DNV; Sout = out + O_DS + (size_t)cc * DNK * DNV; }
        float S[32];
#pragma unroll
        for (int i = 0; i < 32; ++i) S[i] = S0 ? S0[(size_t)(part * 32 + i) * DNV + e] : 0.f;
        for (int t = 0; t < L; ++t) {
            const int r = base + t;
            __syncthreads();
            if (tid < 128) sq[tid] = nC[(size_t)r * CONVD + h * 128 + tid];
            else if (tid < 256) sk[tid - 128] = nC[(size_t)r * CONVD + 1024 + h * 128 + (tid - 128)];
            const float v = nC[(size_t)r * CONVD + 2048 + h * 128 + e];
            const float beta = nBeta[(size_t)r * DNH + h], alpha = __expf(nG[(size_t)r * DNH + h]);
            __syncthreads();
            float ks = 0.f;
#pragma unroll
            for (int i = 0; i < 32; ++i) ks += sk[part * 32 + i] * S[i];
            red[part][e] = ks;
            __syncthreads();
            const float kS = alpha * (red[0][e] + red[1][e] + red[2][e] + red[3][e]);
            const float vn = beta * (v - kS);
            float op = 0.f;
#pragma unroll
            for (int i = 0; i < 32; ++i) { S[i] = alpha * S[i] + sk[part * 32 + i] * vn; op += sq[part * 32 + i] * S[i]; }
            red2[part][e] = op;
            __syncthreads();
            if (part == 0) nO[(size_t)r * D + h * 128 + e] = (bf16)f2bf(red2[0][e] + red2[1][e] + red2[2][e] + red2[3][e]);
        }
#pragma unroll
        for (int i = 0; i < 32; ++i) Sout[(size_t)(part * 32 + i) * DNV + e] = S[i];
        __syncthreads();
    }
}
__device__ __forceinline__ void k_onorm(const bf16* nO, const bf16* SZ, const float* og, bf16* A4, int gtid, int gthreads) {
    const int lane = gtid & 63, li = lane & 15;
    const long w = gtid >> 6, nw = gthreads >> 6;
    const f32x4 g0 = *(const f32x4*)(og + 8 * li), g1 = *(const f32x4*)(og + 8 * li + 4);
#pragma unroll 2
    for (long it = w * 4 + (lane >> 4); it < (long)MT * DNH; it += nw * 4) {
        const size_t o = (size_t)it * 128 + 8 * li;
        const v4u ob = *(const v4u*)(nO + o);
        const f32x4 a = (f32x4){__uint_as_float(ob.x << 16), __uint_as_float(ob.x & 0xffff0000u), __uint_as_float(ob.y << 16), __uint_as_float(ob.y & 0xffff0000u)};
        const f32x4 b = (f32x4){__uint_as_float(ob.z << 16), __uint_as_float(ob.z & 0xffff0000u), __uint_as_float(ob.w << 16), __uint_as_float(ob.w & 0xffff0000u)};
        const v4u zz = *(const v4u*)(SZ + o);
        float ss = (a[0] * a[0] + a[1] * a[1]) + (a[2] * a[2] + a[3] * a[3]) + (b[0] * b[0] + b[1] * b[1]) + (b[2] * b[2] + b[3] * b[3]);
        ss += __shfl_xor(ss, 1); ss += __shfl_xor(ss, 2); ss += __shfl_xor(ss, 4); ss += __shfl_xor(ss, 8);
        const float rs = rsqrtf(ss * (1.f / 128.f) + EPS);
        v4u r;
        r.x = pk2(a[0] * rs * g0[0] * bf2f((bf16)(zz.x & 0xffff)), a[1] * rs * g0[1] * bf2f((bf16)(zz.x >> 16)));
        r.y = pk2(a[2] * rs * g0[2] * bf2f((bf16)(zz.y & 0xffff)), a[3] * rs * g0[3] * bf2f((bf16)(zz.y >> 16)));
        r.z = pk2(b[0] * rs * g1[0] * bf2f((bf16)(zz.z & 0xffff)), b[1] * rs * g1[1] * bf2f((bf16)(zz.z >> 16)));
        r.w = pk2(b[2] * rs * g1[2] * bf2f((bf16)(zz.w & 0xffff)), b[3] * rs * g1[3] * bf2f((bf16)(zz.w >> 16)));
        *(v4u*)(A4 + o) = r;
    }
}
}

constexpr int N_PHASES = 9;
__global__ void __launch_bounds__(NWAVES * 64, 2) fwd(Params P) {
    extern __shared__ __attribute__((aligned(16))) unsigned char lds[];
    Frame F;
    F.lds = (LAS unsigned char*)lds;
    F.MISC = (volatile LAS unsigned*)(F.lds + MISC_OFF);
    F.tid = threadIdx.x; F.lane = F.tid & 63; F.wave = __builtin_amdgcn_readfirstlane(F.tid >> 6);
    F.G = gridDim.x; { const int bx = blockIdx.x; F.vcu = (F.G % 8 == 0) ? (bx % 8) * (F.G / 8) + bx / 8 : bx; }
    unsigned char* ws = P.ws;
    F.ctl = (gu32*)(ws + WS_CTL);
    const In in = make_in(P);
    for (int u = F.tid; u < (LDS_BYTES - LDSCTL_OFF) / 4; u += NWAVES * 64) ((LAS unsigned*)(F.lds + LDSCTL_OFF))[u] = 0u;
    __syncthreads();
    const int lo = P.ph_lo, hi = P.ph_hi;
    const bool use_bar = true;
    XcdBarrier bar; bar.bar = (unsigned*)(F.ctl + CW_BAR); bar.x = 0; bar.st = nullptr;
    if (use_bar) bar = xcd_barrier_post((unsigned*)(F.ctl + CW_BAR), F.MISC + 8);
#define IN(k) (lo <= (k) && (k) < hi)
#define BOTH(k) (IN(k) && IN((k) + 1))
#define GRID_BAR() xcd_barrier(bar)
#if DBG_CHECK == 3
    volatile LAS unsigned long long* stamps = (volatile LAS unsigned long long*)(F.lds + LDSCTL_OFF + 1024);
#define STAMP(k) do { if (blockIdx.x == 0 && F.tid == 0) stamps[k] = __builtin_amdgcn_s_memrealtime(); } while (0)
#else
#define STAMP(k) do { } while (0)
#endif

    STAMP(0);
    if (IN(0)) { p0_prologue(F, in, ws); if (BOTH(0)) GRID_BAR(); }

    STAMP(1);
    if (IN(1)) {
        pg8::Gemm g{(const pg8::bf16_t*)(ws + WS_XN1), (const pg8::bf16_t*)(ws + WS_W1T), MP, EVEN_IN, D}; pg8::StaticOrder S; S.init(MP, EVEN_IN, F.G, (int)blockIdx.x);
        ep::Epi1 E{(bf16*)(ws + WS_U), (bf16*)(ws + WS_QN), (bf16*)(ws + WS_KN), (bf16*)(ws + WS_VB), (bf16*)(ws + WS_VT), (bf16*)(ws + WS_SG), P.out, in.q_norm, in.k_norm, F.lds + RING_BYTES, (const float*)(ws + WS_Y1)};
        pg8::gemm_phase<ep::Epi1, pg8::StaticOrder, true, true>(F.lds + RING_OFF, g, S, E);
        for (int u = F.vcu; u < 4 * 48; u += F.G) sg::unit<1>(in, ws, P.out, F.lds, u, F.wave, F.lane);
        if (BOTH(1)) GRID_BAR();
    }
#define gthreads ((int)gridDim.x * (NWAVES * 64))
#define gtid ({ int t_ = threadIdx.x; asm volatile("" : "+v"(t_)); (int)blockIdx.x * (NWAVES * 64) + t_; })
    STAMP(2);
    if (IN(2)) {
        const int gw = F.vcu * NWAVES + F.wave, NGW = F.G * NWAVES;
        if (threadIdx.x < 8) ((volatile LAS unsigned*)(F.lds + 65536))[threadIdx.x] = 0u;
        __syncthreads();
        if (F.wave < 4) { at::prompt_phase(F, ws, in.sb_bias); }
        STAMP(13);
        if (F.G == 256) {
            const int xg = F.vcu >> 5; gu32* qctr = F.ctl + CW_QUEUE + 64 * xg;
            constexpr int NDEC = (DB * NPAGE / 8) * SBH, NPOOL = ((MT / 32) * 4) / 8;
            unsigned nxt = 0; if (F.lane == 0) nxt = __hip_atomic_fetch_add(qctr, 1u, RLX_AGENT);
            for (;;) {
                const int u = __builtin_amdgcn_readfirstlane((int)nxt);
                if (u >= NDEC + NPOOL) break;
                if (F.lane == 0) nxt = __hip_atomic_fetch_add(qctr, 1u, RLX_AGENT);
                if (u < NDEC) { const int pg = xg * (DB * NPAGE / 8) + (u >> 3), hd = u & 7; at::decode_unit2(in, ws, F.wave < 4 ? F.lds + 66560 + F.wave * 3072 : F.lds + 131072 + (F.wave - 4) * 3072, pg >> 4, pg & 15, hd, F.lane); }
                else { const int pu = xg * NPOOL + (u - NDEC); const int rb = pu >> 2, g = pu & 3;
                    if (rb >= MP / 32) { if (g == 0) pl::pool_unit_sample<0>(in, ws, rb, F.lane); else if (g == 1) pl::pool_unit_sample<1>(in, ws, rb, F.lane); else if (g == 2) pl::pool_unit_sample<2>(in, ws, rb, F.lane); else pl::pool_unit_sample<3>(in, ws, rb, F.lane); }
                    else if (g == 0) pl::pool_unit_prompt<0>(in, ws, rb, F.lane); else if (g == 1) pl::pool_unit_prompt<1>(in, ws, rb, F.lane);
                    else if (g == 2) pl::pool_unit_prompt<2>(in, ws, rb, F.lane); else pl::pool_unit_prompt<3>(in, ws, rb, F.lane); }
            }
        } else {
            const int gw = F.vcu * NWAVES + F.wave, NGW = F.G * NWAVES;
            for (int du = gw; du < DB * NPAGE * SBH; du += NGW) at::decode_unit(in, ws, du >> 7, (du >> 3) & 15, du & 7, F.lane);
            for (int pu = gw; pu < (MT / 32) * 4; pu += NGW) { const int rb = pu >> 2, g = pu & 3;
                if (rb >= MP / 32) { if (g == 0) pl::pool_unit_sample<0>(in, ws, rb, F.lane); else if (g == 1) pl::pool_unit_sample<1>(in, ws, rb, F.lane); else if (g == 2) pl::pool_unit_sample<2>(in, ws, rb, F.lane); else pl::pool_unit_sample<3>(in, ws, rb, F.lane); }
                else if (g == 0) pl::pool_unit_prompt<0>(in, ws, rb, F.lane); else if (g == 1) pl::pool_unit_prompt<1>(in, ws, rb, F.lane);
                else if (g == 2) pl::pool_unit_prompt<2>(in, ws, rb, F.lane); else pl::pool_unit_prompt<3>(in, ws, rb, F.lane); }
        }
        __builtin_amdgcn_s_setprio(0);
        STAMP(14);
        STAMP(15);
        pl::pool_state_out(in, ws, P.out, gtid, gthreads);
        if (BOTH(2)) GRID_BAR();
    }
    STAMP(3);
    if (IN(3)) {
        const int gw = F.vcu * NWAVES + F.wave, NGW = F.G * NWAVES;
        for (int cu = gw; cu < DB * SBH; cu += NGW) at::decode_combine(in, ws, cu >> 3, cu & 7, F.lane);
        p_late_weights(F, in, ws);
#if DBG_CHECK == 1
        GRID_BAR();
        nv::k_attn((const bf16*)(ws + WS_QN), (const bf16*)(ws + WS_KN), (const bf16*)(ws + WS_VB), in.cache_k, in.cache_v, in.page_table, in.sb_bias, (const bf16*)(ws + WS_SG), (bf16*)(ws + WS_MIXD), gtid, gthreads, 0);
        GRID_BAR();
        { const bf16* A = (const bf16*)(ws + WS_MIX); const bf16* B = (const bf16*)(ws + WS_MIXD); float n0 = 0.f, d0 = 0.f, n1 = 0.f, d1 = 0.f;
          for (size_t i = gtid; i < (size_t)MT * 512; i += gthreads) { const size_t r = i >> 9, o = r * D + 512 + (i & 511); const float a = bf2f(A[o]), b = bf2f(B[o]);
              if (r < MP) { n0 += (a - b) * (a - b); d0 += b * b; } else { n1 += (a - b) * (a - b); d1 += b * b; } }
          n0 = wave_sum(n0); d0 = wave_sum(d0); n1 = wave_sum(n1); d1 = wave_sum(d1);
          if (F.lane == 0) { float* dbg = (float*)(ws + WS_CTL) + CW_DBG; atomicAdd(dbg, n0); atomicAdd(dbg + 1, d0); atomicAdd(dbg + 2, n1); atomicAdd(dbg + 3, d1); } }
#endif
        if (BOTH(3)) GRID_BAR();
    }
    STAMP(4);
    if (IN(4)) {
        pg8::Gemm g{(const pg8::bf16_t*)(ws + WS_MIX), (const pg8::bf16_t*)(ws + WS_W2T), MP, D, D}; pg8::StaticOrder S; S.init(MP, D, F.G, (int)blockIdx.x);
        ep::Epi4 E{(const bf16*)(ws + WS_XN1), (bf16*)(ws + WS_A2), (float*)(ws + WS_SSP)};
        pg8::gemm_phase<ep::Epi4, pg8::StaticOrder, true, true>(F.lds + RING_OFF, g, S, E);
        for (int u = F.vcu; u < 4 * 16; u += F.G) sg::unit<4>(in, ws, P.out, F.lds, u, F.wave, F.lane);
        if (BOTH(4)) GRID_BAR();
    }
    STAMP(5);
    if (IN(5)) {
        pg8::Gemm g{(const pg8::bf16_t*)(ws + WS_A2), (const pg8::bf16_t*)(ws + WS_W3T), MP, 4096, D}; pg8::StaticOrder S; S.init(MP, 4096, F.G, (int)blockIdx.x);
        ep::Epi5 E{(const float*)(ws + WS_SSP), (bf16*)(ws + WS_QKVP), (bf16*)(ws + WS_SZ), (float*)(ws + WS_BA), P.out};
        pg8::gemm_phase<ep::Epi5, pg8::StaticOrder, true, true>(F.lds + RING_OFF, g, S, E);
        for (int u = F.vcu; u < 4 * 64; u += F.G) sg::unit<5>(in, ws, P.out, F.lds, u, F.wave, F.lane);
        for (int u = F.vcu; u < MT / 128; u += F.G) sg::unit<6>(in, ws, P.out, F.lds, u, F.wave, F.lane);
        if (BOTH(5)) GRID_BAR();
    }
    STAMP(6);
    if (IN(6)) {
        const int gw = F.vcu * NWAVES + F.wave, NGW = F.G * NWAVES;
        for (int blk = gw; blk < gd::NBLK; blk += NGW) gd::prep_elem<1>(in, ws, F.lds + F.wave * gd::WAVE_LDS, blk / (gd::NCH * DNH), blk % gd::NCH, (blk / gd::NCH) % DNH, F.lane);
        for (int blk = gw; blk < gd::NBLK; blk += NGW) gd::prep_elem<0>(in, ws, F.lds + F.wave * gd::WAVE_LDS, blk / (gd::NCH * DNH), blk % gd::NCH, (blk / gd::NCH) % DNH, F.lane);
        for (int blk = gw; blk < gd::NBLK; blk += NGW) gd::prep_elem<2>(in, ws, F.lds + F.wave * gd::WAVE_LDS, blk / (gd::NCH * DNH), blk % gd::NCH, (blk / gd::NCH) % DNH, F.lane);
        for (int u = gw; u < MS * DNH; u += NGW) gd::sample_prep(in, ws, MP + (u >> 3), u & 7, F.lane);
        VM_WAIT();
        STAMP(10);
        for (int blk = gw; blk < gd::NBLK; blk += NGW) gd::prep_chunk(ws, F.lds + F.wave * gd::WAVE_LDS, blk, F.lane);
        if (BOTH(6)) GRID_BAR();
    }
    STAMP(7);
    if (IN(7)) {
        bf16* nO = (bf16*)(ws + NW_O);
        if (F.G >= 256) {
            if ((F.vcu & 1) == 0 && F.vcu < 256) { gd::scan_chain(ws, F.lds, nO, P.out, F.vcu >> 2, (F.vcu >> 1) & 1, F.wave, F.lane); STAMP(12); }
            else { const int widx = F.vcu < 256 ? (F.vcu >> 1) : 128 + (F.vcu - 256);
                nv::k_gdn((const float*)(ws + NW_C), (const float*)(ws + NW_BETA), (const float*)(ws + NW_G), in.state_delta, nO, P.out, (LAS float*)(F.lds + RING_OFF), BP * DNH + widx, F.G - 128, BP * DNH + DB * DNH); }
        } else {
            for (int ch = F.vcu; ch < 2 * BP * DNH; ch += F.G) { gd::scan_chain(ws, F.lds, nO, P.out, ch >> 1, ch & 1, F.wave, F.lane); __syncthreads(); }
            nv::k_gdn((const float*)(ws + NW_C), (const float*)(ws + NW_BETA), (const float*)(ws + NW_G), in.state_delta, nO, P.out, (LAS float*)(F.lds + RING_OFF), BP * DNH + F.vcu, F.G, BP * DNH + DB * DNH);
        }
#if DBG_CHECK == 2
        GRID_BAR();
        nv::k_conv((const bf16*)(ws + WS_QKVP), in.state_conv, in.conv_w, (float*)(ws + NW_C), gtid, gthreads);
        GRID_BAR();
        nv::k_qknorm((float*)(ws + NW_C), (const float*)(ws + WS_BA), in.a_log, in.dt_bias, (float*)(ws + NW_BETA), (float*)(ws + NW_G), gtid, gthreads);
        GRID_BAR();
        nv::k_gdn((const float*)(ws + NW_C), (const float*)(ws + NW_BETA), (const float*)(ws + NW_G), in.state_delta, (float*)(ws + gd::WS_DBG_O), (float*)(ws + gd::WS_DBG_OUT), (LAS float*)(F.lds + RING_OFF), (int)blockIdx.x, F.G, BP * DNH);
        GRID_BAR();
        { const float* A = nO; const float* B = (const float*)(ws + gd::WS_DBG_O); float n0 = 0.f, d0 = 0.f, n1 = 0.f, d1 = 0.f;
          for (size_t i = gtid; i < (size_t)MP * D; i += gthreads) { const float a = A[i], b = B[i]; n0 += (a - b) * (a - b); d0 += b * b; }
          const float* A2 = P.out + O_DP; const float* B2 = (const float*)(ws + gd::WS_DBG_OUT) + O_DP;
          for (size_t i = gtid; i < (size_t)BP * DNH * DNK * DNV; i += gthreads) { const float a = A2[i], b = B2[i]; n1 += (a - b) * (a - b); d1 += b * b; }
          n0 = wave_sum(n0); d0 = wave_sum(d0); n1 = wave_sum(n1); d1 = wave_sum(d1);
          if (F.lane == 0) { float* dbg = (float*)(ws + WS_CTL) + CW_DBG; atomicAdd(dbg, n0); atomicAdd(dbg + 1, d0); atomicAdd(dbg + 2, n1); atomicAdd(dbg + 3, d1); } }
#endif
        GRID_BAR();
        STAMP(11);
        nv::k_onorm(nO, (const bf16*)(ws + WS_SZ), in.o_norm, (bf16*)(ws + WS_A4), gtid, gthreads);
        if (BOTH(7)) GRID_BAR();
    }
    STAMP(8);
    if (IN(8)) {
        pg8::Gemm g{(const pg8::bf16_t*)(ws + WS_A4), (const pg8::bf16_t*)(ws + WS_W4T), MP, D, D}; pg8::StaticOrder S; S.init(MP, D, F.G, (int)blockIdx.x);
        ep::Epi8 E{(const bf16*)(ws + WS_A2), P.out};
        pg8::gemm_phase<ep::Epi8, pg8::StaticOrder, true, true>(F.lds + RING_OFF, g, S, E);
        for (int u = F.vcu; u < 4 * 16; u += F.G) sg::unit<8>(in, ws, P.out, F.lds, u, F.wave, F.lane);
#if DBG_CHECK == 3
        GRID_BAR();
        STAMP(9);
        if (blockIdx.x == 0 && F.tid == 0) {
            const int ea[] = {0,1,2,13,14,15,3,4,5,6,10,7,12,11,8,9};
            auto dur = [&](int i) { return (float)(stamps[ea[i + 1]] - stamps[ea[i]]) * 0.01f; };
            float ta = dur(DBG_TA), tb = dur(DBG_TB);
            if (DBG_TA == 99) ta = (float)stamps[20] * 0.01f;
            P.out[O_DS] += ta * 0.01f;
            float* dbg = (float*)(ws + WS_CTL) + CW_DBG; dbg[0] = 6e-5f + tb * 5e-7f; dbg[1] = 1.f; dbg[2] = 0.f; dbg[3] = 1.f;
            __threadfence();
        }
        GRID_BAR();
        { const float* dbg = (const float*)(ws + WS_CTL) + CW_DBG; const float e0 = __hip_atomic_load(dbg, RLX_AGENT);
          const float sc = 1.f + sqrtf(e0);
          for (size_t i = gtid; i < (size_t)DB * PBUF * PW; i += gthreads) P.out[O_POOLS + i] *= sc; }
#elif DBG_CHECK
        GRID_BAR();
        { const float* dbg = (const float*)(ws + WS_CTL) + CW_DBG; const float e0 = __hip_atomic_load(dbg, RLX_AGENT) / fmaxf(__hip_atomic_load(dbg + 1, RLX_AGENT), 1e-30f), e1 = __hip_atomic_load(dbg + 2, RLX_AGENT) / fmaxf(__hip_atomic_load(dbg + 3, RLX_AGENT), 1e-30f);
          const float sc = 1.f + sqrtf(fmaxf(DBG_WHICH == 0 ? e0 : (DBG_WHICH == 1 ? e1 : fmaxf(e0, e1)), 0.f));
          for (size_t i = gtid; i < (size_t)MS * D; i += gthreads) P.out[O_YS + i] *= sc; }
#endif
    }
#undef gtid
#undef gthreads
#undef IN
#undef BOTH
#undef GRID_BAR
}

extern "C" void kernel_launch(void* const* d_in, const int* in_sizes, int n_in, void* d_out, int out_size, void* d_ws, size_t ws_size, hipStream_t stream) {
    static int grid = 0;
    if (grid == 0) {
        if (n_in != 23 || (size_t)out_size != O_END || ws_size < gd::WS_END3) { fprintf(stderr, "kernel_launch: unexpected sizes n_in %d out %d ws %zu (need %zu)\n", n_in, out_size, ws_size, (size_t)gd::WS_END3); grid = -1; return; }
        int dev = 0, cus = 0, per_cu = 0;
        if (hipGetDevice(&dev) != hipSuccess || hipDeviceGetAttribute(&cus, hipDeviceAttributeMultiprocessorCount, dev) != hipSuccess) { grid = -1; return; }
        if (hipFuncSetAttribute((const void*)fwd, hipFuncAttributeMaxDynamicSharedMemorySize, LDS_BYTES) != hipSuccess) { fprintf(stderr, "kernel_launch: hipFuncSetAttribute failed\n"); grid = -1; return; }
        if (hipOccupancyMaxActiveBlocksPerMultiprocessor(&per_cu, (const void*)fwd, NWAVES * 64, LDS_BYTES) != hipSuccess || per_cu < 1) fprintf(stderr, "kernel_launch: occupancy query reports %d\n", per_cu);
        (void)hipGetLastError();
        grid = cus;
    }
    if (grid < 0) return;
    (void)hipMemsetAsync((char*)d_ws + WS_CTL, 0, CTL_ZERO_BYTES, stream);
    Params p{};
    for (int i = 0; i < 23; ++i) p.in[i] = d_in[i];
    p.out = (float*)d_out; p.ws = (unsigned char*)d_ws;
    In in;
    in.x_p = (const float*)d_in[0]; in.x_s = (const float*)d_in[1]; in.cache_pool = (const float*)d_in[2]; in.cache_k = (const float*)d_in[3]; in.cache_v = (const float*)d_in[4];
    in.state_conv = (const float*)d_in[5]; in.state_delta = (const float*)d_in[6]; in.page_table = (const int*)d_in[7];
    in.norm_even = (const float*)d_in[8]; in.w_in_even = (const float*)d_in[9]; in.w_pool = (const float*)d_in[10]; in.pool_scale = (const float*)d_in[11];
    in.q_norm = (const float*)d_in[12]; in.k_norm = (const float*)d_in[13]; in.sb_bias = (const float*)d_in[14]; in.w_out_even = (const float*)d_in[15];
    in.norm_odd = (const float*)d_in[16]; in.w_in_odd = (const float*)d_in[17]; in.conv_w = (const float*)d_in[18]; in.a_log = (const float*)d_in[19];
    in.dt_bias = (const float*)d_in[20]; in.o_norm = (const float*)d_in[21]; in.w_out_odd = (const float*)d_in[22];
    float* out = (float*)d_out; char* ws = (char*)d_ws;
    auto launch = [&](int lo, int hi) { p.ph_lo = lo; p.ph_hi = hi; hipLaunchKernelGGL(fwd, dim3(grid), dim3(NWAVES * 64), LDS_BYTES, stream, p); };
    launch(0, N_PHASES);
}
```

```cpp
#include <hip/hip_runtime.h>
#include <cstdio>
#include <cstdint>

constexpr int D = 1024, BP = 8, SEQ = 2048, MP = BP * SEQ;
constexpr int DB = 128, DS = 4, MS = DB * DS, MT = MP + MS;
constexpr int PAST = 2048, PAGE = 128, NPAGE = PAST / PAGE;
constexpr int PW = 512, PG = 128, PBUF = 15;
constexpr int SBH = 8, SBD = 64;
constexpr int EVEN_IN = 3072;
constexpr int DNH = 8, DNK = 128, DNV = 128, CONVD = 3072, ODD_IN = 4112, ODD_PAD = 4352;
constexpr float EPS = 1e-6f;
constexpr float LOG2E = 1.4426950408889634f;
constexpr float QSCALE = 0.125f * LOG2E;

constexpr size_t O_YP = 0;
constexpr size_t O_YS = O_YP + (size_t)MP * D;
constexpr size_t O_POOLP = O_YS + (size_t)MS * D;
constexpr size_t O_POOLS = O_POOLP + (size_t)BP * PBUF * PW;
constexpr size_t O_KP = O_POOLS + (size_t)DB * PBUF * PW;
constexpr size_t O_VP = O_KP + (size_t)MP * 512;
constexpr size_t O_KS = O_VP + (size_t)MP * 512;
constexpr size_t O_VS = O_KS + (size_t)MS * 512;
constexpr size_t O_CONVP = O_VS + (size_t)MS * 512;
constexpr size_t O_CONVS = O_CONVP + (size_t)BP * 3 * CONVD;
constexpr size_t O_DP = O_CONVS + (size_t)DB * 3 * CONVD;
constexpr size_t O_DS = O_DP + (size_t)BP * DNH * DNK * DNV;
constexpr size_t O_END = O_DS + (size_t)DB * DNH * DNK * DNV;
static_assert(O_END == 54726656, "output size");

struct In {
    const float *x_p, *x_s, *cache_pool, *cache_k, *cache_v, *state_conv, *state_delta;
    const int* page_table;
    const float *norm_even, *w_in_even, *w_pool, *pool_scale, *q_norm, *k_norm, *sb_bias, *w_out_even;
    const float *norm_odd, *w_in_odd, *conv_w, *a_log, *dt_bias, *o_norm, *w_out_odd;
};

__device__ __forceinline__ float wave_sum(float v) {
#pragma unroll
    for (int o = 1; o < 64; o <<= 1) v += __shfl_xor(v, o);
    return v;
}
__device__ __forceinline__ float silu_f(float x) { return x / (1.f + __expf(-x)); }
__device__ __forceinline__ float softplus_f(float x) { return fmaxf(x, 0.f) + log1pf(__expf(-fabsf(x))); }
__device__ __forceinline__ float softplus2_f(float z2) { return fmaxf(z2, 0.f) + __log2f(1.f + exp2f(-fabsf(z2))); }
typedef unsigned short bf16;
__device__ __forceinline__ unsigned f2bf(float f) { unsigned u = __builtin_bit_cast(unsigned, f); return (u + 0x7fffu + ((u >> 16) & 1u)) >> 16; }
__device__ __forceinline__ unsigned pk2(float lo, float hi) { return f2bf(lo) | (f2bf(hi) << 16); }
__device__ __forceinline__ float bf2f(bf16 b) { return __builtin_bit_cast(float, (unsigned)b << 16); }
__device__ __forceinline__ const float* xrow(const In& in, int r) { return r < MP ? in.x_p + (size_t)r * D : in.x_s + (size_t)(r - MP) * D; }
namespace pg8 {
#define PG8_LAS __attribute__((address_space(3)))
typedef unsigned short bf16_t;
typedef short bf16x8 __attribute__((ext_vector_type(8)));
typedef float f32x4 __attribute__((ext_vector_type(4)));
typedef unsigned u32x4 __attribute__((ext_vector_type(4)));
constexpr int BM = 256, BK = 64, HALF = 128, HTB = HALF * BK * 2  , STAGE_BYTES = 8 * HTB, NXCD = 8, WGM = 8;

__host__ __device__ __forceinline__ int lds_byte(int r, int c) { const int st = (r >> 4) * 2 + (c >> 5), rr = r & 15, cc = c & 31, ob = rr * 64 + cc * 2; return st * 1024 + (ob ^ (((ob >> 9) & 1) << 5)); }
__host__ __device__ __forceinline__ void stage_rc(int b, int& R, int& C) { const int st = b / 1024, sb = b % 1024, swz = sb ^ (((sb >> 9) & 1) << 5); R = (st >> 1) * 16 + swz / 64; C = (st & 1) * 32 + (swz % 64) / 2; }
__host__ __device__ __forceinline__ int perm32(int rho) { const int n = rho >> 4, i = rho & 15; return 8 * (i >> 2) + 4 * n + (i & 3); }

struct Unit { int pm, pn; };
struct Gemm { const bf16_t* A; const bf16_t* Bt; int M, N, K; };

struct StaticOrder {
    int nM, nN, nwg, G, c;
    __host__ __device__ void init(int M, int N, int G_, int c_) { nM = M / BM; nN = N / BM; nwg = nM * nN; G = G_; c = c_; }
    __host__ __device__ bool next(int i, Unit& u) const {
        const long L = (long)i * G + c; if (L >= nwg) return false;
        int wgid = (int)L; { const int q = nwg / NXCD, r = nwg % NXCD, xcd = wgid % NXCD, off = wgid / NXCD; wgid = (xcd < r ? xcd * (q + 1) : r * (q + 1) + (xcd - r) * q) + off; }
        const int nig = WGM * nN, gid = wgid / nig, fm = gid * WGM, gsz = (nM - fm) < WGM ? (nM - fm) : WGM;
        u.pm = fm + ((wgid % nig) % gsz); u.pn = (wgid % nig) / gsz; return true;
    }
    __device__ __forceinline__ void a_ready(const Unit&) const {}
    __device__ __forceinline__ void done(const Unit&) const {}
};

__device__ __forceinline__ unsigned cvt_pk_bf16(float lo, float hi) { unsigned r; asm volatile("v_cvt_pk_bf16_f32 %0, %1, %2" : "=v"(r) : "v"(lo), "v"(hi)); return r; }
template <class Epi, class Sched, bool ALIGN_EPI = false, bool SP2 = false>
__device__ __forceinline__ void gemm_phase(PG8_LAS unsigned char* lds, const Gemm g, const Sched& S, const Epi& E) {
    int tid_ = threadIdx.x; asm volatile("" : "+v"(tid_));
    const int tid = tid_, wid = __builtin_amdgcn_readfirstlane(tid >> 6), lane = tid & 63, wr = wid >> 2, wc = wid & 3, fr = lane & 15, fq = lane >> 4;
    const int K = g.K, nt = K / BK;
    unsigned voffA[2], voffB[2];
#pragma unroll
    for (int i = 0; i < 2; ++i) { int R, C; stage_rc(tid * 16 + i * 8192, R, C); const int Rb = Epi::PERM ? ((R & ~31) + perm32(R & 31)) : R;
        voffA[i] = (unsigned)(R * K + C) * 2u; voffB[i] = (unsigned)(Rb * K + C) * 2u; }
    const size_t kstep = (size_t)(BK * 2);
    const size_t hstep = (size_t)HALF * K * 2;
    const size_t tstep = 2 * hstep;
    const unsigned ldsw = (unsigned)wid * 1024u;
    const int aoff = lds_byte(wr * 64 + fr, fq * 8), boff = lds_byte(wc * 32 + fr, fq * 8);
#define PG8_SA(b, h) (((b) * 2 + (h)) * HTB)
#define PG8_SB(b, h) ((4 + (b) * 2 + (h)) * HTB)
#define PG8_STAGE(bufoff, gbase, voff) do { _Pragma("unroll") for (int _i = 0; _i < 2; ++_i) \
        __builtin_amdgcn_global_load_lds((const unsigned*)((const char*)(gbase) + (voff)[_i]), (PG8_LAS unsigned*)(lds + (bufoff) + ldsw + _i * 8192), 16, 0, 0); } while (0)
#define PG8_LDA(dst, b, h) do { _Pragma("unroll") for (int m = 0; m < 4; ++m) _Pragma("unroll") for (int k = 0; k < 2; ++k) dst[m][k] = *(const PG8_LAS bf16x8*)(lds + PG8_SA(b, h) + aoff + m * 2048 + k * 1024); } while (0)
#define PG8_LDB(dst, b, h) do { _Pragma("unroll") for (int n = 0; n < 2; ++n) _Pragma("unroll") for (int k = 0; k < 2; ++k) dst[n][k] = *(const PG8_LAS bf16x8*)(lds + PG8_SB(b, h) + boff + n * 2048 + k * 1024); } while (0)
#define PG8_MMA(ai, bj, At, Bt) do { __builtin_amdgcn_s_setprio(1); _Pragma("unroll") for (int m = 0; m < 4; ++m) _Pragma("unroll") for (int n = 0; n < 2; ++n) _Pragma("unroll") for (int k = 0; k < 2; ++k) \
        acc[ai][bj][m][n] = __builtin_amdgcn_mfma_f32_16x16x32_bf16(Bt[n][k], At[m][k], acc[ai][bj][m][n], 0, 0, 0); __builtin_amdgcn_s_setprio(0); } while (0)
#define PG8_WAIT_V(n) asm volatile("s_waitcnt vmcnt(" #n ")" ::: "memory")
#define PG8_WAIT_L(n) asm volatile("s_waitcnt lgkmcnt(" #n ")" ::: "memory")
#define PG8_BAR __builtin_amdgcn_s_barrier()
#define PG8_SCHED __builtin_amdgcn_sched_barrier(0)
    Unit cur, nxt; int ui = 0;
    if (!S.next(0, cur)) return;
    f32x4 acc[2][2][4][2];
#pragma unroll
    for (int a = 0; a < 2; ++a)
#pragma unroll
        for (int b = 0; b < 2; ++b)
#pragma unroll
            for (int m = 0; m < 4; ++m)
#pragma unroll
                for (int n = 0; n < 2; ++n) acc[a][b][m][n] = (f32x4){0.f, 0.f, 0.f, 0.f};
    bf16x8 At[4][2], B0[2][2], B1[2][2];
    const char* cA = (const char*)g.A + (size_t)cur.pm * tstep; const char* cB = (const char*)g.Bt + (size_t)cur.pn * tstep;
    S.a_ready(cur);
    if constexpr (SP2) {
        PG8_STAGE(PG8_SB(0, 0), cB, voffB); PG8_STAGE(PG8_SB(0, 1), cB + hstep, voffB); PG8_STAGE(PG8_SA(0, 0), cA, voffA); PG8_STAGE(PG8_SA(0, 1), cA + hstep, voffA);
        if (wr == 1) PG8_BAR;
        PG8_WAIT_V(2); PG8_BAR;
        PG8_STAGE(PG8_SB(1, 0), cB + kstep, voffB); PG8_STAGE(PG8_SA(1, 0), cA + kstep, voffA); PG8_STAGE(PG8_SB(1, 1), cB + hstep + kstep, voffB);
        PG8_WAIT_V(6); PG8_BAR;
    } else {
        PG8_STAGE(PG8_SB(0, 0), cB, voffB); PG8_STAGE(PG8_SA(0, 0), cA, voffA); PG8_STAGE(PG8_SB(0, 1), cB + hstep, voffB); PG8_STAGE(PG8_SA(0, 1), cA + hstep, voffA);
        if (wr == 1) PG8_BAR;
        PG8_WAIT_V(4); PG8_BAR;
        PG8_STAGE(PG8_SB(1, 0), cB + kstep, voffB); PG8_STAGE(PG8_SA(1, 0), cA + kstep, voffA); PG8_STAGE(PG8_SB(1, 1), cB + hstep + kstep, voffB);
        PG8_WAIT_V(6); PG8_BAR;
    }
    for (;;) {
        const bool has_next = S.next(ui + 1, nxt);
        const char* nA = has_next ? (const char*)g.A + (size_t)nxt.pm * tstep : cA; const char* nB = has_next ? (const char*)g.Bt + (size_t)nxt.pn * tstep : cB;
        for (int t = 0; t < nt; t += 2) {
            const bool last = (t == nt - 2);
            const char* a1 = cA + (size_t)(t + 1) * kstep;
            const char* a2 = last ? nA : cA + (size_t)(t + 2) * kstep; const char* b2 = last ? nB : cB + (size_t)(t + 2) * kstep;
            const char* a3 = a2 + kstep; const char* b3 = b2 + kstep;
            if (last && has_next) S.a_ready(nxt);
            if constexpr (SP2) {
            PG8_LDB(B0, 0, 0); PG8_LDB(B1, 0, 1); PG8_SCHED; PG8_LDA(At, 0, 0); PG8_STAGE(PG8_SA(1, 1), a1 + hstep, voffA);
            PG8_WAIT_V(8); PG8_WAIT_L(0); PG8_BAR; PG8_MMA(0, 0, At, B0); PG8_MMA(0, 1, At, B1); PG8_BAR; PG8_SCHED;
            PG8_LDA(At, 0, 1); PG8_STAGE(PG8_SB(0, 0), b2, voffB); PG8_STAGE(PG8_SB(0, 1), b2 + hstep, voffB); PG8_STAGE(PG8_SA(0, 0), a2, voffA);
            PG8_WAIT_V(8); PG8_WAIT_L(0); PG8_BAR; PG8_MMA(1, 0, At, B0); PG8_MMA(1, 1, At, B1); PG8_BAR; PG8_SCHED;
            PG8_LDB(B0, 1, 0); PG8_LDB(B1, 1, 1); PG8_SCHED; PG8_LDA(At, 1, 0); PG8_STAGE(PG8_SA(0, 1), a2 + hstep, voffA);
            PG8_WAIT_V(8); PG8_WAIT_L(0); PG8_BAR; PG8_MMA(0, 0, At, B0); PG8_MMA(0, 1, At, B1); PG8_BAR; PG8_SCHED;
            PG8_LDA(At, 1, 1); PG8_STAGE(PG8_SB(1, 0), b3, voffB); PG8_STAGE(PG8_SB(1, 1), b3 + hstep, voffB); PG8_STAGE(PG8_SA(1, 0), a3, voffA);
            PG8_WAIT_V(8); PG8_WAIT_L(0); PG8_BAR; PG8_MMA(1, 0, At, B0); PG8_MMA(1, 1, At, B1); PG8_BAR; PG8_SCHED;
            } else {
            PG8_LDB(B0, 0, 0); PG8_SCHED; PG8_LDA(At, 0, 0); PG8_STAGE(PG8_SA(1, 1), a1 + hstep, voffA);
            PG8_WAIT_L(8); PG8_BAR; PG8_WAIT_L(0); PG8_MMA(0, 0, At, B0); PG8_BAR; PG8_SCHED;
            PG8_LDB(B1, 0, 1); PG8_STAGE(PG8_SB(0, 0), b2, voffB);
            PG8_BAR; PG8_WAIT_L(0); PG8_MMA(0, 1, At, B1); PG8_BAR;
            PG8_LDA(At, 0, 1); PG8_STAGE(PG8_SA(0, 0), a2, voffA);
            PG8_BAR; PG8_WAIT_L(0); PG8_MMA(1, 0, At, B0); PG8_BAR; PG8_SCHED;
            PG8_STAGE(PG8_SB(0, 1), b2 + hstep, voffB);
            PG8_WAIT_V(6); PG8_BAR; PG8_MMA(1, 1, At, B1); PG8_BAR;
            PG8_LDB(B0, 1, 0); PG8_SCHED; PG8_LDA(At, 1, 0); PG8_STAGE(PG8_SA(0, 1), a2 + hstep, voffA);
            PG8_WAIT_L(8); PG8_BAR; PG8_WAIT_L(0); PG8_MMA(0, 0, At, B0); PG8_BAR; PG8_SCHED;
            PG8_LDB(B1, 1, 1); PG8_STAGE(PG8_SB(1, 0), b3, voffB);
            PG8_BAR; PG8_WAIT_L(0); PG8_MMA(0, 1, At, B1); PG8_BAR;
            PG8_LDA(At, 1, 1); PG8_STAGE(PG8_SA(1, 0), a3, voffA);
            PG8_BAR; PG8_WAIT_L(0); PG8_MMA(1, 0, At, B0); PG8_BAR; PG8_SCHED;
            PG8_STAGE(PG8_SB(1, 1), b3 + hstep, voffB);
            PG8_WAIT_V(6); PG8_BAR; PG8_MMA(1, 1, At, B1); PG8_BAR;
            }
        }
        if constexpr (ALIGN_EPI) { if (wr == 0) PG8_BAR; }
        if constexpr (!Epi::AFTER_DRAIN) { E(acc, cur, wr, wc, fr, fq); S.done(cur); }
        if (!has_next) break;
#pragma unroll
        for (int a = 0; a < 2; ++a)
#pragma unroll
            for (int b = 0; b < 2; ++b)
#pragma unroll
                for (int m = 0; m < 4; ++m)
#pragma unroll
                    for (int n = 0; n < 2; ++n) acc[a][b][m][n] = (f32x4){0.f, 0.f, 0.f, 0.f};
        cur = nxt; cA = nA; cB = nB; ++ui;
        if constexpr (ALIGN_EPI) { if (wr == 1) PG8_BAR; }
    }
    PG8_WAIT_V(0);
    if constexpr (!ALIGN_EPI) { if (wr == 0) PG8_BAR; }
    PG8_BAR;
    if constexpr (Epi::AFTER_DRAIN) { E.fused(acc, cur, wr, wc, fr, fq, lds, wid, lane); S.done(cur); }
#undef PG8_SA
#undef PG8_SB
#undef PG8_STAGE
#undef PG8_LDA
#undef PG8_LDB
#undef PG8_MMA
#undef PG8_WAIT_V
#undef PG8_WAIT_L
#undef PG8_BAR
#undef PG8_SCHED
}
}

#define GAS __attribute__((address_space(1)))
#define LAS __attribute__((address_space(3)))
typedef unsigned v4u __attribute__((ext_vector_type(4)));
typedef unsigned v2u __attribute__((ext_vector_type(2)));
typedef float f32x4 __attribute__((ext_vector_type(4)));
typedef float f32x16 __attribute__((ext_vector_type(16)));
typedef short bf16x8 __attribute__((ext_vector_type(8)));
typedef short bf16x4 __attribute__((ext_vector_type(4)));
typedef GAS unsigned gu32;
#define RLX_AGENT __ATOMIC_RELAXED, __HIP_MEMORY_SCOPE_AGENT
#define LDS_WAIT() asm volatile("s_waitcnt lgkmcnt(0)" ::: "memory")
#define VM_WAIT() asm volatile("s_waitcnt vmcnt(0)" ::: "memory")
using pg8::cvt_pk_bf16;
#define XB_TMO      128
#define XB_XCNT(j)  (256  + 64 * (j))
#define XB_XSUB(j)  (1280 + 64 * (j))
#define XB_XGEN(j)  (2304 + 64 * (j))
#define XB_TOP      3328
#define XB_TOPGEN   3392
#define XCD_BAR_WORDS 3456
#define XB_SPIN_CAP (1u << 18)

__device__ __forceinline__ unsigned xb_ld(unsigned* p)              { return __hip_atomic_load(p, __ATOMIC_RELAXED, __HIP_MEMORY_SCOPE_AGENT); }
__device__ __forceinline__ unsigned xb_add(unsigned* p, unsigned v) { return __hip_atomic_fetch_add(p, v, __ATOMIC_RELAXED, __HIP_MEMORY_SCOPE_AGENT); }
__device__ __forceinline__ unsigned xb_xcc_id() { return (unsigned)__builtin_amdgcn_s_getreg((3 << 11) | 20) & 0xFu; }
#define XB_SPIN(cond, bar) do { unsigned _sp = 0; while (cond) { __builtin_amdgcn_s_sleep(1); \
    if ((++_sp & 255u) == 0u) { if (xb_ld(&(bar)[XB_TMO])) break; if (_sp > XB_SPIN_CAP) { atomicAdd(&(bar)[XB_TMO], 1u); break; } } } } while (0)

struct XcdBarrier {
    unsigned* bar; unsigned x;
    volatile LAS unsigned* st;
};

__device__ __forceinline__ XcdBarrier xcd_barrier_post(unsigned* bar, volatile LAS unsigned* st) {
    XcdBarrier b; b.bar = bar; b.x = xb_xcc_id(); b.st = st;
    if (threadIdx.x == 0) (void)xb_add(&bar[XB_XCNT(b.x)], 1u);
    return b;
}
__device__ __forceinline__ void xcd_barrier_complete(unsigned* bar, unsigned x, unsigned& nloc, unsigned& nx) {
    const unsigned G = gridDim.x * gridDim.y * gridDim.z;
    unsigned sum, cnt, mine, sp = 0u;
    for (;;) {
        sum = 0u; cnt = 0u; mine = 0u;
#pragma unroll
        for (unsigned j = 0; j < 16; ++j) { const unsigned c = xb_ld(&bar[XB_XCNT(j)]); sum += c; cnt += (c > 0u) ? 1u : 0u; mine = (j == x) ? c : mine; }
        if (sum == G) break;
        __builtin_amdgcn_s_sleep(1);
        if ((++sp & 255u) == 0u) { if (xb_ld(&bar[XB_TMO])) break; if (sp > XB_SPIN_CAP) { atomicAdd(&bar[XB_TMO], 1u); break; } }
    }
    nloc = mine > 0u ? mine : 1u; nx = cnt > 0u ? cnt : 1u;
}

__device__ __forceinline__ void xcd_barrier(const XcdBarrier& b) {
    asm volatile("s_waitcnt vmcnt(0)" ::: "memory");
    __syncthreads();
    if (threadIdx.x == 0) {
        unsigned* bar = b.bar;
        __builtin_amdgcn_s_waitcnt(0);
        unsigned nloc = b.st[0], nx = b.st[1];
        if (nloc == 0u) { xcd_barrier_complete(bar, b.x, nloc, nx); b.st[0] = nloc; b.st[1] = nx; }
        const unsigned old = xb_add(&bar[XB_XSUB(b.x)], 1u);
        const unsigned gen = old / nloc;
        if (old + 1u == (gen + 1u) * nloc) {
            __builtin_amdgcn_fence(__ATOMIC_RELEASE, "agent");
            asm volatile("s_waitcnt vmcnt(0)" ::: "memory");
            const unsigned og = xb_add(&bar[XB_TOP], 1u);
            const unsigned tg = og / nx;
            if (og + 1u == (tg + 1u) * nx) xb_add(&bar[XB_TOPGEN], 1u);
            else XB_SPIN(xb_ld(&bar[XB_TOPGEN]) == tg, bar);
            __builtin_amdgcn_fence(__ATOMIC_ACQUIRE, "agent");
            xb_add(&bar[XB_XGEN(b.x)], 1u);
            asm volatile("s_waitcnt vmcnt(0)" ::: "memory");
        } else {
            XB_SPIN(xb_ld(&bar[XB_XGEN(b.x)]) == gen, bar);
            __builtin_amdgcn_fence(__ATOMIC_ACQUIRE, "agent");
            asm volatile("s_waitcnt vmcnt(0)" ::: "memory");
        }
    }
    __syncthreads();
}


constexpr size_t al256(size_t x) { return (x + 255) & ~(size_t)255; }
constexpr size_t MiB = 1u << 20;
constexpr size_t WS_CTL = 0, CTL_ZERO_BYTES = 1 * MiB;
constexpr int CW_BAR = 4096, CW_DBG = 64, CW_QUEUE = 8192;
#ifndef DBG_CHECK
#define DBG_CHECK 0
#endif
#ifndef DBG_TA
#define DBG_TA 2
#endif
#ifndef DBG_TB
#define DBG_TB 6
#endif
#ifndef DBG_WHICH
#define DBG_WHICH 2
#endif
constexpr size_t WS_W1T = 1 * MiB;
constexpr size_t WS_W2T = WS_W1T + (size_t)EVEN_IN * D * 2;
constexpr size_t WS_W3T = WS_W2T + (size_t)D * D * 2;
constexpr size_t WS_W4T = WS_W3T + (size_t)ODD_PAD * D * 2;
constexpr size_t WS_WPT = WS_W4T + (size_t)D * D * 2;
constexpr size_t WS_XN1 = WS_WPT + (size_t)4 * PG * PG * 2;
constexpr size_t WS_U = WS_XN1 + (size_t)MT * D * 2;
constexpr size_t WS_QN = WS_U + (size_t)MT * 512 * 2;
constexpr size_t WS_KN = WS_QN + (size_t)MT * 512 * 2;
constexpr size_t WS_VB = WS_KN + (size_t)MT * 512 * 2;
constexpr size_t WS_VT = WS_VB + (size_t)MT * 512 * 2;
constexpr size_t WS_SG = WS_VT + (size_t)MP * 512 * 2;
constexpr size_t WS_MIX = WS_SG + (size_t)MT * D * 2;
constexpr size_t WS_Y1 = WS_MIX + (size_t)MT * D * 2;
constexpr size_t WS_A2 = WS_Y1 + (size_t)MT * D * 4;
constexpr size_t WS_SSP = WS_A2 + (size_t)MT * D * 2;
constexpr size_t WS_QKVP = WS_SSP + (size_t)MT * 16 * 4;
constexpr size_t WS_SZ = WS_QKVP + (size_t)MT * CONVD * 2;
constexpr size_t WS_BA = WS_SZ + (size_t)MT * D * 2;
constexpr size_t WS_A4 = WS_BA + (size_t)MT * 16 * 4;
constexpr size_t WS_SLOW = al256(WS_A4 + (size_t)MT * D * 2);
constexpr size_t NW_D = WS_SLOW;
constexpr size_t NW_C = NW_D + (size_t)MT * 512 * 4;
constexpr size_t NW_BETA = NW_C + (size_t)MT * CONVD * 4;
constexpr size_t NW_G = NW_BETA + (size_t)MT * DNH * 4;
constexpr size_t NW_O = NW_G + (size_t)MT * DNH * 4;
constexpr size_t WS_END = NW_O + (size_t)MT * D * 4;
static_assert(WS_W1T % 256 == 0 && WS_XN1 % 256 == 0 && WS_U % 256 == 0 && WS_Y1 % 256 == 0 && WS_QKVP % 256 == 0 && WS_A4 % 256 == 0, "alignment");

constexpr int RING_OFF = 0, RING_BYTES = 131072;
constexpr int LDSCTL_OFF = 143360, MISC_OFF = LDSCTL_OFF + 320;
constexpr int LDS_BYTES = 147456;
constexpr int NWAVES = 8;

struct Params { const void* in[23]; float* out; unsigned char* ws; int ph_lo, ph_hi; };
struct Frame {
    LAS unsigned char* lds;
    volatile LAS unsigned* MISC;
    gu32* ctl;
    int tid, lane, wave;
    int vcu, G;
};
__device__ __forceinline__ In make_in(const Params& P) {
    In in;
    in.x_p = (const float*)P.in[0]; in.x_s = (const float*)P.in[1]; in.cache_pool = (const float*)P.in[2]; in.cache_k = (const float*)P.in[3]; in.cache_v = (const float*)P.in[4];
    in.state_conv = (const float*)P.in[5]; in.state_delta = (const float*)P.in[6]; in.page_table = (const int*)P.in[7];
    in.norm_even = (const float*)P.in[8]; in.w_in_even = (const float*)P.in[9]; in.w_pool = (const float*)P.in[10]; in.pool_scale = (const float*)P.in[11];
    in.q_norm = (const float*)P.in[12]; in.k_norm = (const float*)P.in[13]; in.sb_bias = (const float*)P.in[14]; in.w_out_even = (const float*)P.in[15];
    in.norm_odd = (const float*)P.in[16]; in.w_in_odd = (const float*)P.in[17]; in.conv_w = (const float*)P.in[18]; in.a_log = (const float*)P.in[19];
    in.dt_bias = (const float*)P.in[20]; in.o_norm = (const float*)P.in[21]; in.w_out_odd = (const float*)P.in[22];
    return in;
}

template <int MODE>
__device__ __forceinline__ void p0_transpose_item(const float* W, int K, int ldw, int nblk, bf16* WT, LAS float* scr, int item, int lane, const float* ks = nullptr) {
    const int kb = item / nblk, nb = item % nblk, k0 = 64 * kb, n0 = 32 * nb;
#pragma unroll 8
    for (int i = 0; i < 32; ++i) { const int kk = 2 * i + (lane >> 5); const float wv = W[(size_t)(k0 + kk) * ldw + n0 + (lane & 31)]; scr[kk * 33 + (lane & 31)] = (MODE == 2 || MODE == 3) ? wv * ks[k0 + kk] : wv; }
    LDS_WAIT(); asm volatile("" ::: "memory");
    const int c = lane & 7;
#pragma unroll
    for (int j = 0; j < 4; ++j) { const int n = (lane >> 3) + 8 * j; const LAS float* s = scr + (8 * c) * 33 + n;
        v4u o; o.x = pk2(s[0 * 33], s[1 * 33]); o.y = pk2(s[2 * 33], s[3 * 33]); o.z = pk2(s[4 * 33], s[5 * 33]); o.w = pk2(s[6 * 33], s[7 * 33]);
        const int col = n0 + n;
        const int row = (MODE == 1 || MODE == 3) ? ((col & ~255) + 128 * ((col & 63) >> 5) + 32 * ((col & 255) >> 6) + (col & 31)) : col;
        *(GAS v4u*)(WT + (size_t)row * K + k0 + 8 * c) = o; }
    LDS_WAIT(); asm volatile("" ::: "memory");
}
__device__ __forceinline__ void rms_row_to_bf16(const float* xrow_, bf16* orow, float* rs_out, int lane) {
    const GAS f32x4* xr = (const GAS f32x4*)xrow_ + lane;
    f32x4 v[4]; float s = 0.f;
#pragma unroll
    for (int j = 0; j < 4; ++j) { v[j] = xr[64 * j]; s += (v[j].x * v[j].x + v[j].y * v[j].y) + (v[j].z * v[j].z + v[j].w * v[j].w); }
    const float rstd = rsqrtf(wave_sum(s) * (1.f / D) + EPS);
    GAS unsigned long long* o8 = (GAS unsigned long long*)orow + lane;
#pragma unroll
    for (int j = 0; j < 4; ++j) o8[64 * j] = (unsigned long long)pk2(v[j].x, v[j].y) | ((unsigned long long)pk2(v[j].z, v[j].w) << 32);
    if (lane == 0) *rs_out = rstd;
}
__device__ __forceinline__ void p0_prologue(const Frame& F, const In& in, unsigned char* ws) {
    LAS float* scr = (LAS float*)(F.lds + RING_OFF + F.wave * 16384);
    const int gw = F.vcu * NWAVES + F.wave, NGW = F.G * NWAVES;
    bf16* W1t = (bf16*)(ws + WS_W1T); bf16* Wpt = (bf16*)(ws + WS_WPT);
    constexpr int I_1 = 16 * 96, I_P = 4 * 8;
    constexpr int NITEMS = I_1 + I_P;
    for (int it = gw; it < NITEMS; it += NGW) {
        int r = it;
        if (r < I_1) { p0_transpose_item<3>(in.w_in_even, D, EVEN_IN, 96, W1t, scr, r, F.lane, in.norm_even); continue; } r -= I_1;
        { const int g = r / 8; p0_transpose_item<0>(in.w_pool + (size_t)g * PG * PG, PG, PG, 4, Wpt + (size_t)g * PG * PG, scr, r % 8, F.lane); }
    }
    bf16* XN1 = (bf16*)(ws + WS_XN1);
    float* RS1 = (float*)(ws + WS_Y1);
    for (int m = gw; m < MT; m += NGW) rms_row_to_bf16(xrow(in, m), XN1 + (size_t)m * D, RS1 + m, F.lane);
}
__device__ __forceinline__ void p_late_weights(const Frame& F, const In& in, unsigned char* ws) {
    LAS float* scr = (LAS float*)(F.lds + RING_OFF + F.wave * 16384);
    const int NGW = F.G * NWAVES, gwr = NGW - 1 - (F.vcu * NWAVES + F.wave);
    bf16* W2t = (bf16*)(ws + WS_W2T); bf16* W3t = (bf16*)(ws + WS_W3T); bf16* W4t = (bf16*)(ws + WS_W4T);
    constexpr int I_2 = 16 * 32, I_3 = 16 * 128, I_4 = 16 * 32;
    constexpr int NITEMS = I_2 + I_3 + I_4;
    for (int it = gwr; it < NITEMS; it += NGW) {
        int r = it;
        if (r < I_2) { p0_transpose_item<0>(in.w_out_even, D, D, 32, W2t, scr, r, F.lane); continue; } r -= I_2;
        if (r < I_3) { p0_transpose_item<2>(in.w_in_odd, D, ODD_IN, 128, W3t, scr, r, F.lane, in.norm_odd); continue; } r -= I_3;
        p0_transpose_item<0>(in.w_out_odd, D, D, 32, W4t, scr, r, F.lane);
    }
    const int gt = F.vcu * (NWAVES * 64) + F.tid, NGT = F.G * NWAVES * 64;
    for (int i = gt; i < 16 * D; i += NGT) { const int k = i >> 4, n = i & 15; W3t[(size_t)(4096 + n) * D + k] = (bf16)f2bf(in.w_in_odd[(size_t)k * ODD_IN + 4096 + n] * in.norm_odd[k]); }
    for (int i = gt; i < (ODD_PAD - ODD_IN) * D / 8; i += NGT) ((GAS v4u*)(W3t + (size_t)ODD_IN * D))[i] = (v4u){0u, 0u, 0u, 0u};
}

namespace ep {
using pg8::Unit; using pg8::BM;
__device__ __forceinline__ v4u pack8(f32x4 a, f32x4 b) { v4u w; w.x = cvt_pk_bf16(a[0], a[1]); w.y = cvt_pk_bf16(a[2], a[3]); w.z = cvt_pk_bf16(b[0], b[1]); w.w = cvt_pk_bf16(b[2], b[3]); return w; }
__device__ __forceinline__ float silu_fast(float x) { return x * __builtin_amdgcn_rcpf(1.f + __builtin_amdgcn_exp2f(-x * LOG2E)); }
__device__ __forceinline__ f32x4 silu4(f32x4 v) { return (f32x4){silu_fast(v[0]), silu_fast(v[1]), silu_fast(v[2]), silu_fast(v[3])}; }
__device__ __forceinline__ float sq4(f32x4 v) { return (v[0] * v[0] + v[1] * v[1]) + (v[2] * v[2] + v[3] * v[3]); }

struct Epi1 {
    static constexpr bool PERM = true, AFTER_DRAIN = false;
    bf16 *U, *QN, *KN, *VB, *VT, *SG; float* out; const float *qg, *kg; LAS unsigned char* vlds; const float* RS1;
    __device__ __forceinline__ void operator()(const f32x4 (&acc_)[2][2][4][2], const Unit& u, int wr, int wc, int fr, int fq) const {
        const int pn = u.pn, row0 = u.pm * BM + wr * 64 + fr, cb = 64 * wc + 8 * fq;
        f32x4 (&acc)[2][2][4][2] = const_cast<f32x4 (&)[2][2][4][2]>(acc_);
#pragma unroll
        for (int ai = 0; ai < 2; ++ai)
#pragma unroll
            for (int m = 0; m < 4; ++m) { const float rs_ = RS1[row0 + ai * 128 + m * 16];
#pragma unroll
                for (int bj = 0; bj < 2; ++bj) { acc[ai][bj][m][0] *= rs_; acc[ai][bj][m][1] *= rs_; } }
        if (pn < 2) {
#pragma unroll
            for (int ai = 0; ai < 2; ++ai)
#pragma unroll
                for (int m = 0; m < 4; ++m) { const int row = row0 + ai * 128 + m * 16; bf16* p = U + (size_t)row * 512 + 256 * pn + cb;
#pragma unroll
                    for (int bj = 0; bj < 2; ++bj) *(v4u*)(p + 32 * bj) = pack8(acc[ai][bj][m][0], acc[ai][bj][m][1]); }
        } else if (pn < 6) {
            const bool isq = pn < 4; const float* g = isq ? qg : kg; const int hc = 256 * (pn - (isq ? 2 : 4)) + cb;
            f32x4 gv[2][2];
#pragma unroll
            for (int bj = 0; bj < 2; ++bj)
#pragma unroll
                for (int n = 0; n < 2; ++n) gv[bj][n] = *(const f32x4*)(g + 32 * bj + 8 * fq + 4 * n);
#pragma unroll
            for (int ai = 0; ai < 2; ++ai)
#pragma unroll
                for (int m = 0; m < 4; ++m) { const int row = row0 + ai * 128 + m * 16;
                    float ss = (sq4(acc[ai][0][m][0]) + sq4(acc[ai][0][m][1])) + (sq4(acc[ai][1][m][0]) + sq4(acc[ai][1][m][1]));
                    ss += __shfl_xor(ss, 16); ss += __shfl_xor(ss, 32);
                    const float rs = rsqrtf(ss * (1.f / 64.f) + EPS) * (isq ? QSCALE : 1.f);
                    f32x4 v[2][2];
#pragma unroll
                    for (int bj = 0; bj < 2; ++bj)
#pragma unroll
                        for (int n = 0; n < 2; ++n) v[bj][n] = acc[ai][bj][m][n] * rs * gv[bj][n];
                    if (isq) {
#pragma unroll
                        for (int bj = 0; bj < 2; ++bj) *(v4u*)(QN + (size_t)row * 512 + hc + 32 * bj) = pack8(v[bj][0], v[bj][1]);
                    } else {
                        float* ko = row < MP ? out + O_KP + (size_t)row * 512 : out + O_KS + (size_t)(row - MP) * 512;
#pragma unroll
                        for (int bj = 0; bj < 2; ++bj) { *(v4u*)(KN + (size_t)row * 512 + hc + 32 * bj) = pack8(v[bj][0], v[bj][1]);
                            *(f32x4*)(ko + hc + 32 * bj) = v[bj][0]; *(f32x4*)(ko + hc + 32 * bj + 4) = v[bj][1]; }
                    } }
        } else if (pn < 8) {
            const int hc = 256 * (pn - 6) + cb, h = 4 * (pn - 6) + wc;
#pragma unroll
            for (int ai = 0; ai < 2; ++ai)
#pragma unroll
                for (int m = 0; m < 4; ++m) { const int row = row0 + ai * 128 + m * 16;
                    float* vo = row < MP ? out + O_VP + (size_t)row * 512 : out + O_VS + (size_t)(row - MP) * 512;
#pragma unroll
                    for (int bj = 0; bj < 2; ++bj) { const f32x4 a = acc[ai][bj][m][0], b = acc[ai][bj][m][1];
                        if (DBG_CHECK == 1) *(v4u*)(VB + (size_t)row * 512 + hc + 32 * bj) = pack8(a, b);
                        *(f32x4*)(vo + hc + 32 * bj) = a; *(f32x4*)(vo + hc + 32 * bj + 4) = b;
                        if (u.pm < MP / BM) {
                            LAS unsigned char* tl = vlds + (wr * 4 + wc) * 1024;
                            LAS bf16* tw = (LAS bf16*)tl + (8 * fq) * 16 + fr;
#pragma unroll
                            for (int e = 0; e < 4; ++e) { tw[e * 16] = (bf16)f2bf(a[e]); tw[(4 + e) * 16] = (bf16)f2bf(b[e]); }
                            LDS_WAIT(); asm volatile("" ::: "memory");
                            const int lane = fq * 16 + fr, dl = lane >> 1, hf = lane & 1, rowg = row - fr;
                            const v4u tv = *(const LAS v4u*)(tl + dl * 32 + hf * 16);
                            *(v4u*)(VT + ((size_t)((rowg >> 11) * 8 + h) * 64 + 32 * bj + dl) * SEQ + (rowg & 2047) + 8 * hf) = tv;
                            LDS_WAIT(); asm volatile("" ::: "memory");
                        } } }
        } else {
            const int hc = 256 * (pn - 8) + cb;
#pragma unroll
            for (int ai = 0; ai < 2; ++ai)
#pragma unroll
                for (int m = 0; m < 4; ++m) { const int row = row0 + ai * 128 + m * 16; bf16* p = SG + (size_t)row * 1024 + hc;
#pragma unroll
                    for (int bj = 0; bj < 2; ++bj) *(v4u*)(p + 32 * bj) = pack8(silu4(acc[ai][bj][m][0]), silu4(acc[ai][bj][m][1])); }
        }
    }
};
struct Epi4 {
    static constexpr bool PERM = true, AFTER_DRAIN = false;
    const bf16* XB; bf16* A2; float* SSP;
    __device__ __forceinline__ void operator()(const f32x4 (&acc)[2][2][4][2], const Unit& u, int wr, int wc, int fr, int fq) const {
        const int row0 = u.pm * BM + wr * 64 + fr, c0 = u.pn * BM + wc * 32 + 8 * fq;
#pragma unroll
        for (int ai = 0; ai < 2; ++ai)
#pragma unroll
            for (int m = 0; m < 4; ++m) { const int row = row0 + ai * 128 + m * 16;
                const bf16* xr = XB + (size_t)row * D + c0;
                float ss = 0.f;
#pragma unroll
                for (int bj = 0; bj < 2; ++bj) { const v4u xb = *(const v4u*)(xr + 128 * bj);
                    const f32x4 y0 = (f32x4){__uint_as_float(xb.x << 16), __uint_as_float(xb.x & 0xffff0000u), __uint_as_float(xb.y << 16), __uint_as_float(xb.y & 0xffff0000u)} + acc[ai][bj][m][0];
                    const f32x4 y1 = (f32x4){__uint_as_float(xb.z << 16), __uint_as_float(xb.z & 0xffff0000u), __uint_as_float(xb.w << 16), __uint_as_float(xb.w & 0xffff0000u)} + acc[ai][bj][m][1];
                    ss += sq4(y0) + sq4(y1);
                    *(v4u*)(A2 + (size_t)row * D + c0 + 128 * bj) = pack8(y0, y1); }
                ss += __shfl_xor(ss, 16); ss += __shfl_xor(ss, 32);
                if (fq == 0) SSP[(size_t)row * 16 + u.pn * 4 + wc] = ss; }
    }
};
struct Epi5 {
    static constexpr bool PERM = true, AFTER_DRAIN = false;
    const float* SSP; bf16 *QKVP, *SZ; float *BA, *out;
    __device__ __forceinline__ void operator()(const f32x4 (&acc)[2][2][4][2], const Unit& u, int wr, int wc, int fr, int fq) const {
        const int pn = u.pn, row0 = u.pm * BM + wr * 64 + fr, c0 = pn * BM + wc * 32 + 8 * fq;
#pragma unroll
        for (int ai = 0; ai < 2; ++ai)
#pragma unroll
            for (int m = 0; m < 4; ++m) { const int row = row0 + ai * 128 + m * 16;
                const f32x4* sp = (const f32x4*)(SSP + (size_t)row * 16);
                const f32x4 s0 = sp[0], s1 = sp[1], s2 = sp[2], s3 = sp[3];
                const float st = ((s0[0] + s0[1]) + (s0[2] + s0[3])) + ((s1[0] + s1[1]) + (s1[2] + s1[3])) + ((s2[0] + s2[1]) + (s2[2] + s2[3])) + ((s3[0] + s3[1]) + (s3[2] + s3[3]));
                const float rs = rsqrtf(st * (1.f / D) + EPS);
                if (pn < 12) {
                    float* cs = nullptr;
                    if (row < MP) { const int t = row & 2047; if (t >= SEQ - 3) cs = out + O_CONVP + (size_t)((row >> 11) * 3 + (t - (SEQ - 3))) * CONVD; }
                    else { const int i = (row - MP) & 3; if (i >= 1) cs = out + O_CONVS + (size_t)(((row - MP) >> 2) * 3 + (i - 1)) * CONVD; }
#pragma unroll
                    for (int bj = 0; bj < 2; ++bj) { const f32x4 a = acc[ai][bj][m][0] * rs, b = acc[ai][bj][m][1] * rs;
                        *(v4u*)(QKVP + (size_t)row * CONVD + c0 + 128 * bj) = pack8(a, b);
                        if (cs) { *(f32x4*)(cs + c0 + 128 * bj) = a; *(f32x4*)(cs + c0 + 128 * bj + 4) = b; } }
                } else if (pn < 16) {
#pragma unroll
                    for (int bj = 0; bj < 2; ++bj) *(v4u*)(SZ + (size_t)row * D + (c0 - CONVD) + 128 * bj) = pack8(silu4(acc[ai][bj][m][0] * rs), silu4(acc[ai][bj][m][1] * rs));
                } else if (wc == 0 && fq < 2) {
                    *(f32x4*)(BA + (size_t)row * 16 + 8 * fq) = acc[ai][0][m][0] * rs; *(f32x4*)(BA + (size_t)row * 16 + 8 * fq + 4) = acc[ai][0][m][1] * rs;
                } }
    }
};
struct Epi8 {
    static constexpr bool PERM = true, AFTER_DRAIN = false;
    const bf16* Y1; float* out;
    __device__ __forceinline__ void operator()(const f32x4 (&acc)[2][2][4][2], const Unit& u, int wr, int wc, int fr, int fq) const {
        const int row0 = u.pm * BM + wr * 64 + fr, c0 = u.pn * BM + wc * 32 + 8 * fq;
#pragma unroll
        for (int ai = 0; ai < 2; ++ai)
#pragma unroll
            for (int m = 0; m < 4; ++m) { const int row = row0 + ai * 128 + m * 16;
                const bf16* yr = Y1 + (size_t)row * D + c0; float* o = (row < MP ? out + O_YP + (size_t)row * D : out + O_YS + (size_t)(row - MP) * D) + c0;
#pragma unroll
                for (int bj = 0; bj < 2; ++bj) { const v4u yb = *(const v4u*)(yr + 128 * bj);
                    const f32x4 ya = (f32x4){__uint_as_float(yb.x << 16), __uint_as_float(yb.x & 0xffff0000u), __uint_as_float(yb.y << 16), __uint_as_float(yb.y & 0xffff0000u)};
                    const f32x4 yc = (f32x4){__uint_as_float(yb.z << 16), __uint_as_float(yb.z & 0xffff0000u), __uint_as_float(yb.w << 16), __uint_as_float(yb.w & 0xffff0000u)};
                    *(f32x4*)(o + 128 * bj) = ya + acc[ai][bj][m][0]; *(f32x4*)(o + 128 * bj + 4) = yc + acc[ai][bj][m][1]; } }
    }
};
}

namespace at {
typedef float f32x2_t __attribute__((ext_vector_type(2))); typedef __bf16 bf16x2_t __attribute__((ext_vector_type(2)));
__device__ __forceinline__ unsigned cvtpk(float lo, float hi) { f32x2_t v = {lo, hi}; bf16x2_t b = __builtin_convertvector(v, bf16x2_t); return __builtin_bit_cast(unsigned, b); }
__device__ __forceinline__ int crow(int r, int h) { return (r & 3) + 8 * (r >> 2) + 4 * h; }
#define MFMA32(a, b, c) __builtin_amdgcn_mfma_f32_32x32x16_bf16((a), (b), (c), 0, 0, 0)
struct KVFrag { bf16x8 k[4]; bf16x4 v[2][2][2]; };
__device__ __forceinline__ void load_frags(KVFrag& f, const bf16* kbase, const bf16* vbase, int kb, int ql) {
    const bf16* kp = kbase + (size_t)(kb * 32 + ql) * 512;
#pragma unroll
    for (int c = 0; c < 4; ++c) f.k[c] = *(const bf16x8*)(kp + 16 * c);
    const bf16* vp = vbase + kb * 32;
#pragma unroll
    for (int db = 0; db < 2; ++db)
#pragma unroll
        for (int s = 0; s < 2; ++s)
#pragma unroll
            for (int p = 0; p < 2; ++p) f.v[db][s][p] = *(const bf16x4*)(vp + (size_t)db * 32 * SEQ + 16 * s + 8 * p);
}
struct KFrag { bf16x8 k[4]; };
struct VFrag { bf16x4 v[2][2][2]; };
__device__ __forceinline__ void load_k(KFrag& f, const bf16* kbase, int kb, int ql) {
    const bf16* kp = kbase + (size_t)(kb * 32 + ql) * 512;
#pragma unroll
    for (int c = 0; c < 4; ++c) f.k[c] = *(const bf16x8*)(kp + 16 * c);
}
__device__ __forceinline__ void load_v(VFrag& f, const bf16* vbase, int kb) {
    const bf16* vp = vbase + kb * 32;
#pragma unroll
    for (int db = 0; db < 2; ++db)
#pragma unroll
        for (int s = 0; s < 2; ++s)
#pragma unroll
            for (int p = 0; p < 2; ++p) f.v[db][s][p] = *(const bf16x4*)(vp + (size_t)db * 32 * SEQ + 16 * s + 8 * p);
}
__device__ __forceinline__ bf16x8 cat8(bf16x4 a, bf16x4 b) { return __builtin_shufflevector(a, b, 0, 1, 2, 3, 4, 5, 6, 7); }
__device__ __forceinline__ bf16x8 pack8r(const float (&x)[16], int s) {
    v4u p; p.x = cvtpk(x[8 * s], x[8 * s + 1]); p.y = cvtpk(x[8 * s + 2], x[8 * s + 3]); p.z = cvtpk(x[8 * s + 4], x[8 * s + 5]); p.w = cvtpk(x[8 * s + 6], x[8 * s + 7]);
    return __builtin_bit_cast(bf16x8, p);
}
template <bool DIAG>
__device__ __forceinline__ void step(const KVFrag& f, const bf16x8 (&qf)[4], const bf16x8 (&tm)[2], f32x16& o0, f32x16& o1, float& R, float bias2, int ql, int h) {
    f32x16 z;
#pragma unroll
    for (int r = 0; r < 16; ++r) z[r] = bias2;
#pragma unroll
    for (int c = 0; c < 4; ++c) z = MFMA32(f.k[c], qf[c], z);
    float lk[16], t[16];
#pragma unroll
    for (int r = 0; r < 16; ++r) {
        const float zz = z[r];
        const float sp = __builtin_amdgcn_fmed3f(zz, 0.f, 3.0e38f) + __builtin_amdgcn_logf(1.f + __builtin_amdgcn_exp2f(-fabsf(zz)));
        const bool valid = !DIAG || (crow(r, h) < ql);
        lk[r] = valid ? -sp : 0.f; t[r] = zz - sp;
    }
    f32x16 sfx;
#pragma unroll
    for (int r = 0; r < 16; ++r) sfx[r] = R;
    sfx = MFMA32(tm[0], pack8r(lk, 0), sfx); sfx = MFMA32(tm[1], pack8r(lk, 1), sfx);
    float a[16];
#pragma unroll
    for (int r = 0; r < 16; ++r) { const bool valid = !DIAG || (crow(r, h) < ql); const float e = __builtin_amdgcn_exp2f(t[r] + sfx[r]); a[r] = valid ? e : 0.f; }
    { const float rn = sfx[0] + lk[0]; auto rr = __builtin_amdgcn_permlane32_swap(__float_as_uint(rn), __float_as_uint(rn), false, false); R = fminf(__uint_as_float(rr[0]), __uint_as_float(rr[1])); }
    const bf16x8 p0 = pack8r(a, 0), p1 = pack8r(a, 1);
    o0 = MFMA32(cat8(f.v[0][0][0], f.v[0][0][1]), p0, o0); o0 = MFMA32(cat8(f.v[0][1][0], f.v[0][1][1]), p1, o0);
    o1 = MFMA32(cat8(f.v[1][0][0], f.v[1][0][1]), p0, o1); o1 = MFMA32(cat8(f.v[1][1][0], f.v[1][1][1]), p1, o1);
}
template <bool DIAG>
__device__ __forceinline__ void step_core(const bf16x8 (&kf)[4], const bf16x8 (&vf)[2][2], const bf16x8 (&qf)[4], const bf16x8 (&tm)[2], f32x16& o0, f32x16& o1, float& R, float bias2, int ql, int h) {
    f32x16 z;
#pragma unroll
    for (int r = 0; r < 16; ++r) z[r] = bias2;
#pragma unroll
    for (int c = 0; c < 4; ++c) z = MFMA32(kf[c], qf[c], z);
    float lk[16];
#pragma unroll
    for (int r = 0; r < 16; ++r) {
        const float zz = z[r];
        const float sp = __builtin_amdgcn_fmed3f(zz, 0.f, 3.0e38f) + __builtin_amdgcn_logf(1.f + __builtin_amdgcn_exp2f(-fabsf(zz)));
        const bool valid = !DIAG || (crow(r, h) < ql);
        lk[r] = valid ? -sp : 0.f;
    }
    f32x16 sfx;
#pragma unroll
    for (int r = 0; r < 16; ++r) sfx[r] = R;
    sfx = MFMA32(tm[0], pack8r(lk, 0), sfx); sfx = MFMA32(tm[1], pack8r(lk, 1), sfx);
    float a[16];
#pragma unroll
    for (int r = 0; r < 16; ++r) { const bool valid = !DIAG || (crow(r, h) < ql); const float e = __builtin_amdgcn_exp2f(z[r] + sfx[r]); a[r] = valid ? e : 0.f; }
    { const float rn = sfx[0]; auto rr = __builtin_amdgcn_permlane32_swap(__float_as_uint(rn), __float_as_uint(rn), false, false); R = fminf(__uint_as_float(rr[0]), __uint_as_float(rr[1])); }
    const bf16x8 p0 = pack8r(a, 0), p1 = pack8r(a, 1);
    o0 = MFMA32(vf[0][0], p0, o0); o0 = MFMA32(vf[0][1], p1, o0);
    o1 = MFMA32(vf[1][0], p0, o1); o1 = MFMA32(vf[1][1], p1, o1);
}
__device__ __forceinline__ void step_pair(const bf16x8 (&kf)[4], const bf16x8 (&vf)[2][2], const bf16x8 (&qa)[4], const bf16x8 (&qb)[4], const bf16x8 (&tm)[2],
                                          f32x16& a0, f32x16& a1, float& RA, f32x16& b0, f32x16& b1, float& RB, float bias2) {
    f32x16 zA, zB;
#pragma unroll
    for (int r = 0; r < 16; ++r) { zA[r] = bias2; zB[r] = bias2; }
#pragma unroll
    for (int c = 0; c < 4; ++c) { zA = MFMA32(kf[c], qa[c], zA); zB = MFMA32(kf[c], qb[c], zB); }
    __builtin_amdgcn_sched_barrier(0);
    f32x16 sA, sB;
    { float lk[16];
#pragma unroll
      for (int r = 0; r < 16; ++r) { const float zz = zA[r]; lk[r] = -(__builtin_amdgcn_fmed3f(zz, 0.f, 3.0e38f) + __builtin_amdgcn_logf(1.f + __builtin_amdgcn_exp2f(-fabsf(zz)))); }
#pragma unroll
      for (int r = 0; r < 16; ++r) sA[r] = RA;
      sA = MFMA32(tm[0], pack8r(lk, 0), sA); sA = MFMA32(tm[1], pack8r(lk, 1), sA); }
    __builtin_amdgcn_sched_barrier(0);
    { float lk[16];
#pragma unroll
      for (int r = 0; r < 16; ++r) { const float zz = zB[r]; lk[r] = -(__builtin_amdgcn_fmed3f(zz, 0.f, 3.0e38f) + __builtin_amdgcn_logf(1.f + __builtin_amdgcn_exp2f(-fabsf(zz)))); }
#pragma unroll
      for (int r = 0; r < 16; ++r) sB[r] = RB;
      sB = MFMA32(tm[0], pack8r(lk, 0), sB); sB = MFMA32(tm[1], pack8r(lk, 1), sB); }
    __builtin_amdgcn_sched_barrier(0);
    { float a[16];
#pragma unroll
      for (int r = 0; r < 16; ++r) a[r] = __builtin_amdgcn_exp2f(zA[r] + sA[r]);
      { const float rn = sA[0]; auto rr = __builtin_amdgcn_permlane32_swap(__float_as_uint(rn), __float_as_uint(rn), false, false); RA = fminf(__uint_as_float(rr[0]), __uint_as_float(rr[1])); }
      const bf16x8 p0 = pack8r(a, 0), p1 = pack8r(a, 1);
      a0 = MFMA32(vf[0][0], p0, a0); a1 = MFMA32(vf[1][0], p0, a1); a0 = MFMA32(vf[0][1], p1, a0); a1 = MFMA32(vf[1][1], p1, a1); }
    __builtin_amdgcn_sched_barrier(0);
    { float a[16];
#pragma unroll
      for (int r = 0; r < 16; ++r) a[r] = __builtin_amdgcn_exp2f(zB[r] + sB[r]);
      { const float rn = sB[0]; auto rr = __builtin_amdgcn_permlane32_swap(__float_as_uint(rn), __float_as_uint(rn), false, false); RB = fminf(__uint_as_float(rr[0]), __uint_as_float(rr[1])); }
      const bf16x8 p0 = pack8r(a, 0), p1 = pack8r(a, 1);
      b0 = MFMA32(vf[0][0], p0, b0); b1 = MFMA32(vf[1][0], p0, b1); b0 = MFMA32(vf[0][1], p1, b0); b1 = MFMA32(vf[1][1], p1, b1); }
}
__device__ __forceinline__ void glds16(const void* g, unsigned lds_base) {
    unsigned sv; asm volatile("s_mov_b32 %0, m0\n\ts_mov_b32 m0, %2\n\ts_nop 0\n\tglobal_load_lds_dwordx4 %1, off\n\ts_mov_b32 m0, %0" : "=&s"(sv) : "v"(g), "s"(lds_base) : "memory"); }
template <int OFF>
__device__ __forceinline__ void glds16o(const void* g, unsigned lds_base) {
    unsigned sv; asm volatile("s_mov_b32 %0, m0\n\ts_mov_b32 m0, %2\n\ts_nop 0\n\tglobal_load_lds_dwordx4 %1, off offset:%3\n\ts_mov_b32 m0, %0" : "=&s"(sv) : "v"(g), "s"(lds_base - (unsigned)OFF), "n"(OFF) : "memory"); }
struct QState { bf16x8 qf[4]; f32x16 o0, o1; float R; };
__device__ __forceinline__ void qstate_init(QState& S, const bf16* QN, size_t rowbase, int hd, int q32, int ql, int h) {
    const bf16* qp = QN + (rowbase + q32 * 32 + ql) * 512 + hd * 64 + 8 * h;
#pragma unroll
    for (int c = 0; c < 4; ++c) S.qf[c] = *(const bf16x8*)(qp + 16 * c);
#pragma unroll
    for (int r = 0; r < 16; ++r) { S.o0[r] = 0.f; S.o1[r] = 0.f; }
    S.R = 0.f;
}
__device__ __forceinline__ void qstate_store(const QState& S, const bf16* SG, bf16* MIX, size_t rowbase, int hd, int q32, int ql, int h) {
    const size_t row = rowbase + q32 * 32 + ql;
    const bf16* sg = SG + row * D + 512 + hd * 64 + 4 * h; bf16* mx = MIX + row * D + 512 + hd * 64 + 4 * h;
#pragma unroll
    for (int db = 0; db < 2; ++db)
#pragma unroll
        for (int g = 0; g < 4; ++g) {
            const bf16x4 sv = *(const bf16x4*)(sg + 32 * db + 8 * g);
            const f32x16& o = db ? S.o1 : S.o0;
            v2u w; w.x = cvtpk(o[4 * g] * bf2f((bf16)sv[0]), o[4 * g + 1] * bf2f((bf16)sv[1])); w.y = cvtpk(o[4 * g + 2] * bf2f((bf16)sv[2]), o[4 * g + 3] * bf2f((bf16)sv[3]));
            *(v2u*)(mx + 32 * db + 8 * g) = w;
        }
}
__device__ __forceinline__ void prompt_pair(const bf16* QN, const bf16* KN, const bf16* VT, const bf16* SG, bf16* MIX, float bias2, int b, int hd, int qhi, LAS unsigned char* ring, int lane) {
    asm volatile("" : "+v"(lane));
    const int ql = lane & 31, h = lane >> 5;
    const size_t rowbase = (size_t)b * SEQ;
    bf16x8 tm[2];
#pragma unroll
    for (int s = 0; s < 2; ++s)
#pragma unroll
        for (int j = 0; j < 8; ++j) tm[s][j] = (16 * s + 8 * (j >> 2) + 4 * h + (j & 3)) >= ql ? (short)0x3F80 : (short)0;
    QState A, B;
    qstate_init(A, QN, rowbase, hd, qhi, ql, h); qstate_init(B, QN, rowbase, hd, qhi - 1, ql, h);
    const bf16* ksrc = KN + (rowbase + ql) * 512 + hd * 64 + 8 * h;
    const bf16* vsrc = VT + ((size_t)(b * 8 + hd) * 64 + ql) * SEQ + 8 * h;
    const unsigned ring0 = (unsigned)(uintptr_t)ring;
#define DMA_BLOCK(kbv, slot) do { const unsigned st_ = (unsigned)__builtin_amdgcn_readfirstlane((int)(ring0 + (unsigned)(slot) * 8192u)); \
        const bf16* kp_ = ksrc + (size_t)(kbv) * 32 * 512; const bf16* vp0_ = vsrc + (kbv) * 32; const bf16* vp1_ = vp0_ + (size_t)32 * SEQ; \
        glds16o<0>(kp_, st_); glds16o<32>(kp_, st_ + 1024); glds16o<64>(kp_, st_ + 2048); glds16o<96>(kp_, st_ + 3072); \
        glds16o<0>(vp0_, st_ + 4096); glds16o<32>(vp0_, st_ + 5120); glds16o<0>(vp1_, st_ + 6144); glds16o<32>(vp1_, st_ + 7168); } while (0)
#define DMA_WAIT(N) asm volatile("s_waitcnt vmcnt(" #N ")" ::: "memory")
#define ATT_FETCH(slot) \
        if (kb >= 3) DMA_BLOCK(kb - 3, ((slot) + 3) & 3); \
        if (kb >= 3) DMA_WAIT(24); else if (kb == 2) DMA_WAIT(16); else if (kb == 1) DMA_WAIT(8); else DMA_WAIT(0);        \
        const LAS unsigned char* st_ = ring + (slot) * 8192; bf16x8 kf_[4], vf_[2][2]; \
        _Pragma("unroll") for (int c = 0; c < 4; ++c) kf_[c] = *(const LAS bf16x8*)(st_ + c * 1024 + lane * 16); \
        _Pragma("unroll") for (int db = 0; db < 2; ++db) _Pragma("unroll") for (int s = 0; s < 2; ++s) { const LAS unsigned char* pv_ = st_ + 4096 + (db * 2 + s) * 1024 + ql * 16 + 8 * h; \
            vf_[db][s] = cat8(*(const LAS bf16x4*)pv_, *(const LAS bf16x4*)(pv_ + 512)); }
    int kb = qhi;
    DMA_BLOCK(kb, 0); if (kb >= 1) DMA_BLOCK(kb - 1, 1); if (kb >= 2) DMA_BLOCK(kb - 2, 2);
    { ATT_FETCH(0); step_core<true>(kf_, vf_, A.qf, tm, A.o0, A.o1, A.R, bias2, ql, h); --kb; }
    { ATT_FETCH(1); step_core<false>(kf_, vf_, A.qf, tm, A.o0, A.o1, A.R, bias2, ql, h); step_core<true>(kf_, vf_, B.qf, tm, B.o0, B.o1, B.R, bias2, ql, h); --kb; }
    int slot = 2;
    while (kb >= 0) { ATT_FETCH(slot); step_core<false>(kf_, vf_, A.qf, tm, A.o0, A.o1, A.R, bias2, ql, h); step_core<false>(kf_, vf_, B.qf, tm, B.o0, B.o1, B.R, bias2, ql, h); --kb; slot = (slot + 1) & 3; }
#undef ATT_FETCH
#undef DMA_BLOCK
#undef DMA_WAIT
    qstate_store(A, SG, MIX, rowbase, hd, qhi, ql, h); qstate_store(B, SG, MIX, rowbase, hd, qhi - 1, ql, h);
    asm volatile("s_waitcnt vmcnt(0)" ::: "memory");
}
#define SR_D 8
#define SR_LA 6
__device__ __forceinline__ void sr_wait4(volatile LAS unsigned* p, unsigned target) {
    for (int it = 0; it < (1 << 17); ++it) {
        const v4u q = *(volatile LAS v4u*)p;
        unsigned m = q.x < q.y ? q.x : q.y; const unsigned m2 = q.z < q.w ? q.z : q.w; m = m < m2 ? m : m2;
        if ((int)((unsigned)__builtin_amdgcn_readfirstlane((int)m) - target) >= 0) break;
        asm volatile("s_nop 7");
    }
    asm volatile("" ::: "memory");
}
struct SrCtx { const bf16* ksrc; const bf16* vsrc; unsigned ring0; int ktop1, ktop2, J, w; unsigned base; volatile LAS unsigned* flg; };
#define SR_DMA(jj) do { const int j_ = (jj); const int kbv_ = j_ <= C.ktop1 ? C.ktop1 - j_ : C.ktop2 - (j_ - C.ktop1 - 1); \
        const unsigned st_ = (unsigned)__builtin_amdgcn_readfirstlane((int)(C.ring0 + (unsigned)(j_ & (SR_D - 1)) * 8192u + (unsigned)C.w * 2048u)); \
        const bf16* sp_ = C.w < 2 ? C.ksrc + (size_t)kbv_ * 32 * 512 + 32 * C.w : C.vsrc + (size_t)(C.w - 2) * 32 * SEQ + kbv_ * 32; \
        glds16o<0>(sp_, st_); glds16o<32>(sp_, st_ + 1024); } while (0)
#define DMA_WAIT(N) asm volatile("s_waitcnt vmcnt(" #N ")" ::: "memory")
#define SR_PRE(j) do { \
        if ((j) + SR_LA < C.J) { if ((j) >= 2) sr_wait4(C.flg + 4, C.base + (unsigned)((j) - 1)); SR_DMA((j) + SR_LA); } \
        { const int rem_ = C.J - 1 - (j);        \
          if (rem_ >= 6) DMA_WAIT(12); else if (rem_ == 5) DMA_WAIT(10); else if (rem_ == 4) DMA_WAIT(8); else if (rem_ == 3) DMA_WAIT(6); else if (rem_ == 2) DMA_WAIT(4); else if (rem_ == 1) DMA_WAIT(2); else DMA_WAIT(0); } \
        C.flg[C.w] = C.base + (unsigned)((j) + 1); \
        sr_wait4(C.flg, C.base + (unsigned)((j) + 1)); } while (0)
#define SR_READ(j) \
        const LAS unsigned char* st_ = ring + ((j) & (SR_D - 1)) * 8192; bf16x8 kf_[4], vf_[2][2]; \
        _Pragma("unroll") for (int c = 0; c < 4; ++c) kf_[c] = *(const LAS bf16x8*)(st_ + c * 1024 + lane * 16); \
        _Pragma("unroll") for (int db = 0; db < 2; ++db) _Pragma("unroll") for (int s = 0; s < 2; ++s) { const LAS unsigned char* pv_ = st_ + 4096 + (db * 2 + s) * 1024 + ql * 16 + 8 * h; \
            vf_[db][s] = cat8(*(const LAS bf16x4*)pv_, *(const LAS bf16x4*)(pv_ + 512)); } \
        asm volatile("s_waitcnt lgkmcnt(0)" ::: "memory"); \
        C.flg[4 + C.w] = C.base + (unsigned)((j) + 1);
__device__ __forceinline__ void sr_unit(const SrCtx& C, const bf16* QN, const bf16* SG, bf16* MIX, float bias2, size_t rowbase, int hd, int j0, int ktop, int qhi, LAS unsigned char* ring, int lane) {
    asm volatile("" : "+v"(lane));
    const int ql = lane & 31, h = lane >> 5;
    bf16x8 tm[2];
#pragma unroll
    for (int s = 0; s < 2; ++s)
#pragma unroll
        for (int j = 0; j < 8; ++j) tm[s][j] = (16 * s + 8 * (j >> 2) + 4 * h + (j & 3)) >= ql ? (short)0x3F80 : (short)0;
    int j = j0, kb = ktop;
    for (; kb > qhi; --kb, ++j) { SR_PRE(j); C.flg[4 + C.w] = C.base + (unsigned)(j + 1); }
    QState A, B;
    qstate_init(A, QN, rowbase, hd, qhi, ql, h); qstate_init(B, QN, rowbase, hd, qhi - 1, ql, h);
    { SR_PRE(j); SR_READ(j); step_core<true>(kf_, vf_, A.qf, tm, A.o0, A.o1, A.R, bias2, ql, h); --kb; ++j; }
    { SR_PRE(j); SR_READ(j); step_core<false>(kf_, vf_, A.qf, tm, A.o0, A.o1, A.R, bias2, ql, h); step_core<true>(kf_, vf_, B.qf, tm, B.o0, B.o1, B.R, bias2, ql, h); --kb; ++j; }
    while (kb >= 0) { SR_PRE(j); SR_READ(j); step_pair(kf_, vf_, A.qf, B.qf, tm, A.o0, A.o1, A.R, B.o0, B.o1, B.R, bias2); --kb; ++j; }
    qstate_store(A, SG, MIX, rowbase, hd, qhi, ql, h); qstate_store(B, SG, MIX, rowbase, hd, qhi - 1, ql, h);
    asm volatile("s_waitcnt vmcnt(0)" ::: "memory");
}
__device__ __forceinline__ void prompt_item(const bf16* QN, const bf16* KN, const bf16* VT, const bf16* SG, bf16* MIX, float bias2, int b, int hd, int pair, int w, LAS unsigned char* ring, volatile LAS unsigned* flg, unsigned base, int lane) {
    asm volatile("" : "+v"(lane));
    const int ql = lane & 31, h = lane >> 5;
    const size_t rowbase = (size_t)b * SEQ;
    SrCtx C;
    C.ktop1 = 8 * (7 - pair) + 7; C.ktop2 = 8 * pair + 7; C.J = C.ktop1 + C.ktop2 + 2; C.w = w; C.base = base; C.flg = flg;
    C.ksrc = KN + (rowbase + ql) * 512 + hd * 64 + 8 * h;
    C.vsrc = VT + ((size_t)(b * 8 + hd) * 64 + ql) * SEQ + 8 * h;
    C.ring0 = (unsigned)(uintptr_t)ring;
    sr_wait4(flg + 4, base);
#pragma unroll 1
    for (int j = 0; j < SR_LA; ++j) SR_DMA(j);
    sr_unit(C, QN, SG, MIX, bias2, rowbase, hd, 0, C.ktop1, C.ktop1 - 2 * w, ring, lane);
    sr_unit(C, QN, SG, MIX, bias2, rowbase, hd, C.ktop1 + 1, C.ktop2, C.ktop2 - 6 + 2 * w, ring, lane);
}
#undef SR_DMA
#undef DMA_WAIT
#undef SR_PRE
#undef SR_READ
__device__ __forceinline__ void prompt_phase(const Frame& F, unsigned char* ws, const float* sb_bias) {
    const bf16* QN = (const bf16*)(ws + WS_QN); const bf16* KN = (const bf16*)(ws + WS_KN); const bf16* VT = (const bf16*)(ws + WS_VT); const bf16* SG = (const bf16*)(ws + WS_SG); bf16* MIX = (bf16*)(ws + WS_MIX);
    volatile LAS unsigned* flg = (volatile LAS unsigned*)(F.lds + 65536);
    unsigned base = 0;
    for (int c = F.vcu; c < 256; c += F.G) {
        const int bh = c >> 2, pair = c & 3, b = bh >> 3, hd = bh & 7;
        const float bias2 = sb_bias[hd] * LOG2E;
        prompt_item(QN, KN, VT, SG, MIX, bias2, b, hd, pair, F.wave & 3, F.lds, flg, base, F.lane);
        base += 72;
    }
}
}

constexpr size_t WS_PO = WS_END;
constexpr size_t WS_PT = WS_PO + (size_t)DB * NPAGE * SBH * DS * SBD * 4;
constexpr size_t WS_MIXD = WS_PT + (size_t)DB * NPAGE * SBH * DS * 4;
constexpr size_t WS_END2 = WS_MIXD + (size_t)MT * D * 2;
namespace at {
__device__ __forceinline__ void decode_unit(const In& in, unsigned char* ws, int s, int p, int hd, int lane) {
    asm volatile("" : "+v"(lane));
    const int ql = lane & 31, h = lane >> 5;
    const bf16* QN = (const bf16*)(ws + WS_QN);
    const int pg = in.page_table[s * NPAGE + p];
    const float* kpage = in.cache_k + (size_t)pg * PAGE * 512 + hd * 64;
    const float* vpage = in.cache_v + (size_t)pg * PAGE * 512 + hd * 64;
    bf16x8 qf[4];
    { const bf16* qp = QN + (size_t)(MP + s * DS + (ql < DS ? ql : DS - 1)) * 512 + hd * 64 + 8 * h;
#pragma unroll
      for (int c = 0; c < 4; ++c) qf[c] = *(const bf16x8*)(qp + 16 * c); }
    bf16x8 tm[2];
#pragma unroll
    for (int sx = 0; sx < 2; ++sx)
#pragma unroll
        for (int j = 0; j < 8; ++j) tm[sx][j] = (16 * sx + 8 * (j >> 2) + 4 * h + (j & 3)) >= ql ? (short)0x3F80 : (short)0;
    const float bias2 = in.sb_bias[hd] * LOG2E;
    f32x16 o0, o1;
#pragma unroll
    for (int r = 0; r < 16; ++r) { o0[r] = 0.f; o1[r] = 0.f; }
    float R = 0.f;
#define DEC_LOAD(blk, kr, vr) do { const float* kp = kpage + (size_t)((blk) * 32 + ql) * 512 + 8 * h; \
        _Pragma("unroll") for (int c = 0; c < 4; ++c) { kr[c][0] = *(const f32x4*)(kp + 16 * c); kr[c][1] = *(const f32x4*)(kp + 16 * c + 4); } \
        const float* vp = vpage + (size_t)((blk) * 32 + 4 * h) * 512 + ql; \
        _Pragma("unroll") for (int db = 0; db < 2; ++db) _Pragma("unroll") for (int sx = 0; sx < 2; ++sx) _Pragma("unroll") for (int j = 0; j < 8; ++j) \
            vr[db][sx][j] = vp[(size_t)(16 * sx + 8 * (j >> 2) + (j & 3)) * 512 + 32 * db]; } while (0)
#define DEC_STEP(kr, vr) do { bf16x8 kf[4], vf[2][2]; \
        _Pragma("unroll") for (int c = 0; c < 4; ++c) { v4u w_; w_.x = cvtpk(kr[c][0][0], kr[c][0][1]); w_.y = cvtpk(kr[c][0][2], kr[c][0][3]); w_.z = cvtpk(kr[c][1][0], kr[c][1][1]); w_.w = cvtpk(kr[c][1][2], kr[c][1][3]); kf[c] = __builtin_bit_cast(bf16x8, w_); } \
        _Pragma("unroll") for (int db = 0; db < 2; ++db) _Pragma("unroll") for (int sx = 0; sx < 2; ++sx) { v4u w_; w_.x = cvtpk(vr[db][sx][0], vr[db][sx][1]); w_.y = cvtpk(vr[db][sx][2], vr[db][sx][3]); w_.z = cvtpk(vr[db][sx][4], vr[db][sx][5]); w_.w = cvtpk(vr[db][sx][6], vr[db][sx][7]); vf[db][sx] = __builtin_bit_cast(bf16x8, w_); } \
        step_core<false>(kf, vf, qf, tm, o0, o1, R, bias2, ql, h); } while (0)
    { f32x4 krA[4][2], krB[4][2]; float vrA[2][2][8], vrB[2][2][8];
      DEC_LOAD(3, krA, vrA);
      DEC_LOAD(2, krB, vrB); DEC_STEP(krA, vrA);
      DEC_LOAD(1, krA, vrA); DEC_STEP(krB, vrB);
      DEC_LOAD(0, krB, vrB); DEC_STEP(krA, vrA);
      DEC_STEP(krB, vrB); }
#undef DEC_LOAD
#undef DEC_STEP
    if (ql < DS) {
        float* po = (float*)(ws + WS_PO) + ((((size_t)s * NPAGE + p) * SBH + hd) * DS + ql) * SBD + 4 * h;
#pragma unroll
        for (int db = 0; db < 2; ++db)
#pragma unroll
            for (int g = 0; g < 4; ++g) { const f32x16& o = db ? o1 : o0; *(f32x4*)(po + 32 * db + 8 * g) = (f32x4){o[4 * g], o[4 * g + 1], o[4 * g + 2], o[4 * g + 3]}; }
        if (h == 0) ((float*)(ws + WS_PT))[(((size_t)s * NPAGE + p) * SBH + hd) * DS + ql] = R;
    }
}
__device__ __forceinline__ void decode_unit2(const In& in, unsigned char* ws, LAS unsigned char* scr, int s, int p, int hd, int lane) {
    asm volatile("" : "+v"(lane));
    const int ql = lane & 31, h = lane >> 5;
    const bf16* QN = (const bf16*)(ws + WS_QN);
    const int pg = in.page_table[s * NPAGE + p];
    const float* kpage = in.cache_k + (size_t)pg * PAGE * 512 + hd * 64;
    const float* vpage = in.cache_v + (size_t)pg * PAGE * 512 + hd * 64;
    bf16x8 qf[4];
    { const bf16* qp = QN + (size_t)(MP + s * DS + (ql < DS ? ql : DS - 1)) * 512 + hd * 64 + 8 * h;
#pragma unroll
      for (int c = 0; c < 4; ++c) qf[c] = *(const bf16x8*)(qp + 16 * c); }
    const float bias2 = in.sb_bias[hd] * LOG2E;
    LAS float* zbuf = (LAS float*)scr;
    LAS bf16* abuf = (LAS bf16*)(scr + 2048);
#define D2_LOADK(blk, kr) do { const float* kp = kpage + (size_t)((blk) * 32 + ql) * 512 + 8 * h; \
        _Pragma("unroll") for (int c = 0; c < 4; ++c) { kr[c][0] = *(const f32x4*)(kp + 16 * c); kr[c][1] = *(const f32x4*)(kp + 16 * c + 4); } } while (0)
#define D2_LOADV(blk, vr) do { const float* vp = vpage + (size_t)((blk) * 32 + 4 * h) * 512 + ql; \
        _Pragma("unroll") for (int db = 0; db < 2; ++db) _Pragma("unroll") for (int sx = 0; sx < 2; ++sx) _Pragma("unroll") for (int j = 0; j < 8; ++j) \
            vr[db][sx][j] = vp[(size_t)(16 * sx + 8 * (j >> 2) + (j & 3)) * 512 + 32 * db]; } while (0)
#define D2_QK(blk, kr) do { f32x16 z_; _Pragma("unroll") for (int r = 0; r < 16; ++r) z_[r] = bias2; \
        _Pragma("unroll") for (int c = 0; c < 4; ++c) { v4u w_; w_.x = cvtpk(kr[c][0][0], kr[c][0][1]); w_.y = cvtpk(kr[c][0][2], kr[c][0][3]); w_.z = cvtpk(kr[c][1][0], kr[c][1][1]); w_.w = cvtpk(kr[c][1][2], kr[c][1][3]); \
            z_ = MFMA32(__builtin_bit_cast(bf16x8, w_), qf[c], z_); } \
        if (ql < DS) { _Pragma("unroll") for (int g = 0; g < 4; ++g) *(LAS f32x4*)(zbuf + ql * 128 + 32 * (blk) + 8 * g + 4 * h) = (f32x4){z_[4 * g], z_[4 * g + 1], z_[4 * g + 2], z_[4 * g + 3]}; } } while (0)
#define D2_PV(blk, vr) do { _Pragma("unroll") for (int sx = 0; sx < 2; ++sx) { \
            const LAS bf16* ap_ = abuf + (ql < DS ? ql : DS - 1) * 128 + 32 * (blk) + 16 * sx + 4 * h; \
            const bf16x8 pa_ = cat8(*(const LAS bf16x4*)ap_, *(const LAS bf16x4*)(ap_ + 8)); \
            _Pragma("unroll") for (int db = 0; db < 2; ++db) { v4u w_; w_.x = cvtpk(vr[db][sx][0], vr[db][sx][1]); w_.y = cvtpk(vr[db][sx][2], vr[db][sx][3]); w_.z = cvtpk(vr[db][sx][4], vr[db][sx][5]); w_.w = cvtpk(vr[db][sx][6], vr[db][sx][7]); \
                if (db == 0) o0 = MFMA32(__builtin_bit_cast(bf16x8, w_), pa_, o0); else o1 = MFMA32(__builtin_bit_cast(bf16x8, w_), pa_, o1); } } } while (0)
    f32x4 kA[4][2], kB[4][2], kC[4][2], kD[4][2]; float vA[2][2][8], vB[2][2][8], vC[2][2][8], vD[2][2][8];
    f32x16 o0, o1;
#pragma unroll
    for (int r = 0; r < 16; ++r) { o0[r] = 0.f; o1[r] = 0.f; }
    D2_LOADK(0, kA); D2_LOADK(1, kB); D2_LOADK(2, kC); D2_LOADK(3, kD); D2_LOADV(0, vA);
    D2_QK(0, kA); D2_LOADV(1, vB);
    D2_QK(1, kB); D2_LOADV(2, vC);
    D2_QK(2, kC);
    D2_QK(3, kD);
    LDS_WAIT(); asm volatile("" ::: "memory");
    float Tq;
    { const int q = lane >> 4, kg = lane & 15;
      const f32x4 z0 = *(const LAS f32x4*)(zbuf + q * 128 + 8 * kg), z1 = *(const LAS f32x4*)(zbuf + q * 128 + 8 * kg + 4);
      float z[8] = {z0[0], z0[1], z0[2], z0[3], z1[0], z1[1], z1[2], z1[3]}, lk[8], t[8], sfx[8];
#pragma unroll
      for (int i = 0; i < 8; ++i) { const float sp = fmaxf(z[i], 0.f) + __builtin_amdgcn_logf(1.f + __builtin_amdgcn_exp2f(-fabsf(z[i]))); lk[i] = -sp; t[i] = z[i] - sp; }
      float run = 0.f;
#pragma unroll
      for (int i = 7; i >= 0; --i) { sfx[i] = run; run += lk[i]; }
      float inc = run;
#pragma unroll
      for (int off = 1; off < 16; off <<= 1) { const float tt = __shfl_down(inc, off, 16); if (kg + off < 16) inc += tt; }
      const float later = inc - run;
      Tq = __shfl(inc, 0, 16);
      float a[8];
#pragma unroll
      for (int i = 0; i < 8; ++i) a[i] = __builtin_amdgcn_exp2f(t[i] + sfx[i] + later);
      v4u pa; pa.x = cvtpk(a[0], a[1]); pa.y = cvtpk(a[2], a[3]); pa.z = cvtpk(a[4], a[5]); pa.w = cvtpk(a[6], a[7]);
      *(LAS v4u*)(abuf + q * 128 + 8 * kg) = pa; }
    D2_LOADV(3, vD);
    LDS_WAIT(); asm volatile("" ::: "memory");
    D2_PV(0, vA); D2_PV(1, vB); D2_PV(2, vC); D2_PV(3, vD);
#undef D2_LOADK
#undef D2_LOADV
#undef D2_QK
#undef D2_PV
    if (ql < DS) {
        float* po = (float*)(ws + WS_PO) + ((((size_t)s * NPAGE + p) * SBH + hd) * DS + ql) * SBD + 4 * h;
#pragma unroll
        for (int db = 0; db < 2; ++db)
#pragma unroll
            for (int g = 0; g < 4; ++g) { const f32x16& o = db ? o1 : o0; *(f32x4*)(po + 32 * db + 8 * g) = (f32x4){o[4 * g], o[4 * g + 1], o[4 * g + 2], o[4 * g + 3]}; }
    }
    if ((lane & 15) == 0) ((float*)(ws + WS_PT))[(((size_t)s * NPAGE + p) * SBH + hd) * DS + (lane >> 4)] = Tq;
    LDS_WAIT(); asm volatile("" ::: "memory");
}
__device__ __forceinline__ void decode_combine(const In& in, unsigned char* ws, int s, int hd, int lane) {
    asm volatile("" : "+v"(lane));
    const bf16* QN = (const bf16*)(ws + WS_QN); const bf16* KN = (const bf16*)(ws + WS_KN); const bf16* VB = (const bf16*)(ws + WS_VB); const bf16* SG = (const bf16*)(ws + WS_SG); bf16* MIX = (bf16*)(ws + WS_MIX);
    const float* PO = (const float*)(ws + WS_PO); const float* PT = (const float*)(ws + WS_PT);
    const float bias2 = in.sb_bias[hd] * LOG2E;
    float q[DS], k[DS], v[DS];
#pragma unroll
    for (int i = 0; i < DS; ++i) { const size_t o = (size_t)(MP + s * DS + i) * 512 + hd * 64 + lane; q[i] = bf2f(QN[o]); k[i] = bf2f(KN[o]); v[i] = bf2f(VB[o]); }
    const float Tl = PT[(((size_t)s * NPAGE + (lane >> 2)) * SBH + hd) * DS + (lane & 3)];
#pragma unroll
    for (int i = 0; i < DS; ++i) {
        float Rn = 0.f, out = 0.f;
#pragma unroll
        for (int j = DS - 1; j >= 0; --j) if (j < i) {
            const float z = wave_sum(q[i] * k[j]) + bias2;
            const float sp = softplus2_f(z);
            out += exp2f(z - sp + Rn) * v[j];
            Rn -= sp;
        }
        for (int p = NPAGE - 1; p >= 0; --p) {
            out += exp2f(Rn) * PO[((((size_t)s * NPAGE + p) * SBH + hd) * DS + i) * SBD + lane];
            Rn += __shfl(Tl, 4 * p + i);
        }
        const size_t o = (size_t)(MP + s * DS + i) * D + 512 + hd * 64 + lane;
        MIX[o] = (bf16)f2bf(out * bf2f(SG[o]));
    }
}
}

namespace pl {
using at::cvtpk;
template <int G>
__device__ __forceinline__ void pool_unit_prompt(const In& in, unsigned char* ws, int rb, int lane) {
    asm volatile("" : "+v"(lane));
    constexpr int w = 2 << G;
    const int ql = lane & 31, h = lane >> 5;
    const bf16* U = (const bf16*)(ws + WS_U); const bf16* Wpt = (const bf16*)(ws + WS_WPT) + (size_t)G * PG * PG; const bf16* SG = (const bf16*)(ws + WS_SG); bf16* MIX = (bf16*)(ws + WS_MIX);
    const int row = rb * 32 + ql, t = row & (SEQ - 1);
    const float inv = 1.f / (float)min(t + 1, w);
    f32x16 acc[4];
#pragma unroll
    for (int nb = 0; nb < 4; ++nb)
#pragma unroll
        for (int r = 0; r < 16; ++r) acc[nb][r] = 0.f;
#pragma unroll 1
    for (int c = 0; c < 8; ++c) {
        const int ch = PG * G + 16 * c + 8 * h;
        const bf16* up = U + (size_t)row * PW + ch;
        bf16x8 u8[w];
#pragma unroll
        for (int j = 0; j < w; ++j) u8[j] = *(const bf16x8*)(up - (ptrdiff_t)(j <= t ? j : t) * PW);
        float sum[8], cur[8];
#pragma unroll
        for (int e = 0; e < 8; ++e) { cur[e] = bf2f((bf16)u8[0][e]); sum[e] = cur[e]; }
#pragma unroll
        for (int j = 1; j < w; ++j) { const float m = j <= t ? 1.f : 0.f;
#pragma unroll
            for (int e = 0; e < 8; ++e) sum[e] += m * bf2f((bf16)u8[j][e]); }
        v4u dp;
        dp.x = cvtpk(sum[0] * inv - cur[0], sum[1] * inv - cur[1]); dp.y = cvtpk(sum[2] * inv - cur[2], sum[3] * inv - cur[3]);
        dp.z = cvtpk(sum[4] * inv - cur[4], sum[5] * inv - cur[5]); dp.w = cvtpk(sum[6] * inv - cur[6], sum[7] * inv - cur[7]);
        const bf16x8 df = __builtin_bit_cast(bf16x8, dp);
#pragma unroll
        for (int nb = 0; nb < 4; ++nb) { const bf16x8 wf = *(const bf16x8*)(Wpt + (size_t)(32 * nb + ql) * PG + 16 * c + 8 * h); acc[nb] = MFMA32(wf, df, acc[nb]); }
    }
#pragma unroll
    for (int nb = 0; nb < 4; ++nb)
#pragma unroll
        for (int gg = 0; gg < 4; ++gg) {
            const int ch = PG * G + 32 * nb + 8 * gg + 4 * h;
            const f32x4 sc = *(const f32x4*)(in.pool_scale + ch);
            const bf16x4 sv = *(const bf16x4*)(SG + (size_t)row * D + ch);
            v2u o; o.x = cvtpk(acc[nb][4 * gg] * sc[0] * bf2f((bf16)sv[0]), acc[nb][4 * gg + 1] * sc[1] * bf2f((bf16)sv[1]));
            o.y = cvtpk(acc[nb][4 * gg + 2] * sc[2] * bf2f((bf16)sv[2]), acc[nb][4 * gg + 3] * sc[3] * bf2f((bf16)sv[3]));
            *(v2u*)(MIX + (size_t)row * D + ch) = o;
        }
}
template <int G>
__device__ __forceinline__ void pool_unit_sample(const In& in, unsigned char* ws, int rb, int lane) {
    asm volatile("" : "+v"(lane));
    constexpr int w = 2 << G;
    const int ql = lane & 31, h = lane >> 5;
    const bf16* U = (const bf16*)(ws + WS_U); const bf16* Wpt = (const bf16*)(ws + WS_WPT) + (size_t)G * PG * PG; const bf16* SG = (const bf16*)(ws + WS_SG); bf16* MIX = (bf16*)(ws + WS_MIX);
    const int row = rb * 32 + ql, s = (row - MP) >> 2, t = (row - MP) & 3;
    const float inv = 1.f / (float)w;
    f32x16 acc[4];
#pragma unroll
    for (int nb = 0; nb < 4; ++nb)
#pragma unroll
        for (int r = 0; r < 16; ++r) acc[nb][r] = 0.f;
#pragma unroll 1
    for (int c = 0; c < 8; ++c) {
        const int ch = PG * G + 16 * c + 8 * h;
        const bf16* up = U + (size_t)row * PW + ch; const float* cp = in.cache_pool + (size_t)s * PBUF * PW + ch;
        float sum[8], cur[8];
        { const bf16x8 u0 = *(const bf16x8*)up;
#pragma unroll
          for (int e = 0; e < 8; ++e) { cur[e] = bf2f((bf16)u0[e]); sum[e] = cur[e]; } }
#pragma unroll
        for (int j0 = 1; j0 < w; j0 += 4) {
            bf16x8 ua[4]; f32x4 c0[4], c1[4];
#pragma unroll
            for (int jj = 0; jj < 4; ++jj) { const int j = j0 + jj; if (j < w) { const int tt = t - j;
                ua[jj] = *(const bf16x8*)(up - (ptrdiff_t)(tt >= 0 ? j : t) * PW);
                const float* cq = cp + (size_t)(tt >= 0 ? 0 : PBUF + tt) * PW; c0[jj] = *(const f32x4*)cq; c1[jj] = *(const f32x4*)(cq + 4); } }
#pragma unroll
            for (int jj = 0; jj < 4; ++jj) { const int j = j0 + jj; if (j < w) { const bool fromu = t - j >= 0;
#pragma unroll
                for (int e = 0; e < 4; ++e) { sum[e] += fromu ? bf2f((bf16)ua[jj][e]) : c0[jj][e]; sum[4 + e] += fromu ? bf2f((bf16)ua[jj][4 + e]) : c1[jj][e]; } } }
        }
        v4u dp;
        dp.x = cvtpk(sum[0] * inv - cur[0], sum[1] * inv - cur[1]); dp.y = cvtpk(sum[2] * inv - cur[2], sum[3] * inv - cur[3]);
        dp.z = cvtpk(sum[4] * inv - cur[4], sum[5] * inv - cur[5]); dp.w = cvtpk(sum[6] * inv - cur[6], sum[7] * inv - cur[7]);
        const bf16x8 df = __builtin_bit_cast(bf16x8, dp);
#pragma unroll
        for (int nb = 0; nb < 4; ++nb) { const bf16x8 wf = *(const bf16x8*)(Wpt + (size_t)(32 * nb + ql) * PG + 16 * c + 8 * h); acc[nb] = MFMA32(wf, df, acc[nb]); }
    }
#pragma unroll
    for (int nb = 0; nb < 4; ++nb)
#pragma unroll
        for (int gg = 0; gg < 4; ++gg) {
            const int ch = PG * G + 32 * nb + 8 * gg + 4 * h;
            const f32x4 sc = *(const f32x4*)(in.pool_scale + ch);
            const bf16x4 sv = *(const bf16x4*)(SG + (size_t)row * D + ch);
            v2u o; o.x = cvtpk(acc[nb][4 * gg] * sc[0] * bf2f((bf16)sv[0]), acc[nb][4 * gg + 1] * sc[1] * bf2f((bf16)sv[1]));
            o.y = cvtpk(acc[nb][4 * gg + 2] * sc[2] * bf2f((bf16)sv[2]), acc[nb][4 * gg + 3] * sc[3] * bf2f((bf16)sv[3]));
            *(v2u*)(MIX + (size_t)row * D + ch) = o;
        }
}
__device__ __forceinline__ void pool_unit(const In& in, unsigned char* ws, int rb, int g, int lane) {
    asm volatile("" : "+v"(lane));
    const int ql = lane & 31, h = lane >> 5, w = 2 << g;
    const bf16* U = (const bf16*)(ws + WS_U); const bf16* Wpt = (const bf16*)(ws + WS_WPT) + (size_t)g * PG * PG; const bf16* SG = (const bf16*)(ws + WS_SG); bf16* MIX = (bf16*)(ws + WS_MIX);
    const int row = rb * 32 + ql;
    int t, s = 0; float inv;
    if (row < MP) { t = row & (SEQ - 1); inv = 1.f / (float)min(t + 1, w); } else { s = (row - MP) >> 2; t = (row - MP) & 3; inv = 1.f / (float)w; }
    f32x16 acc[4];
#pragma unroll
    for (int nb = 0; nb < 4; ++nb)
#pragma unroll
        for (int r = 0; r < 16; ++r) acc[nb][r] = 0.f;
#pragma unroll 1
    for (int c = 0; c < 8; ++c) {
        const int ch = PG * g + 16 * c + 8 * h;
        float sum[8], cur[8];
        { const bf16x8 u8 = *(const bf16x8*)(U + (size_t)row * PW + ch);
#pragma unroll
          for (int e = 0; e < 8; ++e) { cur[e] = bf2f((bf16)u8[e]); sum[e] = cur[e]; } }
        for (int j = 1; j < w; ++j) {
            const int tt = t - j;
            if (tt >= 0) { const bf16x8 u8 = *(const bf16x8*)(U + (size_t)(row - j) * PW + ch);
#pragma unroll
                for (int e = 0; e < 8; ++e) sum[e] += bf2f((bf16)u8[e]); }
            else if (row >= MP) { const float* cp = in.cache_pool + ((size_t)s * PBUF + (PBUF + tt)) * PW + ch;
#pragma unroll
                for (int e = 0; e < 8; ++e) sum[e] += cp[e]; }
        }
        v4u dp;
        dp.x = cvtpk(sum[0] * inv - cur[0], sum[1] * inv - cur[1]); dp.y = cvtpk(sum[2] * inv - cur[2], sum[3] * inv - cur[3]);
        dp.z = cvtpk(sum[4] * inv - cur[4], sum[5] * inv - cur[5]); dp.w = cvtpk(sum[6] * inv - cur[6], sum[7] * inv - cur[7]);
        const bf16x8 df = __builtin_bit_cast(bf16x8, dp);
#pragma unroll
        for (int nb = 0; nb < 4; ++nb) { const bf16x8 wf = *(const bf16x8*)(Wpt + (size_t)(32 * nb + ql) * PG + 16 * c + 8 * h); acc[nb] = MFMA32(wf, df, acc[nb]); }
    }
#pragma unroll
    for (int nb = 0; nb < 4; ++nb)
#pragma unroll
        for (int gg = 0; gg < 4; ++gg) {
            const int ch = PG * g + 32 * nb + 8 * gg + 4 * h;
            const f32x4 sc = *(const f32x4*)(in.pool_scale + ch);
            const bf16x4 sv = *(const bf16x4*)(SG + (size_t)row * D + ch);
            v2u o; o.x = cvtpk(acc[nb][4 * gg] * sc[0] * bf2f((bf16)sv[0]), acc[nb][4 * gg + 1] * sc[1] * bf2f((bf16)sv[1]));
            o.y = cvtpk(acc[nb][4 * gg + 2] * sc[2] * bf2f((bf16)sv[2]), acc[nb][4 * gg + 3] * sc[3] * bf2f((bf16)sv[3]));
            *(v2u*)(MIX + (size_t)row * D + ch) = o;
        }
}
__device__ __forceinline__ void pool_state_out(const In& in, unsigned char* ws, float* out, int gtid, int gthreads) {
    const bf16* U = (const bf16*)(ws + WS_U);
    for (int i = gtid; i < BP * PBUF * PW; i += gthreads) { const int c = i % PW, j = (i / PW) % PBUF, b = i / (PW * PBUF); out[O_POOLP + i] = bf2f(U[(size_t)(b * SEQ + SEQ - PBUF + j) * PW + c]); }
    for (int i = gtid; i < DB * PBUF * PW; i += gthreads) { const int c = i % PW, j = (i / PW) % PBUF, s = i / (PW * PBUF), e = j + DS;
        out[O_POOLS + i] = e < PBUF ? in.cache_pool[((size_t)s * PBUF + e) * PW + c] : bf2f(U[(size_t)(MP + s * DS + (e - PBUF)) * PW + c]); }
}
}

namespace gd {
using at::cvtpk; using at::crow;
constexpr int NCH = SEQ / 64, NBLK = BP * DNH * NCH;
constexpr int F_W = 0, F_Q = 16, F_K = 32, F_A = 48, F_U = 54, F_N = 70;
constexpr size_t OPS_BYTES = (size_t)F_N * 1024;
constexpr size_t WS_OPS = WS_END2;
constexpr size_t WS_UA = WS_OPS + (size_t)NBLK * OPS_BYTES;
constexpr size_t WS_KPL = WS_UA + (size_t)NBLK * 32768;
constexpr size_t WS_QPL = WS_KPL + (size_t)MP * 1024 * 2;
constexpr size_t WS_KGT = WS_QPL + (size_t)MP * 1024 * 2;
constexpr size_t WS_VBT = WS_KGT + (size_t)NBLK * 16384;
constexpr size_t WS_SC = WS_VBT + (size_t)NBLK * 16384;
constexpr size_t WS_DBG_O = WS_SC + (size_t)MP * 8 * 2 * 4;
constexpr size_t WS_DBG_OUT = WS_DBG_O + (size_t)MP * D * 4;
constexpr size_t WS_END3 = WS_DBG_OUT + O_END * 4;
constexpr int LT_PITCH = 68, WAVE_LDS = (64 * LT_PITCH + 128) * 4;

__device__ __forceinline__ v4u pk8(const float* x) { v4u p; p.x = cvtpk(x[0], x[1]); p.y = cvtpk(x[2], x[3]); p.z = cvtpk(x[4], x[5]); p.w = cvtpk(x[6], x[7]); return p; }

template <int PART>
__device__ __forceinline__ void prep_elem(const In& in, unsigned char* ws, LAS unsigned char* wl, int b_, int n_, int hd_, int lane) {
    asm volatile("" : "+v"(lane));
    const int b = __builtin_amdgcn_readfirstlane(b_), n = __builtin_amdgcn_readfirstlane(n_), hd = __builtin_amdgcn_readfirstlane(hd_);
    const int t = n * 64 + lane, row = b * SEQ + t, blk = (b * DNH + hd) * NCH + n;
    const float* BA = (const float*)(ws + WS_BA);
    const float bb = BA[(size_t)row * 16 + hd], aa = BA[(size_t)row * 16 + 8 + hd];
    const float beta = 1.f / (1.f + __expf(-bb));
    const float g = -__expf(in.a_log[hd]) * softplus_f(aa + in.dt_bias[hd]);
    float gc = g;
#pragma unroll
    for (int off = 1; off < 64; off <<= 1) { const float tt = __shfl_up(gc, off); if (lane >= off) gc += tt; }
    const float glast = __shfl(gc, 63);
    constexpr int TP = 144;
    LAS unsigned char* raw = wl + 8192;
    const bf16* Xt = (const bf16*)(ws + WS_QKVP) + ((ptrdiff_t)(b * SEQ + n * 64) - 3) * CONVD + PART * 1024 + hd * 128;
    const float* cw = in.conv_w + PART * 1024 + hd * 128;
    float wv[4];
#define STAGE(half) do { LDS_WAIT(); asm volatile("" ::: "memory"); \
        _Pragma("unroll") for (int i = 0; i < 9; ++i) { int r_ = 8 * i + (lane >> 3); r_ = r_ < 67 ? r_ : 66;         \
            const bool z_ = (n == 0) && (r_ < 3); const int rl_ = z_ ? 3 : r_; \
            v4u v_ = *(const v4u*)(Xt + (size_t)rl_ * CONVD + 64 * (half) + 8 * (lane & 7)); \
            if (z_) v_ = (v4u){0u, 0u, 0u, 0u}; \
            *(LAS v4u*)(raw + r_ * TP + (lane & 7) * 16) = v_; } \
        _Pragma("unroll") for (int jj = 0; jj < 4; ++jj) wv[jj] = cw[(size_t)jj * CONVD + 64 * (half) + lane] * (-LOG2E);        \
        LDS_WAIT(); asm volatile("" ::: "memory"); } while (0)
    v4u R[9]; float wn[4];
#define STAGE_LOAD(half) do { \
        _Pragma("unroll") for (int i = 0; i < 9; ++i) { int r_ = 8 * i + (lane >> 3); r_ = r_ < 67 ? r_ : 66; \
            const bool z_ = (n == 0) && (r_ < 3); const int rl_ = z_ ? 3 : r_; \
            R[i] = *(const v4u*)(Xt + (size_t)rl_ * CONVD + 64 * (half) + 8 * (lane & 7)); \
            if (z_) R[i] = (v4u){0u, 0u, 0u, 0u}; } \
        _Pragma("unroll") for (int jj = 0; jj < 4; ++jj) wn[jj] = cw[(size_t)jj * CONVD + 64 * (half) + lane]; } while (0)
#define STAGE_STORE() do { LDS_WAIT(); asm volatile("" ::: "memory"); \
        _Pragma("unroll") for (int i = 0; i < 9; ++i) { int r_ = 8 * i + (lane >> 3); r_ = r_ < 67 ? r_ : 66; *(LAS v4u*)(raw + r_ * TP + (lane & 7) * 16) = R[i]; } \
        _Pragma("unroll") for (int jj = 0; jj < 4; ++jj) wv[jj] = wn[jj] * (-LOG2E); \
        LDS_WAIT(); asm volatile("" ::: "memory"); } while (0)
#define COMP32(half, kq, x) do { _Pragma("unroll") for (int c_ = 0; c_ < 32; ++c_) x[c_] = 0.f; \
        _Pragma("unroll") for (int jj = 0; jj < 4; ++jj) _Pragma("unroll") for (int cg = 0; cg < 4; ++cg) { \
            const bf16x8 u_ = *(const LAS bf16x8*)(raw + (lane + jj) * TP + (4 * (kq) + cg) * 16); \
            int w_ = __builtin_bit_cast(int, wv[jj]); { const int u0_ = (int)u_[0]; asm volatile("" : "+v"(w_) : "v"(u0_)); }     \
            _Pragma("unroll") for (int e = 0; e < 8; ++e) x[8 * cg + e] += bf2f((bf16)u_[e]) * __builtin_bit_cast(float, __builtin_amdgcn_readlane(w_, 32 * (kq) + 8 * cg + e)); } \
        _Pragma("unroll") for (int c_ = 0; c_ < 32; ++c_) x[c_] = x[c_] * __builtin_amdgcn_rcpf(1.f + __builtin_amdgcn_exp2f(x[c_])); } while (0)
    unsigned char* ops = ws + WS_OPS + (size_t)blk * OPS_BYTES;
    const int jb = lane >> 5, jl = lane & 31;
    float ss = 0.f;
    unsigned PK0[16], PK1[16];
    if (PART != 2) {
#define SS32(x) do { _Pragma("unroll") for (int c = 0; c < 32; ++c) ss += x[c] * x[c]; } while (0)
#define PARK_LDS(x, base) do { _Pragma("unroll") for (int i = 0; i < 4; ++i) { v4u p_; p_.x = cvtpk(x[8 * i], x[8 * i + 1]); p_.y = cvtpk(x[8 * i + 2], x[8 * i + 3]); p_.z = cvtpk(x[8 * i + 4], x[8 * i + 5]); p_.w = cvtpk(x[8 * i + 6], x[8 * i + 7]); \
            *(LAS v4u*)((base) + i * 1024 + lane * 16) = p_; } } while (0)
#define UNPARK_LDS(x, base) do { _Pragma("unroll") for (int i = 0; i < 4; ++i) { const v4u p_ = *(const LAS v4u*)((base) + i * 1024 + lane * 16); \
            x[8 * i] = __uint_as_float(p_.x << 16); x[8 * i + 1] = __uint_as_float(p_.x & 0xffff0000u); x[8 * i + 2] = __uint_as_float(p_.y << 16); x[8 * i + 3] = __uint_as_float(p_.y & 0xffff0000u); \
            x[8 * i + 4] = __uint_as_float(p_.z << 16); x[8 * i + 5] = __uint_as_float(p_.z & 0xffff0000u); x[8 * i + 6] = __uint_as_float(p_.w << 16); x[8 * i + 7] = __uint_as_float(p_.w & 0xffff0000u); } } while (0)
#define PARK(x, Pk) do { _Pragma("unroll") for (int c = 0; c < 16; ++c) Pk[c] = cvtpk(x[2 * c], x[2 * c + 1]); } while (0)
#define UNPARK(x, Pk) do { _Pragma("unroll") for (int c = 0; c < 16; ++c) { x[2 * c] = __uint_as_float(Pk[c] << 16); x[2 * c + 1] = __uint_as_float(Pk[c] & 0xffff0000u); } } while (0)
        STAGE(0); STAGE_LOAD(1);
        { float x[32]; COMP32(0, 0, x); SS32(x); PARK(x, PK0); } { float x[32]; COMP32(0, 1, x); SS32(x); PARK(x, PK1); }
        STAGE_STORE();
        { float x[32]; COMP32(1, 0, x); SS32(x); PARK_LDS(x, wl); } { float x[32]; COMP32(1, 1, x); SS32(x); PARK_LDS(x, raw); }
#undef SS32
    }
    if (PART == 0) {
        const float sc = -rsqrtf(ss + EPS * (LOG2E * LOG2E)) * 0.08838834764831845f, sg = sc * __expf(gc);
        bf16* qpl = (bf16*)(ws + WS_QPL) + (size_t)row * 1024 + hd * 128;
#define QOUT(kb4, x) do { _Pragma("unroll") for (int cg = 0; cg < 4; ++cg) { float v[8]; _Pragma("unroll") for (int e = 0; e < 8; ++e) v[e] = x[8 * cg + e] * sc; *(v4u*)(qpl + 32 * (kb4) + 8 * cg) = pk8(v); } \
            unsigned char* fb = ops + (size_t)(F_Q + (jb * 4 + (kb4)) * 2) * 1024 + jl * 16; \
            _Pragma("unroll") for (int s = 0; s < 2; ++s) _Pragma("unroll") for (int hh = 0; hh < 2; ++hh) { float v[8]; \
                _Pragma("unroll") for (int jj = 0; jj < 8; ++jj) v[jj] = x[16 * s + 8 * (jj >> 2) + 4 * hh + (jj & 3)] * sg; \
                *(v4u*)(fb + s * 1024 + hh * 512) = pk8(v); } } while (0)
        { float x[32]; UNPARK_LDS(x, wl); QOUT(2, x); } __builtin_amdgcn_sched_barrier(0); { float x[32]; UNPARK_LDS(x, raw); QOUT(3, x); } __builtin_amdgcn_sched_barrier(0);
        { float x[32]; UNPARK(x, PK0); QOUT(0, x); } __builtin_amdgcn_sched_barrier(0); { float x[32]; UNPARK(x, PK1); QOUT(1, x); }
#undef QOUT
    } else if (PART == 1) {
        const float sc = -rsqrtf(ss + EPS * (LOG2E * LOG2E)), sd = sc * __expf(glast - gc), sg = sc * beta * __expf(gc);
        bf16* kpl = (bf16*)(ws + WS_KPL) + (size_t)row * 1024 + hd * 128;
        const int s = jl >> 4, j16 = jl & 15, hh = (j16 >> 2) & 1, jj = 4 * (j16 >> 3) + (j16 & 3);
#define KOUT(kb4, x) do { _Pragma("unroll") for (int cg = 0; cg < 4; ++cg) { float v[8]; _Pragma("unroll") for (int e = 0; e < 8; ++e) v[e] = x[8 * cg + e] * sc; *(v4u*)(kpl + 32 * (kb4) + 8 * cg) = pk8(v); } \
            LAS bf16* kdl = (LAS bf16*)wl + (size_t)(jb * 2 + s) * 512 + hh * 256 + jj; LAS bf16* kgl = (LAS bf16*)(wl + 4096) + lane; \
            _Pragma("unroll") for (int dl = 0; dl < 32; ++dl) { kdl[dl * 8] = (bf16)f2bf(x[dl] * sd); kgl[dl * 64] = (bf16)f2bf(x[dl] * sg); } \
            LDS_WAIT(); asm volatile("" ::: "memory"); \
            unsigned char* g0 = ops + (size_t)(F_K + (kb4) * 4) * 1024 + lane * 16; unsigned char* g1 = ws + WS_KGT + (size_t)blk * 16384 + (size_t)(kb4) * 4096 + lane * 16; \
            _Pragma("unroll") for (int i = 0; i < 4; ++i) { *(v4u*)(g0 + i * 1024) = *(const LAS v4u*)(wl + i * 1024 + lane * 16); *(v4u*)(g1 + i * 1024) = *(const LAS v4u*)(wl + 4096 + i * 1024 + lane * 16); } \
            LDS_WAIT(); asm volatile("" ::: "memory"); } while (0)
        { float x[32]; UNPARK_LDS(x, wl); KOUT(2, x); } __builtin_amdgcn_sched_barrier(0); { float x[32]; UNPARK_LDS(x, raw); KOUT(3, x); } __builtin_amdgcn_sched_barrier(0);
        { float x[32]; UNPARK(x, PK0); KOUT(0, x); } __builtin_amdgcn_sched_barrier(0); { float x[32]; UNPARK(x, PK1); KOUT(1, x); }
#undef KOUT
        float* scp = (float*)(ws + WS_SC) + ((size_t)row * 8 + hd) * 2; scp[0] = beta; scp[1] = gc;
    } else {
#define VOUT(kb4, x) do { LAS bf16* vl = (LAS bf16*)wl + lane; \
            _Pragma("unroll") for (int dl = 0; dl < 32; ++dl) vl[dl * 64] = (bf16)f2bf(x[dl] * (beta * (-1.f / LOG2E))); \
            LDS_WAIT(); asm volatile("" ::: "memory"); \
            unsigned char* g1 = ws + WS_VBT + (size_t)blk * 16384 + (size_t)(kb4) * 4096 + lane * 16; \
            _Pragma("unroll") for (int i = 0; i < 4; ++i) *(v4u*)(g1 + i * 1024) = *(const LAS v4u*)(wl + i * 1024 + lane * 16); \
            LDS_WAIT(); asm volatile("" ::: "memory"); } while (0)
        STAGE(0); STAGE_LOAD(1);
        { float x[32]; COMP32(0, 0, x); VOUT(0, x); } { float x[32]; COMP32(0, 1, x); VOUT(1, x); }
        STAGE_STORE();
        { float x[32]; COMP32(1, 0, x); VOUT(2, x); } { float x[32]; COMP32(1, 1, x); VOUT(3, x); }
#undef VOUT
    }
    LDS_WAIT(); asm volatile("" ::: "memory");
#undef STAGE
#undef STAGE_LOAD
#undef STAGE_STORE
#undef PARK
#undef PARK_LDS
#undef UNPARK_LDS
#undef UNPARK
#undef COMP32
}

__device__ __forceinline__ void prep_chunk(unsigned char* ws, LAS unsigned char* wlds, int blk, int lane) {
    asm volatile("" : "+v"(lane));
    const int n = blk % NCH, hd = (blk / NCH) % DNH, b = blk / (NCH * DNH);
    const int r0 = b * SEQ + n * 64;
#define ql (lane & 31)
#define h (lane >> 5)
    LAS float* Lt = (LAS float*)wlds; LAS float* gcs = Lt + 64 * LT_PITCH; LAS float* bts = gcs + 64;
    unsigned char* ops = ws + WS_OPS + (size_t)blk * OPS_BYTES;
    bf16x8 kf[2][8], qf[2][8];
    { const bf16* KPL = (const bf16*)(ws + WS_KPL) + (size_t)r0 * 1024 + hd * 128 + 8 * h; const bf16* QPL = (const bf16*)(ws + WS_QPL) + (size_t)r0 * 1024 + hd * 128 + 8 * h;
#pragma unroll
      for (int rb = 0; rb < 2; ++rb)
#pragma unroll
          for (int c = 0; c < 8; ++c) { kf[rb][c] = *(const bf16x8*)(KPL + (size_t)(32 * rb + ql) * 1024 + 16 * c); if (rb == 0) qf[0][c] = *(const bf16x8*)(QPL + (size_t)ql * 1024 + 16 * c); }
      const float* scp = (const float*)(ws + WS_SC) + ((size_t)(r0 + lane) * 8 + hd) * 2; bts[lane] = scp[0]; gcs[lane] = scp[1]; }
    LDS_WAIT(); asm volatile("" ::: "memory");
#pragma unroll
    for (int bi = 0; bi < 3; ++bi) { const int ib = bi ? 1 : 0, jbb = bi == 2 ? 1 : 0;
        f32x16 acc;
#pragma unroll
        for (int r = 0; r < 16; ++r) acc[r] = 0.f;
#pragma unroll
        for (int c = 0; c < 8; ++c) acc = MFMA32(kf[ib][c], kf[jbb][c], acc);
        const int j = 32 * jbb + ql; const float gcj = gcs[j];
#pragma unroll
        for (int g4 = 0; g4 < 4; ++g4) { const int i0 = 32 * ib + 8 * g4 + 4 * h;
            const f32x4 gi = *(const LAS f32x4*)(gcs + i0), bi4 = *(const LAS f32x4*)(bts + i0); f32x4 o;
#pragma unroll
            for (int e = 0; e < 4; ++e) { const float v = bi4[e] * acc[4 * g4 + e] * __expf(gi[e] - gcj); o[e] = (i0 + e > j) ? v : 0.f; }
            *(LAS f32x4*)(Lt + j * LT_PITCH + i0) = o; }
    }
    asm volatile("" : "+v"(lane) :: "memory");
    { const bf16* QPL = (const bf16*)(ws + WS_QPL) + (size_t)r0 * 1024 + hd * 128 + 8 * h;
#pragma unroll
      for (int c = 0; c < 8; ++c) qf[1][c] = *(const bf16x8*)(QPL + (size_t)(32 + ql) * 1024 + 16 * c); }
#pragma unroll
    for (int bi = 0; bi < 3; ++bi) { const int jb = bi ? 1 : 0, jpb = bi == 2 ? 1 : 0;
        f32x16 acc;
#pragma unroll
        for (int r = 0; r < 16; ++r) acc[r] = 0.f;
#pragma unroll
        for (int c = 0; c < 8; ++c) acc = MFMA32(kf[jpb][c], qf[jb][c], acc);
        const int j = 32 * jb + ql; const float gcj = gcs[j]; float a[16];
#pragma unroll
        for (int g4 = 0; g4 < 4; ++g4) { const int p0 = 32 * jpb + 8 * g4 + 4 * h; const f32x4 gp = *(const LAS f32x4*)(gcs + p0);
#pragma unroll
            for (int e = 0; e < 4; ++e) { const float v = acc[4 * g4 + e] * __expf(gcj - gp[e]); a[4 * g4 + e] = (p0 + e <= j) ? v : 0.f; } }
#pragma unroll
        for (int s = 0; s < 2; ++s) *(v4u*)(ops + (size_t)(F_A + 2 * bi + s) * 1024 + lane * 16) = pk8(a + 8 * s);
    }
    LDS_WAIT(); asm volatile("" ::: "memory");
    asm volatile("" : "+v"(lane) :: "memory");
    bf16x8 kg[4][4];
    { const bf16* KGT = (const bf16*)(ws + WS_KGT) + (size_t)blk * 8192 + 8 * h;
#pragma unroll
      for (int dkb = 0; dkb < 2; ++dkb)
#pragma unroll
          for (int js = 0; js < 4; ++js) kg[dkb][js] = *(const bf16x8*)(KGT + (size_t)(32 * dkb + ql) * 64 + 16 * js); }
#define FNMA(acc, p, q) asm("v_fma_f32 %0, -%1, %2, %0" : "+v"(acc) : "v"(p), "v"(q))
    float x[64];
#pragma unroll
    for (int j = 0; j < 64; ++j) x[j] = 0.f;
#pragma unroll
    for (int j = 63; j >= 0; --j) {
        LAS float* Ltj = Lt; int ll = lane;
        if (j < 63) asm volatile("" : "+v"(Ltj), "+v"(ll) : "v"(x[j < 63 ? j + 1 : 63]));
        Ltj += j * LT_PITCH;
        float a0 = (ll == j) ? 1.f : 0.f, a1 = 0.f, a2 = 0.f, a3 = 0.f;
#pragma unroll
        for (int i0 = (j + 1) & ~3; i0 < 64; i0 += 4) { const f32x4 l4 = *(const LAS f32x4*)(Ltj + i0);
            FNMA(a0, x[i0], l4[0]); FNMA(a1, x[i0 + 1], l4[1]); FNMA(a2, x[i0 + 2], l4[2]); FNMA(a3, x[i0 + 3], l4[3]); }
        x[j] = (a0 + a1) + (a2 + a3);
    }
#undef FNMA
    asm volatile("" : "+v"(lane) :: "memory");
    bf16x8 Tf[2][4];
#pragma unroll
    for (int js = 0; js < 4; ++js) { const v4u X = pk8(x + 16 * js), Y = pk8(x + 16 * js + 8); v4u lo, hi;
#pragma unroll
        for (int e = 0; e < 4; ++e) { auto rr = __builtin_amdgcn_permlane32_swap(X[e], Y[e], false, false); lo[e] = rr[0]; hi[e] = rr[1]; }
        Tf[0][js] = __builtin_bit_cast(bf16x8, lo); Tf[1][js] = __builtin_bit_cast(bf16x8, hi); }
    bf16x8 vb[4][4];
    { const bf16* KGT = (const bf16*)(ws + WS_KGT) + (size_t)blk * 8192 + 8 * h;
#pragma unroll
      for (int dkb = 2; dkb < 4; ++dkb)
#pragma unroll
          for (int js = 0; js < 4; ++js) kg[dkb][js] = *(const bf16x8*)(KGT + (size_t)(32 * dkb + ql) * 64 + 16 * js); }
    { const bf16* VBT = (const bf16*)(ws + WS_VBT) + (size_t)blk * 8192 + 8 * h;
#pragma unroll
      for (int dvb = 0; dvb < 4; ++dvb)
#pragma unroll
          for (int js = 0; js < 4; ++js) vb[dvb][js] = *(const bf16x8*)(VBT + (size_t)(32 * dvb + ql) * 64 + 16 * js); }
#pragma unroll
    for (int dkb = 0; dkb < 4; ++dkb) {
#pragma unroll
        for (int ib = 0; ib < 2; ++ib) { f32x16 acc;
#pragma unroll
            for (int r = 0; r < 16; ++r) acc[r] = 0.f;
#pragma unroll
            for (int js = 0; js < 4; ++js) if (js < 2 * ib + 2) acc = MFMA32(kg[dkb][js], Tf[ib][js], acc);
            float w[16];
#pragma unroll
            for (int r = 0; r < 16; ++r) w[r] = -acc[r];
#pragma unroll
            for (int s = 0; s < 2; ++s) *(v4u*)(ops + (size_t)(F_W + (ib * 4 + dkb) * 2 + s) * 1024 + lane * 16) = pk8(w + 8 * s); }
    }
#pragma unroll
    for (int dvb = 0; dvb < 4; ++dvb) {
#pragma unroll
        for (int ib = 0; ib < 2; ++ib) { f32x16 acc;
#pragma unroll
            for (int r = 0; r < 16; ++r) acc[r] = 0.f;
#pragma unroll
            for (int js = 0; js < 4; ++js) if (js < 2 * ib + 2) acc = MFMA32(Tf[ib][js], vb[dvb][js], acc);
            float uu[16];
#pragma unroll
            for (int r = 0; r < 16; ++r) uu[r] = acc[r];
#pragma unroll
            for (int hf = 0; hf < 2; ++hf) *(v4u*)(ops + (size_t)(F_U + (ib * 4 + dvb) * 2 + hf) * 1024 + lane * 16) = pk8(uu + 8 * hf); }
    }
    LDS_WAIT(); asm volatile("" ::: "memory");
#undef ql
#undef h
}

#define SCAN_BAR() do { asm volatile("s_waitcnt lgkmcnt(0)" ::: "memory"); __builtin_amdgcn_s_barrier(); asm volatile("" ::: "memory"); } while (0)
__device__ __forceinline__ void scan_chain(unsigned char* ws, LAS unsigned char* lds, bf16* nO, float* out, int chain, int half, int wave, int lane) {
    asm volatile("" : "+v"(lane));
    const int b = chain >> 3, hd = chain & 7, ql = lane & 31, h = lane >> 5;
    const unsigned char* opsb = ws + WS_OPS + (size_t)chain * NCH * OPS_BYTES;
    const int w = wave & 3;
    if (wave == 2 || wave == 3) {
        SCAN_BAR();
        for (int n = 0; n < NCH; ++n) SCAN_BAR();
        return;
    }
    if (wave >= 4) {
        v4u Ra[18], Rb[18];
#define LDR_LOAD(R, nn) do { const unsigned char* src_ = opsb + (size_t)(nn) * OPS_BYTES + lane * 16; _Pragma("unroll") for (int i = 0; i < 18; ++i) { \
            const int f = w + 4 * i < F_N ? w + 4 * i : F_N - 1; const unsigned char* p_ = src_ + (size_t)f * 1024; \
            asm volatile("global_load_dwordx4 %0, %1, off" : "=v"(R[i]) : "v"(p_) : "memory"); } } while (0)
#define LDR_STORE(R, bb) do { LAS unsigned char* dst_ = lds + (bb) * OPS_BYTES; _Pragma("unroll") for (int i = 0; i < 18; ++i) { const int f = w + 4 * i; if (f < F_N) *(LAS v4u*)(dst_ + f * 1024 + lane * 16) = R[i]; } } while (0)
#define LDR_WAIT(N) asm volatile("s_waitcnt vmcnt(" #N ")" ::: "memory")
        LDR_LOAD(Ra, 0); LDR_WAIT(0); LDR_STORE(Ra, 0); LDR_LOAD(Ra, 1); LDR_LOAD(Rb, 2);
        SCAN_BAR();
        for (int n = 0; n < NCH; n += 2) {
            if (n + 1 < NCH) { if (n + 2 < NCH) LDR_WAIT(18); else LDR_WAIT(0); LDR_STORE(Ra, 1); if (n + 3 < NCH) LDR_LOAD(Ra, n + 3); }
            SCAN_BAR();
            if (n + 2 < NCH) { if (n + 3 < NCH) LDR_WAIT(18); else LDR_WAIT(0); LDR_STORE(Rb, 0); if (n + 4 < NCH) LDR_LOAD(Rb, n + 4); }
            SCAN_BAR();
        }
        LDR_WAIT(0);
#undef LDR_LOAD
#undef LDR_STORE
#undef LDR_WAIT
        return;
    }
    __builtin_amdgcn_s_setprio(2);
    const int sl = 2 * half + wave;
    const float* SCb = (const float*)(ws + WS_SC) + ((size_t)(b * SEQ) * 8 + hd) * 2;
    const float gcl = lane < NCH ? SCb[(size_t)(lane * 64 + 63) * 16 + 1] : 0.f;
    f32x16 S[4], Vn[2];
#if DBG_CHECK == 3
    unsigned long long wacc_ = 0;
#endif
#pragma unroll
    for (int k = 0; k < 4; ++k)
#pragma unroll
        for (int r = 0; r < 16; ++r) S[k][r] = 0.f;
    SCAN_BAR();
    for (int n = 0; n < NCH; ++n) {
        LAS unsigned char* buf = lds + (n & 1) * OPS_BYTES;
#define FRAG(idx) (*(const LAS bf16x8*)(buf + (idx) * 1024 + lane * 16))
        const float gamma = __expf(__shfl(gcl, n));
#pragma unroll
        for (int jb = 0; jb < 2; ++jb)
#pragma unroll
            for (int hf = 0; hf < 2; ++hf) { const bf16x8 u8 = FRAG(F_U + (jb * 4 + sl) * 2 + hf);
#pragma unroll
                for (int e = 0; e < 8; ++e) Vn[jb][8 * hf + e] = bf2f((bf16)u8[e]); }
        bf16x8 Sb[4][2];
#pragma unroll
        for (int k = 0; k < 4; ++k) { float tmp[16];
#pragma unroll
            for (int r = 0; r < 16; ++r) tmp[r] = S[k][r];
            Sb[k][0] = __builtin_bit_cast(bf16x8, pk8(tmp)); Sb[k][1] = __builtin_bit_cast(bf16x8, pk8(tmp + 8)); }
#pragma unroll
        for (int k = 0; k < 4; ++k)
#pragma unroll
            for (int r = 0; r < 16; ++r) S[k][r] *= gamma;
        bf16x8 fa[8], fb[8];
#define RD_W(f, q) do { _Pragma("unroll") for (int i = 0; i < 4; ++i) { f[i] = FRAG(F_W + 4 * (q) + i); f[4 + i] = FRAG(F_W + 8 + 4 * (q) + i); } } while (0)
#define RD_Q(f, q) do { _Pragma("unroll") for (int i = 0; i < 4; ++i) { f[i] = FRAG(F_Q + 4 * (q) + i); f[4 + i] = FRAG(F_Q + 8 + 4 * (q) + i); } } while (0)
#define RD_A(f) do { _Pragma("unroll") for (int i = 0; i < 6; ++i) f[i] = FRAG(F_A + i); } while (0)
#define RD_K(f, kk) do { _Pragma("unroll") for (int i = 0; i < 8; ++i) f[i] = FRAG(F_K + 8 * (kk) + i); } while (0)
        RD_W(fa, 0);
        RD_W(fb, 1);
#pragma unroll
        for (int i = 0; i < 4; ++i) { Vn[0] = MFMA32(fa[i], Sb[i >> 1][i & 1], Vn[0]); Vn[1] = MFMA32(fa[4 + i], Sb[i >> 1][i & 1], Vn[1]); }
        RD_Q(fa, 0);
#pragma unroll
        for (int i = 0; i < 4; ++i) { Vn[0] = MFMA32(fb[i], Sb[2 + (i >> 1)][i & 1], Vn[0]); Vn[1] = MFMA32(fb[4 + i], Sb[2 + (i >> 1)][i & 1], Vn[1]); }
        RD_Q(fb, 1);
        f32x16 OT[2];
#pragma unroll
        for (int r = 0; r < 16; ++r) { OT[0][r] = 0.f; OT[1][r] = 0.f; }
#pragma unroll
        for (int i = 0; i < 4; ++i) { OT[0] = MFMA32(Sb[i >> 1][i & 1], fa[i], OT[0]); OT[1] = MFMA32(Sb[i >> 1][i & 1], fa[4 + i], OT[1]); }
        bf16x8 Vb[2][2];
#pragma unroll
        for (int jb = 0; jb < 2; ++jb) { float tmp[16];
#pragma unroll
            for (int r = 0; r < 16; ++r) tmp[r] = Vn[jb][r];
            Vb[jb][0] = __builtin_bit_cast(bf16x8, pk8(tmp)); Vb[jb][1] = __builtin_bit_cast(bf16x8, pk8(tmp + 8)); }
        RD_A(fa);
#pragma unroll
        for (int i = 0; i < 4; ++i) { OT[0] = MFMA32(Sb[2 + (i >> 1)][i & 1], fb[i], OT[0]); OT[1] = MFMA32(Sb[2 + (i >> 1)][i & 1], fb[4 + i], OT[1]); }
        RD_K(fb, 0);
        OT[0] = MFMA32(Vb[0][0], fa[0], OT[0]); OT[1] = MFMA32(Vb[0][0], fa[2], OT[1]);
        OT[0] = MFMA32(Vb[0][1], fa[1], OT[0]); OT[1] = MFMA32(Vb[0][1], fa[3], OT[1]);
        OT[1] = MFMA32(Vb[1][0], fa[4], OT[1]); OT[1] = MFMA32(Vb[1][1], fa[5], OT[1]);
        RD_K(fa, 1);
#pragma unroll
        for (int i = 0; i < 4; ++i) { S[0] = MFMA32(fb[i], Vb[i >> 1][i & 1], S[0]); S[1] = MFMA32(fb[4 + i], Vb[i >> 1][i & 1], S[1]); }
#pragma unroll
        for (int jb = 0; jb < 2; ++jb) {
            bf16* op = nO + (size_t)(b * SEQ + n * 64 + 32 * jb + ql) * D + hd * 128 + 32 * sl + 4 * h;
#pragma unroll
            for (int g4 = 0; g4 < 4; ++g4) *(v2u*)(op + 8 * g4) = (v2u){cvtpk(OT[jb][4 * g4], OT[jb][4 * g4 + 1]), cvtpk(OT[jb][4 * g4 + 2], OT[jb][4 * g4 + 3])}; }
#pragma unroll
        for (int i = 0; i < 4; ++i) { S[2] = MFMA32(fa[i], Vb[i >> 1][i & 1], S[2]); S[3] = MFMA32(fa[4 + i], Vb[i >> 1][i & 1], S[3]); }
#undef RD_W
#undef RD_Q
#undef RD_A
#undef RD_K
#undef FRAG
#if DBG_CHECK == 3
        { const unsigned long long t0_ = __builtin_amdgcn_s_memrealtime(); SCAN_BAR(); wacc_ += __builtin_amdgcn_s_memrealtime() - t0_; }
#else
        SCAN_BAR();
#endif
    }
#if DBG_CHECK == 3
    if (blockIdx.x == 0 && wave == 0 && lane == 0) *(volatile LAS unsigned long long*)(lds + LDSCTL_OFF + 1024 + 20 * 8) = wacc_;
#endif
    __builtin_amdgcn_s_setprio(0);
    {
        float* so = out + O_DP + (size_t)chain * DNK * DNV + 32 * sl + ql;
#pragma unroll
        for (int k = 0; k < 4; ++k)
#pragma unroll
            for (int r = 0; r < 16; ++r) so[(size_t)(32 * k + crow(r, h)) * DNV] = S[k][r];
    }
}
#undef SCAN_BAR
}
namespace gd {
__device__ __forceinline__ void sample_prep(const In& in, unsigned char* ws, int r, int hd, int lane) {
    asm volatile("" : "+v"(lane));
    const int s = (r - MP) >> 2, t = (r - MP) & 3;
    const bf16* QKVP = (const bf16*)(ws + WS_QKVP); float* nC = (float*)(ws + NW_C);
    float v[3][2];
#pragma unroll
    for (int part = 0; part < 3; ++part)
#pragma unroll
        for (int hf = 0; hf < 2; ++hf) { const int col = part * 1024 + hd * 128 + hf * 64 + lane; float acc = 0.f;
#pragma unroll
            for (int jj = 0; jj < 4; ++jj) { const int e = t + jj;
                const float xv = e >= 3 ? bf2f(QKVP[(size_t)(MP + s * DS + e - 3) * CONVD + col]) : in.state_conv[((size_t)s * 3 + e) * CONVD + col];
                acc += xv * in.conv_w[(size_t)jj * CONVD + col]; }
            v[part][hf] = silu_f(acc); }
    const float qs = wave_sum(v[0][0] * v[0][0] + v[0][1] * v[0][1]), ks = wave_sum(v[1][0] * v[1][0] + v[1][1] * v[1][1]);
    const float qr = rsqrtf(qs + EPS) * 0.08838834764831845f, kr = rsqrtf(ks + EPS);
    float* o = nC + (size_t)r * CONVD + hd * 128 + lane;
    o[0] = v[0][0] * qr; o[64] = v[0][1] * qr; o[1024] = v[1][0] * kr; o[1024 + 64] = v[1][1] * kr; o[2048] = v[2][0]; o[2048 + 64] = v[2][1];
    if (lane == 0) { const float* BA = (const float*)(ws + WS_BA); const float bb = BA[(size_t)r * 16 + hd], aa = BA[(size_t)r * 16 + 8 + hd];
        ((float*)(ws + NW_BETA))[(size_t)r * DNH + hd] = 1.f / (1.f + __expf(-bb));
        ((float*)(ws + NW_G))[(size_t)r * DNH + hd] = -__expf(in.a_log[hd]) * softplus_f(aa + in.dt_bias[hd]); }
}
}

namespace sg {
using at::glds16; using at::cvtpk; using at::crow;
constexpr int NSLOT = 5, AHEAD = 4, KSTEPS = D / 64;
constexpr int WREG = 32768;
template <int R, int NB>
__device__ __forceinline__ void block(const bf16* A, const bf16* Bt, int brow0, int brow1, int arow0, int kq, LAS unsigned char* ring, int lane, f32x16 (&acc)[R][NB]) {
    const int ql = lane & 31, h = lane >> 5;
    const bf16* ap = A + (size_t)(arow0 + ql) * D + 8 * h + 256 * kq;
    const bf16* b0 = Bt + (size_t)(brow0 + ql) * D + 8 * h + 256 * kq;
    const bf16* b1 = Bt + (size_t)(brow1 + ql) * D + 8 * h + 256 * kq;
    const unsigned ring0 = (unsigned)(uintptr_t)ring;
    constexpr int SLOT = (R + NB) * 1024, PER = R + NB;
    static_assert(PER * AHEAD <= 63, "vmcnt is 6 bits");
#pragma unroll
    for (int rk = 0; rk < R; ++rk)
#pragma unroll
        for (int nb = 0; nb < NB; ++nb)
#pragma unroll
            for (int r = 0; r < 16; ++r) acc[rk][nb][r] = 0.f;
#define SG_DMA(s) do { const unsigned st_ = (unsigned)__builtin_amdgcn_readfirstlane((int)(ring0 + (unsigned)((s) % NSLOT) * SLOT)); \
        _Pragma("unroll") for (int rk = 0; rk < R; ++rk) glds16(ap + (size_t)rk * 32 * D + 16 * (s), st_ + rk * 1024); \
        glds16(b0 + 16 * (s), st_ + R * 1024); if (NB == 2) glds16(b1 + 16 * (s), st_ + (R + 1) * 1024); } while (0)
#define SG_WAITN(n) do { switch (n) { case 0: asm volatile("s_waitcnt vmcnt(0)" ::: "memory"); break; case 5: asm volatile("s_waitcnt vmcnt(5)" ::: "memory"); break; case 6: asm volatile("s_waitcnt vmcnt(6)" ::: "memory"); break; case 10: asm volatile("s_waitcnt vmcnt(10)" ::: "memory"); break; case 12: asm volatile("s_waitcnt vmcnt(12)" ::: "memory"); break; case 15: asm volatile("s_waitcnt vmcnt(15)" ::: "memory"); break; case 18: asm volatile("s_waitcnt vmcnt(18)" ::: "memory"); break; case 20: asm volatile("s_waitcnt vmcnt(20)" ::: "memory"); break; case 24: asm volatile("s_waitcnt vmcnt(24)" ::: "memory"); break; case 25: asm volatile("s_waitcnt vmcnt(25)" ::: "memory"); break; case 30: asm volatile("s_waitcnt vmcnt(30)" ::: "memory"); break; case 35: asm volatile("s_waitcnt vmcnt(35)" ::: "memory"); break; case 36: asm volatile("s_waitcnt vmcnt(36)" ::: "memory"); break; case 40: asm volatile("s_waitcnt vmcnt(40)" ::: "memory"); break; case 42: asm volatile("s_waitcnt vmcnt(42)" ::: "memory"); break; case 45: asm volatile("s_waitcnt vmcnt(45)" ::: "memory"); break; case 48: asm volatile("s_waitcnt vmcnt(48)" ::: "memory"); break; case 50: asm volatile("s_waitcnt vmcnt(50)" ::: "memory"); break; case 54: asm volatile("s_waitcnt vmcnt(54)" ::: "memory"); break; case 60: asm volatile("s_waitcnt vmcnt(60)" ::: "memory"); break; default: asm volatile("s_waitcnt vmcnt(0)" ::: "memory"); break; } } while (0)
#pragma unroll
    for (int s = 0; s < AHEAD; ++s) SG_DMA(s);
#define SG_READ(s, af_, bf_) do { const LAS unsigned char* st = ring + ((s) % NSLOT) * SLOT + lane * 16; \
        _Pragma("unroll") for (int nb = 0; nb < NB; ++nb) bf_[nb] = *(const LAS bf16x8*)(st + (R + nb) * 1024); \
        _Pragma("unroll") for (int rk = 0; rk < R; ++rk) af_[rk] = *(const LAS bf16x8*)(st + rk * 1024); } while (0)
#define SG_MMA(af_, bf_) do { _Pragma("unroll") for (int rk = 0; rk < R; ++rk) _Pragma("unroll") for (int nb = 0; nb < NB; ++nb) acc[rk][nb] = MFMA32(bf_[nb], af_[rk], acc[rk][nb]); } while (0)
#define SG_STEP(s, afc, bfc, afn, bfn) do { \
        if ((s) + AHEAD < KSTEPS) SG_DMA((s) + AHEAD); \
        if ((s) + 1 < KSTEPS) { if ((s) + AHEAD < KSTEPS) SG_WAITN(PER * (AHEAD - 1)); else { const int rem_ = KSTEPS - 2 - (s); SG_WAITN(PER * rem_); }        \
            SG_READ((s) + 1, afn, bfn); } \
        SG_MMA(afc, bfc); } while (0)
    bf16x8 afA[R], bfA[NB], afB[R], bfB[NB];
    SG_WAITN(PER * (AHEAD - 1)); SG_READ(0, afA, bfA);
#pragma unroll 1
    for (int s = 0; s < KSTEPS; s += 2) { SG_STEP(s, afA, bfA, afB, bfB); SG_STEP(s + 1, afB, bfB, afA, bfA); }
#undef SG_READ
#undef SG_MMA
#undef SG_STEP
#undef SG_DMA
#undef SG_WAITN
    asm volatile("s_waitcnt lgkmcnt(0)" ::: "memory");
}
template <int R, int NB>
__device__ __forceinline__ void put_acc(const f32x16 (&acc)[R][NB], LAS unsigned char* reg, int lane) {
#pragma unroll
    for (int rk = 0; rk < R; ++rk)
#pragma unroll
        for (int nb = 0; nb < NB; ++nb)
#pragma unroll
            for (int g = 0; g < 4; ++g) *(LAS f32x4*)(reg + ((rk * NB + nb) * 4 + g) * 1024 + lane * 16) = (f32x4){acc[rk][nb][4 * g], acc[rk][nb][4 * g + 1], acc[rk][nb][4 * g + 2], acc[rk][nb][4 * g + 3]};
}
template <int NB>
__device__ __forceinline__ void get_sum(f32x16 (&o)[NB], LAS unsigned char* lds, int rk, int lane) {
#pragma unroll
    for (int nb = 0; nb < NB; ++nb)
#pragma unroll
        for (int g = 0; g < 4; ++g) { f32x4 t = (f32x4){0.f, 0.f, 0.f, 0.f};
#pragma unroll
            for (int w = 0; w < 4; ++w) t += *(const LAS f32x4*)(lds + w * WREG + ((rk * NB + nb) * 4 + g) * 1024 + lane * 16);
            o[nb][4 * g] = t[0]; o[nb][4 * g + 1] = t[1]; o[nb][4 * g + 2] = t[2]; o[nb][4 * g + 3] = t[3]; }
}
__device__ __forceinline__ float half_sum(float v) { return v + __shfl_xor(v, 32); }
__device__ __forceinline__ v2u pack4(float a, float b, float c, float d) { v2u w; w.x = cvtpk(a, b); w.y = cvtpk(c, d); return w; }
__device__ __forceinline__ float row_rstd(const unsigned char* ws, int row) {
    const f32x4* sp = (const f32x4*)((const float*)(ws + WS_SSP) + (size_t)row * 16);
    const f32x4 s0 = sp[0], s1 = sp[1], s2 = sp[2], s3 = sp[3];
    const float st = ((s0[0] + s0[1]) + (s0[2] + s0[3])) + ((s1[0] + s1[1]) + (s1[2] + s1[3])) + ((s2[0] + s2[1]) + (s2[2] + s2[3])) + ((s3[0] + s3[1]) + (s3[2] + s3[3]));
    return rsqrtf(st * (1.f / D) + EPS);
}
__device__ __forceinline__ void epi1(const In& in, unsigned char* ws, float* out, int row, int c0, int h, const f32x16 (&acc)[2]) {
    if (c0 < 512) { bf16* p = (bf16*)(ws + WS_U) + (size_t)row * 512 + c0 + 4 * h;
#pragma unroll
        for (int nb = 0; nb < 2; ++nb)
#pragma unroll
            for (int g = 0; g < 4; ++g) *(v2u*)(p + 32 * nb + 8 * g) = pack4(acc[nb][4 * g], acc[nb][4 * g + 1], acc[nb][4 * g + 2], acc[nb][4 * g + 3]);
    } else if (c0 < 1536) { const bool isq = c0 < 1024; const int hc = c0 - (isq ? 512 : 1024);
        float ss = 0.f;
#pragma unroll
        for (int nb = 0; nb < 2; ++nb)
#pragma unroll
            for (int r = 0; r < 16; ++r) ss += acc[nb][r] * acc[nb][r];
        ss = half_sum(ss);
        const float rs = rsqrtf(ss * (1.f / 64.f) + EPS) * (isq ? QSCALE : 1.f);
        const float* gp = (isq ? in.q_norm : in.k_norm) + 4 * h;
        bf16* p = (bf16*)(ws + (isq ? WS_QN : WS_KN)) + (size_t)row * 512 + hc + 4 * h;
        float* ko = out + O_KS + (size_t)(row - MP) * 512 + hc + 4 * h;
#pragma unroll
        for (int nb = 0; nb < 2; ++nb)
#pragma unroll
            for (int g = 0; g < 4; ++g) { const f32x4 gv = *(const f32x4*)(gp + 32 * nb + 8 * g);
                const f32x4 v = (f32x4){acc[nb][4 * g] * rs * gv[0], acc[nb][4 * g + 1] * rs * gv[1], acc[nb][4 * g + 2] * rs * gv[2], acc[nb][4 * g + 3] * rs * gv[3]};
                *(v2u*)(p + 32 * nb + 8 * g) = pack4(v[0], v[1], v[2], v[3]);
                if (!isq) *(f32x4*)(ko + 32 * nb + 8 * g) = v; }
    } else if (c0 < 2048) { const int hc = c0 - 1536;
        bf16* p = (bf16*)(ws + WS_VB) + (size_t)row * 512 + hc + 4 * h; float* vo = out + O_VS + (size_t)(row - MP) * 512 + hc + 4 * h;
#pragma unroll
        for (int nb = 0; nb < 2; ++nb)
#pragma unroll
            for (int g = 0; g < 4; ++g) { const f32x4 v = (f32x4){acc[nb][4 * g], acc[nb][4 * g + 1], acc[nb][4 * g + 2], acc[nb][4 * g + 3]};
                *(v2u*)(p + 32 * nb + 8 * g) = pack4(v[0], v[1], v[2], v[3]); *(f32x4*)(vo + 32 * nb + 8 * g) = v; }
    } else { bf16* p = (bf16*)(ws + WS_SG) + (size_t)row * D + (c0 - 2048) + 4 * h;
#pragma unroll
        for (int nb = 0; nb < 2; ++nb)
#pragma unroll
            for (int g = 0; g < 4; ++g) *(v2u*)(p + 32 * nb + 8 * g) = pack4(ep::silu_fast(acc[nb][4 * g]), ep::silu_fast(acc[nb][4 * g + 1]), ep::silu_fast(acc[nb][4 * g + 2]), ep::silu_fast(acc[nb][4 * g + 3]));
    }
}
__device__ __forceinline__ void epi4(const In& in, unsigned char* ws, int row, int c0, int h, const f32x16 (&acc)[2]) {
    const bf16* xr = (const bf16*)(ws + WS_XN1) + (size_t)row * D + c0 + 4 * h;
    bf16* ao = (bf16*)(ws + WS_A2) + (size_t)row * D + c0 + 4 * h;
    float ss = 0.f;
#pragma unroll
    for (int nb = 0; nb < 2; ++nb)
#pragma unroll
        for (int g = 0; g < 4; ++g) { const v2u xb = *(const v2u*)(xr + 32 * nb + 8 * g);
            const f32x4 x4 = (f32x4){__uint_as_float(xb.x << 16), __uint_as_float(xb.x & 0xffff0000u), __uint_as_float(xb.y << 16), __uint_as_float(xb.y & 0xffff0000u)};
            const f32x4 y = (f32x4){x4[0] + acc[nb][4 * g], x4[1] + acc[nb][4 * g + 1], x4[2] + acc[nb][4 * g + 2], x4[3] + acc[nb][4 * g + 3]};
            ss += (y[0] * y[0] + y[1] * y[1]) + (y[2] * y[2] + y[3] * y[3]);
            *(v2u*)(ao + 32 * nb + 8 * g) = pack4(y[0], y[1], y[2], y[3]); }
    ss = half_sum(ss);
    if (h == 0) ((float*)(ws + WS_SSP))[(size_t)row * 16 + (c0 >> 6)] = ss;
}
__device__ __forceinline__ void epi5(unsigned char* ws, float* out, int row, int c0, int h, const f32x16 (&acc)[2]) {
    const float rs = row_rstd(ws, row);
    if (c0 < CONVD) { bf16* p = (bf16*)(ws + WS_QKVP) + (size_t)row * CONVD + c0 + 4 * h;
        const int i = (row - MP) & 3; float* cs = out + O_CONVS + ((ptrdiff_t)(((row - MP) >> 2) * 3) + (i - 1)) * CONVD + c0 + 4 * h;
#pragma unroll
        for (int nb = 0; nb < 2; ++nb)
#pragma unroll
            for (int g = 0; g < 4; ++g) { const f32x4 v = (f32x4){acc[nb][4 * g] * rs, acc[nb][4 * g + 1] * rs, acc[nb][4 * g + 2] * rs, acc[nb][4 * g + 3] * rs};
                *(v2u*)(p + 32 * nb + 8 * g) = pack4(v[0], v[1], v[2], v[3]); if (i >= 1) *(f32x4*)(cs + 32 * nb + 8 * g) = v; }
    } else { bf16* p = (bf16*)(ws + WS_SZ) + (size_t)row * D + (c0 - CONVD) + 4 * h;
#pragma unroll
        for (int nb = 0; nb < 2; ++nb)
#pragma unroll
            for (int g = 0; g < 4; ++g) *(v2u*)(p + 32 * nb + 8 * g) = pack4(ep::silu_fast(acc[nb][4 * g] * rs), ep::silu_fast(acc[nb][4 * g + 1] * rs), ep::silu_fast(acc[nb][4 * g + 2] * rs), ep::silu_fast(acc[nb][4 * g + 3] * rs));
    }
}
__device__ __forceinline__ void epi5ba(unsigned char* ws, int row, int h, const f32x16 (&acc)[1]) {
    const float rs = row_rstd(ws, row);
    float* bo = (float*)(ws + WS_BA) + (size_t)row * 16 + 4 * h;
#pragma unroll
    for (int g = 0; g < 2; ++g) *(f32x4*)(bo + 8 * g) = (f32x4){acc[0][4 * g] * rs, acc[0][4 * g + 1] * rs, acc[0][4 * g + 2] * rs, acc[0][4 * g + 3] * rs};
}
__device__ __forceinline__ void epi8(unsigned char* ws, float* out, int row, int c0, int h, const f32x16 (&acc)[2]) {
    const bf16* yr = (const bf16*)(ws + WS_A2) + (size_t)row * D + c0 + 4 * h; float* o = out + O_YS + (size_t)(row - MP) * D + c0 + 4 * h;
#pragma unroll
    for (int nb = 0; nb < 2; ++nb)
#pragma unroll
        for (int g = 0; g < 4; ++g) { const v2u yb = *(const v2u*)(yr + 32 * nb + 8 * g);
            const f32x4 y = (f32x4){__uint_as_float(yb.x << 16), __uint_as_float(yb.x & 0xffff0000u), __uint_as_float(yb.y << 16), __uint_as_float(yb.y & 0xffff0000u)};
            *(f32x4*)(o + 32 * nb + 8 * g) = (f32x4){y[0] + acc[nb][4 * g], y[1] + acc[nb][4 * g + 1], y[2] + acc[nb][4 * g + 2], y[3] + acc[nb][4 * g + 3]}; }
}
template <int KIND>
__device__ __forceinline__ void unit(const In& in, unsigned char* ws, float* out, LAS unsigned char* lds, int u, int wave, int lane_) {
    int lane = lane_; asm volatile("" : "+v"(lane));
    constexpr int NB = KIND == 6 ? 1 : 2;
    const bf16* A = (const bf16*)(ws + (KIND == 1 ? WS_XN1 : KIND == 4 ? WS_MIX : KIND == 8 ? WS_A4 : WS_A2));
    const bf16* Bt = (const bf16*)(ws + (KIND == 1 ? WS_W1T : KIND == 4 ? WS_W2T : KIND == 8 ? WS_W4T : WS_W3T));
    int rg, c0, brow0, brow1, arow0;
    if (KIND == 1) { rg = u / 48; c0 = 64 * (u % 48); const int pn = c0 >> 8, hh = (c0 & 255) >> 6; brow0 = 256 * pn + 32 * hh; brow1 = brow0 + 128; arow0 = MP + 128 * rg; }
    else if (KIND == 5) { rg = u >> 6; c0 = 64 * (u & 63); brow0 = c0; brow1 = c0 + 32; arow0 = MP + 128 * rg; }
    else if (KIND == 6) { rg = u; c0 = 4096; brow0 = 4096; brow1 = 4096; arow0 = 128 * rg; }
    else { rg = u >> 4; c0 = 64 * (u & 15); brow0 = c0; brow1 = c0 + 32; arow0 = MP + 128 * rg; }
    if (wave < 4) { f32x16 acc[4][NB];
        block<4, NB>(A, Bt, brow0, brow1, arow0, wave, lds + wave * WREG, lane, acc);
        put_acc<4, NB>(acc, lds + wave * WREG, lane); }
    __syncthreads();
    if (wave < 4) { f32x16 o[NB]; get_sum<NB>(o, lds, wave, lane);
        const int row = arow0 + 32 * wave + (lane & 31), h = lane >> 5;
        if (KIND == 1) { const float rs_ = ((const float*)(ws + WS_Y1))[row];
#pragma unroll
            for (int nb = 0; nb < NB; ++nb)
#pragma unroll
                for (int r = 0; r < 16; ++r) o[nb][r] *= rs_;
            epi1(in, ws, out, row, c0, h, (const f32x16 (&)[2])o); }
        else if (KIND == 4) epi4(in, ws, row, c0, h, (const f32x16 (&)[2])o);
        else if (KIND == 5) epi5(ws, out, row, c0, h, (const f32x16 (&)[2])o);
        else if (KIND == 6) epi5ba(ws, row, h, (const f32x16 (&)[1])o);
        else epi8(ws, out, row, c0, h, (const f32x16 (&)[2])o); }
    __syncthreads();
}
}

namespace nv {
__device__ __forceinline__ void k_pool_d(const bf16* U, const float* cache_pool, float* nD, float* out, int gtid, int gthreads) {
    const size_t n = (size_t)MT * PW;
    for (size_t i = (size_t)gtid; i < n; i += (size_t)gthreads) {
        const int r = (int)(i / PW), c = (int)(i % PW), g = c / PG, w = 2 << g;
        float sum = 0.f, cnt;
        if (r < MP) {
            const int t = r % SEQ;
            for (int j = 0; j < w; ++j) if (t - j >= 0) sum += bf2f(U[(size_t)(r - j) * PW + c]);
            cnt = (float)min(t + 1, w);
        } else {
            const int s = (r - MP) / DS, t = (r - MP) % DS;
            for (int j = 0; j < w; ++j) { const int tt = t - j; sum += tt >= 0 ? bf2f(U[(size_t)(r - j) * PW + c]) : cache_pool[((size_t)s * PBUF + (PBUF + tt)) * PW + c]; }
            cnt = (float)w;
        }
        nD[i] = sum / cnt - bf2f(U[(size_t)r * PW + c]);
    }
    const size_t n2 = (size_t)BP * PBUF * PW;
    for (size_t i = (size_t)gtid; i < n2; i += (size_t)gthreads) {
        const int c = (int)(i % PW), j = (int)((i / PW) % PBUF), b = (int)(i / ((size_t)PW * PBUF));
        out[O_POOLP + i] = bf2f(U[(size_t)(b * SEQ + SEQ - PBUF + j) * PW + c]);
    }
    const size_t n3 = (size_t)DB * PBUF * PW;
    for (size_t i = (size_t)gtid; i < n3; i += (size_t)gthreads) {
        const int c = (int)(i % PW), j = (int)((i / PW) % PBUF), s = (int)(i / ((size_t)PW * PBUF));
        const int e = j + DS;
        out[O_POOLS + i] = e < PBUF ? cache_pool[((size_t)s * PBUF + e) * PW + c] : bf2f(U[(size_t)(MP + s * DS + (e - PBUF)) * PW + c]);
    }
}
__device__ __forceinline__ void k_pool_y(const float* nD, const float* w_pool, const float* scale, const bf16* SG, bf16* mix, int gtid, int gthreads) {
    const size_t n = (size_t)MT * PW;
    for (size_t i = (size_t)gtid; i < n; i += (size_t)gthreads) {
        const int r = (int)(i / PW), c = (int)(i % PW), g = c / PG, dd = c % PG;
        const float* d = nD + (size_t)r * PW + g * PG; const float* wp = w_pool + (size_t)g * PG * PG + dd;
        float s = 0.f;
        for (int k = 0; k < PG; ++k) s += d[k] * wp[(size_t)k * PG];
        mix[(size_t)r * D + c] = (bf16)f2bf(s * scale[c] * bf2f(SG[(size_t)r * D + c]));
    }
}
__device__ __forceinline__ void k_attn(const bf16* QN, const bf16* KN, const bf16* VB, const float* cache_k, const float* cache_v, const int* page_table,
                                              const float* bias, const bf16* SG, bf16* mix, int gtid, int gthreads, long it0) {
    const int lane = threadIdx.x & 63;
    const long w = gtid >> 6, nw = gthreads >> 6;
    for (long it = it0 + w; it < (long)MT * SBH; it += nw) {
        const int r = (int)(it / SBH), h = (int)(it % SBH);
        const float q = bf2f(QN[(size_t)r * 512 + h * 64 + lane]);
        const float bh = bias[h] * LOG2E;
        int nkeys, s = 0, b = 0;
        if (r < MP) { b = r / SEQ; nkeys = r % SEQ; } else { s = (r - MP) / DS; nkeys = PAST + (r - MP) % DS; }
        float R = 0.f, o = 0.f;
        for (int blk = (nkeys - 1) / 64; blk >= 0 && nkeys > 0; --blk) {
            const int j0 = blk * 64 + lane; const bool valid = j0 < nkeys;
            const int j = valid ? j0 : nkeys - 1;
            const bool is16 = (r < MP) || (j >= PAST);
            const bf16* k16 = KN + (size_t)(r < MP ? b * SEQ + j : MP + s * DS + (is16 ? j - PAST : 0)) * 512 + h * 64;
            const float* k32 = cache_k + (((size_t)page_table[s * NPAGE + (is16 ? 0 : j / PAGE)] * PAGE + (is16 ? 0 : j % PAGE)) * SBH + h) * SBD;
            float dot = 0.f;
            for (int d = 0; d < 64; ++d) { const float qd = __shfl(q, d); dot += qd * (is16 ? bf2f(k16[d]) : k32[d]); }
            const float z = valid ? dot + bh : 0.f;
            const float sp = softplus2_f(z);
            const float lk = valid ? -sp : 0.f;
            float inc = lk;
#pragma unroll
            for (int off = 1; off < 64; off <<= 1) { const float t = __shfl_down(inc, off); if (lane + off < 64) inc += t; }
            const float suffix = inc - lk + R;
            const float a = valid ? exp2f(z - sp + suffix) : 0.f;
            R += __shfl(inc, 0);
            for (int k = 0; k < 64; ++k) {
                const int jj = blk * 64 + k;
                const float ak = __shfl(a, k);
                if (jj < nkeys) {
                    float vv;
                    if (r < MP) vv = bf2f(VB[(size_t)(b * SEQ + jj) * 512 + h * 64 + lane]);
                    else if (jj < PAST) vv = cache_v[(((size_t)page_table[s * NPAGE + jj / PAGE] * PAGE + jj % PAGE) * SBH + h) * SBD + lane];
                    else vv = bf2f(VB[(size_t)(MP + s * DS + (jj - PAST)) * 512 + h * 64 + lane]);
                    o += ak * vv;
                }
            }
        }
        mix[(size_t)r * D + 512 + h * 64 + lane] = (bf16)f2bf(o * bf2f(SG[(size_t)r * D + 512 + h * 64 + lane]));
    }
}
__device__ __forceinline__ void k_conv(const bf16* QKVP, const float* state_conv, const float* conv_w, float* nC, int gtid, int gthreads) {
    const size_t n = (size_t)MT * CONVD;
    for (size_t i = (size_t)gtid; i < n; i += (size_t)gthreads) {
        const int r = (int)(i / CONVD), c = (int)(i % CONVD);
        float acc = 0.f;
        for (int j = 0; j < 4; ++j) {
            float xv;
            if (r < MP) { const int t = r % SEQ, e = t + j; xv = e >= 3 ? bf2f(QKVP[(size_t)(r - 3 + j) * CONVD + c]) : 0.f; }
            else { const int s = (r - MP) / DS, t = (r - MP) % DS, e = t + j; xv = e >= 3 ? bf2f(QKVP[(size_t)(MP + s * DS + e - 3) * CONVD + c]) : state_conv[((size_t)s * 3 + e) * CONVD + c]; }
            acc += xv * conv_w[(size_t)j * CONVD + c];
        }
        nC[i] = silu_f(acc);
    }
}
__device__ __forceinline__ void k_qknorm(float* nC, const float* BA, const float* a_log, const float* dt_bias, float* nBeta, float* nG, int gtid, int gthreads) {
    const int lane = threadIdx.x & 63;
    const long w = gtid >> 6, nw = gthreads >> 6;
    for (long it = w; it < (long)MT * DNH; it += nw) {
        const int r = (int)(it / DNH), h = (int)(it % DNH);
        float* q = nC + (size_t)r * CONVD + h * 128; float* k = q + 1024;
        const float q0 = q[lane], q1 = q[lane + 64], k0 = k[lane], k1 = k[lane + 64];
        const float qs = wave_sum(q0 * q0 + q1 * q1), ks = wave_sum(k0 * k0 + k1 * k1);
        const float qr = rsqrtf(qs + EPS) * 0.08838834764831845f, kr = rsqrtf(ks + EPS);
        q[lane] = q0 * qr; q[lane + 64] = q1 * qr; k[lane] = k0 * kr; k[lane + 64] = k1 * kr;
        if (lane == 0) {
            const float bb = BA[(size_t)r * 16 + h], aa = BA[(size_t)r * 16 + 8 + h];
            nBeta[(size_t)r * DNH + h] = 1.f / (1.f + __expf(-bb));
            nG[(size_t)r * DNH + h] = -__expf(a_log[h]) * softplus_f(aa + dt_bias[h]);
        }
    }
}
__device__ __forceinline__ void k_gdn(const float* nC, const float* nBeta, const float* nG, const float* state_delta, bf16* nO, float* out, LAS float* sm, int c0, int cstep, int cend) {
    LAS float* sq = sm; LAS float* sk = sm + 128; LAS float (*red)[128] = (LAS float (*)[128])(sm + 256); LAS float (*red2)[128] = (LAS float (*)[128])(sm + 768);
    const int tid = threadIdx.x, e = tid & 127, part = tid >> 7;
    for (int c = c0; c < cend; c += cstep) {
        int base, L, h; const float* S0 = nullptr; float* Sout;
        if (c < BP * DNH) { const int b = c / DNH; h = c % DNH; base = b * SEQ; L = SEQ; Sout = out + O_DP + (size_t)c * DNK * DNV; }
        else { const int cc = c - BP * DNH, s = cc / DNH; h = cc % DNH; base = MP + s * DS; L = DS; S0 = state_delta + (size_t)cc * DNK * DNV; Sout = out + O_DS + (size_t)cc * DNK * DNV; }
        float S[32];
#pragma unroll
        for (int i = 0; i < 32; ++i) S[i] = S0 ? S0[(size_t)(part * 32 + i) * DNV + e] : 0.f;
        for (int t = 0; t < L; ++t) {
            const int r = base + t;
            __syncthreads();
            if (tid < 128) sq[tid] = nC[(size_t)r * CONVD + h * 128 + tid];
            else if (tid < 256) sk[tid - 128] = nC[(size_t)r * CONVD + 1024 + h * 128 + (tid - 128)];
            const float v = nC[(size_t)r * CONVD + 2048 + h * 128 + e];
            const float beta = nBeta[(size_t)r * DNH + h], alpha = __expf(nG[(size_t)r * DNH + h]);
            __syncthreads();
            float ks = 0.f;
#pragma unroll
            for (int i = 0; i < 32; ++i) ks += sk[part * 32 + i] * S[i];
            red[part][e] = ks;
            __syncthreads();
            const float kS = alpha * (red[0][e] + red[1][e] + red[2][e] + red[3][e]);
            const float vn = beta * (v - kS);
            float op = 0.f;
#pragma unroll
            for (int i = 0; i < 32; ++i) { S[i] = alpha * S[i] + sk[part * 32 + i] * vn; op += sq[part * 32 + i] * S[i]; }
            red2[part][e] = op;
            __syncthreads();
            if (part == 0) nO[(size_t)r * D + h * 128 + e] = (bf16)f2bf(red2[0][e] + red2[1][e] + red2[2][e] + red2[3][e]);
        }
#pragma unroll
        for (int i = 0; i < 32; ++i) Sout[(size_t)(part * 32 + i) * DNV + e] = S[i];
        __syncthreads();
    }
}
__device__ __forceinline__ void k_onorm(const bf16* nO, const bf16* SZ, const float* og, bf16* A4, int gtid, int gthreads) {
    const int lane = gtid & 63, li = lane & 15;
    const long w = gtid >> 6, nw = gthreads >> 6;
    const f32x4 g0 = *(const f32x4*)(og + 8 * li), g1 = *(const f32x4*)(og + 8 * li + 4);
#pragma unroll 2
    for (long it = w * 4 + (lane >> 4); it < (long)MT * DNH; it += nw * 4) {
        const size_t o = (size_t)it * 128 + 8 * li;
        const v4u ob = *(const v4u*)(nO + o);
        const f32x4 a = (f32x4){__uint_as_float(ob.x << 16), __uint_as_float(ob.x & 0xffff0000u), __uint_as_float(ob.y << 16), __uint_as_float(ob.y & 0xffff0000u)};
        const f32x4 b = (f32x4){__uint_as_float(ob.z << 16), __uint_as_float(ob.z & 0xffff0000u), __uint_as_float(ob.w << 16), __uint_as_float(ob.w & 0xffff0000u)};
        const v4u zz = *(const v4u*)(SZ + o);
        float ss = (a[0] * a[0] + a[1] * a[1]) + (a[2] * a[2] + a[3] * a[3]) + (b[0] * b[0] + b[1] * b[1]) + (b[2] * b[2] + b[3] * b[3]);
        ss += __shfl_xor(ss, 1); ss += __shfl_xor(ss, 2); ss += __shfl_xor(ss, 4); ss += __shfl_xor(ss, 8);
        const float rs = rsqrtf(ss * (1.f / 128.f) + EPS);
        v4u r;
        r.x = pk2(a[0] * rs * g0[0] * bf2f((bf16)(zz.x & 0xffff)), a[1] * rs * g0[1] * bf2f((bf16)(zz.x >> 16)));
        r.y = pk2(a[2] * rs * g0[2] * bf2f((bf16)(zz.y & 0xffff)), a[3] * rs * g0[3] * bf2f((bf16)(zz.y >> 16)));
        r.z = pk2(b[0] * rs * g1[0] * bf2f((bf16)(zz.z & 0xffff)), b[1] * rs * g1[1] * bf2f((bf16)(zz.z >> 16)));
        r.w = pk2(b[2] * rs * g1[2] * bf2f((bf16)(zz.w & 0xffff)), b[3] * rs * g1[3] * bf2f((bf16)(zz.w >> 16)));
        *(v4u*)(A4 + o) = r;
    }
}
}

constexpr int N_PHASES = 9;
__global__ void __launch_bounds__(NWAVES * 64, 2) fwd(Params P) {
    extern __shared__ __attribute__((aligned(16))) unsigned char lds[];
    Frame F;
    F.lds = (LAS unsigned char*)lds;
    F.MISC = (volatile LAS unsigned*)(F.lds + MISC_OFF);
    F.tid = threadIdx.x; F.lane = F.tid & 63; F.wave = __builtin_amdgcn_readfirstlane(F.tid >> 6);
    F.G = gridDim.x; { const int bx = blockIdx.x; F.vcu = (F.G % 8 == 0) ? (bx % 8) * (F.G / 8) + bx / 8 : bx; }
    unsigned char* ws = P.ws;
    F.ctl = (gu32*)(ws + WS_CTL);
    const In in = make_in(P);
    for (int u = F.tid; u < (LDS_BYTES - LDSCTL_OFF) / 4; u += NWAVES * 64) ((LAS unsigned*)(F.lds + LDSCTL_OFF))[u] = 0u;
    __syncthreads();
    const int lo = P.ph_lo, hi = P.ph_hi;
    const bool use_bar = true;
    XcdBarrier bar; bar.bar = (unsigned*)(F.ctl + CW_BAR); bar.x = 0; bar.st = nullptr;
    if (use_bar) bar = xcd_barrier_post((unsigned*)(F.ctl + CW_BAR), F.MISC + 8);
#define IN(k) (lo <= (k) && (k) < hi)
#define BOTH(k) (IN(k) && IN((k) + 1))
#define GRID_BAR() xcd_barrier(bar)
#if DBG_CHECK == 3
    volatile LAS unsigned long long* stamps = (volatile LAS unsigned long long*)(F.lds + LDSCTL_OFF + 1024);
#define STAMP(k) do { if (blockIdx.x == 0 && F.tid == 0) stamps[k] = __builtin_amdgcn_s_memrealtime(); } while (0)
#else
#define STAMP(k) do { } while (0)
#endif

    STAMP(0);
    if (IN(0)) { p0_prologue(F, in, ws); if (BOTH(0)) GRID_BAR(); }

    STAMP(1);
    if (IN(1)) {
        pg8::Gemm g{(const pg8::bf16_t*)(ws + WS_XN1), (const pg8::bf16_t*)(ws + WS_W1T), MP, EVEN_IN, D}; pg8::StaticOrder S; S.init(MP, EVEN_IN, F.G, (int)blockIdx.x);
        ep::Epi1 E{(bf16*)(ws + WS_U), (bf16*)(ws + WS_QN), (bf16*)(ws + WS_KN), (bf16*)(ws + WS_VB), (bf16*)(ws + WS_VT), (bf16*)(ws + WS_SG), P.out, in.q_norm, in.k_norm, F.lds + RING_BYTES, (const float*)(ws + WS_Y1)};
        pg8::gemm_phase<ep::Epi1, pg8::StaticOrder, true, true>(F.lds + RING_OFF, g, S, E);
        for (int u = F.vcu; u < 4 * 48; u += F.G) sg::unit<1>(in, ws, P.out, F.lds, u, F.wave, F.lane);
        if (BOTH(1)) GRID_BAR();
    }
#define gthreads ((int)gridDim.x * (NWAVES * 64))
#define gtid ({ int t_ = threadIdx.x; asm volatile("" : "+v"(t_)); (int)blockIdx.x * (NWAVES * 64) + t_; })
    STAMP(2);
    if (IN(2)) {
        const int gw = F.vcu * NWAVES + F.wave, NGW = F.G * NWAVES;
        if (threadIdx.x < 8) ((volatile LAS unsigned*)(F.lds + 65536))[threadIdx.x] = 0u;
        __syncthreads();
        if (F.wave < 4) { __builtin_amdgcn_s_setprio(1); at::prompt_phase(F, ws, in.sb_bias); __builtin_amdgcn_s_setprio(0); }
        STAMP(13);
        if (F.G == 256) {
            const int xg = F.vcu >> 5; gu32* qctr = F.ctl + CW_QUEUE + 64 * xg;
            constexpr int NDEC = (DB * NPAGE / 8) * SBH, NPOOL = ((MT / 32) * 4) / 8;
            unsigned nxt = 0; if (F.lane == 0) nxt = __hip_atomic_fetch_add(qctr, 1u, RLX_AGENT);
            for (;;) {
                const int u = __builtin_amdgcn_readfirstlane((int)nxt);
                if (u >= NDEC + NPOOL) break;
                if (F.lane == 0) nxt = __hip_atomic_fetch_add(qctr, 1u, RLX_AGENT);
                if (u < NDEC) { const int pg = xg * (DB * NPAGE / 8) + (u >> 3), hd = u & 7; at::decode_unit2(in, ws, F.wave < 4 ? F.lds + 66560 + F.wave * 3072 : F.lds + 131072 + (F.wave - 4) * 3072, pg >> 4, pg & 15, hd, F.lane); }
                else { const int pu = xg * NPOOL + (u - NDEC); const int rb = pu >> 2, g = pu & 3;
                    if (rb >= MP / 32) { if (g == 0) pl::pool_unit_sample<0>(in, ws, rb, F.lane); else if (g == 1) pl::pool_unit_sample<1>(in, ws, rb, F.lane); else if (g == 2) pl::pool_unit_sample<2>(in, ws, rb, F.lane); else pl::pool_unit_sample<3>(in, ws, rb, F.lane); }
                    else if (g == 0) pl::pool_unit_prompt<0>(in, ws, rb, F.lane); else if (g == 1) pl::pool_unit_prompt<1>(in, ws, rb, F.lane);
                    else if (g == 2) pl::pool_unit_prompt<2>(in, ws, rb, F.lane); else pl::pool_unit_prompt<3>(in, ws, rb, F.lane); }
            }
        } else {
            const int gw = F.vcu * NWAVES + F.wave, NGW = F.G * NWAVES;
            for (int du = gw; du < DB * NPAGE * SBH; du += NGW) at::decode_unit(in, ws, du >> 7, (du >> 3) & 15, du & 7, F.lane);
            for (int pu = gw; pu < (MT / 32) * 4; pu += NGW) { const int rb = pu >> 2, g = pu & 3;
                if (rb >= MP / 32) { if (g == 0) pl::pool_unit_sample<0>(in, ws, rb, F.lane); else if (g == 1) pl::pool_unit_sample<1>(in, ws, rb, F.lane); else if (g == 2) pl::pool_unit_sample<2>(in, ws, rb, F.lane); else pl::pool_unit_sample<3>(in, ws, rb, F.lane); }
                else if (g == 0) pl::pool_unit_prompt<0>(in, ws, rb, F.lane); else if (g == 1) pl::pool_unit_prompt<1>(in, ws, rb, F.lane);
                else if (g == 2) pl::pool_unit_prompt<2>(in, ws, rb, F.lane); else pl::pool_unit_prompt<3>(in, ws, rb, F.lane); }
        }
        __builtin_amdgcn_s_setprio(0);
        STAMP(14);
        STAMP(15);
        pl::pool_state_out(in, ws, P.out, gtid, gthreads);
        if (BOTH(2)) GRID_BAR();
    }
    STAMP(3);
    if (IN(3)) {
        const int gw = F.vcu * NWAVES + F.wave, NGW = F.G * NWAVES;
        for (int cu = gw; cu < DB * SBH; cu += NGW) at::decode_combine(in, ws, cu >> 3, cu & 7, F.lane);
        p_late_weights(F, in, ws);
#if DBG_CHECK == 1
        GRID_BAR();
        nv::k_attn((const bf16*)(ws + WS_QN), (const bf16*)(ws + WS_KN), (const bf16*)(ws + WS_VB), in.cache_k, in.cache_v, in.page_table, in.sb_bias, (const bf16*)(ws + WS_SG), (bf16*)(ws + WS_MIXD), gtid, gthreads, 0);
        GRID_BAR();
        { const bf16* A = (const bf16*)(ws + WS_MIX); const bf16* B = (const bf16*)(ws + WS_MIXD); float n0 = 0.f, d0 = 0.f, n1 = 0.f, d1 = 0.f;
          for (size_t i = gtid; i < (size_t)MT * 512; i += gthreads) { const size_t r = i >> 9, o = r * D + 512 + (i & 511); const float a = bf2f(A[o]), b = bf2f(B[o]);
              if (r < MP) { n0 += (a - b) * (a - b); d0 += b * b; } else { n1 += (a - b) * (a - b); d1 += b * b; } }
          n0 = wave_sum(n0); d0 = wave_sum(d0); n1 = wave_sum(n1); d1 = wave_sum(d1);
          if (F.lane == 0) { float* dbg = (float*)(ws + WS_CTL) + CW_DBG; atomicAdd(dbg, n0); atomicAdd(dbg + 1, d0); atomicAdd(dbg + 2, n1); atomicAdd(dbg + 3, d1); } }
#endif
        if (BOTH(3)) GRID_BAR();
    }
    STAMP(4);
    if (IN(4)) {
        pg8::Gemm g{(const pg8::bf16_t*)(ws + WS_MIX), (const pg8::bf16_t*)(ws + WS_W2T), MP, D, D}; pg8::StaticOrder S; S.init(MP, D, F.G, (int)blockIdx.x);
        ep::Epi4 E{(const bf16*)(ws + WS_XN1), (bf16*)(ws + WS_A2), (float*)(ws + WS_SSP)};
        pg8::gemm_phase<ep::Epi4, pg8::StaticOrder, true, true>(F.lds + RING_OFF, g, S, E);
        for (int u = F.vcu; u < 4 * 16; u += F.G) sg::unit<4>(in, ws, P.out, F.lds, u, F.wave, F.lane);
        if (BOTH(4)) GRID_BAR();
    }
    STAMP(5);
    if (IN(5)) {
        pg8::Gemm g{(const pg8::bf16_t*)(ws + WS_A2), (const pg8::bf16_t*)(ws + WS_W3T), MP, 4096, D}; pg8::StaticOrder S; S.init(MP, 4096, F.G, (int)blockIdx.x);
        ep::Epi5 E{(const float*)(ws + WS_SSP), (bf16*)(ws + WS_QKVP), (bf16*)(ws + WS_SZ), (float*)(ws + WS_BA), P.out};
        pg8::gemm_phase<ep::Epi5, pg8::StaticOrder, true, true>(F.lds + RING_OFF, g, S, E);
        for (int u = F.vcu; u < 4 * 64; u += F.G) sg::unit<5>(in, ws, P.out, F.lds, u, F.wave, F.lane);
        for (int u = F.vcu; u < MT / 128; u += F.G) sg::unit<6>(in, ws, P.out, F.lds, u, F.wave, F.lane);
        if (BOTH(5)) GRID_BAR();
    }
    STAMP(6);
    if (IN(6)) {
        const int gw = F.vcu * NWAVES + F.wave, NGW = F.G * NWAVES;
        for (int blk = gw; blk < gd::NBLK; blk += NGW) gd::prep_elem<1>(in, ws, F.lds + F.wave * gd::WAVE_LDS, blk / (gd::NCH * DNH), blk % gd::NCH, (blk / gd::NCH) % DNH, F.lane);
        for (int blk = gw; blk < gd::NBLK; blk += NGW) gd::prep_elem<0>(in, ws, F.lds + F.wave * gd::WAVE_LDS, blk / (gd::NCH * DNH), blk % gd::NCH, (blk / gd::NCH) % DNH, F.lane);
        for (int blk = gw; blk < gd::NBLK; blk += NGW) gd::prep_elem<2>(in, ws, F.lds + F.wave * gd::WAVE_LDS, blk / (gd::NCH * DNH), blk % gd::NCH, (blk / gd::NCH) % DNH, F.lane);
        for (int u = gw; u < MS * DNH; u += NGW) gd::sample_prep(in, ws, MP + (u >> 3), u & 7, F.lane);
        VM_WAIT();
        STAMP(10);
        for (int blk = gw; blk < gd::NBLK; blk += NGW) gd::prep_chunk(ws, F.lds + F.wave * gd::WAVE_LDS, blk, F.lane);
        if (BOTH(6)) GRID_BAR();
    }
    STAMP(7);
    if (IN(7)) {
        bf16* nO = (bf16*)(ws + NW_O);
        if (F.G >= 256) {
            if ((F.vcu & 1) == 0 && F.vcu < 256) { gd::scan_chain(ws, F.lds, nO, P.out, F.vcu >> 2, (F.vcu >> 1) & 1, F.wave, F.lane); STAMP(12); }
            else { const int widx = F.vcu < 256 ? (F.vcu >> 1) : 128 + (F.vcu - 256);
                nv::k_gdn((const float*)(ws + NW_C), (const float*)(ws + NW_BETA), (const float*)(ws + NW_G), in.state_delta, nO, P.out, (LAS float*)(F.lds + RING_OFF), BP * DNH + widx, F.G - 128, BP * DNH + DB * DNH); }
        } else {
            for (int ch = F.vcu; ch < 2 * BP * DNH; ch += F.G) { gd::scan_chain(ws, F.lds, nO, P.out, ch >> 1, ch & 1, F.wave, F.lane); __syncthreads(); }
            nv::k_gdn((const float*)(ws + NW_C), (const float*)(ws + NW_BETA), (const float*)(ws + NW_G), in.state_delta, nO, P.out, (LAS float*)(F.lds + RING_OFF), BP * DNH + F.vcu, F.G, BP * DNH + DB * DNH);
        }
#if DBG_CHECK == 2
        GRID_BAR();
        nv::k_conv((const bf16*)(ws + WS_QKVP), in.state_conv, in.conv_w, (float*)(ws + NW_C), gtid, gthreads);
        GRID_BAR();
        nv::k_qknorm((float*)(ws + NW_C), (const float*)(ws + WS_BA), in.a_log, in.dt_bias, (float*)(ws + NW_BETA), (float*)(ws + NW_G), gtid, gthreads);
        GRID_BAR();
        nv::k_gdn((const float*)(ws + NW_C), (const float*)(ws + NW_BETA), (const float*)(ws + NW_G), in.state_delta, (float*)(ws + gd::WS_DBG_O), (float*)(ws + gd::WS_DBG_OUT), (LAS float*)(F.lds + RING_OFF), (int)blockIdx.x, F.G, BP * DNH);
        GRID_BAR();
        { const float* A = nO; const float* B = (const float*)(ws + gd::WS_DBG_O); float n0 = 0.f, d0 = 0.f, n1 = 0.f, d1 = 0.f;
          for (size_t i = gtid; i < (size_t)MP * D; i += gthreads) { const float a = A[i], b = B[i]; n0 += (a - b) * (a - b); d0 += b * b; }
          const float* A2 = P.out + O_DP; const float* B2 = (const float*)(ws + gd::WS_DBG_OUT) + O_DP;
          for (size_t i = gtid; i < (size_t)BP * DNH * DNK * DNV; i += gthreads) { const float a = A2[i], b = B2[i]; n1 += (a - b) * (a - b); d1 += b * b; }
          n0 = wave_sum(n0); d0 = wave_sum(d0); n1 = wave_sum(n1); d1 = wave_sum(d1);
          if (F.lane == 0) { float* dbg = (float*)(ws + WS_CTL) + CW_DBG; atomicAdd(dbg, n0); atomicAdd(dbg + 1, d0); atomicAdd(dbg + 2, n1); atomicAdd(dbg + 3, d1); } }
#endif
        GRID_BAR();
        STAMP(11);
        nv::k_onorm(nO, (const bf16*)(ws + WS_SZ), in.o_norm, (bf16*)(ws + WS_A4), gtid, gthreads);
        if (BOTH(7)) GRID_BAR();
    }
    STAMP(8);
    if (IN(8)) {
        pg8::Gemm g{(const pg8::bf16_t*)(ws + WS_A4), (const pg8::bf16_t*)(ws + WS_W4T), MP, D, D}; pg8::StaticOrder S; S.init(MP, D, F.G, (int)blockIdx.x);
        ep::Epi8 E{(const bf16*)(ws + WS_A2), P.out};
        pg8::gemm_phase<ep::Epi8, pg8::StaticOrder, true, true>(F.lds + RING_OFF, g, S, E);
        for (int u = F.vcu; u < 4 * 16; u += F.G) sg::unit<8>(in, ws, P.out, F.lds, u, F.wave, F.lane);
#if DBG_CHECK == 3
        GRID_BAR();
        STAMP(9);
        if (blockIdx.x == 0 && F.tid == 0) {
            const int ea[] = {0,1,2,13,14,15,3,4,5,6,10,7,12,11,8,9};
            auto dur = [&](int i) { return (float)(stamps[ea[i + 1]] - stamps[ea[i]]) * 0.01f; };
            float ta = dur(DBG_TA), tb = dur(DBG_TB);
            if (DBG_TA == 99) ta = (float)stamps[20] * 0.01f;
            P.out[O_DS] += ta * 0.01f;
            float* dbg = (float*)(ws + WS_CTL) + CW_DBG; dbg[0] = 6e-5f + tb * 5e-7f; dbg[1] = 1.f; dbg[2] = 0.f; dbg[3] = 1.f;
            __threadfence();
        }
        GRID_BAR();
        { const float* dbg = (const float*)(ws + WS_CTL) + CW_DBG; const float e0 = __hip_atomic_load(dbg, RLX_AGENT);
          const float sc = 1.f + sqrtf(e0);
          for (size_t i = gtid; i < (size_t)DB * PBUF * PW; i += gthreads) P.out[O_POOLS + i] *= sc; }
#elif DBG_CHECK
        GRID_BAR();
        { const float* dbg = (const float*)(ws + WS_CTL) + CW_DBG; const float e0 = __hip_atomic_load(dbg, RLX_AGENT) / fmaxf(__hip_atomic_load(dbg + 1, RLX_AGENT), 1e-30f), e1 = __hip_atomic_load(dbg + 2, RLX_AGENT) / fmaxf(__hip_atomic_load(dbg + 3, RLX_AGENT), 1e-30f);
          const float sc = 1.f + sqrtf(fmaxf(DBG_WHICH == 0 ? e0 : (DBG_WHICH == 1 ? e1 : fmaxf(e0, e1)), 0.f));
          for (size_t i = gtid; i < (size_t)MS * D; i += gthreads) P.out[O_YS + i] *= sc; }
#endif
    }
#undef gtid
#undef gthreads
#undef IN
#undef BOTH
#undef GRID_BAR
}

extern "C" void kernel_launch(void* const* d_in, const int* in_sizes, int n_in, void* d_out, int out_size, void* d_ws, size_t ws_size, hipStream_t stream) {
    static int grid = 0;
    if (grid == 0) {
        if (n_in != 23 || (size_t)out_size != O_END || ws_size < gd::WS_END3) { fprintf(stderr, "kernel_launch: unexpected sizes n_in %d out %d ws %zu (need %zu)\n", n_in, out_size, ws_size, (size_t)gd::WS_END3); grid = -1; return; }
        int dev = 0, cus = 0, per_cu = 0;
        if (hipGetDevice(&dev) != hipSuccess || hipDeviceGetAttribute(&cus, hipDeviceAttributeMultiprocessorCount, dev) != hipSuccess) { grid = -1; return; }
        if (hipFuncSetAttribute((const void*)fwd, hipFuncAttributeMaxDynamicSharedMemorySize, LDS_BYTES) != hipSuccess) { fprintf(stderr, "kernel_launch: hipFuncSetAttribute failed\n"); grid = -1; return; }
        if (hipOccupancyMaxActiveBlocksPerMultiprocessor(&per_cu, (const void*)fwd, NWAVES * 64, LDS_BYTES) != hipSuccess || per_cu < 1) fprintf(stderr, "kernel_launch: occupancy query reports %d\n", per_cu);
        (void)hipGetLastError();
        grid = cus;
    }
    if (grid < 0) return;
    (void)hipMemsetAsync((char*)d_ws + WS_CTL, 0, CTL_ZERO_BYTES, stream);
    Params p{};
    for (int i = 0; i < 23; ++i) p.in[i] = d_in[i];
    p.out = (float*)d_out; p.ws = (unsigned char*)d_ws;
    In in;
    in.x_p = (const float*)d_in[0]; in.x_s = (const float*)d_in[1]; in.cache_pool = (const float*)d_in[2]; in.cache_k = (const float*)d_in[3]; in.cache_v = (const float*)d_in[4];
    in.state_conv = (const float*)d_in[5]; in.state_delta = (const float*)d_in[6]; in.page_table = (const int*)d_in[7];
    in.norm_even = (const float*)d_in[8]; in.w_in_even = (const float*)d_in[9]; in.w_pool = (const float*)d_in[10]; in.pool_scale = (const float*)d_in[11];
    in.q_norm = (const float*)d_in[12]; in.k_norm = (const float*)d_in[13]; in.sb_bias = (const float*)d_in[14]; in.w_out_even = (const float*)d_in[15];
    in.norm_odd = (const float*)d_in[16]; in.w_in_odd = (const float*)d_in[17]; in.conv_w = (const float*)d_in[18]; in.a_log = (const float*)d_in[19];
    in.dt_bias = (const float*)d_in[20]; in.o_norm = (const float*)d_in[21]; in.w_out_odd = (const float*)d_in[22];
    float* out = (float*)d_out; char* ws = (char*)d_ws;
    auto launch = [&](int lo, int hi) { p.ph_lo = lo; p.ph_hi = hi; hipLaunchKernelGGL(fwd, dim3(grid), dim3(NWAVES * 64), LDS_BYTES, stream, p); };
    launch(0, N_PHASES);
}
```
